# Optimizing an MI355X kernel written in HIP

```python
import math
import jax
import jax.numpy as jnp
from jax import lax
import numpy as np


D_MODEL = 1024
BATCH = 8
SEQ = 4096
DEPTH = 4

N_MIXERS = 2
N_A_LAYERS = (DEPTH + 1) // 2
N_B_LAYERS = DEPTH // 2
N_VRES = max(N_B_LAYERS - 1, 0)

DEEPNORM_ALPHA = (2 * DEPTH) ** 0.25
DEEPNORM_BETA = (8 * DEPTH) ** -0.25
LN_EPS = 1e-5

A_HEAD_DIM = 64
A_HEADS = D_MODEL // A_HEAD_DIM
MOBA_BLOCK = 256
MOBA_TOPK = 3
MOBA_QCHUNK = 128
N_BUCKETS = 32
MAX_DISTANCE = 128

B_HEAD_DIM = 64
B_HEADS = D_MODEL // B_HEAD_DIM
DECAY_LORA = 64
AAA_LORA = 64
MV_LORA = 32
GATE_LORA = 160
GN_EPS = 64e-5

N_EXPERTS = 64
N_GROUPS = 8
TOPK_GROUPS = 4
TOP_K = 8
D_EXPERT = 256
ROUTED_SCALE = 2.5
MOE_BLOCK = 512

kernel_name = 'moba_rwkv7_moe_deepnorm_hybrid'


def _layer_norm(x, g, b):
    xf = x.astype(jnp.float32)
    mu = jnp.mean(xf, -1, keepdims=True)
    var = jnp.mean(jnp.square(xf - mu), -1, keepdims=True)
    return ((xf - mu) * lax.rsqrt(var + LN_EPS) * g + b).astype(x.dtype)


def _rel_bucket(dist):
    n = jnp.maximum(dist, 0)
    max_exact = N_BUCKETS // 2
    nf = jnp.maximum(n, 1).astype(jnp.float32)
    large = max_exact + (jnp.log(nf / max_exact) / math.log(MAX_DISTANCE / max_exact)
                         * (N_BUCKETS - max_exact)).astype(jnp.int32)
    return jnp.where(n < max_exact, n, jnp.minimum(large, N_BUCKETS - 1))


def _attend(s, v):
    m = jnp.max(s, -1, keepdims=True)
    p = jnp.exp(s - m)
    l = jnp.sum(p, -1, keepdims=True)
    o = jnp.einsum('...qk,...kd->...qd', p, v) / l
    return o, (m + jnp.log(l))[..., 0]


def _group_rows(group_ids, n_groups, block):
    n = group_ids.shape[0]
    n_blocks = -(-n // block) + n_groups
    n_rows = n_blocks * block
    order = jnp.argsort(group_ids).astype(jnp.int32)
    g_sorted = group_ids[order]
    counts = jnp.bincount(group_ids, length=n_groups + 1)[:n_groups]
    padded = (counts + block - 1) // block * block
    pend = jnp.cumsum(padded)
    pstart = pend - padded
    sstart = jnp.cumsum(counts) - counts
    gc = jnp.minimum(g_sorted, n_groups - 1)
    row = jnp.where(g_sorted < n_groups, pstart[gc] + jnp.arange(n) - sstart[gc], n_rows)
    row_item = jnp.full((n_rows,), n, jnp.int32).at[row].set(order, mode='drop')
    block_group = jnp.minimum(jnp.searchsorted(pend, jnp.arange(n_blocks) * block, side='right'), n_groups - 1)
    return row_item, block_group


def _moba_head(q, k, v, bias_h):
    sp, dh = q.shape
    nblk = sp // MOBA_BLOCK
    qb = q.reshape(nblk, MOBA_BLOCK, dh)
    kb = k.reshape(nblk, MOBA_BLOCK, dh)
    vb = v.reshape(nblk, MOBA_BLOCK, dh)
    off = jnp.arange(MOBA_BLOCK)
    rel = off[:, None] - off[None, :]
    s_self = jnp.einsum('nqd,nkd->nqk', qb, kb) + bias_h[_rel_bucket(rel)]
    s_self = jnp.where(rel >= 0, s_self, -jnp.inf)
    o_self, lse_self = _attend(s_self, vb)
    o_self = o_self.reshape(sp, dh)
    lse_self = lse_self.reshape(sp)
    k_eff = min(MOBA_TOPK, nblk - 1)
    if k_eff == 0:
        return o_self
    pos = jnp.arange(sp)
    qblk = pos // MOBA_BLOCK
    gate = q @ jnp.mean(kb, axis=1).T
    gate = jnp.where(jnp.arange(nblk)[None, :] < qblk[:, None], gate, -jnp.inf)
    _, sel = lax.top_k(gate, k_eff)
    valid = jnp.arange(k_eff)[None, :] < qblk[:, None]
    n_sel = sp * k_eff
    blk_flat = jnp.where(valid, sel, nblk).reshape(n_sel)
    row_sel, chunk_blk = _group_rows(blk_flat, nblk, MOBA_QCHUNK)
    n_rows = row_sel.shape[0]
    n_chunks = chunk_blk.shape[0]
    row_q = jnp.where(row_sel < n_sel, row_sel // k_eff, sp)
    q_pad = jnp.concatenate([q, jnp.zeros((1, dh), q.dtype)], 0)
    qg = q_pad[row_q].reshape(n_chunks, MOBA_QCHUNK, dh)
    kg = kb[chunk_blk]
    vg = vb[chunk_blk]
    qpos = row_q.reshape(n_chunks, MOBA_QCHUNK)
    kpos = chunk_blk[:, None] * MOBA_BLOCK + off[None, :]
    s = jnp.einsum('ncd,ntd->nct', qg, kg) + bias_h[_rel_bucket(qpos[:, :, None] - kpos[:, None, :])]
    o, lse = _attend(s, vg)
    o_sel = jnp.zeros((n_sel + 1, dh), o.dtype).at[row_sel].set(o.reshape(n_rows, dh))[:n_sel]
    lse_sel = jnp.full((n_sel + 1,), -jnp.inf, jnp.float32).at[row_sel].set(lse.reshape(n_rows))[:n_sel]
    lse_all = jnp.concatenate([lse_sel.reshape(sp, k_eff), lse_self[:, None]], 1)
    o_all = jnp.concatenate([o_sel.reshape(sp, k_eff, dh), o_self[:, None]], 1)
    wts = jax.nn.softmax(lse_all, axis=-1)
    return jnp.einsum('sj,sjd->sd', wts, o_all)


def _moba_mixer(x, w_qkv, w_o, rel_bias):
    b, s, d = x.shape
    qkv = (x @ w_qkv).astype(jnp.float32).reshape(b, s, 3, A_HEADS, A_HEAD_DIM)
    qkv = jnp.transpose(qkv, (2, 0, 3, 1, 4))
    sp = -(-s // MOBA_BLOCK) * MOBA_BLOCK
    qkv = jnp.pad(qkv, ((0, 0), (0, 0), (0, 0), (0, sp - s), (0, 0)))
    q = qkv[0] * (A_HEAD_DIM ** -0.5)
    k, v = qkv[1], qkv[2]
    bias_hd = rel_bias.astype(jnp.float32).T
    per_head = jax.vmap(_moba_head)
    o = lax.map(lambda t: per_head(t[0], t[1], t[2], bias_hd), (q, k, v))
    o = jnp.transpose(o[:, :, :s], (0, 2, 1, 3)).reshape(b, s, d).astype(x.dtype)
    return o @ w_o


def _wkv7_scan(r, w, k, v, a, b):
    bsz, t, h, n = r.shape

    def step(state, inp):
        r_t, w_t, k_t, v_t, a_t, b_t = inp
        sa = jnp.einsum('bhvk,bhk->bhv', state, a_t)
        state = (state * w_t[:, :, None, :] + sa[..., None] * b_t[:, :, None, :]
                 + v_t[..., None] * k_t[:, :, None, :])
        return state, jnp.einsum('bhvk,bhk->bhv', state, r_t)

    xs = tuple(jnp.moveaxis(z, 1, 0) for z in (r, w, k, v, a, b))
    _, ys = lax.scan(step, jnp.zeros((bsz, h, n, n), jnp.float32), xs)
    return jnp.moveaxis(ys, 0, 1)


def _rwkv7_mixer(x, v_first, mix, w_rkv, w0, w1, w2, a0, a1, a2, g1, g2,
                 k_k, k_a, r_k, gn_g, gn_b, w_o, vres):
    b, t, d = x.shape
    xx = jnp.pad(x, ((0, 0), (1, 0), (0, 0)))[:, :-1] - x
    r = (x + xx * mix[0]) @ w_rkv[0]
    k = (x + xx * mix[1]) @ w_rkv[1]
    xv = x + xx * mix[2]
    v = xv @ w_rkv[2]
    w_log = -jax.nn.softplus(-(w0 + jnp.tanh((x + xx * mix[3]) @ w1) @ w2)) - 0.5
    a = jax.nn.sigmoid(a0 + ((x + xx * mix[4]) @ a1) @ a2)
    g = jax.nn.sigmoid((x + xx * mix[5]) @ g1) @ g2
    if vres is None:
        v_first = v
    else:
        v0, v1, v2 = vres
        v = v + (v_first - v) * jax.nn.sigmoid(v0 + (xv @ v1) @ v2)

    def heads(z):
        return z.astype(jnp.float32).reshape(b, t, B_HEADS, B_HEAD_DIM)

    kk = heads(k * k_k)
    kk = kk / jnp.maximum(jnp.sqrt(jnp.sum(kk * kk, -1, keepdims=True)), 1e-12)
    a_h = heads(a)
    k_h = heads(k * (1.0 + (a - 1.0) * k_a))
    r_h = heads(r)
    v_h = heads(v)
    decay = jnp.exp(-jnp.exp(heads(w_log)))
    y = _wkv7_scan(r_h, decay, k_h, v_h, -kk, kk * a_h)
    mu = jnp.mean(y, -1, keepdims=True)
    var = jnp.mean(jnp.square(y - mu), -1, keepdims=True)
    y = ((y - mu) * lax.rsqrt(var + GN_EPS)).reshape(b, t, d) * gn_g + gn_b
    bonus = jnp.sum(r_h * k_h * r_k, -1, keepdims=True) * v_h
    y = (y + bonus.reshape(b, t, d)).astype(x.dtype)
    return (y * g) @ w_o, v_first


def _routed_experts(xt, top_e, gate, w_gate, w_up, w_down):
    t, d = xt.shape
    n_assign = t * TOP_K
    row_item, block_expert = _group_rows(top_e.reshape(n_assign), N_EXPERTS, MOE_BLOCK)
    valid = row_item < n_assign
    row_tok = jnp.where(valid, row_item // TOP_K, t).reshape(-1, MOE_BLOCK)
    row_gate = jnp.where(valid, gate.reshape(n_assign)[jnp.minimum(row_item, n_assign - 1)], 0.0)
    row_gate = row_gate.reshape(-1, MOE_BLOCK).astype(xt.dtype)
    x_pad = jnp.concatenate([xt, jnp.zeros((1, d), xt.dtype)], 0)

    def body(acc, blk):
        tok, g, e = blk
        xe = x_pad[tok]
        h = jax.nn.silu(xe @ w_gate[e]) * (xe @ w_up[e])
        return acc.at[tok].add((h @ w_down[e]) * g[:, None]), None

    acc, _ = lax.scan(body, jnp.zeros((t + 1, d), xt.dtype), (row_tok, row_gate, block_expert))
    return acc[:t]


def _moe_ffn(x, w_router, router_bias, w_gate, w_up, w_down, sh_gate, sh_up, sh_down):
    b, s, d = x.shape
    xt = x.reshape(b * s, d)
    scores = jax.nn.sigmoid(xt.astype(jnp.float32) @ w_router.astype(jnp.float32))
    biased = scores + router_bias.astype(jnp.float32)
    per_group = biased.reshape(-1, N_GROUPS, N_EXPERTS // N_GROUPS)
    group_score = jnp.sum(lax.top_k(per_group, 2)[0], -1)
    _, top_g = lax.top_k(group_score, TOPK_GROUPS)
    group_keep = jnp.any(top_g[:, :, None] == jnp.arange(N_GROUPS)[None, None, :], axis=1)
    expert_keep = jnp.repeat(group_keep, N_EXPERTS // N_GROUPS, axis=1)
    _, top_e = lax.top_k(jnp.where(expert_keep, biased, -jnp.inf), TOP_K)
    gate = jnp.take_along_axis(scores, top_e, axis=1)
    gate = gate / jnp.sum(gate, -1, keepdims=True) * ROUTED_SCALE
    routed = _routed_experts(xt, top_e, gate, w_gate, w_up, w_down)
    shared = (jax.nn.silu(xt @ sh_gate) * (xt @ sh_up)) @ sh_down
    return (routed + shared).reshape(b, s, d)


def setup_inputs(seed: int = 0) -> dict:
    key = jax.random.key(seed)
    ks = jax.random.split(key, 64)
    counter = iter(range(64))
    f32 = jnp.float32

    def nrm(shape, scale):
        return jax.random.normal(ks[next(counter)], shape, f32) * scale

    def unif(shape, lo, hi):
        return jax.random.uniform(ks[next(counter)], shape, f32, lo, hi)

    d, L = D_MODEL, DEPTH
    na, nb, nv = N_A_LAYERS, N_B_LAYERS, N_VRES
    sd = d ** -0.5
    beta = DEEPNORM_BETA
    x = nrm((BATCH, SEQ, d), 1.0)
    moba_w_qkv = jnp.concatenate([nrm((na, d, 2 * d), sd), nrm((na, d, d), sd * beta)], axis=-1)
    moba_w_o = nrm((na, d, d), sd * beta)
    rel_bias = nrm((N_BUCKETS, A_HEADS), 0.5)
    rwkv_mix = unif((nb, 6, d), 0.0, 1.0)
    rwkv_w_rkv = jnp.concatenate([nrm((nb, 2, d, d), sd), nrm((nb, 1, d, d), sd * beta)], axis=1)
    rwkv_w0 = unif((nb, d), -6.5, -1.5)
    rwkv_w1 = nrm((nb, d, DECAY_LORA), sd)
    rwkv_w2 = nrm((nb, DECAY_LORA, d), 0.1 * DECAY_LORA ** -0.5)
    rwkv_a0 = nrm((nb, d), 0.1)
    rwkv_a1 = nrm((nb, d, AAA_LORA), sd)
    rwkv_a2 = nrm((nb, AAA_LORA, d), 0.1 * AAA_LORA ** -0.5)
    rwkv_v0 = 1.0 + nrm((nv, d), 0.1)
    rwkv_v1 = nrm((nv, d, MV_LORA), sd)
    rwkv_v2 = nrm((nv, MV_LORA, d), 0.1 * MV_LORA ** -0.5)
    rwkv_g1 = nrm((nb, d, GATE_LORA), sd)
    rwkv_g2 = nrm((nb, GATE_LORA, d), GATE_LORA ** -0.5)
    rwkv_k_k = 0.85 + nrm((nb, d), 0.05)
    rwkv_k_a = 1.0 + nrm((nb, d), 0.05)
    rwkv_r_k = nrm((nb, B_HEADS, B_HEAD_DIM), 0.1)
    rwkv_gn_g = 1.0 + nrm((nb, d), 0.05)
    rwkv_gn_b = nrm((nb, d), 0.02)
    rwkv_w_o = nrm((nb, d, d), sd * beta)
    moe_w_router = nrm((L, d, N_EXPERTS), sd)
    moe_router_bias = nrm((L, N_EXPERTS), 0.01)
    moe_w_gate = nrm((L, N_EXPERTS, d, D_EXPERT), sd)
    moe_w_up = nrm((L, N_EXPERTS, d, D_EXPERT), sd)
    moe_w_down = nrm((L, N_EXPERTS, D_EXPERT, d), D_EXPERT ** -0.5 * beta)
    moe_sh_gate = nrm((L, d, D_EXPERT), sd)
    moe_sh_up = nrm((L, d, D_EXPERT), sd)
    moe_sh_down = nrm((L, D_EXPERT, d), D_EXPERT ** -0.5 * beta)
    ln_mix_g = 1.0 + nrm((L, d), 0.05)
    ln_mix_b = nrm((L, d), 0.02)
    ln_ffn_g = 1.0 + nrm((L, d), 0.05)
    ln_ffn_b = nrm((L, d), 0.02)
    return {
        'x': x, 'moba_w_qkv': moba_w_qkv, 'moba_w_o': moba_w_o, 'rel_bias': rel_bias,
        'rwkv_mix': rwkv_mix, 'rwkv_w_rkv': rwkv_w_rkv, 'rwkv_w0': rwkv_w0, 'rwkv_w1': rwkv_w1,
        'rwkv_w2': rwkv_w2, 'rwkv_a0': rwkv_a0, 'rwkv_a1': rwkv_a1, 'rwkv_a2': rwkv_a2,
        'rwkv_v0': rwkv_v0, 'rwkv_v1': rwkv_v1, 'rwkv_v2': rwkv_v2, 'rwkv_g1': rwkv_g1,
        'rwkv_g2': rwkv_g2, 'rwkv_k_k': rwkv_k_k, 'rwkv_k_a': rwkv_k_a, 'rwkv_r_k': rwkv_r_k,
        'rwkv_gn_g': rwkv_gn_g, 'rwkv_gn_b': rwkv_gn_b, 'rwkv_w_o': rwkv_w_o,
        'moe_w_router': moe_w_router, 'moe_router_bias': moe_router_bias, 'moe_w_gate': moe_w_gate,
        'moe_w_up': moe_w_up, 'moe_w_down': moe_w_down, 'moe_sh_gate': moe_sh_gate,
        'moe_sh_up': moe_sh_up, 'moe_sh_down': moe_sh_down,
        'ln_mix_g': ln_mix_g, 'ln_mix_b': ln_mix_b, 'ln_ffn_g': ln_ffn_g, 'ln_ffn_b': ln_ffn_b,
    }


def reference(x, moba_w_qkv, moba_w_o, rel_bias, rwkv_mix, rwkv_w_rkv, rwkv_w0, rwkv_w1, rwkv_w2,
              rwkv_a0, rwkv_a1, rwkv_a2, rwkv_v0, rwkv_v1, rwkv_v2, rwkv_g1, rwkv_g2, rwkv_k_k,
              rwkv_k_a, rwkv_r_k, rwkv_gn_g, rwkv_gn_b, rwkv_w_o, moe_w_router, moe_router_bias,
              moe_w_gate, moe_w_up, moe_w_down, moe_sh_gate, moe_sh_up, moe_sh_down,
              ln_mix_g, ln_mix_b, ln_ffn_g, ln_ffn_b):
    v_first = None
    for i in range(DEPTH):
        j = i // N_MIXERS
        if i % N_MIXERS == 0:
            h = _moba_mixer(x, moba_w_qkv[j], moba_w_o[j], rel_bias)
        else:
            vres = None if j == 0 else (rwkv_v0[j - 1], rwkv_v1[j - 1], rwkv_v2[j - 1])
            h, v_first = _rwkv7_mixer(x, v_first, rwkv_mix[j], rwkv_w_rkv[j], rwkv_w0[j], rwkv_w1[j],
                                      rwkv_w2[j], rwkv_a0[j], rwkv_a1[j], rwkv_a2[j], rwkv_g1[j],
                                      rwkv_g2[j], rwkv_k_k[j], rwkv_k_a[j], rwkv_r_k[j],
                                      rwkv_gn_g[j], rwkv_gn_b[j], rwkv_w_o[j], vres)
        x = _layer_norm(DEEPNORM_ALPHA * x + h, ln_mix_g[i], ln_mix_b[i])
        f = _moe_ffn(x, moe_w_router[i], moe_router_bias[i], moe_w_gate[i], moe_w_up[i], moe_w_down[i],
                     moe_sh_gate[i], moe_sh_up[i], moe_sh_down[i])
        x = _layer_norm(DEEPNORM_ALPHA * x + f, ln_ffn_g[i], ln_ffn_b[i])
    return x
```

```cpp
#include <hip/hip_runtime.h>
#include <cstdio>
#include <cstdint>

#define GAS __attribute__((address_space(1)))
#define LAS __attribute__((address_space(3)))
typedef unsigned short bf16;
typedef unsigned v4u __attribute__((ext_vector_type(4)));
typedef unsigned v2u __attribute__((ext_vector_type(2)));
typedef float f32x4 __attribute__((ext_vector_type(4)));
typedef float f32x2 __attribute__((ext_vector_type(2)));
typedef short bf16x8 __attribute__((ext_vector_type(8)));
typedef short bf16x4 __attribute__((ext_vector_type(4)));

#ifndef EN_DEFAULT
#define EN_DEFAULT 1
#endif
#ifndef EN_P0
#define EN_P0 EN_DEFAULT
#endif
#ifndef EN_QKV
#define EN_QKV EN_DEFAULT
#endif
#ifndef EN_KMEAN
#define EN_KMEAN EN_DEFAULT
#endif
#ifndef EN_SEL
#define EN_SEL EN_DEFAULT
#endif
#ifndef EN_ATTN
#define EN_ATTN EN_DEFAULT
#endif
#ifndef EN_OPA
#define EN_OPA EN_DEFAULT
#endif
#ifndef EN_MIX
#define EN_MIX EN_DEFAULT
#endif
#ifndef EN_RKV
#define EN_RKV EN_DEFAULT
#endif
#ifndef EN_L2
#define EN_L2 EN_DEFAULT
#endif
#ifndef EN_SCAN
#define EN_SCAN EN_DEFAULT
#endif
#ifndef EN_POST
#define EN_POST EN_DEFAULT
#endif
#ifndef EN_OPB
#define EN_OPB EN_DEFAULT
#endif
#ifndef EN_LN1
#define EN_LN1 EN_DEFAULT
#endif
#ifndef EN_CVT
#define EN_CVT EN_DEFAULT
#endif
#ifndef EN_ROUTER
#define EN_ROUTER EN_DEFAULT
#endif
#ifndef EN_ROUTE
#define EN_ROUTE EN_DEFAULT
#endif
#ifndef EN_G1
#define EN_G1 EN_DEFAULT
#endif
#ifndef EN_G2
#define EN_G2 EN_DEFAULT
#endif
#ifndef EN_LN2
#define EN_LN2 EN_DEFAULT
#endif
constexpr int D = 1024, NBATCH = 8, SEQ = 4096, T = NBATCH * SEQ, NH = 16, HD = 64, DEPTH = 4;
constexpr int NE = 64, TOPK = 8, DE = 256, NEX = NE + 1;
constexpr int MBLK = 256, NMB = SEQ / MBLK;
constexpr float ALPHA = 1.6817928305074290f;
constexpr float LN_EPS = 1e-5f, GN_EPS = 64e-5f;
constexpr int NWAVES = 8, NTHREADS = 512;

constexpr size_t MiB = 1u << 20;
constexpr size_t WS_CTL = 0, CTL_ZERO_BYTES = 1 * MiB;
constexpr size_t WS_WR = 1 * MiB;
constexpr size_t WS_KMEAN = 3 * MiB;
constexpr size_t WS_MASK = 4 * MiB;
constexpr size_t WS_TSEL = 5 * MiB;
constexpr size_t WS_WQKV = 8 * MiB;
constexpr size_t WS_WOA = 20 * MiB;
constexpr size_t WS_WRKV = 24 * MiB;
constexpr size_t WS_WOB = 36 * MiB;
constexpr size_t WS_L1 = 40 * MiB;
constexpr size_t WS_L2 = 44 * MiB;
constexpr size_t WS_WGU = 48 * MiB;
constexpr size_t WS_WD = 113 * MiB;
constexpr size_t WS_XB = 146 * MiB;
constexpr size_t WS_VF = 210 * MiB;
constexpr size_t WS_S = 274 * MiB;
constexpr size_t WS_LOGITS = WS_S;
constexpr size_t WS_TOKLIST = WS_S + 8 * MiB;
constexpr size_t WS_H = WS_S + 16 * MiB;
constexpr size_t WS_Y = WS_S + 168 * MiB;
constexpr size_t WS_Q = WS_S, WS_K = WS_S + 64 * MiB, WS_VT = WS_S + 128 * MiB, WS_O = WS_S + 192 * MiB;
constexpr size_t WS_XMIX = WS_S;
constexpr size_t WS_R = WS_S + 384 * MiB, WS_KK = WS_S + 448 * MiB, WS_V = WS_S + 512 * MiB;
constexpr size_t WS_HL = WS_S + 576 * MiB;
constexpr size_t WS_LW = WS_S;
constexpr size_t WS_A = WS_S + 128 * MiB, WS_G = WS_S + 192 * MiB;
constexpr size_t WS_YS = WS_S + 256 * MiB;
constexpr size_t WS_YG = WS_S + 640 * MiB;
constexpr size_t WS_END = 1024 * MiB;
static_assert(WS_Y + (size_t)278528 * 2048 <= WS_END && WS_YG + 64 * MiB <= WS_END, "d_ws map");

constexpr int CW_TMO = 0;
constexpr int CW_BAR = 4096;
constexpr int CW_CNT = 8192;

constexpr int RING_BYTES = 131072;
constexpr int MISC_OFF = RING_BYTES;
constexpr int TAB_OFF = MISC_OFF + 256;
constexpr int PTAB_OFF = MISC_OFF + 2048;
constexpr int LDS_BYTES = 147456;

#define RLX_AGENT __ATOMIC_RELAXED, __HIP_MEMORY_SCOPE_AGENT
#define LDS_WAIT() asm volatile("s_waitcnt lgkmcnt(0)" ::: "memory")
#define VM_WAIT() asm volatile("s_waitcnt vmcnt(0)" ::: "memory")
typedef float f32x2_t_ __attribute__((ext_vector_type(2))); typedef __bf16 bf16x2_t_ __attribute__((ext_vector_type(2)));
__device__ __forceinline__ unsigned cvt_pk_bf16(float lo, float hi) { const f32x2_t_ v = {lo, hi}; const bf16x2_t_ b = __builtin_convertvector(v, bf16x2_t_); return __builtin_bit_cast(unsigned, b); }
__device__ __forceinline__ float bflo(unsigned w) { return __uint_as_float(w << 16); }
__device__ __forceinline__ float bfhi(unsigned w) { return __uint_as_float(w & 0xffff0000u); }
__device__ __forceinline__ float bf1(bf16 b) { return __uint_as_float(((unsigned)b) << 16); }
__device__ __forceinline__ float fast_exp(float x) { return __builtin_amdgcn_exp2f(x * 1.4426950408889634f); }
__device__ __forceinline__ float fast_rcp(float x) { return __builtin_amdgcn_rcpf(x); }
__device__ __forceinline__ float sigmoidf_(float x) { return fast_rcp(1.0f + fast_exp(-x)); }
__device__ __forceinline__ float wave_sum(float v) {
#pragma unroll
    for (int o = 1; o < 64; o <<= 1) v += __shfl_xor(v, o);
    return v;
}
template <int CTRL> __device__ __forceinline__ float dpp_add(float v) {
    const int t = __builtin_amdgcn_update_dpp(0, __float_as_int(v), CTRL, 0xf, 0xf, true);
    return v + __int_as_float(t);
}
__device__ __forceinline__ float reduce16(float v) {
    v = dpp_add<0xB1>(v); v = dpp_add<0x4E>(v); v = dpp_add<0x141>(v); v = dpp_add<0x140>(v);
    return v;
}
__device__ const unsigned char T5_BUCKET[129] = {
    0, 1, 2, 3, 4, 5, 6, 7, 8, 9, 10, 11, 12, 13, 14, 15, 16, 16, 16, 17, 17, 18, 18, 18, 19, 19, 19, 20, 20, 20, 20, 21, 21, 21, 21, 22, 22, 22, 22, 22, 23, 23, 23, 23, 23, 23, 24, 24, 24,
    24, 24, 24, 25, 25, 25, 25, 25, 25, 25, 26, 26, 26, 26, 26, 26, 26, 26, 27, 27, 27, 27, 27, 27, 27, 27, 27, 27, 28, 28, 28, 28, 28, 28, 28, 28, 28, 28, 29, 29, 29, 29, 29, 29, 29, 29, 29, 29,
    29, 29, 30, 30, 30, 30, 30, 30, 30, 30, 30, 30, 30, 30, 30, 30, 31, 31, 31, 31, 31, 31, 31, 31, 31, 31, 31, 31, 31, 31, 31, 31};

namespace pg8 {
constexpr int BM = 256, BK = 64, HALF = 128, HTB = HALF * BK * 2, STAGE_BYTES = 8 * HTB, NXCD = 8, WGM = 8;
__host__ __device__ __forceinline__ int lds_byte(int r, int c) { const int st = (r >> 4) * 2 + (c >> 5), rr = r & 15, cc = c & 31, ob = rr * 64 + cc * 2; return st * 1024 + (ob ^ (((ob >> 9) & 1) << 5)); }
__host__ __device__ __forceinline__ void stage_rc(int b, int& R, int& C) { const int st = b / 1024, sb = b % 1024, swz = sb ^ (((sb >> 9) & 1) << 5); R = (st >> 1) * 16 + swz / 64; C = (st & 1) * 32 + (swz % 64) / 2; }
__host__ __device__ __forceinline__ int perm32(int rho) { const int n = rho >> 4, i = rho & 15; return 8 * (i >> 2) + 4 * n + (i & 3); }

struct Unit { int pm, pn, e, nvalid, arow0, orow0; const int* gidx; };

__device__ __forceinline__ bool static_tile(int i, int G, int c, int nM, int nN, int& pm, int& pn) {
    const int nwg = nM * nN; const long L = (long)i * G + c; if (L >= nwg) return false;
    int wgid = (int)L; { const int q = nwg / NXCD, r = nwg % NXCD, xcd = wgid % NXCD, off = wgid / NXCD; wgid = (xcd < r ? xcd * (q + 1) : r * (q + 1) + (xcd - r) * q) + off; }
    const int nig = WGM * nN, gid = wgid / nig, fm = gid * WGM, gsz = (nM - fm) < WGM ? (nM - fm) : WGM;
    pm = fm + ((wgid % nig) % gsz); pn = (wgid % nig) / gsz; return true;
}

template <int K, class Epi, class Sched>
__device__ __forceinline__ void gemm_phase(LAS unsigned char* lds, const int tid, const Sched& S, const Epi& E) {
    constexpr bool GA = Sched::GATHER;
    const int wid = __builtin_amdgcn_readfirstlane(tid >> 6), lane = tid & 63, wr = wid >> 2, wc = wid & 3, fr = lane & 15, fq = lane >> 4;
    constexpr int nt = K / BK;
    unsigned voffA[2], voffB[2];
#pragma unroll
    for (int i = 0; i < 2; ++i) { int R, C; stage_rc(tid * 16 + i * 8192, R, C); const int Rb = Epi::PERM ? ((R & ~31) + perm32(R & 31)) : R;
        voffA[i] = (unsigned)(R * K + C) * 2u; voffB[i] = (unsigned)(Rb * K + C) * 2u; }
    const size_t kstep = (size_t)(BK * 2);
    const size_t hstep = (size_t)HALF * K * 2;
    const unsigned rowb = (unsigned)K * 2u;
    const unsigned ldsw = (unsigned)wid * 1024u;
    const int aoff = lds_byte(wr * 64 + fr, fq * 8), boff = lds_byte(wc * 32 + fr, fq * 8);
#define PG8_SA(b, h) (((b) * 2 + (h)) * HTB)
#define PG8_SB(b, h) ((4 + (b) * 2 + (h)) * HTB)
#define PG8_STAGE(bufoff, gbase, voff) do { _Pragma("unroll") for (int _i = 0; _i < 2; ++_i) \
        __builtin_amdgcn_global_load_lds((const unsigned*)((const char*)(gbase) + (voff)[_i]), (LAS unsigned*)(lds + (bufoff) + ldsw + _i * 8192), 16, 0, 0); } while (0)
#define PG8_STAGE_A(bufoff, p, h, O) do { if constexpr (GA) { PG8_STAGE(bufoff, p, O[h]); } else { PG8_STAGE(bufoff, (p) + (h) * hstep, voffA); } } while (0)
#define PG8_LDA(dst, b, h) do { _Pragma("unroll") for (int m = 0; m < 4; ++m) _Pragma("unroll") for (int k = 0; k < 2; ++k) dst[m][k] = *(const LAS bf16x8*)(lds + PG8_SA(b, h) + aoff + m * 2048 + k * 1024); } while (0)
#define PG8_LDB(dst, b, h) do { _Pragma("unroll") for (int n = 0; n < 2; ++n) _Pragma("unroll") for (int k = 0; k < 2; ++k) dst[n][k] = *(const LAS bf16x8*)(lds + PG8_SB(b, h) + boff + n * 2048 + k * 1024); } while (0)
#define PG8_MMA(ai, bj, At, Bt) do { __builtin_amdgcn_s_setprio(1); _Pragma("unroll") for (int m = 0; m < 4; ++m) _Pragma("unroll") for (int n = 0; n < 2; ++n) _Pragma("unroll") for (int k = 0; k < 2; ++k) \
        acc[ai][bj][m][n] = __builtin_amdgcn_mfma_f32_16x16x32_bf16(Bt[n][k], At[m][k], acc[ai][bj][m][n], 0, 0, 0); __builtin_amdgcn_s_setprio(0); } while (0)
#define PG8_WAIT_V(n) asm volatile("s_waitcnt vmcnt(" #n ")" ::: "memory")
#define PG8_WAIT_L(n) asm volatile("s_waitcnt lgkmcnt(" #n ")" ::: "memory")
#define PG8_BAR __builtin_amdgcn_s_barrier()
#define PG8_SCHED __builtin_amdgcn_sched_barrier(0)
#define PG8_OFFS(u, o) do { if constexpr (GA) { _Pragma("unroll") for (int _h = 0; _h < 2; ++_h) _Pragma("unroll") for (int _i = 0; _i < 2; ++_i) { int R_, C_; stage_rc(tid * 16 + _i * 8192, R_, C_); \
        o[_h][_i] = (unsigned)S.a_row(u, _h * HALF + R_) * rowb + (unsigned)C_ * 2u; } } } while (0)
#define PG8_TRIP(a1, a2, b2, O1, O2) do { const char* a3 = (a2) + kstep; const char* b3 = (b2) + kstep; \
            PG8_LDB(B0, 0, 0); PG8_LDB(B1, 0, 1); PG8_SCHED; PG8_LDA(At, 0, 0); PG8_STAGE_A(PG8_SA(1, 1), a1, 1, O1); \
            PG8_WAIT_V(8); PG8_WAIT_L(0); PG8_BAR; PG8_MMA(0, 0, At, B0); PG8_MMA(0, 1, At, B1); PG8_BAR; PG8_SCHED; \
            PG8_LDA(At, 0, 1); PG8_STAGE(PG8_SB(0, 0), b2, voffB); PG8_STAGE(PG8_SB(0, 1), (b2) + hstep, voffB); PG8_STAGE_A(PG8_SA(0, 0), a2, 0, O2); \
            PG8_WAIT_V(8); PG8_WAIT_L(0); PG8_BAR; PG8_MMA(1, 0, At, B0); PG8_MMA(1, 1, At, B1); PG8_BAR; PG8_SCHED; \
            PG8_LDB(B0, 1, 0); PG8_LDB(B1, 1, 1); PG8_SCHED; PG8_LDA(At, 1, 0); PG8_STAGE_A(PG8_SA(0, 1), a2, 1, O2); \
            PG8_WAIT_V(8); PG8_WAIT_L(0); PG8_BAR; PG8_MMA(0, 0, At, B0); PG8_MMA(0, 1, At, B1); PG8_BAR; PG8_SCHED; \
            PG8_LDA(At, 1, 1); PG8_STAGE(PG8_SB(1, 0), b3, voffB); PG8_STAGE(PG8_SB(1, 1), b3 + hstep, voffB); PG8_STAGE_A(PG8_SA(1, 0), a3, 0, O2); \
            PG8_WAIT_V(8); PG8_WAIT_L(0); PG8_BAR; PG8_MMA(1, 0, At, B0); PG8_MMA(1, 1, At, B1); PG8_BAR; PG8_SCHED; } while (0)
    Unit cur, nxt; int ui = 0;
    if (!S.next(0, cur)) return;
    f32x4 acc[2][2][4][2];
#pragma unroll
    for (int a = 0; a < 2; ++a)
#pragma unroll
        for (int b = 0; b < 2; ++b)
#pragma unroll
            for (int m = 0; m < 4; ++m)
#pragma unroll
                for (int n = 0; n < 2; ++n) acc[a][b][m][n] = (f32x4){0.f, 0.f, 0.f, 0.f};
    bf16x8 At[4][2], B0[2][2], B1[2][2];
    unsigned cOff[2][2], nOff[2][2];
    PG8_OFFS(cur, cOff);
    const char* cA = S.a_tile(cur); const char* cB = S.b_tile(cur);
    PG8_STAGE(PG8_SB(0, 0), cB, voffB); PG8_STAGE(PG8_SB(0, 1), cB + hstep, voffB); PG8_STAGE_A(PG8_SA(0, 0), cA, 0, cOff); PG8_STAGE_A(PG8_SA(0, 1), cA, 1, cOff);
    if (wr == 1) PG8_BAR;
    PG8_WAIT_V(2); PG8_BAR;
    PG8_STAGE(PG8_SB(1, 0), cB + kstep, voffB); PG8_STAGE_A(PG8_SA(1, 0), cA + kstep, 0, cOff); PG8_STAGE(PG8_SB(1, 1), cB + hstep + kstep, voffB);
    PG8_WAIT_V(6); PG8_BAR;
    for (;;) {
        const bool has_next = S.next(ui + 1, nxt);
        const char* nA = cA; const char* nB = cB;
        if constexpr (GA) {
#pragma unroll
            for (int h = 0; h < 2; ++h)
#pragma unroll
                for (int i = 0; i < 2; ++i) nOff[h][i] = cOff[h][i]; }
        if (has_next) { PG8_OFFS(nxt, nOff); nA = S.a_tile(nxt); nB = S.b_tile(nxt); }
_Pragma("nounroll")
        for (int t = 0; t < nt; t += 2) { const bool last = (t == nt - 2);
            const char* a2 = last ? nA : cA + (size_t)(t + 2) * kstep; const char* b2 = last ? nB : cB + (size_t)(t + 2) * kstep;
            if constexpr (GA) { unsigned o2[2][2];
#pragma unroll
                for (int h = 0; h < 2; ++h)
#pragma unroll
                    for (int i = 0; i < 2; ++i) o2[h][i] = last ? nOff[h][i] : cOff[h][i];
                PG8_TRIP(cA + (size_t)(t + 1) * kstep, a2, b2, cOff, o2);
            } else { PG8_TRIP(cA + (size_t)(t + 1) * kstep, a2, b2, cOff, cOff); } }
        if (wr == 0) PG8_BAR;
        PG8_SCHED; E(acc, cur, wr, wc, fr, fq); PG8_SCHED;
        if (!has_next) break;
#pragma unroll
        for (int a = 0; a < 2; ++a)
#pragma unroll
            for (int b = 0; b < 2; ++b)
#pragma unroll
                for (int m = 0; m < 4; ++m)
#pragma unroll
                    for (int n = 0; n < 2; ++n) acc[a][b][m][n] = (f32x4){0.f, 0.f, 0.f, 0.f};
        cur = nxt; cA = nA; cB = nB; ++ui;
        if constexpr (GA) {
#pragma unroll
            for (int h = 0; h < 2; ++h)
#pragma unroll
                for (int i = 0; i < 2; ++i) cOff[h][i] = nOff[h][i]; }
        if (wr == 1) PG8_BAR;
    }
    PG8_WAIT_V(0);
    PG8_BAR;
#undef PG8_SA
#undef PG8_SB
#undef PG8_STAGE
#undef PG8_STAGE_A
#undef PG8_LDA
#undef PG8_LDB
#undef PG8_MMA
#undef PG8_WAIT_V
#undef PG8_WAIT_L
#undef PG8_BAR
#undef PG8_SCHED
#undef PG8_OFFS
#undef PG8_TRIP
}
}
using pg8::Unit;
typedef f32x4 AccT[2][2][4][2];

struct SchedDense {
    int nM, nN, G, c, K; const char* A; const char* Bt;
    __device__ __forceinline__ bool next(int i, Unit& u) const { int pm, pn; if (!pg8::static_tile(i, G, c, nM, nN, pm, pn)) return false;
        u.pm = pm; u.pn = pn; u.e = 0; u.nvalid = 256; u.arow0 = pm * 256; u.orow0 = pm * 256; u.gidx = nullptr; return true; }
    static constexpr bool GATHER = false;
    __device__ __forceinline__ const char* a_tile(const Unit& u) const { return A + (size_t)u.arow0 * K * 2; }
    __device__ __forceinline__ const char* b_tile(const Unit& u) const { return Bt + (size_t)u.pn * 256 * K * 2; }
    __device__ __forceinline__ int a_row(const Unit& u, int r) const { return u.arow0 + r; }
};
struct SchedRkv {
    int nM, nN, G, c; const char* xmix; const char* Wrkv; const char* L1;
    __device__ __forceinline__ bool next(int i, Unit& u) const { int pm, pn; if (!pg8::static_tile(i, G, c, nM, nN, pm, pn)) return false;
        u.pm = pm; u.pn = pn; u.e = 0; u.nvalid = 256; u.arow0 = pm * 256; u.orow0 = pm * 256; u.gidx = nullptr; return true; }
    static constexpr bool GATHER = false;
    __device__ __forceinline__ const char* a_tile(const Unit& u) const { const int grp = u.pn < 12 ? (u.pn >> 2) : (u.pn == 15 ? 2 : u.pn - 9); return xmix + ((size_t)grp * T + u.arow0) * D * 2; }
    __device__ __forceinline__ const char* b_tile(const Unit& u) const { return u.pn < 12 ? Wrkv + (size_t)u.pn * 256 * D * 2 : L1 + (size_t)(u.pn - 12) * 256 * D * 2; }
    __device__ __forceinline__ int a_row(const Unit& u, int r) const { return u.arow0 + r; }
};
struct SchedL2 {
    int nM, nN, G, c; const char* hl; const char* L2;
    __device__ __forceinline__ bool next(int i, Unit& u) const { int pm, pn; if (!pg8::static_tile(i, G, c, nM, nN, pm, pn)) return false;
        u.pm = pm; u.pn = pn & 3; u.e = pn >> 2; u.nvalid = 256; u.arow0 = pm * 256; u.orow0 = pm * 256; u.gidx = nullptr; return true; }
    static constexpr bool GATHER = false;
    __device__ __forceinline__ const char* a_tile(const Unit& u) const { return hl + ((size_t)u.e * T + u.arow0) * 256 * 2; }
    __device__ __forceinline__ const char* b_tile(const Unit& u) const { return L2 + ((size_t)u.e * 1024 + (size_t)u.pn * 256) * 256 * 2; }
    __device__ __forceinline__ int a_row(const Unit& u, int r) const { return u.arow0 + r; }
};
struct MoeTab { const LAS int* cnt; const LAS int* mtpref; const LAS int* hoff; };
__device__ __forceinline__ int moe_find_expert(const MoeTab& M, int m) { int e = 0;
    for (int k = 1; k < NEX; ++k) e = (M.mtpref[k] <= m) ? k : e;
    return __builtin_amdgcn_readfirstlane(e); }
struct SchedMoe1 {
    int G, c; MoeTab M; const char* xb; const char* Wgu; const int* toklist;
    __device__ __forceinline__ bool next(int i, Unit& u) const { const long L = (long)i * G + c; const int nun = M.mtpref[NEX] * 2; if (L >= nun) return false;
        const int m = (int)(L >> 1), e = moe_find_expert(M, m), mt = m - M.mtpref[e];
        u.pm = mt; u.pn = (int)(L & 1); u.e = e; u.arow0 = mt * 256; u.orow0 = M.hoff[e] + mt * 256;
        if (e < NE) { const int left = M.cnt[e] - mt * 256; u.nvalid = left < 256 ? left : 256; u.gidx = toklist + (size_t)e * T + mt * 256; } else { u.nvalid = 256; u.gidx = nullptr; }
        return true; }
    static constexpr bool GATHER = true;
    __device__ __forceinline__ const char* a_tile(const Unit&) const { return xb; }
    __device__ __forceinline__ const char* b_tile(const Unit& u) const { return Wgu + ((size_t)u.e * 512 + (size_t)u.pn * 256) * D * 2; }
    __device__ __forceinline__ int a_row(const Unit& u, int r) const { if (u.gidx) return r < u.nvalid ? u.gidx[r] : 0; return u.arow0 + r; }
};
struct SchedMoe2 {
    int G, c; MoeTab M; const char* hb; const char* Wd;
    __device__ __forceinline__ bool next(int i, Unit& u) const { const long L = (long)i * G + c; const int nun = M.mtpref[NEX] * 4; if (L >= nun) return false;
        const int m = (int)(L >> 2), e = moe_find_expert(M, m), mt = m - M.mtpref[e];
        u.pm = mt; u.pn = (int)(L & 3); u.e = e; u.nvalid = 256; u.arow0 = M.hoff[e] + mt * 256; u.orow0 = (e < NE) ? (M.hoff[e] + mt * 256) : mt * 256; u.gidx = nullptr; return true; }
    static constexpr bool GATHER = false;
    __device__ __forceinline__ const char* a_tile(const Unit& u) const { return hb + (size_t)u.arow0 * 256 * 2; }
    __device__ __forceinline__ const char* b_tile(const Unit& u) const { return Wd + ((size_t)u.e * 1024 + (size_t)u.pn * 256) * 256 * 2; }
    __device__ __forceinline__ int a_row(const Unit& u, int r) const { return u.arow0 + r; }
};

#define EPI_ARGS const AccT& acc, const Unit& u, int wr, int wc, int fr, int fq
struct EpiQKV { static constexpr bool PERM = true; bf16* Q; bf16* Kb; bf16* Vt;
    __device__ __forceinline__ void operator()(EPI_ARGS) const {
        const int row0 = u.orow0 + wr * 64 + fr, sec = u.pn >> 2, col0 = (u.pn & 3) * 256 + wc * 32 + 8 * fq;
        if (sec < 2) { bf16* base = sec == 0 ? Q : Kb; const float sc = sec == 0 ? 0.125f : 1.0f;
#pragma unroll
            for (int ai = 0; ai < 2; ++ai)
#pragma unroll
                for (int m = 0; m < 4; ++m) { bf16* rowp = base + (size_t)(row0 + ai * 128 + m * 16) * D + col0;
#pragma unroll
                    for (int bj = 0; bj < 2; ++bj) { const f32x4 v0 = acc[ai][bj][m][0] * sc, v1 = acc[ai][bj][m][1] * sc; v4u w;
                        w.x = cvt_pk_bf16(v0[0], v0[1]); w.y = cvt_pk_bf16(v0[2], v0[3]); w.z = cvt_pk_bf16(v1[0], v1[1]); w.w = cvt_pk_bf16(v1[2], v1[3]); *(v4u*)(rowp + bj * 128) = w; } }
        } else {
#pragma unroll
            for (int ai = 0; ai < 2; ++ai)
#pragma unroll
                for (int m = 0; m < 4; ++m) { const int r = row0 + ai * 128 + m * 16, b = r >> 12, s = r & 4095;
#pragma unroll
                    for (int bj = 0; bj < 2; ++bj)
#pragma unroll
                        for (int n = 0; n < 2; ++n) { const f32x4 v = acc[ai][bj][m][n];
#pragma unroll
                            for (int j = 0; j < 4; j += 2) { const int c = col0 + bj * 128 + 4 * n + j, h = c >> 6, d = c & 63; const unsigned w = cvt_pk_bf16(v[j], v[j + 1]);
                                bf16* p = Vt + ((((size_t)(b * NH + h) * HD + d)) << 12) + s; p[0] = (bf16)(w & 0xffffu); p[SEQ] = (bf16)(w >> 16); } } }
        }
    }
};
struct EpiAdd { static constexpr bool PERM = false; float* out;
    __device__ __forceinline__ void operator()(EPI_ARGS) const {
        const int row0 = u.orow0 + wr * 64 + fr, col0 = u.pn * 256 + wc * 32 + 4 * fq;
#pragma unroll
        for (int ai = 0; ai < 2; ++ai)
#pragma unroll
            for (int m = 0; m < 4; ++m) { float* rowp = out + (size_t)(row0 + ai * 128 + m * 16) * D + col0;
#pragma unroll
                for (int bj = 0; bj < 2; ++bj)
#pragma unroll
                    for (int n = 0; n < 2; ++n) { f32x4* p = (f32x4*)(rowp + bj * 128 + n * 16); *p = *p + acc[ai][bj][m][n]; } }
    }
};
struct EpiLogits { static constexpr bool PERM = false; float* lg;
    __device__ __forceinline__ void operator()(EPI_ARGS) const {
        if (wc >= 2) return;
        const int row0 = u.orow0 + wr * 64 + fr, col0 = wc * 32 + 4 * fq;
#pragma unroll
        for (int ai = 0; ai < 2; ++ai)
#pragma unroll
            for (int m = 0; m < 4; ++m) { float* rowp = lg + (size_t)(row0 + ai * 128 + m * 16) * NE + col0;
#pragma unroll
                for (int n = 0; n < 2; ++n) *(f32x4*)(rowp + n * 16) = acc[ai][0][m][n]; }
    }
};
struct EpiSwiglu { static constexpr bool PERM = true; bf16* hb;
    __device__ __forceinline__ void operator()(EPI_ARGS) const {
        const int row0 = u.orow0 + wr * 64 + fr, col0 = u.pn * 128 + wc * 32 + 8 * fq;
#pragma unroll
        for (int ai = 0; ai < 2; ++ai)
#pragma unroll
            for (int m = 0; m < 4; ++m) { bf16* rowp = hb + (size_t)(row0 + ai * 128 + m * 16) * DE + col0; float o[8];
#pragma unroll
                for (int n = 0; n < 2; ++n)
#pragma unroll
                    for (int j = 0; j < 4; ++j) { const float g = acc[ai][0][m][n][j], up = acc[ai][1][m][n][j]; o[4 * n + j] = g * sigmoidf_(g) * up; }
                v4u w; w.x = cvt_pk_bf16(o[0], o[1]); w.y = cvt_pk_bf16(o[2], o[3]); w.z = cvt_pk_bf16(o[4], o[5]); w.w = cvt_pk_bf16(o[6], o[7]); *(v4u*)rowp = w; }
    }
};
struct EpiMoeDown { static constexpr bool PERM = true; bf16* yb; float* out;
    __device__ __forceinline__ void operator()(EPI_ARGS) const {
        const int row0 = u.orow0 + wr * 64 + fr, col0 = u.pn * 256 + wc * 32 + 8 * fq;
        if (u.e < NE) {
#pragma unroll
            for (int ai = 0; ai < 2; ++ai)
#pragma unroll
                for (int m = 0; m < 4; ++m) { bf16* rowp = yb + (size_t)(row0 + ai * 128 + m * 16) * D + col0;
#pragma unroll
                    for (int bj = 0; bj < 2; ++bj) { const f32x4 v0 = acc[ai][bj][m][0], v1 = acc[ai][bj][m][1]; v4u w;
                        w.x = cvt_pk_bf16(v0[0], v0[1]); w.y = cvt_pk_bf16(v0[2], v0[3]); w.z = cvt_pk_bf16(v1[0], v1[1]); w.w = cvt_pk_bf16(v1[2], v1[3]); *(v4u*)(rowp + bj * 128) = w; } }
        } else {
#pragma unroll
            for (int ai = 0; ai < 2; ++ai)
#pragma unroll
                for (int m = 0; m < 4; ++m) { float* rowp = out + (size_t)(row0 + ai * 128 + m * 16) * D + col0;
#pragma unroll
                    for (int bj = 0; bj < 2; ++bj)
#pragma unroll
                        for (int n = 0; n < 2; ++n) { f32x4* p = (f32x4*)(rowp + bj * 128 + 4 * n); *p = *p + acc[ai][bj][m][n]; } }
        }
    }
};
struct EpiRkv { static constexpr bool PERM = true; unsigned char* ws; size_t voff;
    __device__ __forceinline__ void operator()(EPI_ARGS) const {
        const int row0 = u.orow0 + wr * 64 + fr;
        size_t boff; int ldc, colt, act = 0;
        if (u.pn < 12) { const int sec = u.pn >> 2; boff = WS_R; if (sec == 1) boff = WS_KK; if (sec == 2) boff = voff; ldc = D; colt = (u.pn & 3) * 256; }
        else { const int kind = u.pn - 12; boff = WS_HL + (size_t)kind * T * 256 * 2; ldc = 256; colt = 0; act = kind == 0 ? 1 : (kind == 2 ? 2 : 0); }
        bf16* base = (bf16*)(ws + boff);
        const int col0 = colt + wc * 32 + 8 * fq;
#pragma unroll
        for (int ai = 0; ai < 2; ++ai)
#pragma unroll
            for (int m = 0; m < 4; ++m) { bf16* rowp = base + (size_t)(row0 + ai * 128 + m * 16) * ldc + col0;
#pragma unroll
                for (int bj = 0; bj < 2; ++bj) { f32x4 v0 = acc[ai][bj][m][0], v1 = acc[ai][bj][m][1];
                    if (act == 1) {
#pragma unroll
                        for (int j = 0; j < 4; ++j) { v0[j] = 1.0f - 2.0f * fast_rcp(fast_exp(2.0f * v0[j]) + 1.0f); v1[j] = 1.0f - 2.0f * fast_rcp(fast_exp(2.0f * v1[j]) + 1.0f); } }
                    if (act == 2) {
#pragma unroll
                        for (int j = 0; j < 4; ++j) { v0[j] = sigmoidf_(v0[j]); v1[j] = sigmoidf_(v1[j]); } }
                    v4u w; w.x = cvt_pk_bf16(v0[0], v0[1]); w.y = cvt_pk_bf16(v0[2], v0[3]); w.z = cvt_pk_bf16(v1[0], v1[1]); w.w = cvt_pk_bf16(v1[2], v1[3]); *(v4u*)(rowp + bj * 128) = w; } }
    }
};
struct EpiL2 { static constexpr bool PERM = true; float* lw; bf16* ab; bf16* gb; bf16* vb; const bf16* vf; const float* w0; const float* a0; const float* v0;
    __device__ __forceinline__ void operator()(EPI_ARGS) const {
        const int row0 = u.orow0 + wr * 64 + fr, col0 = u.pn * 256 + wc * 32 + 8 * fq, kind = u.e;
#pragma unroll
        for (int ai = 0; ai < 2; ++ai)
#pragma unroll
            for (int m = 0; m < 4; ++m) { const size_t ro = (size_t)(row0 + ai * 128 + m * 16) * D + col0;
#pragma unroll
                for (int bj = 0; bj < 2; ++bj) { const size_t o = ro + bj * 128; const int c = col0 + bj * 128; float x[8];
#pragma unroll
                    for (int n = 0; n < 2; ++n)
#pragma unroll
                        for (int j = 0; j < 4; ++j) x[4 * n + j] = acc[ai][bj][m][n][j];
                    if (kind == 0) { const f32x4 b0 = *(const f32x4*)(w0 + c), b1 = *(const f32x4*)(w0 + c + 4); f32x4 r0, r1;
#pragma unroll
                        for (int j = 0; j < 8; ++j) { const float z = x[j] + (j < 4 ? b0[j & 3] : b1[j & 3]);
                            const float wl = fminf(z, 0.0f) - __logf(1.0f + fast_exp(-fabsf(z))) - 0.5f; const float v = -fast_exp(wl); if (j < 4) r0[j & 3] = v; else r1[j & 3] = v; }
                        *(f32x4*)(lw + o) = r0; *(f32x4*)(lw + o + 4) = r1;
                    } else if (kind == 1) { const f32x4 b0 = *(const f32x4*)(a0 + c), b1 = *(const f32x4*)(a0 + c + 4);
#pragma unroll
                        for (int j = 0; j < 8; ++j) x[j] = sigmoidf_(x[j] + (j < 4 ? b0[j & 3] : b1[j & 3]));
                        v4u w; w.x = cvt_pk_bf16(x[0], x[1]); w.y = cvt_pk_bf16(x[2], x[3]); w.z = cvt_pk_bf16(x[4], x[5]); w.w = cvt_pk_bf16(x[6], x[7]); *(v4u*)(ab + o) = w;
                    } else if (kind == 2) {
                        v4u w; w.x = cvt_pk_bf16(x[0], x[1]); w.y = cvt_pk_bf16(x[2], x[3]); w.z = cvt_pk_bf16(x[4], x[5]); w.w = cvt_pk_bf16(x[6], x[7]); *(v4u*)(gb + o) = w;
                    } else { const f32x4 b0 = *(const f32x4*)(v0 + c), b1 = *(const f32x4*)(v0 + c + 4); const v4u vv = *(const v4u*)(vb + o), ff = *(const v4u*)(vf + o); float y[8];
#pragma unroll
                        for (int j = 0; j < 8; ++j) { const unsigned wv = vv[j >> 1], wf = ff[j >> 1]; const float v = (j & 1) ? bfhi(wv) : bflo(wv), f = (j & 1) ? bfhi(wf) : bflo(wf);
                            const float gt = sigmoidf_(x[j] + (j < 4 ? b0[j & 3] : b1[j & 3])); y[j] = v + (f - v) * gt; }
                        v4u w; w.x = cvt_pk_bf16(y[0], y[1]); w.y = cvt_pk_bf16(y[2], y[3]); w.z = cvt_pk_bf16(y[4], y[5]); w.w = cvt_pk_bf16(y[6], y[7]); *(v4u*)(vb + o) = w; }
                } }
    }
};

typedef GAS unsigned gu32;
#define XB_TMO      128
#define XB_XCNT(j)  (256  + 64 * (j))
#define XB_XSUB(j)  (1280 + 64 * (j))
#define XB_XGEN(j)  (2304 + 64 * (j))
#define XB_TOP      3328
#define XB_TOPGEN   3392
#define XCD_BAR_WORDS 3456
#define XB_SPIN_CAP (1u << 23)
__device__ __forceinline__ unsigned xb_ld(unsigned* p)              { return __hip_atomic_load(p, __ATOMIC_RELAXED, __HIP_MEMORY_SCOPE_AGENT); }
__device__ __forceinline__ unsigned xb_add(unsigned* p, unsigned v) { return __hip_atomic_fetch_add(p, v, __ATOMIC_RELAXED, __HIP_MEMORY_SCOPE_AGENT); }
__device__ __forceinline__ unsigned xb_xcc_id() { return (unsigned)__builtin_amdgcn_s_getreg((3 << 11) | 20) & 0xFu; }
#define XB_SPIN(cond, bar) do { unsigned _sp = 0; while (cond) { __builtin_amdgcn_s_sleep(1); \
    if ((++_sp & 255u) == 0u) { if (xb_ld(&(bar)[XB_TMO])) break; if (_sp > XB_SPIN_CAP) { atomicAdd(&(bar)[XB_TMO], 1u); break; } } } } while (0)
struct XcdBarrier { unsigned* bar; unsigned x; volatile LAS unsigned* st; };
__device__ __forceinline__ XcdBarrier xcd_barrier_post(unsigned* bar, volatile LAS unsigned* st) {
    XcdBarrier b; b.bar = bar; b.x = xb_xcc_id(); b.st = st;
    if (threadIdx.x == 0) (void)xb_add(&bar[XB_XCNT(b.x)], 1u);
    return b;
}
__device__ __forceinline__ void xcd_barrier_complete(unsigned* bar, unsigned x, unsigned& nloc, unsigned& nx) {
    const unsigned G = gridDim.x * gridDim.y * gridDim.z;
    unsigned sum, cnt, mine, sp = 0u;
    for (;;) {
        sum = 0u; cnt = 0u; mine = 0u;
#pragma unroll
        for (unsigned j = 0; j < 16; ++j) { const unsigned c = xb_ld(&bar[XB_XCNT(j)]); sum += c; cnt += (c > 0u) ? 1u : 0u; mine = (j == x) ? c : mine; }
        if (sum == G) break;
        __builtin_amdgcn_s_sleep(1);
        if ((++sp & 255u) == 0u) { if (xb_ld(&bar[XB_TMO])) break; if (sp > XB_SPIN_CAP) { atomicAdd(&bar[XB_TMO], 1u); break; } }
    }
    nloc = mine > 0u ? mine : 1u; nx = cnt > 0u ? cnt : 1u;
}
__device__ __forceinline__ void xcd_barrier(const XcdBarrier& b) {
    asm volatile("s_waitcnt vmcnt(0)" ::: "memory");
    __syncthreads();
    if (threadIdx.x == 0) {
        unsigned long long bp = (unsigned long long)b.bar; unsigned bx = b.x;
        asm volatile("" : "+s"(bp), "+s"(bx));
        unsigned* bar = (unsigned*)(GAS unsigned*)bp;
        __builtin_amdgcn_s_waitcnt(0);
        unsigned nloc = b.st[0], nx = b.st[1];
        if (nloc == 0u) { xcd_barrier_complete(bar, bx, nloc, nx); b.st[0] = nloc; b.st[1] = nx; }
        const unsigned old = xb_add(&bar[XB_XSUB(bx)], 1u);
        const unsigned gen = old / nloc;
        if (old + 1u == (gen + 1u) * nloc) {
            __builtin_amdgcn_fence(__ATOMIC_RELEASE, "agent");
            asm volatile("s_waitcnt vmcnt(0)" ::: "memory");
            const unsigned og = xb_add(&bar[XB_TOP], 1u);
            const unsigned tg = og / nx;
            if (og + 1u == (tg + 1u) * nx) xb_add(&bar[XB_TOPGEN], 1u);
            else XB_SPIN(xb_ld(&bar[XB_TOPGEN]) == tg, bar);
            __builtin_amdgcn_fence(__ATOMIC_ACQUIRE, "agent");
            xb_add(&bar[XB_XGEN(bx)], 1u);
            asm volatile("s_waitcnt vmcnt(0)" ::: "memory");
        } else {
            XB_SPIN(xb_ld(&bar[XB_XGEN(bx)]) == gen, bar);
            __builtin_amdgcn_fence(__ATOMIC_ACQUIRE, "agent");
            asm volatile("s_waitcnt vmcnt(0)" ::: "memory");
        }
    }
    __syncthreads();
}

struct Args { const float* in[35]; float* out; unsigned char* ws; };
struct Frame {
    LAS unsigned char* lds; gu32* ctl; unsigned char* ws; float* out;
    int tid, lane, wave, vcu, G, gw, NGW;
};

__device__ __forceinline__ Frame phase_frame(const Frame& F) {
    Frame P = F; asm volatile("" : "+v"(P.tid)); P.lane = P.tid & 63; P.wave = __builtin_amdgcn_readfirstlane(P.tid >> 6); P.gw = P.vcu * NWAVES + P.wave; return P;
}
__device__ __forceinline__ const float* in_ptr(const Frame& F, int k) {
    const unsigned long long v = ((const LAS unsigned long long*)(F.lds + PTAB_OFF))[k];
    const unsigned lo = (unsigned)__builtin_amdgcn_readfirstlane((int)(unsigned)v), hi = (unsigned)__builtin_amdgcn_readfirstlane((int)(unsigned)(v >> 32));
    return (const float*)(GAS const float*)(((unsigned long long)hi << 32) | lo);
}
__device__ __forceinline__ void transpose_item(const float* W, int N, int k0, int n0, bf16* WT, size_t orow, int ldk, LAS float* scr, int lane) {
#pragma unroll 8
    for (int i = 0; i < 32; ++i) { const int kk = 2 * i + (lane >> 5); scr[kk * 33 + (lane & 31)] = W[(size_t)(k0 + kk) * N + n0 + (lane & 31)]; }
    LDS_WAIT(); asm volatile("" ::: "memory");
    const int c = lane & 7;
#pragma unroll
    for (int j = 0; j < 4; ++j) { const int n = (lane >> 3) + 8 * j; const LAS float* s = scr + (8 * c) * 33 + n;
        v4u o; o.x = cvt_pk_bf16(s[0 * 33], s[1 * 33]); o.y = cvt_pk_bf16(s[2 * 33], s[3 * 33]); o.z = cvt_pk_bf16(s[4 * 33], s[5 * 33]); o.w = cvt_pk_bf16(s[6 * 33], s[7 * 33]);
        *(v4u*)(WT + (orow + n) * ldk + k0 + 8 * c) = o; }
    LDS_WAIT(); asm volatile("" ::: "memory");
}
__device__ __forceinline__ void convert_plain(Frame& F, const float* W, int K, int N, bf16* WT, int row_off) {
    LAS float* scr = (LAS float*)(F.lds + F.wave * 16384);
    const int nblk = N / 32, nitems = (K / 64) * nblk;
    for (int it = F.gw; it < nitems; it += F.NGW) { const int kb = it / nblk, nb = it % nblk; transpose_item(W, N, 64 * kb, 32 * nb, WT, (size_t)row_off + 32 * nb, K, scr, F.lane); }
}
__device__ __forceinline__ void convert_small(Frame& F, const float* W, int K, int N, bf16* WT, int Np, int Kp) {
    const size_t tot = (size_t)Np * Kp;
    for (size_t i = (size_t)F.gw * 64 + F.lane; i < tot; i += (size_t)F.NGW * 64) { const int n = (int)(i / Kp), k = (int)(i % Kp);
        const float v = (k < K && n < N) ? W[(size_t)k * N + n] : 0.0f; WT[i] = (bf16)(cvt_pk_bf16(v, 0.0f) & 0xffffu); }
}
__device__ __forceinline__ void convert_moe(Frame& F, const float* wg, const float* wu, const float* wd, const float* sg, const float* su, const float* sd) {
    LAS float* scr = (LAS float*)(F.lds + F.wave * 16384);
    bf16* Wgu = (bf16*)(F.ws + WS_WGU); bf16* Wd = (bf16*)(F.ws + WS_WD);
    constexpr int PER = 128;
    const int total = NEX * 3 * PER;
    for (int it = F.gw; it < total; it += F.NGW) {
        const int e = it / (3 * PER), r = it % (3 * PER), which = r / PER, q = r % PER;
        if (which < 2) { const float* W = (e < NE) ? (which == 0 ? wg : wu) + (size_t)e * D * DE : (which == 0 ? sg : su);
            const int kb = q >> 3, nb = q & 7, n0 = 32 * nb; const size_t orow = (size_t)e * 512 + (n0 >> 7) * 256 + which * 128 + (n0 & 127);
            transpose_item(W, DE, 64 * kb, n0, Wgu, orow, D, scr, F.lane);
        } else { const float* W = (e < NE) ? wd + (size_t)e * DE * D : sd;
            const int kb = q >> 5, nb = q & 31, n0 = 32 * nb;
            transpose_item(W, D, 64 * kb, n0, Wd, (size_t)e * 1024 + n0, DE, scr, F.lane); }
    }
}

template <int MODE>
__device__ __forceinline__ void ln_phase(Frame& F, const float* src, const float* g, const float* bsh, bool final, const MoeTab& M) {
    float* out = F.out; bf16* xb = (bf16*)(F.ws + WS_XB);
    const bf16* yb = (const bf16*)(F.ws + WS_Y); const int2* tsel = (const int2*)(F.ws + WS_TSEL);
    f32x4 gv[4], bv[4];
    if (MODE != 2) {
#pragma unroll
        for (int j = 0; j < 4; ++j) { gv[j] = *(const f32x4*)(g + 256 * j + 4 * F.lane); bv[j] = *(const f32x4*)(bsh + 256 * j + 4 * F.lane); } }
    for (int row = F.gw; row < T; row += F.NGW) {
        const f32x4* xr = (const f32x4*)(src + (size_t)row * D) + F.lane;
        f32x4 v[4];
#pragma unroll
        for (int j = 0; j < 4; ++j) v[j] = xr[64 * j];
        if (MODE == 1) {
#pragma unroll
            for (int jj = 0; jj < TOPK; ++jj) { const int2 ts = tsel[(size_t)row * TOPK + jj]; const int e = ts.x >> 20, slot = ts.x & 0xfffff; const float gt = __int_as_float(ts.y);
                const bf16* yp = yb + (size_t)(M.hoff[e] + slot) * D + 4 * F.lane;
#pragma unroll
                for (int j = 0; j < 4; ++j) { const v2u w = *(const v2u*)(yp + 256 * j); v[j][0] += gt * bflo(w.x); v[j][1] += gt * bfhi(w.x); v[j][2] += gt * bflo(w.y); v[j][3] += gt * bfhi(w.y); } }
        }
        f32x4 o[4];
        if (MODE == 2) {
#pragma unroll
            for (int j = 0; j < 4; ++j) o[j] = v[j];
        } else {
            float s = 0.f;
#pragma unroll
            for (int j = 0; j < 4; ++j) s += (v[j][0] + v[j][1]) + (v[j][2] + v[j][3]);
            const float mean = wave_sum(s) * (1.0f / D); float s2 = 0.f;
#pragma unroll
            for (int j = 0; j < 4; ++j) { v[j] = v[j] - mean; s2 += (v[j][0] * v[j][0] + v[j][1] * v[j][1]) + (v[j][2] * v[j][2] + v[j][3] * v[j][3]); }
            const float rstd = 1.0f / sqrtf(wave_sum(s2) * (1.0f / D) + LN_EPS);
#pragma unroll
            for (int j = 0; j < 4; ++j) o[j] = v[j] * rstd * gv[j] + bv[j];
        }
        f32x4* orow = (f32x4*)(out + (size_t)row * D) + F.lane; v2u* brow = (v2u*)(xb + (size_t)row * D) + F.lane;
        const float sc = final ? 1.0f : ALPHA;
#pragma unroll
        for (int j = 0; j < 4; ++j) { orow[64 * j] = o[j] * sc; v2u w; w.x = cvt_pk_bf16(o[j][0], o[j][1]); w.y = cvt_pk_bf16(o[j][2], o[j][3]); brow[64 * j] = w; }
    }
}

__device__ __forceinline__ void moe_tables(Frame& F, int layer) {
    LAS int* cnt = (LAS int*)(F.lds + TAB_OFF); LAS int* mtp = cnt + 65; LAS int* hoff = mtp + 66;
    __syncthreads();
    if (F.tid < NE) cnt[F.tid] = (int)__hip_atomic_load(F.ctl + CW_CNT + (layer * 64 + F.tid) * 64, RLX_AGENT);
    if (F.tid == NE) cnt[NE] = T;
    __syncthreads();
    if (F.tid == 0) { int m = 0; for (int e = 0; e < NEX; ++e) { mtp[e] = m; hoff[e] = m * 256; m += (cnt[e] + 255) >> 8; } mtp[NEX] = m; hoff[NEX] = m * 256; }
    __syncthreads();
}

__device__ __forceinline__ void route_phase(Frame& F, int layer, const float* rbias) {
    const float* lg = (const float*)(F.ws + WS_LOGITS); int* toklist = (int*)(F.ws + WS_TOKLIST); int2* tsel = (int2*)(F.ws + WS_TSEL);
    LAS float* sw = (LAS float*)(F.lds + F.wave * 256);
    const float rb = rbias[F.lane];
    for (int row = F.gw; row < T; row += F.NGW) {
        const float sc = sigmoidf_(lg[(size_t)row * NE + F.lane]); const float bz = sc + rb;
        sw[F.lane] = bz; LDS_WAIT();
        float v[64];
#pragma unroll
        for (int q = 0; q < 16; ++q) { const f32x4 t = *(const LAS f32x4*)(sw + 4 * q); v[4 * q] = t[0]; v[4 * q + 1] = t[1]; v[4 * q + 2] = t[2]; v[4 * q + 3] = t[3]; }
        LDS_WAIT();
        float gs[8];
#pragma unroll
        for (int gi = 0; gi < 8; ++gi) { float m1 = -INFINITY, m2 = -INFINITY;
#pragma unroll
            for (int k = 0; k < 8; ++k) { const float x = v[8 * gi + k]; const bool a = x > m1; const float nm2 = a ? m1 : fmaxf(m2, x); m1 = a ? x : m1; m2 = nm2; }
            gs[gi] = m1 + m2; }
        unsigned keep = 0u;
#pragma unroll
        for (int gi = 0; gi < 8; ++gi) { int rank = 0;
#pragma unroll
            for (int g2 = 0; g2 < 8; ++g2) rank += (gs[g2] > gs[gi] || (gs[g2] == gs[gi] && g2 < gi)) ? 1 : 0;
            keep |= (rank < 4) ? (1u << gi) : 0u; }
        const bool kown = (keep >> (F.lane >> 3)) & 1u; int rank = 0;
#pragma unroll
        for (int e2 = 0; e2 < 64; ++e2) { const bool k2 = (keep >> (e2 >> 3)) & 1u; rank += (k2 && (v[e2] > bz || (v[e2] == bz && e2 < F.lane))) ? 1 : 0; }
        const bool sel = kown && rank < TOPK;
        const unsigned long long bal = __ballot(sel);
        const float ssum = wave_sum(sel ? sc : 0.0f);
        if (sel) { const int j = __popcll(bal & ((1ull << F.lane) - 1ull)); const float gate = sc / ssum * 2.5f;
            const unsigned slot = __hip_atomic_fetch_add(F.ctl + CW_CNT + (layer * 64 + F.lane) * 64, 1u, RLX_AGENT);
            toklist[(size_t)F.lane * T + slot] = row;
            if (j < TOPK) tsel[(size_t)row * TOPK + j] = make_int2((F.lane << 20) | (int)slot, __float_as_int(gate)); }
    }
}

__device__ __forceinline__ void mix_phase(Frame& F, const float* mix) {
    bf16* xm = (bf16*)(F.ws + WS_XMIX);
    for (int row = F.gw; row < T; row += F.NGW) {
        const f32x4* xr = (const f32x4*)(F.out + (size_t)row * D) + F.lane; const bool first = (row & (SEQ - 1)) == 0;
#pragma unroll
        for (int j = 0; j < 4; ++j) { const f32x4 x = xr[64 * j] * (1.0f / ALPHA); const f32x4 xp = first ? (f32x4){0.f, 0.f, 0.f, 0.f} : xr[64 * j - 256] * (1.0f / ALPHA); const f32x4 xx = xp - x;
#pragma unroll
            for (int i = 0; i < 6; ++i) { const f32x4 mv = *(const f32x4*)(mix + i * D + 256 * j + 4 * F.lane); const f32x4 o = x + xx * mv;
                v2u w; w.x = cvt_pk_bf16(o[0], o[1]); w.y = cvt_pk_bf16(o[2], o[3]); *((v2u*)(xm + ((size_t)i * T + row) * D) + 64 * j + F.lane) = w; } }
    }
}

__device__ __forceinline__ void kmean_phase(Frame& F) {
    const bf16* Kb = (const bf16*)(F.ws + WS_K); float* km = (float*)(F.ws + WS_KMEAN);
    for (int u = F.gw; u < NBATCH * NH * NMB; u += F.NGW) { const int bh = u >> 4, blk = u & 15, b = bh >> 4, h = bh & 15;
        const bf16* p = Kb + ((size_t)b * SEQ + blk * MBLK) * D + h * HD + F.lane; float s = 0.f;
#pragma unroll 16
        for (int r = 0; r < MBLK; ++r) s += bf1(p[(size_t)r * D]);
        km[(size_t)u * HD + F.lane] = s * (1.0f / MBLK); }
}
__device__ __forceinline__ void sel_phase(Frame& F) {
    const bf16* Q = (const bf16*)(F.ws + WS_Q); const float* km = (const float*)(F.ws + WS_KMEAN); unsigned short* maskb = (unsigned short*)(F.ws + WS_MASK);
    LAS float* kl = (LAS float*)F.lds;
    for (int u = F.vcu; u < NBATCH * NH * (SEQ / NTHREADS); u += F.G) { const int bh = u >> 3, ch = u & 7, b = bh >> 4, h = bh & 15;
        __syncthreads();
        for (int i = F.tid; i < NMB * HD; i += NTHREADS) kl[i] = km[(size_t)bh * NMB * HD + i];
        __syncthreads();
        const int qpos = ch * NTHREADS + F.tid, qblk = qpos >> 8;
        const v4u* qp = (const v4u*)(Q + ((size_t)b * SEQ + qpos) * D + h * HD); float q[64];
#pragma unroll
        for (int i = 0; i < 8; ++i) { const v4u w = qp[i];
#pragma unroll
            for (int k = 0; k < 4; ++k) { q[8 * i + 2 * k] = bflo(w[k]); q[8 * i + 2 * k + 1] = bfhi(w[k]); } }
        float v1 = -INFINITY, v2 = -INFINITY, v3 = -INFINITY; int i1 = -1, i2 = -1, i3 = -1;
        for (int j = 0; j < qblk; ++j) { float gsum = 0.f; const LAS f32x4* kr = (const LAS f32x4*)(kl + j * HD);
#pragma unroll
            for (int i = 0; i < 16; ++i) { const f32x4 kv = kr[i]; gsum += q[4 * i] * kv[0] + q[4 * i + 1] * kv[1] + q[4 * i + 2] * kv[2] + q[4 * i + 3] * kv[3]; }
            if (gsum > v1) { v3 = v2; i3 = i2; v2 = v1; i2 = i1; v1 = gsum; i1 = j; }
            else if (gsum > v2) { v3 = v2; i3 = i2; v2 = gsum; i2 = j; }
            else if (gsum > v3) { v3 = gsum; i3 = j; } }
        unsigned mk = 0u; if (i1 >= 0) mk |= 1u << i1; if (i2 >= 0) mk |= 1u << i2; if (i3 >= 0) mk |= 1u << i3;
        maskb[(size_t)bh * SEQ + qpos] = (unsigned short)mk; }
}
__device__ __forceinline__ void attn_phase(Frame& F, const float* rel_bias) {
    const bf16* Q = (const bf16*)(F.ws + WS_Q); const bf16* Kb = (const bf16*)(F.ws + WS_K); const bf16* Vt = (const bf16*)(F.ws + WS_VT); bf16* O = (bf16*)(F.ws + WS_O);
    const unsigned short* maskb = (const unsigned short*)(F.ws + WS_MASK);
    constexpr int TB = 18432, RS = 144;
    LAS float* tbl = (LAS float*)(F.lds + 2 * TB);
    __syncthreads();
    for (int i = F.tid; i < NH * 129; i += NTHREADS) { const int h = i / 129, d = i % 129; tbl[h * 132 + d] = rel_bias[(int)T5_BUCKET[d] * NH + h]; }
    __syncthreads();
    const int qi = F.lane & 15, g = F.lane >> 4; unsigned tcount = 0;
    const int nunits = NBATCH * NH * NMB * 2;
    for (int it = 0;; ++it) {
        int bh, blk, half;
        if (F.G == 256) { if (it >= 16) break; const int k = it >> 1; bh = F.vcu >> 1; blk = 2 * k + ((k ^ F.vcu) & 1); half = it & 1; }
        else { const int L = it * F.G + F.vcu; if (L >= nunits) break; bh = L >> 5; blk = (L & 31) >> 1; half = L & 1; }
        const int b = bh >> 4, h = bh & 15;
        const int qpos = blk * MBLK + half * 128 + 16 * F.wave + qi; const size_t qrow = (size_t)b * SEQ + qpos;
        bf16x8 qf[2];
#pragma unroll
        for (int ks = 0; ks < 2; ++ks) qf[ks] = *(const bf16x8*)(Q + qrow * D + h * HD + 32 * ks + 8 * g);
        const unsigned qmask = maskb[(size_t)bh * SEQ + qpos];
        const LAS float* tblh = tbl + h * 132;
        float m = -1e30f, l = 0.f; f32x4 o[4];
#pragma unroll
        for (int dt = 0; dt < 4; ++dt) o[dt] = (f32x4){0.f, 0.f, 0.f, 0.f};
        const int nown = half ? 4 : 2, ntiles = nown + 4 * blk;
        const int lkey = F.tid >> 3, lch = F.tid & 7;
        const bf16* kbase = Kb + ((size_t)b * SEQ + lkey) * D + h * HD + 8 * lch;
        const bf16* vbase = Vt + (((size_t)bh * HD + lkey) << 12) + 8 * lch;
        v4u kreg, vreg;
        { const int key0 = blk * MBLK; kreg = *(const v4u*)(kbase + (size_t)key0 * D); vreg = *(const v4u*)(vbase + key0); }
        for (int n = 0; n < ntiles; ++n) {
            int jb, key0; if (n < nown) { jb = blk; key0 = blk * MBLK + 64 * n; } else { const int mm = n - nown; jb = blk - 1 - (mm >> 2); key0 = jb * MBLK + 64 * (mm & 3); }
            LAS unsigned char* buf = F.lds + (tcount & 1u) * TB; ++tcount;
            *(LAS v4u*)(buf + lkey * RS + lch * 16) = kreg; *(LAS v4u*)(buf + 9216 + lkey * RS + lch * 16) = vreg;
            __syncthreads();
            if (n + 1 < ntiles) { const int n1 = n + 1; int k1; if (n1 < nown) k1 = blk * MBLK + 64 * n1; else { const int mm = n1 - nown; k1 = (blk - 1 - (mm >> 2)) * MBLK + 64 * (mm & 3); }
                kreg = *(const v4u*)(kbase + (size_t)k1 * D); vreg = *(const v4u*)(vbase + k1); }
            f32x4 s[4];
#pragma unroll
            for (int kt = 0; kt < 4; ++kt) { s[kt] = (f32x4){0.f, 0.f, 0.f, 0.f};
#pragma unroll
                for (int ks = 0; ks < 2; ++ks) { const bf16x8 a = *(const LAS bf16x8*)(buf + (16 * kt + qi) * RS + 64 * ks + 16 * g); s[kt] = __builtin_amdgcn_mfma_f32_16x16x32_bf16(a, qf[ks], s[kt], 0, 0, 0); } }
            const bool own = (jb == blk), nearb = (jb >= blk - 1); const bool selb = (qmask >> jb) & 1u; const float bfar = tblh[128];
            float mx = -INFINITY;
#pragma unroll
            for (int kt = 0; kt < 4; ++kt)
#pragma unroll
                for (int r = 0; r < 4; ++r) { const int dist = qpos - (key0 + 16 * kt + 4 * g + r);
                    float bias = bfar; if (nearb) { const int dd = dist < 0 ? 0 : (dist > 128 ? 128 : dist); bias = tblh[dd]; }
                    const bool valid = own ? (dist >= 0) : selb;
                    const float x = valid ? s[kt][r] + bias : -INFINITY; s[kt][r] = x; mx = fmaxf(mx, x); }
            mx = fmaxf(mx, __shfl_xor(mx, 16)); mx = fmaxf(mx, __shfl_xor(mx, 32));
            const float mnew = fmaxf(m, mx), alpha = fast_exp(m - mnew); m = mnew;
            float ps = 0.f;
#pragma unroll
            for (int kt = 0; kt < 4; ++kt)
#pragma unroll
                for (int r = 0; r < 4; ++r) { const float p = fast_exp(s[kt][r] - mnew); s[kt][r] = p; ps += p; }
            l = l * alpha + ps;
#pragma unroll
            for (int dt = 0; dt < 4; ++dt) o[dt] = o[dt] * alpha;
#pragma unroll
            for (int k2 = 0; k2 < 2; ++k2) { v4u pw; pw.x = cvt_pk_bf16(s[2 * k2][0], s[2 * k2][1]); pw.y = cvt_pk_bf16(s[2 * k2][2], s[2 * k2][3]); pw.z = cvt_pk_bf16(s[2 * k2 + 1][0], s[2 * k2 + 1][1]); pw.w = cvt_pk_bf16(s[2 * k2 + 1][2], s[2 * k2 + 1][3]);
                const bf16x8 pb = __builtin_bit_cast(bf16x8, pw);
#pragma unroll
                for (int dt = 0; dt < 4; ++dt) { const LAS unsigned char* vp = buf + 9216 + (16 * dt + qi) * RS + 64 * k2 + 8 * g; const v2u lo = *(const LAS v2u*)vp, hi = *(const LAS v2u*)(vp + 32);
                    v4u aw; aw.x = lo.x; aw.y = lo.y; aw.z = hi.x; aw.w = hi.y; o[dt] = __builtin_amdgcn_mfma_f32_16x16x32_bf16(__builtin_bit_cast(bf16x8, aw), pb, o[dt], 0, 0, 0); } }
        }
        l += __shfl_xor(l, 16); l += __shfl_xor(l, 32); const float inv = 1.0f / l;
#pragma unroll
        for (int dt = 0; dt < 4; ++dt) { v2u w; w.x = cvt_pk_bf16(o[dt][0] * inv, o[dt][1] * inv); w.y = cvt_pk_bf16(o[dt][2] * inv, o[dt][3] * inv); *(v2u*)(O + qrow * D + h * HD + 16 * dt + 4 * g) = w; }
    }
    __syncthreads();
}

__device__ __forceinline__ void scan_phase(Frame& F, const bf16* vbuf, const float* k_k, const float* k_a) {
    const bf16* rb = (const bf16*)(F.ws + WS_R); const bf16* kb = (const bf16*)(F.ws + WS_KK); const bf16* ab = (const bf16*)(F.ws + WS_A);
    const float* lw = (const float*)(F.ws + WS_LW); float* ys = (float*)(F.ws + WS_YS);
    constexpr int TS = 32, BUFB = 49152, OW = 0, OA = 8192, OB = 16384, OK = 24576, OR = 32768, OV = 40960, OY = 45056;
    const int st = F.tid >> 4, sc4 = F.tid & 15;
    const int vt = F.tid >> 3, vr4 = F.tid & 7;
    const int rl = 4 * F.wave + (F.lane >> 4), c = F.lane & 15;
    for (int u = F.vcu; u < NBATCH * NH * 2; u += F.G) {
        const int bh = u >> 1, half = u & 1, b = bh >> 4, h = bh & 15;
        const f32x4 kkv = *(const f32x4*)(k_k + h * HD + 4 * sc4), kav = *(const f32x4*)(k_a + h * HD + 4 * sc4);
        const size_t base = (size_t)b * SEQ * D + h * HD;
        v2u pr, pk, pa, pv; f32x4 pw;
#define SCAN_LOAD(t0) do { const size_t o = base + (size_t)((t0) + st) * D + 4 * sc4; pr = *(const v2u*)(rb + o); pk = *(const v2u*)(kb + o); pa = *(const v2u*)(ab + o); pw = *(const f32x4*)(lw + o); \
        if (F.tid < 256) pv = *(const v2u*)(vbuf + base + (size_t)((t0) + vt) * D + 32 * half + 4 * vr4); } while (0)
#define SCAN_STAGE(bufp) do { LAS unsigned char* B_ = (bufp); \
        const f32x4 k4 = {bflo(pk.x), bfhi(pk.x), bflo(pk.y), bfhi(pk.y)}, a4 = {bflo(pa.x), bfhi(pa.x), bflo(pa.y), bfhi(pa.y)}, r4 = {bflo(pr.x), bfhi(pr.x), bflo(pr.y), bfhi(pr.y)}; \
        f32x4 kk = k4 * kkv; float ss = (kk[0] * kk[0] + kk[1] * kk[1]) + (kk[2] * kk[2] + kk[3] * kk[3]); ss = reduce16(ss); \
        const float inv = 1.0f / fmaxf(sqrtf(ss), 1e-12f); kk = kk * inv; \
        const f32x4 dec = {fast_exp(pw[0]), fast_exp(pw[1]), fast_exp(pw[2]), fast_exp(pw[3])}; \
        const f32x4 kh = k4 * (1.0f + (a4 - 1.0f) * kav); const int eo = (st * 64 + 4 * sc4) * 4; \
        *(LAS f32x4*)(B_ + OW + eo) = dec; *(LAS f32x4*)(B_ + OA + eo) = -kk; *(LAS f32x4*)(B_ + OB + eo) = kk * a4; *(LAS f32x4*)(B_ + OK + eo) = kh; *(LAS f32x4*)(B_ + OR + eo) = r4; \
        if (F.tid < 256) { const f32x4 v4 = {bflo(pv.x), bfhi(pv.x), bflo(pv.y), bfhi(pv.y)}; *(LAS f32x4*)(B_ + OV + (vt * 32 + 4 * vr4) * 4) = v4; } } while (0)
        __syncthreads();
        SCAN_LOAD(0); SCAN_STAGE(F.lds);
        __syncthreads();
        float S0 = 0.f, S1 = 0.f, S2 = 0.f, S3 = 0.f;
        constexpr int NCH = SEQ / TS;
        for (int ch = 0; ch < NCH; ++ch) {
            LAS unsigned char* B = F.lds + (ch & 1) * BUFB;
            if (ch + 1 < NCH) SCAN_LOAD((ch + 1) * TS);
#pragma unroll 4
            for (int t = 0; t < TS; ++t) { const int eo = (t * 64 + 4 * c) * 4;
                const f32x4 a4 = *(const LAS f32x4*)(B + OA + eo), w4 = *(const LAS f32x4*)(B + OW + eo), b4 = *(const LAS f32x4*)(B + OB + eo), k4 = *(const LAS f32x4*)(B + OK + eo), r4 = *(const LAS f32x4*)(B + OR + eo);
                const float vv = *(const LAS float*)(B + OV + (t * 32 + rl) * 4);
                float sa = (S0 * a4[0] + S1 * a4[1]) + (S2 * a4[2] + S3 * a4[3]); sa = reduce16(sa);
                S0 = S0 * w4[0] + sa * b4[0] + vv * k4[0]; S1 = S1 * w4[1] + sa * b4[1] + vv * k4[1]; S2 = S2 * w4[2] + sa * b4[2] + vv * k4[2]; S3 = S3 * w4[3] + sa * b4[3] + vv * k4[3];
                float y = (S0 * r4[0] + S1 * r4[1]) + (S2 * r4[2] + S3 * r4[3]); y = reduce16(y);
                if (c == 0) *(LAS float*)(B + OY + (t * 32 + rl) * 4) = y; }
            if (ch + 1 < NCH) SCAN_STAGE(F.lds + ((ch + 1) & 1) * BUFB);
            __syncthreads();
            if (F.tid < 256) { const f32x4 yv = *(const LAS f32x4*)(B + OY + (vt * 32 + 4 * vr4) * 4); *(f32x4*)(ys + base + (size_t)(ch * TS + vt) * D + 32 * half + 4 * vr4) = yv; }
        }
#undef SCAN_LOAD
#undef SCAN_STAGE
    }
    __syncthreads();
}
__device__ __forceinline__ void post_phase(Frame& F, const bf16* vbuf, const float* k_a, const float* r_k, const float* gn_g, const float* gn_b) {
    const bf16* rb = (const bf16*)(F.ws + WS_R); const bf16* kb = (const bf16*)(F.ws + WS_KK); const bf16* ab = (const bf16*)(F.ws + WS_A); const bf16* gb = (const bf16*)(F.ws + WS_G);
    const float* ys = (const float*)(F.ws + WS_YS); bf16* yg = (bf16*)(F.ws + WS_YG);
    for (int row = F.gw; row < T; row += F.NGW) {
#pragma unroll
        for (int j = 0; j < 4; ++j) { const size_t o = (size_t)row * D + 256 * j + 4 * F.lane; const int cc = 256 * j + 4 * F.lane;
            const f32x4 y = *(const f32x4*)(ys + o); const v2u wr_ = *(const v2u*)(rb + o), wk = *(const v2u*)(kb + o), wa = *(const v2u*)(ab + o), wv = *(const v2u*)(vbuf + o), wg = *(const v2u*)(gb + o);
            const f32x4 r4 = {bflo(wr_.x), bfhi(wr_.x), bflo(wr_.y), bfhi(wr_.y)}, k4 = {bflo(wk.x), bfhi(wk.x), bflo(wk.y), bfhi(wk.y)}, a4 = {bflo(wa.x), bfhi(wa.x), bflo(wa.y), bfhi(wa.y)};
            const f32x4 v4 = {bflo(wv.x), bfhi(wv.x), bflo(wv.y), bfhi(wv.y)}, g4 = {bflo(wg.x), bfhi(wg.x), bflo(wg.y), bfhi(wg.y)};
            const f32x4 kav = *(const f32x4*)(k_a + cc), rkv = *(const f32x4*)(r_k + cc), gg = *(const f32x4*)(gn_g + cc), gbv = *(const f32x4*)(gn_b + cc);
            const float mean = reduce16((y[0] + y[1]) + (y[2] + y[3])) * (1.0f / HD); const f32x4 dy = y - mean;
            const float var = reduce16((dy[0] * dy[0] + dy[1] * dy[1]) + (dy[2] * dy[2] + dy[3] * dy[3])) * (1.0f / HD); const float rstd = 1.0f / sqrtf(var + GN_EPS);
            const f32x4 kh = k4 * (1.0f + (a4 - 1.0f) * kav); const f32x4 pr = r4 * kh * rkv; const float rk = reduce16((pr[0] + pr[1]) + (pr[2] + pr[3]));
            const f32x4 res = (dy * rstd * gg + gbv + v4 * rk) * g4;
            v2u w; w.x = cvt_pk_bf16(res[0], res[1]); w.y = cvt_pk_bf16(res[2], res[3]); *(v2u*)(yg + o) = w; }
    }
}

__global__ void __launch_bounds__(NTHREADS, 2) fwd_kernel(Args args) {
    extern __shared__ __attribute__((aligned(16))) unsigned char lds_raw[];
    Frame F;
    F.lds = (LAS unsigned char*)lds_raw; F.ws = args.ws; F.out = args.out; F.ctl = (gu32*)(args.ws + WS_CTL);
    F.tid = threadIdx.x; F.lane = F.tid & 63; F.wave = __builtin_amdgcn_readfirstlane(F.tid >> 6);
    F.G = gridDim.x; { const int bx = blockIdx.x; F.vcu = (F.G % 8 == 0) ? (bx % 8) * (F.G / 8) + bx / 8 : bx; }
    F.gw = F.vcu * NWAVES + F.wave; F.NGW = F.G * NWAVES;
    for (int i = F.tid; i < (LDS_BYTES - MISC_OFF) / 4; i += NTHREADS) ((LAS unsigned*)(F.lds + MISC_OFF))[i] = 0u;
    __syncthreads();
    XcdBarrier bar = xcd_barrier_post((unsigned*)(F.ctl + CW_BAR), (volatile LAS unsigned*)(F.lds + MISC_OFF) + 8);
#define GRID_BAR() xcd_barrier(bar)
    if (F.tid < 35) ((LAS unsigned long long*)(F.lds + PTAB_OFF))[F.tid] = (unsigned long long)args.in[F.tid];
    __syncthreads();
#define IN(k) in_ptr(F, (k))
    unsigned char* ws = args.ws;
    MoeTab MT; MT.cnt = (const LAS int*)(F.lds + TAB_OFF); MT.mtpref = MT.cnt + 65; MT.hoff = MT.mtpref + 66;

#if EN_P0
    { Frame P = phase_frame(F);
    ln_phase<2>(P, IN(0), nullptr, nullptr, false, MT);
    for (int j = 0; j < 2; ++j) {
        convert_plain(P, IN(1) + (size_t)j * D * 3 * D, D, 3 * D, (bf16*)(ws + WS_WQKV) + (size_t)j * 3 * D * D, 0);
        convert_plain(P, IN(2) + (size_t)j * D * D, D, D, (bf16*)(ws + WS_WOA) + (size_t)j * D * D, 0);
        for (int s = 0; s < 3; ++s) convert_plain(P, IN(5) + ((size_t)j * 3 + s) * D * D, D, D, (bf16*)(ws + WS_WRKV) + (size_t)j * 3 * D * D, s * D);
        convert_plain(P, IN(22) + (size_t)j * D * D, D, D, (bf16*)(ws + WS_WOB) + (size_t)j * D * D, 0);
        bf16* L1 = (bf16*)(ws + WS_L1) + (size_t)j * 4 * 256 * D; bf16* L2 = (bf16*)(ws + WS_L2) + (size_t)j * 4 * D * 256;
        convert_small(P, IN(7) + (size_t)j * D * 64, D, 64, L1, 256, D);
        convert_small(P, IN(10) + (size_t)j * D * 64, D, 64, L1 + 256 * D, 256, D);
        convert_small(P, IN(15) + (size_t)j * D * 160, D, 160, L1 + 2 * 256 * D, 256, D);
        convert_small(P, IN(8) + (size_t)j * 64 * D, 64, D, L2, D, 256);
        convert_small(P, IN(11) + (size_t)j * 64 * D, 64, D, L2 + D * 256, D, 256);
        convert_small(P, IN(16) + (size_t)j * 160 * D, 160, D, L2 + 2 * D * 256, D, 256);
        if (j == 1) { convert_small(P, IN(13), D, 32, L1 + 3 * 256 * D, 256, D); convert_small(P, IN(14), 32, D, L2 + 3 * D * 256, D, 256); }
    }
    for (int i = 0; i < DEPTH; ++i) convert_small(P, IN(23) + (size_t)i * D * NE, D, NE, (bf16*)(ws + WS_WR) + (size_t)i * 256 * D, 256, D);
    }
#endif
    GRID_BAR();

#define PH_BEGIN { Frame P = phase_frame(F);
#define PH_END } GRID_BAR();
    for (int i = 0; i < DEPTH; ++i) {
        const int j = i >> 1;
        if ((i & 1) == 0) {
            PH_BEGIN
#if EN_QKV
              SchedDense S{T / 256, 12, P.G, (int)blockIdx.x, D, (const char*)(ws + WS_XB), (const char*)(ws + WS_WQKV) + (size_t)j * 3 * D * D * 2};
              EpiQKV E{(bf16*)(ws + WS_Q), (bf16*)(ws + WS_K), (bf16*)(ws + WS_VT)};
              pg8::gemm_phase<D>(P.lds, P.tid, S, E);
#endif
            PH_END
            PH_BEGIN
#if EN_KMEAN
            kmean_phase(P);
#endif
            PH_END
            PH_BEGIN
#if EN_SEL
            sel_phase(P);
#endif
            PH_END
            PH_BEGIN
#if EN_ATTN
            attn_phase(P, IN(3));
#endif
            PH_END
            PH_BEGIN
#if EN_OPA
              SchedDense S{T / 256, 4, P.G, (int)blockIdx.x, D, (const char*)(ws + WS_O), (const char*)(ws + WS_WOA) + (size_t)j * D * D * 2};
              EpiAdd E{P.out};
              pg8::gemm_phase<D>(P.lds, P.tid, S, E);
#endif
            PH_END
        } else {
            const size_t voff = (j == 0 ? WS_VF : WS_V);
            PH_BEGIN
#if EN_MIX
            mix_phase(P, IN(4) + (size_t)j * 6 * D);
#endif
            PH_END
            PH_BEGIN
#if EN_RKV
              SchedRkv S{T / 256, j == 0 ? 15 : 16, P.G, (int)blockIdx.x, (const char*)(ws + WS_XMIX), (const char*)(ws + WS_WRKV) + (size_t)j * 3 * D * D * 2, (const char*)(ws + WS_L1) + (size_t)j * 4 * 256 * D * 2};
              EpiRkv E{ws, voff};
              pg8::gemm_phase<D>(P.lds, P.tid, S, E);
#endif
            PH_END
            PH_BEGIN
#if EN_L2
              SchedL2 S{T / 256, j == 0 ? 12 : 16, P.G, (int)blockIdx.x, (const char*)(ws + WS_HL), (const char*)(ws + WS_L2) + (size_t)j * 4 * D * 256 * 2};
              EpiL2 E{(float*)(ws + WS_LW), (bf16*)(ws + WS_A), (bf16*)(ws + WS_G), (bf16*)(ws + voff), (const bf16*)(ws + WS_VF), IN(6) + j * D, IN(9) + j * D, IN(12)};
              pg8::gemm_phase<256>(P.lds, P.tid, S, E);
#endif
            PH_END
            PH_BEGIN
#if EN_SCAN
#ifdef DBG_SCAN_COPY
            { const bf16* vb_ = (const bf16*)(ws + voff); float* ys_ = (float*)(ws + WS_YS); for (size_t q = (size_t)P.gw * 64 + P.lane; q < (size_t)T * D; q += (size_t)P.NGW * 64) ys_[q] = bf1(vb_[q]); }
#else
            scan_phase(P, (const bf16*)(ws + voff), IN(17) + j * D, IN(18) + j * D);
#endif
#endif
            PH_END
            PH_BEGIN
#if EN_POST
#ifdef DBG_POST_COPY
            { const v4u* s_ = (const v4u*)(ws + WS_A); v4u* d_ = (v4u*)(ws + WS_YG); for (size_t q = (size_t)P.gw * 64 + P.lane; q < (size_t)T * D / 8; q += (size_t)P.NGW * 64) d_[q] = s_[q]; }
#else
            post_phase(P, (const bf16*)(ws + voff), IN(18) + j * D, IN(19) + j * D, IN(20) + j * D, IN(21) + j * D);
#endif
#endif
            PH_END
            PH_BEGIN
#if EN_OPB
              SchedDense S{T / 256, 4, P.G, (int)blockIdx.x, D, (const char*)(ws + WS_YG), (const char*)(ws + WS_WOB) + (size_t)j * D * D * 2};
              EpiAdd E{P.out};
              pg8::gemm_phase<D>(P.lds, P.tid, S, E);
#endif
            PH_END
        }
        PH_BEGIN
#if EN_LN1
        ln_phase<0>(P, P.out, IN(31) + i * D, IN(32) + i * D, false, MT);
#endif
#if EN_CVT
        convert_moe(P, IN(25) + (size_t)i * NE * D * DE, IN(26) + (size_t)i * NE * D * DE, IN(27) + (size_t)i * NE * DE * D, IN(28) + (size_t)i * D * DE, IN(29) + (size_t)i * D * DE, IN(30) + (size_t)i * DE * D);
#endif
        PH_END
        PH_BEGIN
#if EN_ROUTER
          SchedDense S{T / 256, 1, P.G, (int)blockIdx.x, D, (const char*)(ws + WS_XB), (const char*)(ws + WS_WR) + (size_t)i * 256 * D * 2};
          EpiLogits E{(float*)(ws + WS_LOGITS)};
          pg8::gemm_phase<D>(P.lds, P.tid, S, E);
#endif
        PH_END
        PH_BEGIN
#if EN_ROUTE
        route_phase(P, i, IN(24) + i * NE);
#endif
        PH_END
        PH_BEGIN
        moe_tables(P, i);
#if EN_G1
          SchedMoe1 S{P.G, P.vcu, MT, (const char*)(ws + WS_XB), (const char*)(ws + WS_WGU), (const int*)(ws + WS_TOKLIST)};
          EpiSwiglu E{(bf16*)(ws + WS_H)};
          pg8::gemm_phase<D>(P.lds, P.tid, S, E);
#endif
        PH_END
        PH_BEGIN
#if EN_G2
          SchedMoe2 S{P.G, P.vcu, MT, (const char*)(ws + WS_H), (const char*)(ws + WS_WD)};
          EpiMoeDown E{(bf16*)(ws + WS_Y), P.out};
          pg8::gemm_phase<DE>(P.lds, P.tid, S, E);
#endif
        PH_END
        { Frame P = phase_frame(F);
#if EN_LN2
        ln_phase<1>(P, P.out, IN(33) + i * D, IN(34) + i * D, i == DEPTH - 1, MT);
#endif
        }
        if (i + 1 < DEPTH) GRID_BAR();
    }
#undef IN
#undef GRID_BAR
}

extern "C" void kernel_launch(void* const* d_in, const int* in_sizes, int n_in, void* d_out, int out_size, void* d_ws, size_t ws_size, hipStream_t stream) {
    static int grid = 0;
    if (grid == 0) {
        if (n_in != 35 || out_size != T * D || ws_size < WS_END) { fprintf(stderr, "kernel_launch: unexpected shapes (n_in %d, out %d, ws %zu)\n", n_in, out_size, ws_size); grid = -1; return; }
        int dev = 0, cus = 0, per_cu = 0;
        if (hipGetDevice(&dev) != hipSuccess || hipDeviceGetAttribute(&cus, hipDeviceAttributeMultiprocessorCount, dev) != hipSuccess) { grid = -1; return; }
        if (hipFuncSetAttribute((const void*)fwd_kernel, hipFuncAttributeMaxDynamicSharedMemorySize, LDS_BYTES) != hipSuccess) { fprintf(stderr, "kernel_launch: hipFuncSetAttribute failed\n"); grid = -1; return; }
        if (hipOccupancyMaxActiveBlocksPerMultiprocessor(&per_cu, (const void*)fwd_kernel, NTHREADS, LDS_BYTES) != hipSuccess || per_cu < 1) { fprintf(stderr, "kernel_launch: occupancy query says %d\n", per_cu); }
        (void)hipGetLastError();
        grid = cus;
    }
    if (grid < 0) return;
    if (hipMemsetAsync((char*)d_ws + WS_CTL, 0, CTL_ZERO_BYTES, stream) != hipSuccess) return;
    Args a{};
    for (int i = 0; i < 35; ++i) a.in[i] = (const float*)d_in[i];
    a.out = (float*)d_out; a.ws = (unsigned char*)d_ws;
    hipLaunchKernelGGL(fwd_kernel, dim3(grid), dim3(NTHREADS), LDS_BYTES, stream, a);
}
```

```cpp
#include <hip/hip_runtime.h>
#include <cstdio>
#include <cstdint>

#define GAS __attribute__((address_space(1)))
#define LAS __attribute__((address_space(3)))
typedef unsigned short bf16;
typedef unsigned v4u __attribute__((ext_vector_type(4)));
typedef unsigned v2u __attribute__((ext_vector_type(2)));
typedef float f32x4 __attribute__((ext_vector_type(4)));
typedef float f32x2 __attribute__((ext_vector_type(2)));
typedef short bf16x8 __attribute__((ext_vector_type(8)));
typedef short bf16x4 __attribute__((ext_vector_type(4)));

#ifndef EN_DEFAULT
#define EN_DEFAULT 1
#endif
#ifndef REP_SCAN
#define REP_SCAN 1
#endif
#ifndef EN_SCANB
#define EN_SCANB EN_DEFAULT
#endif
#ifndef REP_SCANB
#define REP_SCANB 1
#endif
#ifndef REP_ATTN
#define REP_ATTN 1
#endif
#ifndef REP_G1
#define REP_G1 1
#endif
#ifndef REP_G2
#define REP_G2 1
#endif
#ifndef REP_CVT
#define REP_CVT 1
#endif
#ifndef REP_MIX
#define REP_MIX 1
#endif
#ifndef REP_QKV
#define REP_QKV 1
#endif
#ifndef EN_P0
#define EN_P0 EN_DEFAULT
#endif
#ifndef EN_QKV
#define EN_QKV EN_DEFAULT
#endif
#ifndef EN_KMEAN
#define EN_KMEAN EN_DEFAULT
#endif
#ifndef EN_SEL
#define EN_SEL EN_DEFAULT
#endif
#ifndef EN_ATTN
#define EN_ATTN EN_DEFAULT
#endif
#ifndef EN_OPA
#define EN_OPA EN_DEFAULT
#endif
#ifndef EN_MIX
#define EN_MIX EN_DEFAULT
#endif
#ifndef EN_RKV
#define EN_RKV EN_DEFAULT
#endif
#ifndef EN_L2
#define EN_L2 EN_DEFAULT
#endif
#ifndef EN_SCAN
#define EN_SCAN EN_DEFAULT
#endif
#ifndef EN_POST
#define EN_POST EN_DEFAULT
#endif
#ifndef EN_OPB
#define EN_OPB EN_DEFAULT
#endif
#ifndef EN_LN1
#define EN_LN1 EN_DEFAULT
#endif
#ifndef EN_CVT
#define EN_CVT EN_DEFAULT
#endif
#ifndef EN_ROUTER
#define EN_ROUTER EN_DEFAULT
#endif
#ifndef EN_ROUTE
#define EN_ROUTE EN_DEFAULT
#endif
#ifndef EN_G1
#define EN_G1 EN_DEFAULT
#endif
#ifndef EN_G2
#define EN_G2 EN_DEFAULT
#endif
#ifndef EN_LN2
#define EN_LN2 EN_DEFAULT
#endif
constexpr int D = 1024, NBATCH = 8, SEQ = 4096, T = NBATCH * SEQ, NH = 16, HD = 64, DEPTH = 4;
constexpr int NE = 64, TOPK = 8, DE = 256, NEX = NE + 1;
constexpr int MBLK = 256, NMB = SEQ / MBLK;
constexpr float ALPHA = 1.6817928305074290f;
constexpr float LN_EPS = 1e-5f, GN_EPS = 64e-5f;
constexpr int NWAVES = 8, NTHREADS = 512;

constexpr size_t MiB = 1u << 20;
constexpr size_t WS_CTL = 0, CTL_ZERO_BYTES = 1 * MiB;
constexpr size_t WS_WR = 1 * MiB;
constexpr size_t WS_KMEAN = 3 * MiB;
constexpr size_t WS_MASK = 4 * MiB;
constexpr size_t WS_TSEL = 5 * MiB;
constexpr size_t WS_WQKV = 8 * MiB;
constexpr size_t WS_WOA = 20 * MiB;
constexpr size_t WS_WRKV = 24 * MiB;
constexpr size_t WS_WOB = 36 * MiB;
constexpr size_t WS_L1 = 40 * MiB;
constexpr size_t WS_L2 = 44 * MiB;
constexpr size_t WS_WGU = 48 * MiB;
constexpr size_t WS_WD = 113 * MiB;
constexpr size_t WS_XB = 146 * MiB;
constexpr size_t WS_VF = 210 * MiB;
constexpr size_t WS_S = 274 * MiB;
constexpr size_t WS_LOGITS = WS_S;
constexpr size_t WS_TOKLIST = WS_S + 8 * MiB;
constexpr size_t WS_H = WS_S + 16 * MiB;
constexpr size_t WS_Y = WS_S + 168 * MiB;
constexpr size_t WS_Q = WS_S, WS_K = WS_S + 64 * MiB, WS_VT = WS_S + 128 * MiB, WS_O = WS_S + 192 * MiB;
constexpr size_t WS_XMIX = WS_S;
constexpr size_t WS_R = WS_S + 384 * MiB, WS_KK = WS_S + 448 * MiB, WS_V = WS_S + 512 * MiB;
constexpr size_t WS_HL = WS_S + 576 * MiB;
constexpr size_t WS_LW = WS_S;
constexpr size_t WS_A = WS_S + 128 * MiB, WS_G = WS_S + 192 * MiB;
constexpr size_t WS_YS = WS_S + 256 * MiB;
constexpr size_t WS_YG = WS_S + 640 * MiB;
constexpr size_t WS_END = 1024 * MiB;
static_assert(WS_Y + (size_t)278528 * 2048 <= WS_END && WS_YG + 64 * MiB <= WS_END, "d_ws map");

constexpr int CW_TMO = 0;
constexpr int CW_BAR = 4096;
constexpr int CW_CNT = 8192;

constexpr int RING_BYTES = 131072;
constexpr int MISC_OFF = RING_BYTES;
constexpr int TAB_OFF = MISC_OFF + 256;
constexpr int PTAB_OFF = MISC_OFF + 2048;
constexpr int LDS_BYTES = 147456;

#define RLX_AGENT __ATOMIC_RELAXED, __HIP_MEMORY_SCOPE_AGENT
#define LDS_WAIT() asm volatile("s_waitcnt lgkmcnt(0)" ::: "memory")
#define VM_WAIT() asm volatile("s_waitcnt vmcnt(0)" ::: "memory")
typedef float f32x2_t_ __attribute__((ext_vector_type(2))); typedef __bf16 bf16x2_t_ __attribute__((ext_vector_type(2)));
__device__ __forceinline__ unsigned cvt_pk_bf16(float lo, float hi) { const f32x2_t_ v = {lo, hi}; const bf16x2_t_ b = __builtin_convertvector(v, bf16x2_t_); return __builtin_bit_cast(unsigned, b); }
__device__ __forceinline__ float bflo(unsigned w) { return __uint_as_float(w << 16); }
__device__ __forceinline__ float bfhi(unsigned w) { return __uint_as_float(w & 0xffff0000u); }
__device__ __forceinline__ float bf1(bf16 b) { return __uint_as_float(((unsigned)b) << 16); }
__device__ __forceinline__ float fast_exp(float x) { return __builtin_amdgcn_exp2f(x * 1.4426950408889634f); }
__device__ __forceinline__ float fast_rcp(float x) { return __builtin_amdgcn_rcpf(x); }
__device__ __forceinline__ float sigmoidf_(float x) { return fast_rcp(1.0f + fast_exp(-x)); }
__device__ __forceinline__ float wave_sum(float v) {
#pragma unroll
    for (int o = 1; o < 64; o <<= 1) v += __shfl_xor(v, o);
    return v;
}
template <int CTRL> __device__ __forceinline__ float dpp_add(float v) {
    const int t = __builtin_amdgcn_update_dpp(0, __float_as_int(v), CTRL, 0xf, 0xf, true);
    return v + __int_as_float(t);
}
__device__ __forceinline__ float reduce16(float v) {
    v = dpp_add<0xB1>(v); v = dpp_add<0x4E>(v); v = dpp_add<0x141>(v); v = dpp_add<0x140>(v);
    return v;
}
__device__ const unsigned char T5_BUCKET[129] = {
    0, 1, 2, 3, 4, 5, 6, 7, 8, 9, 10, 11, 12, 13, 14, 15, 16, 16, 16, 17, 17, 18, 18, 18, 19, 19, 19, 20, 20, 20, 20, 21, 21, 21, 21, 22, 22, 22, 22, 22, 23, 23, 23, 23, 23, 23, 24, 24, 24,
    24, 24, 24, 25, 25, 25, 25, 25, 25, 25, 26, 26, 26, 26, 26, 26, 26, 26, 27, 27, 27, 27, 27, 27, 27, 27, 27, 27, 28, 28, 28, 28, 28, 28, 28, 28, 28, 28, 29, 29, 29, 29, 29, 29, 29, 29, 29, 29,
    29, 29, 30, 30, 30, 30, 30, 30, 30, 30, 30, 30, 30, 30, 30, 30, 31, 31, 31, 31, 31, 31, 31, 31, 31, 31, 31, 31, 31, 31, 31, 31};

namespace pg8 {
constexpr int BM = 256, BK = 64, HALF = 128, HTB = HALF * BK * 2, STAGE_BYTES = 8 * HTB, NXCD = 8, WGM = 8;
__host__ __device__ __forceinline__ int lds_byte(int r, int c) { const int st = (r >> 4) * 2 + (c >> 5), rr = r & 15, cc = c & 31, ob = rr * 64 + cc * 2; return st * 1024 + (ob ^ (((ob >> 9) & 1) << 5)); }
__host__ __device__ __forceinline__ void stage_rc(int b, int& R, int& C) { const int st = b / 1024, sb = b % 1024, swz = sb ^ (((sb >> 9) & 1) << 5); R = (st >> 1) * 16 + swz / 64; C = (st & 1) * 32 + (swz % 64) / 2; }
__host__ __device__ __forceinline__ int perm32(int rho) { const int n = rho >> 4, i = rho & 15; return 8 * (i >> 2) + 4 * n + (i & 3); }

struct Unit { int pm, pn, e, nvalid, arow0, orow0; const int* gidx; };

__device__ __forceinline__ bool static_tile(int i, int G, int c, int nM, int nN, int& pm, int& pn) {
    const int nwg = nM * nN; const long L = (long)i * G + c; if (L >= nwg) return false;
    int wgid = (int)L; { const int q = nwg / NXCD, r = nwg % NXCD, xcd = wgid % NXCD, off = wgid / NXCD; wgid = (xcd < r ? xcd * (q + 1) : r * (q + 1) + (xcd - r) * q) + off; }
    const int nig = WGM * nN, gid = wgid / nig, fm = gid * WGM, gsz = (nM - fm) < WGM ? (nM - fm) : WGM;
    pm = fm + ((wgid % nig) % gsz); pn = (wgid % nig) / gsz; return true;
}

template <int K, class Epi, class Sched>
__device__ __forceinline__ void gemm_phase(LAS unsigned char* lds, const int tid, const Sched& S, const Epi& E) {
    constexpr bool GA = Sched::GATHER;
    const int wid = __builtin_amdgcn_readfirstlane(tid >> 6), lane = tid & 63, wr = wid >> 2, wc = wid & 3, fr = lane & 15, fq = lane >> 4;
    constexpr int nt = K / BK;
    unsigned voffA[2], voffB[2];
#pragma unroll
    for (int i = 0; i < 2; ++i) { int R, C; stage_rc(tid * 16 + i * 8192, R, C); const int Rb = Epi::PERM ? ((R & ~31) + perm32(R & 31)) : R;
        voffA[i] = (unsigned)(R * K + C) * 2u; voffB[i] = (unsigned)(Rb * K + C) * 2u; }
    const size_t kstep = (size_t)(BK * 2);
    const size_t hstep = (size_t)HALF * K * 2;
    const unsigned rowb = (unsigned)K * 2u;
    const unsigned ldsw = (unsigned)wid * 1024u;
    const int aoff = lds_byte(wr * 64 + fr, fq * 8), boff = lds_byte(wc * 32 + fr, fq * 8);
#define PG8_SA(b, h) (((b) * 2 + (h)) * HTB)
#define PG8_SB(b, h) ((4 + (b) * 2 + (h)) * HTB)
#define PG8_STAGE(bufoff, gbase, voff) do { _Pragma("unroll") for (int _i = 0; _i < 2; ++_i) \
        __builtin_amdgcn_global_load_lds((const unsigned*)((const char*)(gbase) + (voff)[_i]), (LAS unsigned*)(lds + (bufoff) + ldsw + _i * 8192), 16, 0, 0); } while (0)
#define PG8_STAGE_A(bufoff, p, h, O) do { if constexpr (GA) { PG8_STAGE(bufoff, p, O[h]); } else { PG8_STAGE(bufoff, (p) + (h) * hstep, voffA); } } while (0)
#define PG8_LDA(dst, b, h) do { _Pragma("unroll") for (int m = 0; m < 4; ++m) _Pragma("unroll") for (int k = 0; k < 2; ++k) dst[m][k] = *(const LAS bf16x8*)(lds + PG8_SA(b, h) + aoff + m * 2048 + k * 1024); } while (0)
#define PG8_LDB(dst, b, h) do { _Pragma("unroll") for (int n = 0; n < 2; ++n) _Pragma("unroll") for (int k = 0; k < 2; ++k) dst[n][k] = *(const LAS bf16x8*)(lds + PG8_SB(b, h) + boff + n * 2048 + k * 1024); } while (0)
#define PG8_MMA(ai, bj, At, Bt) do { __builtin_amdgcn_s_setprio(1); _Pragma("unroll") for (int m = 0; m < 4; ++m) _Pragma("unroll") for (int n = 0; n < 2; ++n) _Pragma("unroll") for (int k = 0; k < 2; ++k) \
        acc[ai][bj][m][n] = __builtin_amdgcn_mfma_f32_16x16x32_bf16(Bt[n][k], At[m][k], acc[ai][bj][m][n], 0, 0, 0); __builtin_amdgcn_s_setprio(0); } while (0)
#define PG8_WAIT_V(n) asm volatile("s_waitcnt vmcnt(" #n ")" ::: "memory")
#define PG8_WAIT_L(n) asm volatile("s_waitcnt lgkmcnt(" #n ")" ::: "memory")
#define PG8_BAR __builtin_amdgcn_s_barrier()
#define PG8_SCHED __builtin_amdgcn_sched_barrier(0)
#define PG8_OFFS(u, o) do { if constexpr (GA) { _Pragma("unroll") for (int _h = 0; _h < 2; ++_h) _Pragma("unroll") for (int _i = 0; _i < 2; ++_i) { int R_, C_; stage_rc(tid * 16 + _i * 8192, R_, C_); \
        o[_h][_i] = (unsigned)S.a_row(u, _h * HALF + R_) * rowb + (unsigned)C_ * 2u; } } } while (0)
#define PG8_TRIP(a1, a2, b2, O1, O2) do { const char* a3 = (a2) + kstep; const char* b3 = (b2) + kstep; \
            PG8_LDB(B0, 0, 0); PG8_LDB(B1, 0, 1); PG8_SCHED; PG8_LDA(At, 0, 0); PG8_STAGE_A(PG8_SA(1, 1), a1, 1, O1); \
            PG8_WAIT_V(8); PG8_WAIT_L(0); PG8_BAR; PG8_MMA(0, 0, At, B0); PG8_MMA(0, 1, At, B1); PG8_BAR; PG8_SCHED; \
            PG8_LDA(At, 0, 1); PG8_STAGE(PG8_SB(0, 0), b2, voffB); PG8_STAGE(PG8_SB(0, 1), (b2) + hstep, voffB); PG8_STAGE_A(PG8_SA(0, 0), a2, 0, O2); \
            PG8_WAIT_V(8); PG8_WAIT_L(0); PG8_BAR; PG8_MMA(1, 0, At, B0); PG8_MMA(1, 1, At, B1); PG8_BAR; PG8_SCHED; \
            PG8_LDB(B0, 1, 0); PG8_LDB(B1, 1, 1); PG8_SCHED; PG8_LDA(At, 1, 0); PG8_STAGE_A(PG8_SA(0, 1), a2, 1, O2); \
            PG8_WAIT_V(8); PG8_WAIT_L(0); PG8_BAR; PG8_MMA(0, 0, At, B0); PG8_MMA(0, 1, At, B1); PG8_BAR; PG8_SCHED; \
            PG8_LDA(At, 1, 1); PG8_STAGE(PG8_SB(1, 0), b3, voffB); PG8_STAGE(PG8_SB(1, 1), b3 + hstep, voffB); PG8_STAGE_A(PG8_SA(1, 0), a3, 0, O2); \
            PG8_WAIT_V(8); PG8_WAIT_L(0); PG8_BAR; PG8_MMA(1, 0, At, B0); PG8_MMA(1, 1, At, B1); PG8_BAR; PG8_SCHED; } while (0)
    Unit cur, nxt; int ui = 0;
    if (!S.next(0, cur)) return;
    f32x4 acc[2][2][4][2];
#pragma unroll
    for (int a = 0; a < 2; ++a)
#pragma unroll
        for (int b = 0; b < 2; ++b)
#pragma unroll
            for (int m = 0; m < 4; ++m)
#pragma unroll
                for (int n = 0; n < 2; ++n) acc[a][b][m][n] = (f32x4){0.f, 0.f, 0.f, 0.f};
    bf16x8 At[4][2], B0[2][2], B1[2][2];
    unsigned cOff[2][2], nOff[2][2];
    PG8_OFFS(cur, cOff);
    const char* cA = S.a_tile(cur); const char* cB = S.b_tile(cur);
    PG8_STAGE(PG8_SB(0, 0), cB, voffB); PG8_STAGE(PG8_SB(0, 1), cB + hstep, voffB); PG8_STAGE_A(PG8_SA(0, 0), cA, 0, cOff); PG8_STAGE_A(PG8_SA(0, 1), cA, 1, cOff);
    if (wr == 1) PG8_BAR;
    PG8_WAIT_V(2); PG8_BAR;
    PG8_STAGE(PG8_SB(1, 0), cB + kstep, voffB); PG8_STAGE_A(PG8_SA(1, 0), cA + kstep, 0, cOff); PG8_STAGE(PG8_SB(1, 1), cB + hstep + kstep, voffB);
    PG8_WAIT_V(6); PG8_BAR;
    for (;;) {
        const bool has_next = S.next(ui + 1, nxt);
        const char* nA = cA; const char* nB = cB;
        if constexpr (GA) {
#pragma unroll
            for (int h = 0; h < 2; ++h)
#pragma unroll
                for (int i = 0; i < 2; ++i) nOff[h][i] = cOff[h][i]; }
        if (has_next) { PG8_OFFS(nxt, nOff); nA = S.a_tile(nxt); nB = S.b_tile(nxt); }
_Pragma("nounroll")
        for (int t = 0; t < nt; t += 2) { const bool last = (t == nt - 2);
            const char* a2 = last ? nA : cA + (size_t)(t + 2) * kstep; const char* b2 = last ? nB : cB + (size_t)(t + 2) * kstep;
            if constexpr (GA) { unsigned o2[2][2];
#pragma unroll
                for (int h = 0; h < 2; ++h)
#pragma unroll
                    for (int i = 0; i < 2; ++i) o2[h][i] = last ? nOff[h][i] : cOff[h][i];
                PG8_TRIP(cA + (size_t)(t + 1) * kstep, a2, b2, cOff, o2);
            } else { PG8_TRIP(cA + (size_t)(t + 1) * kstep, a2, b2, cOff, cOff); } }
        if (wr == 0) PG8_BAR;
        PG8_SCHED; E(acc, cur, wr, wc, fr, fq); PG8_SCHED;
        if (!has_next) break;
#pragma unroll
        for (int a = 0; a < 2; ++a)
#pragma unroll
            for (int b = 0; b < 2; ++b)
#pragma unroll
                for (int m = 0; m < 4; ++m)
#pragma unroll
                    for (int n = 0; n < 2; ++n) acc[a][b][m][n] = (f32x4){0.f, 0.f, 0.f, 0.f};
        cur = nxt; cA = nA; cB = nB; ++ui;
        if constexpr (GA) {
#pragma unroll
            for (int h = 0; h < 2; ++h)
#pragma unroll
                for (int i = 0; i < 2; ++i) cOff[h][i] = nOff[h][i]; }
        if (wr == 1) PG8_BAR;
    }
    PG8_WAIT_V(0);
    PG8_BAR;
#undef PG8_SA
#undef PG8_SB
#undef PG8_STAGE
#undef PG8_STAGE_A
#undef PG8_LDA
#undef PG8_LDB
#undef PG8_MMA
#undef PG8_WAIT_V
#undef PG8_WAIT_L
#undef PG8_BAR
#undef PG8_SCHED
#undef PG8_OFFS
#undef PG8_TRIP
}
}
using pg8::Unit;
typedef f32x4 AccT[2][2][4][2];

struct SchedDense {
    int nM, nN, G, c, K; const char* A; const char* Bt;
    __device__ __forceinline__ bool next(int i, Unit& u) const { int pm, pn; if (!pg8::static_tile(i, G, c, nM, nN, pm, pn)) return false;
        u.pm = pm; u.pn = pn; u.e = 0; u.nvalid = 256; u.arow0 = pm * 256; u.orow0 = pm * 256; u.gidx = nullptr; return true; }
    static constexpr bool GATHER = false;
    __device__ __forceinline__ const char* a_tile(const Unit& u) const { return A + (size_t)u.arow0 * K * 2; }
    __device__ __forceinline__ const char* b_tile(const Unit& u) const { return Bt + (size_t)u.pn * 256 * K * 2; }
    __device__ __forceinline__ int a_row(const Unit& u, int r) const { return u.arow0 + r; }
};
struct SchedRkv {
    int nM, nN, G, c; const char* xmix; const char* Wrkv; const char* L1;
    __device__ __forceinline__ bool next(int i, Unit& u) const { int pm, pn; if (!pg8::static_tile(i, G, c, nM, nN, pm, pn)) return false;
        u.pm = pm; u.pn = pn; u.e = 0; u.nvalid = 256; u.arow0 = pm * 256; u.orow0 = pm * 256; u.gidx = nullptr; return true; }
    static constexpr bool GATHER = false;
    __device__ __forceinline__ const char* a_tile(const Unit& u) const { const int grp = u.pn < 12 ? (u.pn >> 2) : (u.pn == 15 ? 2 : u.pn - 9); return xmix + ((size_t)grp * T + u.arow0) * D * 2; }
    __device__ __forceinline__ const char* b_tile(const Unit& u) const { return u.pn < 12 ? Wrkv + (size_t)u.pn * 256 * D * 2 : L1 + (size_t)(u.pn - 12) * 256 * D * 2; }
    __device__ __forceinline__ int a_row(const Unit& u, int r) const { return u.arow0 + r; }
};
struct SchedL2 {
    int nM, nN, G, c; const char* hl; const char* L2;
    __device__ __forceinline__ bool next(int i, Unit& u) const { int pm, pn; if (!pg8::static_tile(i, G, c, nM, nN, pm, pn)) return false;
        u.pm = pm; u.pn = pn & 3; u.e = pn >> 2; u.nvalid = 256; u.arow0 = pm * 256; u.orow0 = pm * 256; u.gidx = nullptr; return true; }
    static constexpr bool GATHER = false;
    __device__ __forceinline__ const char* a_tile(const Unit& u) const { return hl + ((size_t)u.e * T + u.arow0) * 256 * 2; }
    __device__ __forceinline__ const char* b_tile(const Unit& u) const { return L2 + ((size_t)u.e * 1024 + (size_t)u.pn * 256) * 256 * 2; }
    __device__ __forceinline__ int a_row(const Unit& u, int r) const { return u.arow0 + r; }
};
struct MoeTab { const LAS int* cnt; const LAS int* mtpref; const LAS int* hoff; };
__device__ __forceinline__ int moe_find_expert(const MoeTab& M, int m) { int e = 0;
_Pragma("nounroll")
    for (int k = 1; k < NEX; ++k) e = (M.mtpref[k] <= m) ? k : e;
    return __builtin_amdgcn_readfirstlane(e); }
struct SchedMoe1 {
    int G, c; MoeTab M; const char* xb; const char* Wgu; const int* toklist;
    __device__ __forceinline__ bool next(int i, Unit& u) const { const long L = (long)i * G + c; const int nun = M.mtpref[NEX] * 2; if (L >= nun) return false;
        const int m = (int)(L >> 1), e = moe_find_expert(M, m), mt = m - M.mtpref[e];
        u.pm = mt; u.pn = (int)(L & 1); u.e = e; u.arow0 = mt * 256; u.orow0 = M.hoff[e] + mt * 256;
        if (e < NE) { const int left = M.cnt[e] - mt * 256; u.nvalid = left < 256 ? left : 256; u.gidx = toklist + (size_t)e * T + mt * 256; } else { u.nvalid = 256; u.gidx = nullptr; }
        return true; }
    static constexpr bool GATHER = true;
    __device__ __forceinline__ const char* a_tile(const Unit&) const { return xb; }
    __device__ __forceinline__ const char* b_tile(const Unit& u) const { return Wgu + ((size_t)u.e * 512 + (size_t)u.pn * 256) * D * 2; }
    __device__ __forceinline__ int a_row(const Unit& u, int r) const { if (u.gidx) return r < u.nvalid ? u.gidx[r] : 0; return u.arow0 + r; }
};
struct SchedMoe2 {
    int G, c; MoeTab M; const char* hb; const char* Wd;
    __device__ __forceinline__ bool next(int i, Unit& u) const { const long L = (long)i * G + c; const int nun = M.mtpref[NEX] * 4; if (L >= nun) return false;
        const int m = (int)(L >> 2), e = moe_find_expert(M, m), mt = m - M.mtpref[e];
        u.pm = mt; u.pn = (int)(L & 3); u.e = e; u.nvalid = 256; u.arow0 = M.hoff[e] + mt * 256; u.orow0 = (e < NE) ? (M.hoff[e] + mt * 256) : mt * 256; u.gidx = nullptr; return true; }
    static constexpr bool GATHER = false;
    __device__ __forceinline__ const char* a_tile(const Unit& u) const { return hb + (size_t)u.arow0 * 256 * 2; }
    __device__ __forceinline__ const char* b_tile(const Unit& u) const { return Wd + ((size_t)u.e * 1024 + (size_t)u.pn * 256) * 256 * 2; }
    __device__ __forceinline__ int a_row(const Unit& u, int r) const { return u.arow0 + r; }
};

#define EPI_ARGS const AccT& acc, const Unit& u, int wr, int wc, int fr, int fq
struct EpiQKV { static constexpr bool PERM = true; bf16* Q; bf16* Kb; bf16* Vt;
    __device__ __forceinline__ void operator()(EPI_ARGS) const {
        const int row0 = u.orow0 + wr * 64 + fr, sec = u.pn >> 2, col0 = (u.pn & 3) * 256 + wc * 32 + 8 * fq;
        if (sec < 2) { bf16* base = sec == 0 ? Q : Kb; const float sc = sec == 0 ? 0.18033688011112042f : 1.0f;
#pragma unroll
            for (int ai = 0; ai < 2; ++ai)
#pragma unroll
                for (int m = 0; m < 4; ++m) { bf16* rowp = base + (size_t)(row0 + ai * 128 + m * 16) * D + col0;
#pragma unroll
                    for (int bj = 0; bj < 2; ++bj) { const f32x4 v0 = acc[ai][bj][m][0] * sc, v1 = acc[ai][bj][m][1] * sc; v4u w;
                        w.x = cvt_pk_bf16(v0[0], v0[1]); w.y = cvt_pk_bf16(v0[2], v0[3]); w.z = cvt_pk_bf16(v1[0], v1[1]); w.w = cvt_pk_bf16(v1[2], v1[3]); *(v4u*)(rowp + bj * 128) = w; } }
        } else {
#pragma unroll
            for (int ai = 0; ai < 2; ++ai)
#pragma unroll
                for (int m = 0; m < 4; ++m) { const int r = row0 + ai * 128 + m * 16, b = r >> 12, s = r & 4095;
#pragma unroll
                    for (int bj = 0; bj < 2; ++bj)
#pragma unroll
                        for (int n = 0; n < 2; ++n) { const f32x4 v = acc[ai][bj][m][n];
#pragma unroll
                            for (int j = 0; j < 4; j += 2) { const int c = col0 + bj * 128 + 4 * n + j, h = c >> 6, d = c & 63; const unsigned w = cvt_pk_bf16(v[j], v[j + 1]);
                                bf16* p = Vt + ((((size_t)(b * NH + h) * HD + d)) << 12) + s; p[0] = (bf16)(w & 0xffffu); p[SEQ] = (bf16)(w >> 16); } } }
        }
    }
};
struct EpiAdd { static constexpr bool PERM = false; float* out;
    __device__ __forceinline__ void operator()(EPI_ARGS) const {
        const int row0 = u.orow0 + wr * 64 + fr, col0 = u.pn * 256 + wc * 32 + 4 * fq;
#pragma unroll
        for (int ai = 0; ai < 2; ++ai)
#pragma unroll
            for (int m = 0; m < 4; ++m) { float* rowp = out + (size_t)(row0 + ai * 128 + m * 16) * D + col0;
#pragma unroll
                for (int bj = 0; bj < 2; ++bj)
#pragma unroll
                    for (int n = 0; n < 2; ++n) { f32x4* p = (f32x4*)(rowp + bj * 128 + n * 16); *p = *p + acc[ai][bj][m][n]; } }
    }
};
struct EpiLogits { static constexpr bool PERM = false; float* lg;
    __device__ __forceinline__ void operator()(EPI_ARGS) const {
        if (wc >= 2) return;
        const int row0 = u.orow0 + wr * 64 + fr, col0 = wc * 32 + 4 * fq;
#pragma unroll
        for (int ai = 0; ai < 2; ++ai)
#pragma unroll
            for (int m = 0; m < 4; ++m) { float* rowp = lg + (size_t)(row0 + ai * 128 + m * 16) * NE + col0;
#pragma unroll
                for (int n = 0; n < 2; ++n) *(f32x4*)(rowp + n * 16) = acc[ai][0][m][n]; }
    }
};
struct EpiSwiglu { static constexpr bool PERM = true; bf16* hb; bool dry;
    __device__ __forceinline__ void operator()(EPI_ARGS) const {
        const int row0 = u.orow0 + wr * 64 + fr, col0 = u.pn * 128 + wc * 32 + 8 * fq;
#pragma unroll
        for (int ai = 0; ai < 2; ++ai)
#pragma unroll
            for (int m = 0; m < 4; ++m) { bf16* rowp = hb + (size_t)(row0 + ai * 128 + m * 16) * DE + col0; float o[8];
#pragma unroll
                for (int n = 0; n < 2; ++n)
#pragma unroll
                    for (int j = 0; j < 4; ++j) { const float g = acc[ai][0][m][n][j], up = acc[ai][1][m][n][j]; o[4 * n + j] = g * sigmoidf_(g) * up; }
                v4u w; w.x = cvt_pk_bf16(o[0], o[1]); w.y = cvt_pk_bf16(o[2], o[3]); w.z = cvt_pk_bf16(o[4], o[5]); w.w = cvt_pk_bf16(o[6], o[7]); if (!dry) *(v4u*)rowp = w; }
    }
};
struct EpiMoeDown { static constexpr bool PERM = true; bf16* yb; float* out; bool dry;
    __device__ __forceinline__ void operator()(EPI_ARGS) const {
        const int row0 = u.orow0 + wr * 64 + fr, col0 = u.pn * 256 + wc * 32 + 8 * fq;
        if (dry) return;
        if (u.e < NE) {
#pragma unroll
            for (int ai = 0; ai < 2; ++ai)
#pragma unroll
                for (int m = 0; m < 4; ++m) { bf16* rowp = yb + (size_t)(row0 + ai * 128 + m * 16) * D + col0;
#pragma unroll
                    for (int bj = 0; bj < 2; ++bj) { const f32x4 v0 = acc[ai][bj][m][0], v1 = acc[ai][bj][m][1]; v4u w;
                        w.x = cvt_pk_bf16(v0[0], v0[1]); w.y = cvt_pk_bf16(v0[2], v0[3]); w.z = cvt_pk_bf16(v1[0], v1[1]); w.w = cvt_pk_bf16(v1[2], v1[3]); *(v4u*)(rowp + bj * 128) = w; } }
        } else {
#pragma unroll
            for (int ai = 0; ai < 2; ++ai)
#pragma unroll
                for (int m = 0; m < 4; ++m) { float* rowp = out + (size_t)(row0 + ai * 128 + m * 16) * D + col0;
#pragma unroll
                    for (int bj = 0; bj < 2; ++bj)
#pragma unroll
                        for (int n = 0; n < 2; ++n) { f32x4* p = (f32x4*)(rowp + bj * 128 + 4 * n); *p = *p + acc[ai][bj][m][n]; } }
        }
    }
};
struct EpiRkv { static constexpr bool PERM = true; unsigned char* ws; size_t voff;
    __device__ __forceinline__ void operator()(EPI_ARGS) const {
        const int row0 = u.orow0 + wr * 64 + fr;
        size_t boff; int ldc, colt, act = 0;
        if (u.pn < 12) { const int sec = u.pn >> 2; boff = WS_R; if (sec == 1) boff = WS_KK; if (sec == 2) boff = voff; ldc = D; colt = (u.pn & 3) * 256; }
        else { const int kind = u.pn - 12; boff = WS_HL + (size_t)kind * T * 256 * 2; ldc = 256; colt = 0; act = kind == 0 ? 1 : (kind == 2 ? 2 : 0); }
        bf16* base = (bf16*)(ws + boff);
        const int col0 = colt + wc * 32 + 8 * fq;
#pragma unroll
        for (int ai = 0; ai < 2; ++ai)
#pragma unroll
            for (int m = 0; m < 4; ++m) { bf16* rowp = base + (size_t)(row0 + ai * 128 + m * 16) * ldc + col0;
#pragma unroll
                for (int bj = 0; bj < 2; ++bj) { f32x4 v0 = acc[ai][bj][m][0], v1 = acc[ai][bj][m][1];
                    if (act == 1) {
#pragma unroll
                        for (int j = 0; j < 4; ++j) { v0[j] = 1.0f - 2.0f * fast_rcp(fast_exp(2.0f * v0[j]) + 1.0f); v1[j] = 1.0f - 2.0f * fast_rcp(fast_exp(2.0f * v1[j]) + 1.0f); } }
                    if (act == 2) {
#pragma unroll
                        for (int j = 0; j < 4; ++j) { v0[j] = sigmoidf_(v0[j]); v1[j] = sigmoidf_(v1[j]); } }
                    v4u w; w.x = cvt_pk_bf16(v0[0], v0[1]); w.y = cvt_pk_bf16(v0[2], v0[3]); w.z = cvt_pk_bf16(v1[0], v1[1]); w.w = cvt_pk_bf16(v1[2], v1[3]); *(v4u*)(rowp + bj * 128) = w; } }
    }
};
struct EpiL2 { static constexpr bool PERM = true; float* lw; bf16* ab; bf16* gb; bf16* vb; const bf16* vf; const float* w0; const float* a0; const float* v0;
    __device__ __forceinline__ void operator()(EPI_ARGS) const {
        const int row0 = u.orow0 + wr * 64 + fr, col0 = u.pn * 256 + wc * 32 + 8 * fq, kind = u.e;
#pragma unroll
        for (int ai = 0; ai < 2; ++ai)
#pragma unroll
            for (int m = 0; m < 4; ++m) { const size_t ro = (size_t)(row0 + ai * 128 + m * 16) * D + col0;
#pragma unroll
                for (int bj = 0; bj < 2; ++bj) { const size_t o = ro + bj * 128; const int c = col0 + bj * 128; float x[8];
#pragma unroll
                    for (int n = 0; n < 2; ++n)
#pragma unroll
                        for (int j = 0; j < 4; ++j) x[4 * n + j] = acc[ai][bj][m][n][j];
                    if (kind == 0) { const f32x4 b0 = *(const f32x4*)(w0 + c), b1 = *(const f32x4*)(w0 + c + 4); f32x4 r0, r1;
#pragma unroll
                        for (int j = 0; j < 8; ++j) { const float z = x[j] + (j < 4 ? b0[j & 3] : b1[j & 3]);
                            const float wl = fminf(z, 0.0f) - __logf(1.0f + fast_exp(-fabsf(z))) - 0.5f; const float v = -fast_exp(wl); if (j < 4) r0[j & 3] = v; else r1[j & 3] = v; }
                        *(f32x4*)(lw + o) = r0; *(f32x4*)(lw + o + 4) = r1;
                    } else if (kind == 1) { const f32x4 b0 = *(const f32x4*)(a0 + c), b1 = *(const f32x4*)(a0 + c + 4);
#pragma unroll
                        for (int j = 0; j < 8; ++j) x[j] = sigmoidf_(x[j] + (j < 4 ? b0[j & 3] : b1[j & 3]));
                        v4u w; w.x = cvt_pk_bf16(x[0], x[1]); w.y = cvt_pk_bf16(x[2], x[3]); w.z = cvt_pk_bf16(x[4], x[5]); w.w = cvt_pk_bf16(x[6], x[7]); *(v4u*)(ab + o) = w;
                    } else if (kind == 2) {
                        v4u w; w.x = cvt_pk_bf16(x[0], x[1]); w.y = cvt_pk_bf16(x[2], x[3]); w.z = cvt_pk_bf16(x[4], x[5]); w.w = cvt_pk_bf16(x[6], x[7]); *(v4u*)(gb + o) = w;
                    } else { const f32x4 b0 = *(const f32x4*)(v0 + c), b1 = *(const f32x4*)(v0 + c + 4); const v4u vv = *(const v4u*)(vb + o), ff = *(const v4u*)(vf + o); float y[8];
#pragma unroll
                        for (int j = 0; j < 8; ++j) { const unsigned wv = vv[j >> 1], wf = ff[j >> 1]; const float v = (j & 1) ? bfhi(wv) : bflo(wv), f = (j & 1) ? bfhi(wf) : bflo(wf);
                            const float gt = sigmoidf_(x[j] + (j < 4 ? b0[j & 3] : b1[j & 3])); y[j] = v + (f - v) * gt; }
                        v4u w; w.x = cvt_pk_bf16(y[0], y[1]); w.y = cvt_pk_bf16(y[2], y[3]); w.z = cvt_pk_bf16(y[4], y[5]); w.w = cvt_pk_bf16(y[6], y[7]); *(v4u*)(vb + o) = w; }
                } }
    }
};

typedef GAS unsigned gu32;
#define XB_TMO      128
#define XB_XCNT(j)  (256  + 64 * (j))
#define XB_XSUB(j)  (1280 + 64 * (j))
#define XB_XGEN(j)  (2304 + 64 * (j))
#define XB_TOP      3328
#define XB_TOPGEN   3392
#define XCD_BAR_WORDS 3456
#define XB_SPIN_CAP (1u << 23)
__device__ __forceinline__ unsigned xb_ld(unsigned* p)              { return __hip_atomic_load(p, __ATOMIC_RELAXED, __HIP_MEMORY_SCOPE_AGENT); }
__device__ __forceinline__ unsigned xb_add(unsigned* p, unsigned v) { return __hip_atomic_fetch_add(p, v, __ATOMIC_RELAXED, __HIP_MEMORY_SCOPE_AGENT); }
__device__ __forceinline__ unsigned xb_xcc_id() { return (unsigned)__builtin_amdgcn_s_getreg((3 << 11) | 20) & 0xFu; }
#define XB_SPIN(cond, bar) do { unsigned _sp = 0; while (cond) { __builtin_amdgcn_s_sleep(1); \
    if ((++_sp & 255u) == 0u) { if (xb_ld(&(bar)[XB_TMO])) break; if (_sp > XB_SPIN_CAP) { atomicAdd(&(bar)[XB_TMO], 1u); break; } } } } while (0)
struct XcdBarrier { unsigned* bar; unsigned x; volatile LAS unsigned* st; };
__device__ __forceinline__ XcdBarrier xcd_barrier_post(unsigned* bar, volatile LAS unsigned* st) {
    XcdBarrier b; b.bar = bar; b.x = xb_xcc_id(); b.st = st;
    if (threadIdx.x == 0) (void)xb_add(&bar[XB_XCNT(b.x)], 1u);
    return b;
}
__device__ __forceinline__ void xcd_barrier_complete(unsigned* bar, unsigned x, unsigned& nloc, unsigned& nx) {
    const unsigned G = gridDim.x * gridDim.y * gridDim.z;
    unsigned sum, cnt, mine, sp = 0u;
    for (;;) {
        sum = 0u; cnt = 0u; mine = 0u;
#pragma unroll
        for (unsigned j = 0; j < 16; ++j) { const unsigned c = xb_ld(&bar[XB_XCNT(j)]); sum += c; cnt += (c > 0u) ? 1u : 0u; mine = (j == x) ? c : mine; }
        if (sum == G) break;
        __builtin_amdgcn_s_sleep(1);
        if ((++sp & 255u) == 0u) { if (xb_ld(&bar[XB_TMO])) break; if (sp > XB_SPIN_CAP) { atomicAdd(&bar[XB_TMO], 1u); break; } }
    }
    nloc = mine > 0u ? mine : 1u; nx = cnt > 0u ? cnt : 1u;
}
__device__ __forceinline__ void xcd_barrier(const XcdBarrier& b) {
    asm volatile("s_waitcnt vmcnt(0)" ::: "memory");
    __syncthreads();
    if (threadIdx.x == 0) {
        unsigned long long bp = (unsigned long long)b.bar; unsigned bx = b.x;
        asm volatile("" : "+s"(bp), "+s"(bx));
        unsigned* bar = (unsigned*)(GAS unsigned*)bp;
        __builtin_amdgcn_s_waitcnt(0);
        unsigned nloc = b.st[0], nx = b.st[1];
        if (nloc == 0u) { xcd_barrier_complete(bar, bx, nloc, nx); b.st[0] = nloc; b.st[1] = nx; }
        const unsigned old = xb_add(&bar[XB_XSUB(bx)], 1u);
        const unsigned gen = old / nloc;
        if (old + 1u == (gen + 1u) * nloc) {
            __builtin_amdgcn_fence(__ATOMIC_RELEASE, "agent");
            asm volatile("s_waitcnt vmcnt(0)" ::: "memory");
            const unsigned og = xb_add(&bar[XB_TOP], 1u);
            const unsigned tg = og / nx;
            if (og + 1u == (tg + 1u) * nx) xb_add(&bar[XB_TOPGEN], 1u);
            else XB_SPIN(xb_ld(&bar[XB_TOPGEN]) == tg, bar);
            __builtin_amdgcn_fence(__ATOMIC_ACQUIRE, "agent");
            xb_add(&bar[XB_XGEN(bx)], 1u);
            asm volatile("s_waitcnt vmcnt(0)" ::: "memory");
        } else {
            XB_SPIN(xb_ld(&bar[XB_XGEN(bx)]) == gen, bar);
            __builtin_amdgcn_fence(__ATOMIC_ACQUIRE, "agent");
            asm volatile("s_waitcnt vmcnt(0)" ::: "memory");
        }
    }
    __syncthreads();
}

struct Args { const float* in[35]; float* out; unsigned char* ws; };
struct Frame {
    LAS unsigned char* lds; gu32* ctl; unsigned char* ws; float* out;
    int tid, lane, wave, vcu, G, gw, NGW;
};

__device__ __forceinline__ Frame phase_frame(const Frame& F) {
    Frame P = F; int lane; asm volatile("v_mbcnt_lo_u32_b32 %0, -1, 0\n\tv_mbcnt_hi_u32_b32 %0, -1, %0" : "=v"(lane)); int wave = F.wave;
    asm volatile("" : "+v"(lane), "+s"(wave)); P.lane = lane; P.wave = wave; P.tid = wave * 64 + lane; P.gw = P.vcu * NWAVES + wave; return P;
}
__device__ __forceinline__ const float* in_ptr(const Frame& F, int k) {
    const unsigned long long v = ((const LAS unsigned long long*)(F.lds + PTAB_OFF))[k];
    const unsigned lo = (unsigned)__builtin_amdgcn_readfirstlane((int)(unsigned)v), hi = (unsigned)__builtin_amdgcn_readfirstlane((int)(unsigned)(v >> 32));
    return (const float*)(GAS const float*)(((unsigned long long)hi << 32) | lo);
}
__device__ __forceinline__ void transpose_item(const float* W, int N, int k0, int n0, bf16* WT, size_t orow, int ldk, LAS float* scr, int lane) {
#pragma unroll 8
    for (int i = 0; i < 32; ++i) { const int kk = 2 * i + (lane >> 5); scr[kk * 33 + (lane & 31)] = W[(size_t)(k0 + kk) * N + n0 + (lane & 31)]; }
    LDS_WAIT(); asm volatile("" ::: "memory");
    const int c = lane & 7;
#pragma unroll
    for (int j = 0; j < 4; ++j) { const int n = (lane >> 3) + 8 * j; const LAS float* s = scr + (8 * c) * 33 + n;
        v4u o; o.x = cvt_pk_bf16(s[0 * 33], s[1 * 33]); o.y = cvt_pk_bf16(s[2 * 33], s[3 * 33]); o.z = cvt_pk_bf16(s[4 * 33], s[5 * 33]); o.w = cvt_pk_bf16(s[6 * 33], s[7 * 33]);
        *(v4u*)(WT + (orow + n) * ldk + k0 + 8 * c) = o; }
    LDS_WAIT(); asm volatile("" ::: "memory");
}
__device__ __forceinline__ void convert_plain(Frame& F, const float* W, int K, int N, bf16* WT, int row_off) {
    LAS float* scr = (LAS float*)(F.lds + F.wave * 16384);
    const int nblk = N / 32, nitems = (K / 64) * nblk;
    for (int it = F.gw; it < nitems; it += F.NGW) { const int kb = it / nblk, nb = it % nblk; transpose_item(W, N, 64 * kb, 32 * nb, WT, (size_t)row_off + 32 * nb, K, scr, F.lane); }
}
__device__ __forceinline__ void convert_small(Frame& F, const float* W, int K, int N, bf16* WT, int Np, int Kp) {
    const size_t tot = (size_t)Np * Kp;
    for (size_t i = (size_t)F.gw * 64 + F.lane; i < tot; i += (size_t)F.NGW * 64) { const int n = (int)(i / Kp), k = (int)(i % Kp);
        const float v = (k < K && n < N) ? W[(size_t)k * N + n] : 0.0f; WT[i] = (bf16)(cvt_pk_bf16(v, 0.0f) & 0xffffu); }
}
__device__ __forceinline__ void convert_moe(Frame& F, const float* wg, const float* wu, const float* wd, const float* sg, const float* su, const float* sd) {
    LAS float* scr = (LAS float*)(F.lds + F.wave * 16384);
    bf16* Wgu = (bf16*)(F.ws + WS_WGU); bf16* Wd = (bf16*)(F.ws + WS_WD);
    constexpr int PER = 128;
    const int total = NEX * 3 * PER;
    for (int it = F.gw; it < total; it += F.NGW) {
        const int e = it / (3 * PER), r = it % (3 * PER), which = r / PER, q = r % PER;
        if (which < 2) { const float* W = (e < NE) ? (which == 0 ? wg : wu) + (size_t)e * D * DE : (which == 0 ? sg : su);
            const int kb = q >> 3, nb = q & 7, n0 = 32 * nb; const size_t orow = (size_t)e * 512 + (n0 >> 7) * 256 + which * 128 + (n0 & 127);
            transpose_item(W, DE, 64 * kb, n0, Wgu, orow, D, scr, F.lane);
        } else { const float* W = (e < NE) ? wd + (size_t)e * DE * D : sd;
            const int kb = q >> 5, nb = q & 31, n0 = 32 * nb;
            transpose_item(W, D, 64 * kb, n0, Wd, (size_t)e * 1024 + n0, DE, scr, F.lane); }
    }
}

template <int MODE>
__device__ __forceinline__ void ln_phase(Frame& F, const float* src, const float* g, const float* bsh, bool final, const MoeTab& M) {
    float* out = F.out; bf16* xb = (bf16*)(F.ws + WS_XB);
    const bf16* yb = (const bf16*)(F.ws + WS_Y); const int2* tsel = (const int2*)(F.ws + WS_TSEL);
    f32x4 gv[4], bv[4];
    if (MODE != 2) {
#pragma unroll
        for (int j = 0; j < 4; ++j) { gv[j] = *(const f32x4*)(g + 256 * j + 4 * F.lane); bv[j] = *(const f32x4*)(bsh + 256 * j + 4 * F.lane); } }
    for (int row = F.gw; row < T; row += F.NGW) {
        const f32x4* xr = (const f32x4*)(src + (size_t)row * D) + F.lane;
        f32x4 v[4];
#pragma unroll
        for (int j = 0; j < 4; ++j) v[j] = xr[64 * j];
        if (MODE == 1) {
#pragma unroll
            for (int jj = 0; jj < TOPK; ++jj) { const int2 ts = tsel[(size_t)row * TOPK + jj]; const int e = ts.x >> 20, slot = ts.x & 0xfffff; const float gt = __int_as_float(ts.y);
                const bf16* yp = yb + (size_t)(M.hoff[e] + slot) * D + 4 * F.lane;
#pragma unroll
                for (int j = 0; j < 4; ++j) { const v2u w = *(const v2u*)(yp + 256 * j); v[j][0] += gt * bflo(w.x); v[j][1] += gt * bfhi(w.x); v[j][2] += gt * bflo(w.y); v[j][3] += gt * bfhi(w.y); } }
        }
        f32x4 o[4];
        if (MODE == 2) {
#pragma unroll
            for (int j = 0; j < 4; ++j) o[j] = v[j];
        } else {
            float s = 0.f;
#pragma unroll
            for (int j = 0; j < 4; ++j) s += (v[j][0] + v[j][1]) + (v[j][2] + v[j][3]);
            const float mean = wave_sum(s) * (1.0f / D); float s2 = 0.f;
#pragma unroll
            for (int j = 0; j < 4; ++j) { v[j] = v[j] - mean; s2 += (v[j][0] * v[j][0] + v[j][1] * v[j][1]) + (v[j][2] * v[j][2] + v[j][3] * v[j][3]); }
            const float rstd = 1.0f / sqrtf(wave_sum(s2) * (1.0f / D) + LN_EPS);
#pragma unroll
            for (int j = 0; j < 4; ++j) o[j] = v[j] * rstd * gv[j] + bv[j];
        }
        f32x4* orow = (f32x4*)(out + (size_t)row * D) + F.lane; v2u* brow = (v2u*)(xb + (size_t)row * D) + F.lane;
        const float sc = final ? 1.0f : ALPHA;
#pragma unroll
        for (int j = 0; j < 4; ++j) { orow[64 * j] = o[j] * sc; v2u w; w.x = cvt_pk_bf16(o[j][0], o[j][1]); w.y = cvt_pk_bf16(o[j][2], o[j][3]); brow[64 * j] = w; }
    }
}

__device__ __forceinline__ void moe_tables(Frame& F, int layer) {
    LAS int* cnt = (LAS int*)(F.lds + TAB_OFF); LAS int* mtp = cnt + 65; LAS int* hoff = mtp + 66;
    __syncthreads();
    if (F.tid < NE) cnt[F.tid] = (int)__hip_atomic_load(F.ctl + CW_CNT + (layer * 64 + F.tid) * 64, RLX_AGENT);
    if (F.tid == NE) cnt[NE] = T;
    __syncthreads();
    if (F.tid == 0) { int m = 0;
_Pragma("nounroll")
        for (int e = 0; e < NEX; ++e) { mtp[e] = m; hoff[e] = m * 256; m += (cnt[e] + 255) >> 8; } mtp[NEX] = m; hoff[NEX] = m * 256; }
    __syncthreads();
}

__device__ __forceinline__ void route_phase(Frame& F, int layer, const float* rbias) {
    const float* lg = (const float*)(F.ws + WS_LOGITS); int* toklist = (int*)(F.ws + WS_TOKLIST); int2* tsel = (int2*)(F.ws + WS_TSEL);
    LAS float* sw = (LAS float*)(F.lds + F.wave * 256);
    const float rb = rbias[F.lane];
    for (int row = F.gw; row < T; row += F.NGW) {
        const float sc = sigmoidf_(lg[(size_t)row * NE + F.lane]); const float bz = sc + rb;
        sw[F.lane] = bz; LDS_WAIT();
        float v[64];
#pragma unroll
        for (int q = 0; q < 16; ++q) { const f32x4 t = *(const LAS f32x4*)(sw + 4 * q); v[4 * q] = t[0]; v[4 * q + 1] = t[1]; v[4 * q + 2] = t[2]; v[4 * q + 3] = t[3]; }
        LDS_WAIT();
        float gs[8];
#pragma unroll
        for (int gi = 0; gi < 8; ++gi) { float m1 = -INFINITY, m2 = -INFINITY;
#pragma unroll
            for (int k = 0; k < 8; ++k) { const float x = v[8 * gi + k]; const bool a = x > m1; const float nm2 = a ? m1 : fmaxf(m2, x); m1 = a ? x : m1; m2 = nm2; }
            gs[gi] = m1 + m2; }
        unsigned keep = 0u;
#pragma unroll
        for (int gi = 0; gi < 8; ++gi) { int rank = 0;
#pragma unroll
            for (int g2 = 0; g2 < 8; ++g2) rank += (gs[g2] > gs[gi] || (gs[g2] == gs[gi] && g2 < gi)) ? 1 : 0;
            keep |= (rank < 4) ? (1u << gi) : 0u; }
        const bool kown = (keep >> (F.lane >> 3)) & 1u; int rank = 0;
#pragma unroll
        for (int e2 = 0; e2 < 64; ++e2) { const bool k2 = (keep >> (e2 >> 3)) & 1u; rank += (k2 && (v[e2] > bz || (v[e2] == bz && e2 < F.lane))) ? 1 : 0; }
        const bool sel = kown && rank < TOPK;
        const unsigned long long bal = __ballot(sel);
        const float ssum = wave_sum(sel ? sc : 0.0f);
        if (sel) { const int j = __popcll(bal & ((1ull << F.lane) - 1ull)); const float gate = sc / ssum * 2.5f;
            const unsigned slot = __hip_atomic_fetch_add(F.ctl + CW_CNT + (layer * 64 + F.lane) * 64, 1u, RLX_AGENT);
            toklist[(size_t)F.lane * T + slot] = row;
            if (j < TOPK) tsel[(size_t)row * TOPK + j] = make_int2((F.lane << 20) | (int)slot, __float_as_int(gate)); }
    }
}

__device__ __forceinline__ void mix_phase(Frame& F, const float* mix) {
    bf16* xm = (bf16*)(F.ws + WS_XMIX);
    for (int row = F.gw; row < T; row += F.NGW) {
        const f32x4* xr = (const f32x4*)(F.out + (size_t)row * D) + F.lane; const bool first = (row & (SEQ - 1)) == 0;
#pragma unroll
        for (int j = 0; j < 4; ++j) { const f32x4 x = xr[64 * j] * (1.0f / ALPHA); const f32x4 xp = first ? (f32x4){0.f, 0.f, 0.f, 0.f} : xr[64 * j - 256] * (1.0f / ALPHA); const f32x4 xx = xp - x;
#pragma unroll
            for (int i = 0; i < 6; ++i) { const f32x4 mv = *(const f32x4*)(mix + i * D + 256 * j + 4 * F.lane); const f32x4 o = x + xx * mv;
                v2u w; w.x = cvt_pk_bf16(o[0], o[1]); w.y = cvt_pk_bf16(o[2], o[3]); *((v2u*)(xm + ((size_t)i * T + row) * D) + 64 * j + F.lane) = w; } }
    }
}

__device__ __forceinline__ void kmean_phase(Frame& F) {
    const bf16* Kb = (const bf16*)(F.ws + WS_K); float* km = (float*)(F.ws + WS_KMEAN);
    for (int u = F.gw; u < NBATCH * NH * NMB; u += F.NGW) { const int bh = u >> 4, blk = u & 15, b = bh >> 4, h = bh & 15;
        const bf16* p = Kb + ((size_t)b * SEQ + blk * MBLK) * D + h * HD + F.lane; float s = 0.f;
#pragma unroll 16
        for (int r = 0; r < MBLK; ++r) s += bf1(p[(size_t)r * D]);
        km[(size_t)u * HD + F.lane] = s * (1.0f / MBLK); }
}
__device__ __forceinline__ void sel_phase(Frame& F) {
    const bf16* Q = (const bf16*)(F.ws + WS_Q); const float* km = (const float*)(F.ws + WS_KMEAN); unsigned short* maskb = (unsigned short*)(F.ws + WS_MASK);
    LAS float* kl = (LAS float*)F.lds;
    for (int u = F.vcu; u < NBATCH * NH * (SEQ / NTHREADS); u += F.G) { const int bh = u >> 3, ch = u & 7, b = bh >> 4, h = bh & 15;
        __syncthreads();
        for (int i = F.tid; i < NMB * HD; i += NTHREADS) kl[i] = km[(size_t)bh * NMB * HD + i];
        __syncthreads();
        const int qpos = ch * NTHREADS + F.tid, qblk = qpos >> 8;
        const v4u* qp = (const v4u*)(Q + ((size_t)b * SEQ + qpos) * D + h * HD); float q[64];
#pragma unroll
        for (int i = 0; i < 8; ++i) { const v4u w = qp[i];
#pragma unroll
            for (int k = 0; k < 4; ++k) { q[8 * i + 2 * k] = bflo(w[k]); q[8 * i + 2 * k + 1] = bfhi(w[k]); } }
        float v1 = -INFINITY, v2 = -INFINITY, v3 = -INFINITY; int i1 = -1, i2 = -1, i3 = -1;
        for (int j = 0; j < qblk; ++j) { float gsum = 0.f; const LAS f32x4* kr = (const LAS f32x4*)(kl + j * HD);
#pragma unroll
            for (int i = 0; i < 16; ++i) { const f32x4 kv = kr[i]; gsum += q[4 * i] * kv[0] + q[4 * i + 1] * kv[1] + q[4 * i + 2] * kv[2] + q[4 * i + 3] * kv[3]; }
            if (gsum > v1) { v3 = v2; i3 = i2; v2 = v1; i2 = i1; v1 = gsum; i1 = j; }
            else if (gsum > v2) { v3 = v2; i3 = i2; v2 = gsum; i2 = j; }
            else if (gsum > v3) { v3 = gsum; i3 = j; } }
        unsigned mk = 0u; if (i1 >= 0) mk |= 1u << i1; if (i2 >= 0) mk |= 1u << i2; if (i3 >= 0) mk |= 1u << i3;
        maskb[(size_t)bh * SEQ + qpos] = (unsigned short)mk; }
}
__device__ __forceinline__ float q4_max(float v) {
    auto a = __builtin_amdgcn_permlane16_swap(__float_as_uint(v), __float_as_uint(v), false, false); v = __builtin_fmaxf(__uint_as_float(a[0]), __uint_as_float(a[1]));
    auto b = __builtin_amdgcn_permlane32_swap(__float_as_uint(v), __float_as_uint(v), false, false); return __builtin_fmaxf(__uint_as_float(b[0]), __uint_as_float(b[1])); }
__device__ __forceinline__ float q4_sum(float v) {
    auto a = __builtin_amdgcn_permlane16_swap(__float_as_uint(v), __float_as_uint(v), false, false); v = __uint_as_float(a[0]) + __uint_as_float(a[1]);
    auto b = __builtin_amdgcn_permlane32_swap(__float_as_uint(v), __float_as_uint(v), false, false); return __uint_as_float(b[0]) + __uint_as_float(b[1]); }
__device__ __forceinline__ void attn_phase(Frame& F, const float* rel_bias) {
    const bf16* Q = (const bf16*)(F.ws + WS_Q); const bf16* Kb = (const bf16*)(F.ws + WS_K); const bf16* Vt = (const bf16*)(F.ws + WS_VT); bf16* O = (bf16*)(F.ws + WS_O);
    const unsigned short* maskb = (const unsigned short*)(F.ws + WS_MASK);
    constexpr int KRS = 144, VRS = 272, KB_ = 128 * KRS, TB = KB_ + 64 * VRS;
    LAS float* tbl = (LAS float*)(F.lds + 2 * TB);
    __syncthreads();
    for (int i = F.tid; i < NH * 129; i += NTHREADS) { const int h = i / 129, d = i % 129; tbl[h * 132 + d] = rel_bias[(int)T5_BUCKET[d] * NH + h] * 1.4426950408889634f; }
    __syncthreads();
    const int qi = F.lane & 15, g = F.lane >> 4; unsigned tcount = 0;
    for (int it = 0;; ++it) {
        int bh, blk;
        if (F.G == 256) { if (it >= 8) break; bh = F.vcu >> 1; blk = (F.vcu & 1) ? ((it & 1) ? 15 - it : it + 1) : ((it & 1) ? 16 - it : it); }
        else { const int L = it * F.G + F.vcu; if (L >= NBATCH * NH * NMB) break; bh = L >> 4; blk = L & 15; }
        const int b = bh >> 4, h = bh & 15;
        const int q0 = blk * MBLK + 32 * F.wave;
        bf16x8 qf[2][2]; unsigned qmask[2];
#pragma unroll
        for (int gp = 0; gp < 2; ++gp) { const int qpos = q0 + 16 * gp + qi; const size_t qrow = (size_t)b * SEQ + qpos; qmask[gp] = maskb[(size_t)bh * SEQ + qpos];
#pragma unroll
            for (int ks = 0; ks < 2; ++ks) qf[gp][ks] = *(const bf16x8*)(Q + qrow * D + h * HD + 32 * ks + 8 * g); }
        const LAS float* tblh = tbl + h * 132; const float bfar = tblh[128];
        float mref[2] = {0.f, 0.f}; f32x4 o[2][5];
#pragma unroll
        for (int gp = 0; gp < 2; ++gp)
#pragma unroll
            for (int dt = 0; dt < 5; ++dt) o[gp][dt] = (f32x4){0.f, 0.f, 0.f, 0.f};
        constexpr float THR = 8.0f;
        const bf16x8 ones = {0x3F80, 0x3F80, 0x3F80, 0x3F80, 0x3F80, 0x3F80, 0x3F80, 0x3F80};
        const int nst = 2 + 2 * blk;
        const int kkey = F.tid >> 3, kch = F.tid & 7;
        const int vd = F.tid >> 3, vch = F.tid & 7;
        const bf16* kbase = Kb + ((size_t)b * SEQ + kkey) * D + h * HD + 8 * kch;
        const bf16* vbase = Vt + (((size_t)bh * HD + vd) << 12) + 8 * vch;
        v4u kreg[2], vreg[2];
        { const int key0 = blk * MBLK; kreg[0] = *(const v4u*)(kbase + (size_t)key0 * D); kreg[1] = *(const v4u*)(kbase + (size_t)(key0 + 64) * D); vreg[0] = *(const v4u*)(vbase + key0); vreg[1] = *(const v4u*)(vbase + key0 + 64); }
        for (int n = 0; n < nst; ++n) {
            int jb, key0; if (n < 2) { jb = blk; key0 = blk * MBLK + 128 * n; } else { const int mm = n - 2; jb = blk - 1 - (mm >> 1); key0 = jb * MBLK + 128 * (mm & 1); }
            LAS unsigned char* buf = F.lds + (tcount & 1u) * TB; ++tcount;
            *(LAS v4u*)(buf + kkey * KRS + kch * 16) = kreg[0]; *(LAS v4u*)(buf + (kkey + 64) * KRS + kch * 16) = kreg[1];
            *(LAS v4u*)(buf + KB_ + vd * VRS + vch * 16) = vreg[0]; *(LAS v4u*)(buf + KB_ + vd * VRS + (vch + 8) * 16) = vreg[1];
            asm volatile("s_waitcnt lgkmcnt(0)" ::: "memory");
            if (n + 1 < nst) { const int n1 = n + 1; int k1; if (n1 < 2) k1 = blk * MBLK + 128 * n1; else { const int mm = n1 - 2; k1 = (blk - 1 - (mm >> 1)) * MBLK + 128 * (mm & 1); }
                kreg[0] = *(const v4u*)(kbase + (size_t)k1 * D); kreg[1] = *(const v4u*)(kbase + (size_t)(k1 + 64) * D); vreg[0] = *(const v4u*)(vbase + k1); vreg[1] = *(const v4u*)(vbase + k1 + 64); }
            asm volatile("s_barrier" ::: "memory");
            const bool own = (jb == blk), nearb = (jb >= blk - 1);
            if (own && 128 * n > 32 * F.wave + 31) continue;
            f32x4 s[2][8]; bool selb[2];
#pragma unroll
            for (int gp = 0; gp < 2; ++gp) { selb[gp] = (qmask[gp] >> jb) & 1u; const float c0 = (n == 0) ? 0.0f : (nearb ? -mref[gp] : (selb[gp] ? bfar - mref[gp] : -INFINITY));
#pragma unroll
                for (int kt = 0; kt < 8; ++kt) s[gp][kt] = (f32x4){c0, c0, c0, c0}; }
#pragma unroll
            for (int kt = 0; kt < 8; ++kt)
#pragma unroll
                for (int ks = 0; ks < 2; ++ks) { const bf16x8 a = *(const LAS bf16x8*)(buf + (16 * kt + qi) * KRS + 64 * ks + 16 * g);
                    s[0][kt] = __builtin_amdgcn_mfma_f32_16x16x32_bf16(a, qf[0][ks], s[0][kt], 0, 0, 0); s[1][kt] = __builtin_amdgcn_mfma_f32_16x16x32_bf16(a, qf[1][ks], s[1][kt], 0, 0, 0);
                    }
#pragma unroll
            for (int gp = 0; gp < 2; ++gp) {
                float mx = -INFINITY;
                if (nearb) {
                    const int qpos = q0 + 16 * gp + qi; const int dist0 = qpos - (key0 + 4 * g);
#pragma unroll
                    for (int kh = 0; kh < 4; ++kh) { float bz[2][4];
#pragma unroll
                        for (int k4 = 0; k4 < 2; ++k4)
#pragma unroll
                            for (int r = 0; r < 4; ++r) { const int dist = dist0 - (16 * (2 * kh + k4) + r); const int dd = dist < 0 ? 0 : (dist > 128 ? 128 : dist); bz[k4][r] = tblh[dd]; }
#pragma unroll
                        for (int k4 = 0; k4 < 2; ++k4) asm volatile("" : "+v"(bz[k4][0]), "+v"(bz[k4][1]), "+v"(bz[k4][2]), "+v"(bz[k4][3]));
#pragma unroll
                        for (int k4 = 0; k4 < 2; ++k4)
#pragma unroll
                            for (int r = 0; r < 4; ++r) { const int kt = 2 * kh + k4; const int dist = dist0 - (16 * kt + r);
                                const bool valid = own ? (dist >= 0) : selb[gp]; const float x = valid ? s[gp][kt][r] + bz[k4][r] : -INFINITY; s[gp][kt][r] = x; mx = __builtin_fmaxf(mx, x); } }
                } else {
#pragma unroll
                    for (int kt = 0; kt < 8; ++kt)
#pragma unroll
                        for (int r = 0; r < 4; ++r) mx = __builtin_fmaxf(mx, s[gp][kt][r]); }
                mx = q4_max(mx);
                if (n == 0) {
                    mref[gp] = mx;
#pragma unroll
                    for (int kt = 0; kt < 8; ++kt)
#pragma unroll
                        for (int r = 0; r < 4; ++r) s[gp][kt][r] -= mx;
                } else if (__any(mx > THR)) {
                    const float dl = __builtin_fmaxf(mx, 0.0f), f = __builtin_amdgcn_exp2f(-dl); mref[gp] += dl;
#pragma unroll
                    for (int kt = 0; kt < 8; ++kt)
#pragma unroll
                        for (int r = 0; r < 4; ++r) s[gp][kt][r] -= dl;
#pragma unroll
                    for (int dt = 0; dt < 5; ++dt) o[gp][dt] = o[gp][dt] * f; }
#pragma unroll
                for (int kt = 0; kt < 8; ++kt)
#pragma unroll
                    for (int r = 0; r < 4; ++r) s[gp][kt][r] = __builtin_amdgcn_exp2f(s[gp][kt][r]);
            }
#pragma unroll
            for (int k2 = 0; k2 < 4; ++k2) { bf16x8 pb[2][4];
#pragma unroll
                for (int gp = 0; gp < 2; ++gp) { v4u pw; pw.x = cvt_pk_bf16(s[gp][2 * k2][0], s[gp][2 * k2][1]); pw.y = cvt_pk_bf16(s[gp][2 * k2][2], s[gp][2 * k2][3]);
                    pw.z = cvt_pk_bf16(s[gp][2 * k2 + 1][0], s[gp][2 * k2 + 1][1]); pw.w = cvt_pk_bf16(s[gp][2 * k2 + 1][2], s[gp][2 * k2 + 1][3]); pb[gp][k2] = __builtin_bit_cast(bf16x8, pw); }
#pragma unroll
                for (int dt = 0; dt < 4; ++dt) { const LAS unsigned char* vp = buf + KB_ + (16 * dt + qi) * VRS + 64 * k2 + 8 * g; const v2u lo = *(const LAS v2u*)vp, hi = *(const LAS v2u*)(vp + 32);
                    v4u aw; aw.x = lo.x; aw.y = lo.y; aw.z = hi.x; aw.w = hi.y; const bf16x8 av = __builtin_bit_cast(bf16x8, aw);
                    o[0][dt] = __builtin_amdgcn_mfma_f32_16x16x32_bf16(av, pb[0][k2], o[0][dt], 0, 0, 0); o[1][dt] = __builtin_amdgcn_mfma_f32_16x16x32_bf16(av, pb[1][k2], o[1][dt], 0, 0, 0); }
                o[0][4] = __builtin_amdgcn_mfma_f32_16x16x32_bf16(ones, pb[0][k2], o[0][4], 0, 0, 0); o[1][4] = __builtin_amdgcn_mfma_f32_16x16x32_bf16(ones, pb[1][k2], o[1][4], 0, 0, 0); }
        }
#pragma unroll
        for (int gp = 0; gp < 2; ++gp) { const float inv = 1.0f / o[gp][4][0]; const size_t qrow = (size_t)b * SEQ + q0 + 16 * gp + qi;
#pragma unroll
            for (int dt = 0; dt < 4; ++dt) { v2u w; w.x = cvt_pk_bf16(o[gp][dt][0] * inv, o[gp][dt][1] * inv); w.y = cvt_pk_bf16(o[gp][dt][2] * inv, o[gp][dt][3] * inv); *(v2u*)(O + qrow * D + h * HD + 16 * dt + 4 * g) = w; } }
    }
    __syncthreads();
}

constexpr int SC = 32, NCHK = SEQ / SC;
constexpr size_t WS_PT = WS_S + 256 * MiB;
constexpr size_t WS_LT = 48 * MiB;
constexpr size_t WS_QT = WS_S + 576 * MiB;
constexpr size_t WS_YS2 = WS_S;
static_assert(WS_LT + 128 * MiB <= WS_VF && WS_QT + 64 * MiB <= WS_YG, "chunk operator buffers");
__device__ __forceinline__ float reduce8(float v) { v = dpp_add<0xB1>(v); v = dpp_add<0x4E>(v); v = dpp_add<0x141>(v); return v; }
template <int KS> __device__ __forceinline__ f32x4 mm_tile(const LAS unsigned char* X, int xs, int m0, const LAS unsigned char* Y, int ys, int n0, f32x4 acc, int qi, int g) {
#pragma unroll
    for (int ks = 0; ks < KS; ++ks) { const bf16x8 a = *(const LAS bf16x8*)(X + (m0 + qi) * xs + 64 * ks + 16 * g), b = *(const LAS bf16x8*)(Y + (n0 + qi) * ys + 64 * ks + 16 * g);
        acc = __builtin_amdgcn_mfma_f32_16x16x32_bf16(a, b, acc, 0, 0, 0); }
    return acc;
}
__device__ __forceinline__ v2u pack4(const f32x4 v) { v2u w; w.x = cvt_pk_bf16(v[0], v[1]); w.y = cvt_pk_bf16(v[2], v[3]); return w; }
__device__ __forceinline__ void chunk_prep(Frame& F, const bf16* vbuf, const float* k_k, const float* k_a, const bool dry = false) {
    const bf16* rb = (const bf16*)(F.ws + WS_R); const bf16* kb = (const bf16*)(F.ws + WS_KK); const bf16* ab = (const bf16*)(F.ws + WS_A); const float* lw = (const float*)(F.ws + WS_LW);
    bf16* PTg = (bf16*)(F.ws + WS_PT); bf16* QTg = (bf16*)(F.ws + WS_QT); bf16* LTg = (bf16*)(F.ws + WS_LT); float* ys = (float*)(F.ws + WS_YS2);
    constexpr int RS = 144, TS_ = 80;
    constexpr int O_AT = 0, O_BT = 4608, O_KT = 9216, O_RT = 13824, O_ATT = 18432, O_BTT = 23552, O_VTT = 28672, O_X2T = 33792, O_GT = 38912,
                  O_TM = 44032, O_NRBT = 46592, O_NAK = 49152, O_X1T = 51712, O_HT = 54272, O_NAB = 56832, O_WC = 61440, O_CL = O_X2T;
    const int grp = F.wave >> 2, wg = F.wave & 3;
    LAS unsigned char* L = F.lds + grp * 65536;
    const int gt0 = F.tid & 255, st0 = gt0 >> 3, c80 = gt0 & 7;
    constexpr int NIT = (NBATCH * NH * NCHK) / (2 * 256);
    v4u pre_r, pre_k, pre_a, pre_v; f32x4 pre_l0, pre_l1;
#define CP_LOAD(it_) do { const int item_ = ((it_) * F.G + F.vcu) * 2 + grp, bh_ = item_ >> 7, ck_ = item_ & (NCHK - 1); \
        const size_t o_ = ((size_t)(bh_ >> 4) * SEQ + ck_ * SC + st0) * D + (bh_ & 15) * HD + 8 * c80; \
        pre_r = *(const v4u*)(rb + o_); pre_k = *(const v4u*)(kb + o_); pre_a = *(const v4u*)(ab + o_); pre_v = *(const v4u*)(vbuf + o_); pre_l0 = *(const f32x4*)(lw + o_); pre_l1 = *(const f32x4*)(lw + o_ + 4); } while (0)
    CP_LOAD(0);
    for (int it = 0; it < NIT; ++it) {
        const int item = (it * F.G + F.vcu) * 2 + grp, bh = item >> 7, ck = item & (NCHK - 1), b = bh >> 4, h = bh & 15, t0 = ck * SC;
        const size_t base = ((size_t)b * SEQ + t0) * D + h * HD;
        int lane_i = F.lane; asm volatile("" : "+v"(lane_i));
        const int gt = (wg << 6) | lane_i, qi = lane_i & 15, g = lane_i >> 4, st = gt >> 3, c8 = gt & 7;
        __syncthreads();
        float r8[8], al8[8], be8[8], kh8[8], v8[8];
        { const v4u wr_ = pre_r, wk = pre_k, wa = pre_a, wv = pre_v;
          const f32x4 l0 = pre_l0, l1 = pre_l1;
          const f32x4 kk0 = *(const f32x4*)(k_k + h * HD + 8 * c8), kk1 = *(const f32x4*)(k_k + h * HD + 8 * c8 + 4), ka0 = *(const f32x4*)(k_a + h * HD + 8 * c8), ka1 = *(const f32x4*)(k_a + h * HD + 8 * c8 + 4);
          float k8[8], a8[8], kk8[8]; float ss = 0.f;
#pragma unroll
          for (int j = 0; j < 8; ++j) { const unsigned xr = wr_[j >> 1], xk = wk[j >> 1], xa = wa[j >> 1], xv = wv[j >> 1];
              r8[j] = (j & 1) ? bfhi(xr) : bflo(xr); k8[j] = (j & 1) ? bfhi(xk) : bflo(xk); a8[j] = (j & 1) ? bfhi(xa) : bflo(xa); v8[j] = (j & 1) ? bfhi(xv) : bflo(xv);
              kk8[j] = k8[j] * (j < 4 ? kk0[j & 3] : kk1[j & 3]); ss += kk8[j] * kk8[j]; }
          ss = reduce8(ss); const float inv = 1.0f / fmaxf(sqrtf(ss), 1e-12f);
#pragma unroll
          for (int j = 0; j < 8; ++j) { const float kk = kk8[j] * inv; al8[j] = -kk; be8[j] = kk * a8[j]; kh8[j] = k8[j] * (1.0f + (a8[j] - 1.0f) * (j < 4 ? ka0[j & 3] : ka1[j & 3])); }
          *(LAS f32x4*)(L + O_CL + (st * 64 + 8 * c8) * 4) = l0; *(LAS f32x4*)(L + O_CL + (st * 64 + 8 * c8 + 4) * 4) = l1; }
        __syncthreads();
        if (gt < 64) { float cv[SC];
#pragma unroll
            for (int t = 0; t < SC; ++t) cv[t] = *(const LAS float*)(L + O_CL + (t * 64 + gt) * 4);
#pragma unroll
            for (int t = 1; t < SC; ++t) cv[t] += cv[t - 1];
#pragma unroll
            for (int t = 0; t < SC; ++t) *(LAS float*)(L + O_CL + (t * 64 + gt) * 4) = cv[t];
            *(LAS float*)(L + O_WC + gt * 4) = fast_exp(cv[SC - 1]); }
        __syncthreads();
        { float cl[8], cm[8];
          { const f32x4 c0 = *(const LAS f32x4*)(L + O_CL + (st * 64 + 8 * c8) * 4), c1 = *(const LAS f32x4*)(L + O_CL + (st * 64 + 8 * c8 + 4) * 4);
            f32x4 m0 = {0.f, 0.f, 0.f, 0.f}, m1 = {0.f, 0.f, 0.f, 0.f};
            if (st > 0) { m0 = *(const LAS f32x4*)(L + O_CL + ((st - 1) * 64 + 8 * c8) * 4); m1 = *(const LAS f32x4*)(L + O_CL + ((st - 1) * 64 + 8 * c8 + 4) * 4); }
#pragma unroll
            for (int j = 0; j < 4; ++j) { cl[j] = c0[j]; cl[4 + j] = c1[j]; cm[j] = m0[j]; cm[4 + j] = m1[j]; } }
          float at8[8], bt8[8], kt8[8], rt8[8];
#pragma unroll
          for (int j = 0; j < 8; ++j) { const float e1 = fast_exp(cl[j]), em = fast_exp(cm[j]), en = fast_exp(-cl[j]); at8[j] = al8[j] * em; bt8[j] = be8[j] * en; kt8[j] = kh8[j] * en; rt8[j] = r8[j] * e1; }
          __syncthreads();
          v4u w; w.x = cvt_pk_bf16(at8[0], at8[1]); w.y = cvt_pk_bf16(at8[2], at8[3]); w.z = cvt_pk_bf16(at8[4], at8[5]); w.w = cvt_pk_bf16(at8[6], at8[7]); *(LAS v4u*)(L + O_AT + st * RS + 16 * c8) = w;
          w.x = cvt_pk_bf16(bt8[0], bt8[1]); w.y = cvt_pk_bf16(bt8[2], bt8[3]); w.z = cvt_pk_bf16(bt8[4], bt8[5]); w.w = cvt_pk_bf16(bt8[6], bt8[7]); *(LAS v4u*)(L + O_BT + st * RS + 16 * c8) = w;
          w.x = cvt_pk_bf16(kt8[0], kt8[1]); w.y = cvt_pk_bf16(kt8[2], kt8[3]); w.z = cvt_pk_bf16(kt8[4], kt8[5]); w.w = cvt_pk_bf16(kt8[6], kt8[7]); *(LAS v4u*)(L + O_KT + st * RS + 16 * c8) = w;
          w.x = cvt_pk_bf16(rt8[0], rt8[1]); w.y = cvt_pk_bf16(rt8[2], rt8[3]); w.z = cvt_pk_bf16(rt8[4], rt8[5]); w.w = cvt_pk_bf16(rt8[6], rt8[7]); *(LAS v4u*)(L + O_RT + st * RS + 16 * c8) = w;
#pragma unroll
          for (int j = 0; j < 8; ++j) { const int ch = 8 * c8 + j;
              *(LAS bf16*)(L + O_ATT + ch * TS_ + st * 2) = (bf16)(cvt_pk_bf16(at8[j], 0.f) & 0xffffu); *(LAS bf16*)(L + O_BTT + ch * TS_ + st * 2) = (bf16)(cvt_pk_bf16(bt8[j], 0.f) & 0xffffu);
              *(LAS bf16*)(L + O_VTT + ch * TS_ + st * 2) = (bf16)(cvt_pk_bf16(v8[j], 0.f) & 0xffffu); } }
        __syncthreads();
        { const int mt = wg >> 1, nt = wg & 1, n = 16 * nt + qi, m0 = 16 * mt + 4 * g; const f32x4 z = {0.f, 0.f, 0.f, 0.f};
          f32x4 c1 = mm_tile<2>(L + O_AT, RS, 16 * mt, L + O_BT, RS, 16 * nt, z, qi, g);
#pragma unroll
          for (int r = 0; r < 4; ++r) c1[r] = (n < m0 + r) ? c1[r] : 0.f;
          *(LAS f32x4*)(L + O_NAB + n * 144 + m0 * 4) = c1;
          f32x4 c2 = mm_tile<2>(L + O_BT, RS, 16 * mt, L + O_RT, RS, 16 * nt, z, qi, g);
#pragma unroll
          for (int r = 0; r < 4; ++r) c2[r] = (m0 + r <= n) ? c2[r] : 0.f;
          *(LAS v2u*)(L + O_NRBT + n * TS_ + m0 * 2) = pack4(c2);
          f32x4 c3 = mm_tile<2>(L + O_AT, RS, 16 * mt, L + O_KT, RS, 16 * nt, z, qi, g);
#pragma unroll
          for (int r = 0; r < 4; ++r) c3[r] = (n < m0 + r) ? c3[r] : 0.f;
          *(LAS v2u*)(L + O_NAK + n * TS_ + m0 * 2) = pack4(c3); }
        __syncthreads();
        if (wg == 0) { const int col = lane_i & 31; float x[SC];
#pragma unroll
            for (int s = SC - 1; s >= 0; --s) { float ac[4] = {(col == s) ? 1.0f : 0.0f, 0.f, 0.f, 0.f};
#pragma unroll
                for (int q4 = SC / 4 - 1; q4 >= (s + 1) >> 2; --q4) { const f32x4 nv = *(const LAS f32x4*)(L + O_NAB + s * 144 + q4 * 16);
#pragma unroll
                    for (int r = 3; r >= 0; --r) { const int t = 4 * q4 + r; if (t > s) ac[r] += nv[r] * x[t]; } }
                x[s] = (ac[0] + ac[1]) + (ac[2] + ac[3]); }
            if (lane_i < 32) {
#pragma unroll
                for (int s = 0; s < SC; ++s) *(LAS bf16*)(L + O_TM + s * TS_ + col * 2) = (bf16)(cvt_pk_bf16(x[s], 0.f) & 0xffffu); } }
        __syncthreads();
        { const f32x4 z = {0.f, 0.f, 0.f, 0.f};
          { const int mt = wg >> 1, nt = wg & 1; const f32x4 c = mm_tile<1>(L + O_TM, TS_, 16 * mt, L + O_NRBT, TS_, 16 * nt, z, qi, g); *(LAS v2u*)(L + O_X1T + (16 * nt + qi) * TS_ + (16 * mt + 4 * g) * 2) = pack4(c); }
#pragma unroll
          for (int q = 0; q < 2; ++q) { const int tix = wg * 2 + q, mt = tix >> 2, nt = tix & 3; const f32x4 c = mm_tile<1>(L + O_TM, TS_, 16 * mt, L + O_BTT, TS_, 16 * nt, z, qi, g);
              *(LAS v2u*)(L + O_X2T + (16 * nt + qi) * TS_ + (16 * mt + 4 * g) * 2) = pack4(c); } }
        if (it + 1 < NIT) CP_LOAD(it + 1);
        __syncthreads();
        { const size_t cid = (size_t)bh * NCHK + ck;
#pragma unroll
          for (int q = 0; q < 2; ++q) { const int tix = wg * 2 + q, mt = tix >> 1, nt = tix & 1, t = 16 * nt + qi; const v2u rw = *(const LAS v2u*)(L + O_RT + t * RS + (16 * mt + 4 * g) * 2);
              f32x4 c = {bflo(rw.x), bfhi(rw.x), bflo(rw.y), bfhi(rw.y)}; c = mm_tile<1>(L + O_ATT, TS_, 16 * mt, L + O_X1T, TS_, 16 * nt, c, qi, g);
              *(v2u*)(QTg + (cid * SC + t) * 64 + 32 * (mt >> 1) + 8 * g + 4 * (mt & 1)) = pack4(c); }
          { const int mt = wg >> 1, nt = wg & 1, n = 16 * nt + qi, m0 = 16 * mt + 4 * g; f32x4 c = mm_tile<2>(L + O_KT, RS, 16 * mt, L + O_RT, RS, 16 * nt, (f32x4){0.f, 0.f, 0.f, 0.f}, qi, g);
#pragma unroll
            for (int r = 0; r < 4; ++r) c[r] = (m0 + r <= n) ? c[r] : 0.f;
            c = mm_tile<1>(L + O_NAK, TS_, 16 * mt, L + O_X1T, TS_, 16 * nt, c, qi, g); *(LAS v2u*)(L + O_HT + n * TS_ + m0 * 2) = pack4(c); }
#pragma unroll
          for (int q = 0; q < 4; ++q) { const int mt = wg, nt = q, k = 16 * nt + qi, m0 = 16 * mt + 4 * g; f32x4 c = mm_tile<1>(L + O_ATT, TS_, 16 * mt, L + O_X2T, TS_, 16 * nt, (f32x4){0.f, 0.f, 0.f, 0.f}, qi, g);
              const float wc = *(const LAS float*)(L + O_WC + k * 4);
#pragma unroll
              for (int r = 0; r < 4; ++r) c[r] = (c[r] + ((m0 + r == k) ? 1.0f : 0.0f)) * wc;
              *(v2u*)(PTg + (cid * 64 + k) * 64 + 32 * (mt >> 1) + 8 * g + 4 * (mt & 1)) = pack4(c); }
#pragma unroll
          for (int q = 0; q < 2; ++q) { const int tix = wg * 2 + q, mt = tix >> 2, nt = tix & 3, k = 16 * nt + qi, m0 = 16 * mt + 4 * g; f32x4 c;
#pragma unroll
              for (int r = 0; r < 4; ++r) c[r] = bf1(*(const LAS bf16*)(L + O_KT + (m0 + r) * RS + k * 2));
              c = mm_tile<1>(L + O_NAK, TS_, 16 * mt, L + O_X2T, TS_, 16 * nt, c, qi, g); const float wc = *(const LAS float*)(L + O_WC + k * 4);
              *(LAS v2u*)(L + O_GT + k * TS_ + m0 * 2) = pack4(c * wc); } }
        __syncthreads();
        { const size_t cid = (size_t)bh * NCHK + ck; const f32x4 z = {0.f, 0.f, 0.f, 0.f};
#pragma unroll
          for (int q = 0; q < 4; ++q) { const int mt = q, nt = wg; const f32x4 c = mm_tile<1>(L + O_GT, TS_, 16 * mt, L + O_VTT, TS_, 16 * nt, z, qi, g);
              *(v2u*)(LTg + (((cid * 4 + nt) * 4 + mt) * 64 + lane_i) * 4) = pack4(c); }
#pragma unroll
          for (int q = 0; q < 2; ++q) { const int mt = q, nt = wg; const f32x4 c = mm_tile<1>(L + O_HT, TS_, 16 * mt, L + O_VTT, TS_, 16 * nt, z, qi, g);
#pragma unroll
              for (int r = 0; r < 4; ++r) if (!dry) ys[base + (size_t)(16 * mt + 4 * g + r) * D + 16 * nt + qi] = c[r]; } }
    }
#undef CP_LOAD
    __syncthreads();
}
__device__ __forceinline__ v4u gl_x4(const void* p) { v4u r; asm volatile("global_load_dwordx4 %0, %1, off" : "=v"(r) : "v"(p) : "memory"); return r; }
__device__ __forceinline__ v2u gl_x2(const void* p) { v2u r; asm volatile("global_load_dwordx2 %0, %1, off" : "=v"(r) : "v"(p) : "memory"); return r; }
__device__ __forceinline__ float gl_f(const void* p) { float r; asm volatile("global_load_dword %0, %1, off" : "=v"(r) : "v"(p) : "memory"); return r; }
__device__ __forceinline__ void gs_f(void* p, float v) { asm volatile("global_store_dword %0, %1, off" :: "v"(p), "v"(v) : "memory"); }
__device__ __forceinline__ void chunk_scan(Frame& F, const bool dry = false) {
    const bf16* PTg = (const bf16*)(F.ws + WS_PT); const bf16* QTg = (const bf16*)(F.ws + WS_QT); const bf16* LTg = (const bf16*)(F.ws + WS_LT); float* ys = (float*)(F.ws + WS_YS2);
    const int qi = F.lane & 15, g = F.lane >> 4;
    for (int bh = F.vcu; bh < NBATCH * NH; bh += F.G) {
        if (F.wave >= 4) continue;
        const int vt = F.wave, b = bh >> 4, h = bh & 15;
        f32x4 S[4];
#pragma unroll
        for (int kt = 0; kt < 4; ++kt) S[kt] = (f32x4){0.f, 0.f, 0.f, 0.f};
        v4u pa0[4][2], qa0[2][2], pa1[4][2], qa1[2][2]; v2u lt0[4], lt1[4]; float yl0[2][4], yl1[2][4];
        asm volatile("s_waitcnt vmcnt(0)" ::: "memory");
#define CS_LOAD(pa, qa, lt, yl, ck_) do { const size_t cid = (size_t)bh * NCHK + (ck_); \
        _Pragma("unroll") for (int kt = 0; kt < 4; ++kt) { _Pragma("unroll") for (int ks = 0; ks < 2; ++ks) pa[kt][ks] = *(const v4u*)(PTg + (cid * 64 + 16 * kt + qi) * 64 + 32 * ks + 8 * g); \
            lt[kt] = *(const v2u*)(LTg + (((cid * 4 + vt) * 4 + kt) * 64 + F.lane) * 4); } \
        _Pragma("unroll") for (int mt = 0; mt < 2; ++mt) { _Pragma("unroll") for (int ks = 0; ks < 2; ++ks) qa[mt][ks] = *(const v4u*)(QTg + (cid * SC + 16 * mt + qi) * 64 + 32 * ks + 8 * g); \
            _Pragma("unroll") for (int r = 0; r < 4; ++r) yl[mt][r] = ys[((size_t)b * SEQ + (ck_) * SC + 16 * mt + 4 * g + r) * D + h * HD + 16 * vt + qi]; } } while (0)
#define CS_STEP(pa, qa, lt, yl, ck_) do { bf16x8 bfr[2]; \
        _Pragma("unroll") for (int ks = 0; ks < 2; ++ks) { v4u w; w.x = cvt_pk_bf16(S[2 * ks][0], S[2 * ks][1]); w.y = cvt_pk_bf16(S[2 * ks][2], S[2 * ks][3]); w.z = cvt_pk_bf16(S[2 * ks + 1][0], S[2 * ks + 1][1]); w.w = cvt_pk_bf16(S[2 * ks + 1][2], S[2 * ks + 1][3]); \
            bfr[ks] = __builtin_bit_cast(bf16x8, w); } \
        f32x4 y_[2]; \
        _Pragma("unroll") for (int mt = 0; mt < 2; ++mt) { y_[mt] = (f32x4){yl[mt][0], yl[mt][1], yl[mt][2], yl[mt][3]}; \
            _Pragma("unroll") for (int ks = 0; ks < 2; ++ks) y_[mt] = __builtin_amdgcn_mfma_f32_16x16x32_bf16(__builtin_bit_cast(bf16x8, qa[mt][ks]), bfr[ks], y_[mt], 0, 0, 0); } \
        _Pragma("unroll") for (int kt = 0; kt < 4; ++kt) { f32x4 sn = {bflo(lt[kt].x), bfhi(lt[kt].x), bflo(lt[kt].y), bfhi(lt[kt].y)}; \
            _Pragma("unroll") for (int ks = 0; ks < 2; ++ks) sn = __builtin_amdgcn_mfma_f32_16x16x32_bf16(__builtin_bit_cast(bf16x8, pa[kt][ks]), bfr[ks], sn, 0, 0, 0); \
            S[kt] = sn; } \
        asm volatile("" : "+v"(y_[0]), "+v"(y_[1]), "+v"(S[0]), "+v"(S[1]), "+v"(S[2]), "+v"(S[3]));        \
        if ((ck_) + 2 < NCHK) CS_LOAD(pa, qa, lt, yl, (ck_) + 2); \
        _Pragma("unroll") for (int mt = 0; mt < 2; ++mt) { _Pragma("unroll") for (int r = 0; r < 4; ++r) { float* yp_ = dry ? (float*)(F.ws + WS_CTL + 917504) : ys + ((size_t)b * SEQ + (ck_) * SC + 16 * mt + 4 * g + r) * D + h * HD + 16 * vt + qi; *yp_ = y_[mt][r]; } } } while (0)
        CS_LOAD(pa0, qa0, lt0, yl0, 0); CS_LOAD(pa1, qa1, lt1, yl1, 1);
#pragma unroll 8
        for (int ck = 0; ck < NCHK; ck += 2) { CS_STEP(pa0, qa0, lt0, yl0, ck); CS_STEP(pa1, qa1, lt1, yl1, ck + 1); }
        asm volatile("s_waitcnt vmcnt(0)" ::: "memory");
#undef CS_STEP
#undef CS_LOAD
    }
}
__device__ __forceinline__ void post_phase(Frame& F, const bf16* vbuf, const float* k_a, const float* r_k, const float* gn_g, const float* gn_b) {
    const bf16* rb = (const bf16*)(F.ws + WS_R); const bf16* kb = (const bf16*)(F.ws + WS_KK); const bf16* ab = (const bf16*)(F.ws + WS_A); const bf16* gb = (const bf16*)(F.ws + WS_G);
    const float* ys = (const float*)(F.ws + WS_YS2); bf16* yg = (bf16*)(F.ws + WS_YG);
    for (int row = F.gw; row < T; row += F.NGW) {
#pragma unroll
        for (int j = 0; j < 4; ++j) { const size_t o = (size_t)row * D + 256 * j + 4 * F.lane; const int cc = 256 * j + 4 * F.lane;
            const f32x4 y = *(const f32x4*)(ys + o); const v2u wr_ = *(const v2u*)(rb + o), wk = *(const v2u*)(kb + o), wa = *(const v2u*)(ab + o), wv = *(const v2u*)(vbuf + o), wg = *(const v2u*)(gb + o);
            const f32x4 r4 = {bflo(wr_.x), bfhi(wr_.x), bflo(wr_.y), bfhi(wr_.y)}, k4 = {bflo(wk.x), bfhi(wk.x), bflo(wk.y), bfhi(wk.y)}, a4 = {bflo(wa.x), bfhi(wa.x), bflo(wa.y), bfhi(wa.y)};
            const f32x4 v4 = {bflo(wv.x), bfhi(wv.x), bflo(wv.y), bfhi(wv.y)}, g4 = {bflo(wg.x), bfhi(wg.x), bflo(wg.y), bfhi(wg.y)};
            const f32x4 kav = *(const f32x4*)(k_a + cc), rkv = *(const f32x4*)(r_k + cc), gg = *(const f32x4*)(gn_g + cc), gbv = *(const f32x4*)(gn_b + cc);
            const float mean = reduce16((y[0] + y[1]) + (y[2] + y[3])) * (1.0f / HD); const f32x4 dy = y - mean;
            const float var = reduce16((dy[0] * dy[0] + dy[1] * dy[1]) + (dy[2] * dy[2] + dy[3] * dy[3])) * (1.0f / HD); const float rstd = 1.0f / sqrtf(var + GN_EPS);
            const f32x4 kh = k4 * (1.0f + (a4 - 1.0f) * kav); const f32x4 pr = r4 * kh * rkv; const float rk = reduce16((pr[0] + pr[1]) + (pr[2] + pr[3]));
            const f32x4 res = (dy * rstd * gg + gbv + v4 * rk) * g4;
            v2u w; w.x = cvt_pk_bf16(res[0], res[1]); w.y = cvt_pk_bf16(res[2], res[3]); *(v2u*)(yg + o) = w; }
    }
}

__global__ void __launch_bounds__(NTHREADS, 2) fwd_kernel(Args args) {
    extern __shared__ __attribute__((aligned(16))) unsigned char lds_raw[];
    Frame F;
    F.lds = (LAS unsigned char*)lds_raw; F.ws = args.ws; F.out = args.out; F.ctl = (gu32*)(args.ws + WS_CTL);
    F.tid = 0; F.lane = 0; F.wave = __builtin_amdgcn_readfirstlane((int)threadIdx.x >> 6);
    F.G = gridDim.x; { const int bx = blockIdx.x; F.vcu = (F.G % 8 == 0) ? (bx % 8) * (F.G / 8) + bx / 8 : bx; }
    F.gw = F.vcu * NWAVES + F.wave; F.NGW = F.G * NWAVES;
    for (int i = threadIdx.x; i < (LDS_BYTES - MISC_OFF) / 4; i += NTHREADS) ((LAS unsigned*)(F.lds + MISC_OFF))[i] = 0u;
    __syncthreads();
    XcdBarrier bar = xcd_barrier_post((unsigned*)(F.ctl + CW_BAR), (volatile LAS unsigned*)(F.lds + MISC_OFF) + 8);
#define GRID_BAR() xcd_barrier(bar)
    if (threadIdx.x < 35) ((LAS unsigned long long*)(F.lds + PTAB_OFF))[threadIdx.x] = (unsigned long long)args.in[threadIdx.x];
    __syncthreads();
#define IN(k) in_ptr(F, (k))
    unsigned char* ws = args.ws;
    MoeTab MT; MT.cnt = (const LAS int*)(F.lds + TAB_OFF); MT.mtpref = MT.cnt + 65; MT.hoff = MT.mtpref + 66;

#if EN_P0
    { Frame P = phase_frame(F);
    ln_phase<2>(P, IN(0), nullptr, nullptr, false, MT);
    for (int j = 0; j < 2; ++j) {
        convert_plain(P, IN(1) + (size_t)j * D * 3 * D, D, 3 * D, (bf16*)(ws + WS_WQKV) + (size_t)j * 3 * D * D, 0);
        convert_plain(P, IN(2) + (size_t)j * D * D, D, D, (bf16*)(ws + WS_WOA) + (size_t)j * D * D, 0);
        for (int s = 0; s < 3; ++s) convert_plain(P, IN(5) + ((size_t)j * 3 + s) * D * D, D, D, (bf16*)(ws + WS_WRKV) + (size_t)j * 3 * D * D, s * D);
        convert_plain(P, IN(22) + (size_t)j * D * D, D, D, (bf16*)(ws + WS_WOB) + (size_t)j * D * D, 0);
        bf16* L1 = (bf16*)(ws + WS_L1) + (size_t)j * 4 * 256 * D; bf16* L2 = (bf16*)(ws + WS_L2) + (size_t)j * 4 * D * 256;
        convert_small(P, IN(7) + (size_t)j * D * 64, D, 64, L1, 256, D);
        convert_small(P, IN(10) + (size_t)j * D * 64, D, 64, L1 + 256 * D, 256, D);
        convert_small(P, IN(15) + (size_t)j * D * 160, D, 160, L1 + 2 * 256 * D, 256, D);
        convert_small(P, IN(8) + (size_t)j * 64 * D, 64, D, L2, D, 256);
        convert_small(P, IN(11) + (size_t)j * 64 * D, 64, D, L2 + D * 256, D, 256);
        convert_small(P, IN(16) + (size_t)j * 160 * D, 160, D, L2 + 2 * D * 256, D, 256);
        if (j == 1) { convert_small(P, IN(13), D, 32, L1 + 3 * 256 * D, 256, D); convert_small(P, IN(14), 32, D, L2 + 3 * D * 256, D, 256); }
    }
    for (int i = 0; i < DEPTH; ++i) convert_small(P, IN(23) + (size_t)i * D * NE, D, NE, (bf16*)(ws + WS_WR) + (size_t)i * 256 * D, 256, D);
    }
#endif
    GRID_BAR();

#define PH_BEGIN { Frame P = phase_frame(F);
#define PH_END } GRID_BAR();
    for (int i = 0; i < DEPTH; ++i) {
        const int j = i >> 1;
        if ((i & 1) == 0) {
            PH_BEGIN
#if EN_QKV
              SchedDense S{T / 256, 12, P.G, (int)blockIdx.x, D, (const char*)(ws + WS_XB), (const char*)(ws + WS_WQKV) + (size_t)j * 3 * D * D * 2};
              EpiQKV E{(bf16*)(ws + WS_Q), (bf16*)(ws + WS_K), (bf16*)(ws + WS_VT)};
              for (int rep = 0; rep < REP_QKV; ++rep) pg8::gemm_phase<D>(P.lds, P.tid, S, E);
#endif
            PH_END
            PH_BEGIN
#if EN_KMEAN
            kmean_phase(P);
#endif
            PH_END
            PH_BEGIN
#if EN_SEL
            sel_phase(P);
#endif
            PH_END
            PH_BEGIN
#if EN_ATTN
            for (int rep = 0; rep < REP_ATTN; ++rep) attn_phase(P, IN(3));
#endif
            PH_END
            PH_BEGIN
#if EN_OPA
              SchedDense S{T / 256, 4, P.G, (int)blockIdx.x, D, (const char*)(ws + WS_O), (const char*)(ws + WS_WOA) + (size_t)j * D * D * 2};
              EpiAdd E{P.out};
              pg8::gemm_phase<D>(P.lds, P.tid, S, E);
#endif
            PH_END
        } else {
            const size_t voff = (j == 0 ? WS_VF : WS_V);
            PH_BEGIN
#if EN_MIX
            for (int rep = 0; rep < REP_MIX; ++rep) mix_phase(P, IN(4) + (size_t)j * 6 * D);
#endif
            PH_END
            PH_BEGIN
#if EN_RKV
              SchedRkv S{T / 256, j == 0 ? 15 : 16, P.G, (int)blockIdx.x, (const char*)(ws + WS_XMIX), (const char*)(ws + WS_WRKV) + (size_t)j * 3 * D * D * 2, (const char*)(ws + WS_L1) + (size_t)j * 4 * 256 * D * 2};
              EpiRkv E{ws, voff};
              pg8::gemm_phase<D>(P.lds, P.tid, S, E);
#endif
            PH_END
            PH_BEGIN
#if EN_L2
              SchedL2 S{T / 256, j == 0 ? 12 : 16, P.G, (int)blockIdx.x, (const char*)(ws + WS_HL), (const char*)(ws + WS_L2) + (size_t)j * 4 * D * 256 * 2};
              EpiL2 E{(float*)(ws + WS_LW), (bf16*)(ws + WS_A), (bf16*)(ws + WS_G), (bf16*)(ws + voff), (const bf16*)(ws + WS_VF), IN(6) + j * D, IN(9) + j * D, IN(12)};
              pg8::gemm_phase<256>(P.lds, P.tid, S, E);
#endif
            PH_END
            PH_BEGIN
#if EN_SCAN
            for (int rep = 0; rep < REP_SCAN; ++rep) chunk_prep(P, (const bf16*)(ws + voff), IN(17) + j * D, IN(18) + j * D, rep + 1 < REP_SCAN);
#endif
            PH_END
            PH_BEGIN
#if EN_SCANB
            for (int rep = 0; rep < REP_SCANB; ++rep) chunk_scan(P, rep + 1 < REP_SCANB);
#endif
            PH_END
            PH_BEGIN
#if EN_POST
#ifdef DBG_POST_COPY
            { const v4u* s_ = (const v4u*)(ws + WS_A); v4u* d_ = (v4u*)(ws + WS_YG); for (size_t q = (size_t)P.gw * 64 + P.lane; q < (size_t)T * D / 8; q += (size_t)P.NGW * 64) d_[q] = s_[q]; }
#else
            post_phase(P, (const bf16*)(ws + voff), IN(18) + j * D, IN(19) + j * D, IN(20) + j * D, IN(21) + j * D);
#endif
#endif
            PH_END
            PH_BEGIN
#if EN_OPB
              SchedDense S{T / 256, 4, P.G, (int)blockIdx.x, D, (const char*)(ws + WS_YG), (const char*)(ws + WS_WOB) + (size_t)j * D * D * 2};
              EpiAdd E{P.out};
              pg8::gemm_phase<D>(P.lds, P.tid, S, E);
#endif
            PH_END
        }
        PH_BEGIN
#if EN_LN1
        ln_phase<0>(P, P.out, IN(31) + i * D, IN(32) + i * D, false, MT);
#endif
#if EN_CVT
        for (int rep = 0; rep < REP_CVT; ++rep) convert_moe(P, IN(25) + (size_t)i * NE * D * DE, IN(26) + (size_t)i * NE * D * DE, IN(27) + (size_t)i * NE * DE * D, IN(28) + (size_t)i * D * DE, IN(29) + (size_t)i * D * DE, IN(30) + (size_t)i * DE * D);
#endif
        PH_END
        PH_BEGIN
#if EN_ROUTER
          SchedDense S{T / 256, 1, P.G, (int)blockIdx.x, D, (const char*)(ws + WS_XB), (const char*)(ws + WS_WR) + (size_t)i * 256 * D * 2};
          EpiLogits E{(float*)(ws + WS_LOGITS)};
          pg8::gemm_phase<D>(P.lds, P.tid, S, E);
#endif
        PH_END
        PH_BEGIN
#if EN_ROUTE
        route_phase(P, i, IN(24) + i * NE);
#endif
        PH_END
        PH_BEGIN
        moe_tables(P, i);
#if EN_G1
          SchedMoe1 S{P.G, P.vcu, MT, (const char*)(ws + WS_XB), (const char*)(ws + WS_WGU), (const int*)(ws + WS_TOKLIST)};
          _Pragma("nounroll") for (int rep = 0; rep < REP_G1; ++rep) { EpiSwiglu E{(bf16*)(ws + WS_H), rep + 1 < REP_G1}; pg8::gemm_phase<D>(P.lds, P.tid, S, E); }
#endif
        PH_END
        PH_BEGIN
#if EN_G2
          SchedMoe2 S{P.G, P.vcu, MT, (const char*)(ws + WS_H), (const char*)(ws + WS_WD)};
          _Pragma("nounroll") for (int rep = 0; rep < REP_G2; ++rep) { EpiMoeDown E{(bf16*)(ws + WS_Y), P.out, rep + 1 < REP_G2}; pg8::gemm_phase<DE>(P.lds, P.tid, S, E); }
#endif
        PH_END
        { Frame P = phase_frame(F);
#if EN_LN2
        ln_phase<1>(P, P.out, IN(33) + i * D, IN(34) + i * D, i == DEPTH - 1, MT);
#endif
        }
        if (i + 1 < DEPTH) GRID_BAR();
    }
#undef IN
#undef GRID_BAR
}

extern "C" void kernel_launch(void* const* d_in, const int* in_sizes, int n_in, void* d_out, int out_size, void* d_ws, size_t ws_size, hipStream_t stream) {
    static int grid = 0;
    if (grid == 0) {
        if (n_in != 35 || out_size != T * D || ws_size < WS_END) { fprintf(stderr, "kernel_launch: unexpected shapes (n_in %d, out %d, ws %zu)\n", n_in, out_size, ws_size); grid = -1; return; }
        int dev = 0, cus = 0, per_cu = 0;
        if (hipGetDevice(&dev) != hipSuccess || hipDeviceGetAttribute(&cus, hipDeviceAttributeMultiprocessorCount, dev) != hipSuccess) { grid = -1; return; }
        if (hipFuncSetAttribute((const void*)fwd_kernel, hipFuncAttributeMaxDynamicSharedMemorySize, LDS_BYTES) != hipSuccess) { fprintf(stderr, "kernel_launch: hipFuncSetAttribute failed\n"); grid = -1; return; }
        if (hipOccupancyMaxActiveBlocksPerMultiprocessor(&per_cu, (const void*)fwd_kernel, NTHREADS, LDS_BYTES) != hipSuccess || per_cu < 1) { fprintf(stderr, "kernel_launch: occupancy query says %d\n", per_cu); }
        (void)hipGetLastError();
        grid = cus;
    }
    if (grid < 0) return;
    if (hipMemsetAsync((char*)d_ws + WS_CTL, 0, CTL_ZERO_BYTES, stream) != hipSuccess) return;
    Args a{};
    for (int i = 0; i < 35; ++i) a.in[i] = (const float*)d_in[i];
    a.out = (float*)d_out; a.ws = (unsigned char*)d_ws;
    hipLaunchKernelGGL(fwd_kernel, dim3(grid), dim3(NTHREADS), LDS_BYTES, stream, a);
}
```

```cpp
#include <hip/hip_runtime.h>
#include <cstdio>
#include <cstdint>

#define GAS __attribute__((address_space(1)))
#define LAS __attribute__((address_space(3)))
typedef unsigned short bf16;
typedef unsigned v4u __attribute__((ext_vector_type(4)));
typedef unsigned v2u __attribute__((ext_vector_type(2)));
typedef float f32x4 __attribute__((ext_vector_type(4)));
typedef float f32x2 __attribute__((ext_vector_type(2)));
typedef short bf16x8 __attribute__((ext_vector_type(8)));
typedef short bf16x4 __attribute__((ext_vector_type(4)));

#ifndef EN_DEFAULT
#define EN_DEFAULT 1
#endif
#ifndef REP_SCAN
#define REP_SCAN 1
#endif
#ifndef EN_SCANB
#define EN_SCANB EN_DEFAULT
#endif
#ifndef DRYCUT
#define DRYCUT 0
#endif
#ifndef REP_SCANB
#define REP_SCANB 1
#endif
#ifndef REP_ATTN
#define REP_ATTN 1
#endif
#ifndef REP_G1
#define REP_G1 1
#endif
#ifndef REP_G2
#define REP_G2 1
#endif
#ifndef REP_CVT
#define REP_CVT 1
#endif
#ifndef REP_MIX
#define REP_MIX 1
#endif
#ifndef REP_QKV
#define REP_QKV 1
#endif
#ifndef EN_P0
#define EN_P0 EN_DEFAULT
#endif
#ifndef EN_QKV
#define EN_QKV EN_DEFAULT
#endif
#ifndef EN_KMEAN
#define EN_KMEAN EN_DEFAULT
#endif
#ifndef EN_SEL
#define EN_SEL EN_DEFAULT
#endif
#ifndef EN_ATTN
#define EN_ATTN EN_DEFAULT
#endif
#ifndef EN_OPA
#define EN_OPA EN_DEFAULT
#endif
#ifndef EN_MIX
#define EN_MIX EN_DEFAULT
#endif
#ifndef EN_RKV
#define EN_RKV EN_DEFAULT
#endif
#ifndef EN_L2
#define EN_L2 EN_DEFAULT
#endif
#ifndef EN_SCAN
#define EN_SCAN EN_DEFAULT
#endif
#ifndef EN_POST
#define EN_POST EN_DEFAULT
#endif
#ifndef EN_OPB
#define EN_OPB EN_DEFAULT
#endif
#ifndef EN_LN1
#define EN_LN1 EN_DEFAULT
#endif
#ifndef EN_CVT
#define EN_CVT EN_DEFAULT
#endif
#ifndef EN_ROUTER
#define EN_ROUTER EN_DEFAULT
#endif
#ifndef EN_ROUTE
#define EN_ROUTE EN_DEFAULT
#endif
#ifndef EN_G1
#define EN_G1 EN_DEFAULT
#endif
#ifndef EN_G2
#define EN_G2 EN_DEFAULT
#endif
#ifndef EN_LN2
#define EN_LN2 EN_DEFAULT
#endif
constexpr int D = 1024, NBATCH = 8, SEQ = 4096, T = NBATCH * SEQ, NH = 16, HD = 64, DEPTH = 4;
constexpr int NE = 64, TOPK = 8, DE = 256, NEX = NE + 1;
constexpr int MBLK = 256, NMB = SEQ / MBLK;
constexpr float ALPHA = 1.6817928305074290f;
constexpr float LN_EPS = 1e-5f, GN_EPS = 64e-5f;
constexpr int NWAVES = 8, NTHREADS = 512;

constexpr size_t MiB = 1u << 20;
constexpr size_t WS_CTL = 0, CTL_ZERO_BYTES = 1 * MiB;
constexpr size_t WS_WR = 1 * MiB;
constexpr size_t WS_KMEAN = 3 * MiB;
constexpr size_t WS_MASK = 4 * MiB;
constexpr size_t WS_TSEL = 5 * MiB;
constexpr size_t WS_WQKV = 8 * MiB;
constexpr size_t WS_WOA = 20 * MiB;
constexpr size_t WS_WRKV = 24 * MiB;
constexpr size_t WS_WOB = 36 * MiB;
constexpr size_t WS_L1 = 40 * MiB;
constexpr size_t WS_L2 = 44 * MiB;
constexpr size_t WS_WGU = 48 * MiB;
constexpr size_t WS_WD = 113 * MiB;
constexpr size_t WS_XB = 146 * MiB;
constexpr size_t WS_VF = 210 * MiB;
constexpr size_t WS_S = 274 * MiB;
constexpr size_t WS_LOGITS = WS_S;
constexpr size_t WS_TOKLIST = WS_S + 8 * MiB;
constexpr size_t WS_H = WS_S + 16 * MiB;
constexpr size_t WS_Y = WS_S + 168 * MiB;
constexpr size_t WS_Q = WS_S, WS_K = WS_S + 64 * MiB, WS_VT = WS_S + 128 * MiB, WS_O = WS_S + 192 * MiB;
constexpr size_t WS_XMIX = WS_S;
constexpr size_t WS_R = WS_S + 384 * MiB, WS_KK = WS_S + 448 * MiB, WS_V = WS_S + 512 * MiB;
constexpr size_t WS_HL = WS_S + 576 * MiB;
constexpr size_t WS_LW = WS_S;
constexpr size_t WS_A = WS_S + 128 * MiB, WS_G = WS_S + 192 * MiB;
constexpr size_t WS_YS = WS_S + 256 * MiB;
constexpr size_t WS_YG = WS_S + 640 * MiB;
constexpr size_t WS_END = 1024 * MiB;
static_assert(WS_Y + (size_t)278528 * 2048 <= WS_END && WS_YG + 64 * MiB <= WS_END, "d_ws map");

constexpr int CW_TMO = 0;
constexpr int CW_BAR = 4096;
constexpr int CW_CNT = 8192;

constexpr int RING_BYTES = 131072;
constexpr int MISC_OFF = RING_BYTES;
constexpr int TAB_OFF = MISC_OFF + 256;
constexpr int PTAB_OFF = MISC_OFF + 2048;
constexpr int LDS_BYTES = 147456;

#define RLX_AGENT __ATOMIC_RELAXED, __HIP_MEMORY_SCOPE_AGENT
#define LDS_WAIT() asm volatile("s_waitcnt lgkmcnt(0)" ::: "memory")
#define VM_WAIT() asm volatile("s_waitcnt vmcnt(0)" ::: "memory")
typedef float f32x2_t_ __attribute__((ext_vector_type(2))); typedef __bf16 bf16x2_t_ __attribute__((ext_vector_type(2)));
__device__ __forceinline__ unsigned cvt_pk_bf16(float lo, float hi) { const f32x2_t_ v = {lo, hi}; const bf16x2_t_ b = __builtin_convertvector(v, bf16x2_t_); return __builtin_bit_cast(unsigned, b); }
__device__ __forceinline__ float bflo(unsigned w) { return __uint_as_float(w << 16); }
__device__ __forceinline__ float bfhi(unsigned w) { return __uint_as_float(w & 0xffff0000u); }
__device__ __forceinline__ float bf1(bf16 b) { return __uint_as_float(((unsigned)b) << 16); }
__device__ __forceinline__ float fast_exp(float x) { return __builtin_amdgcn_exp2f(x * 1.4426950408889634f); }
__device__ __forceinline__ float fast_rcp(float x) { return __builtin_amdgcn_rcpf(x); }
__device__ __forceinline__ float sigmoidf_(float x) { return fast_rcp(1.0f + fast_exp(-x)); }
__device__ __forceinline__ float wave_sum(float v) {
#pragma unroll
    for (int o = 1; o < 64; o <<= 1) v += __shfl_xor(v, o);
    return v;
}
template <int CTRL> __device__ __forceinline__ float dpp_add(float v) {
    const int t = __builtin_amdgcn_update_dpp(0, __float_as_int(v), CTRL, 0xf, 0xf, true);
    return v + __int_as_float(t);
}
__device__ __forceinline__ float reduce16(float v) {
    v = dpp_add<0xB1>(v); v = dpp_add<0x4E>(v); v = dpp_add<0x141>(v); v = dpp_add<0x140>(v);
    return v;
}
__device__ const unsigned char T5_BUCKET[129] = {
    0, 1, 2, 3, 4, 5, 6, 7, 8, 9, 10, 11, 12, 13, 14, 15, 16, 16, 16, 17, 17, 18, 18, 18, 19, 19, 19, 20, 20, 20, 20, 21, 21, 21, 21, 22, 22, 22, 22, 22, 23, 23, 23, 23, 23, 23, 24, 24, 24,
    24, 24, 24, 25, 25, 25, 25, 25, 25, 25, 26, 26, 26, 26, 26, 26, 26, 26, 27, 27, 27, 27, 27, 27, 27, 27, 27, 27, 28, 28, 28, 28, 28, 28, 28, 28, 28, 28, 29, 29, 29, 29, 29, 29, 29, 29, 29, 29,
    29, 29, 30, 30, 30, 30, 30, 30, 30, 30, 30, 30, 30, 30, 30, 30, 31, 31, 31, 31, 31, 31, 31, 31, 31, 31, 31, 31, 31, 31, 31, 31};

namespace pg8 {
constexpr int BM = 256, BK = 64, HALF = 128, HTB = HALF * BK * 2, STAGE_BYTES = 8 * HTB, NXCD = 8, WGM = 8;
__host__ __device__ __forceinline__ int lds_byte(int r, int c) { const int st = (r >> 4) * 2 + (c >> 5), rr = r & 15, cc = c & 31, ob = rr * 64 + cc * 2; return st * 1024 + (ob ^ (((ob >> 9) & 1) << 5)); }
__host__ __device__ __forceinline__ void stage_rc(int b, int& R, int& C) { const int st = b / 1024, sb = b % 1024, swz = sb ^ (((sb >> 9) & 1) << 5); R = (st >> 1) * 16 + swz / 64; C = (st & 1) * 32 + (swz % 64) / 2; }
__host__ __device__ __forceinline__ int perm32(int rho) { const int n = rho >> 4, i = rho & 15; return 8 * (i >> 2) + 4 * n + (i & 3); }

struct Unit { int pm, pn, e, nvalid, arow0, orow0; const int* gidx; };

__device__ __forceinline__ bool static_tile(int i, int G, int c, int nM, int nN, int& pm, int& pn) {
    const int nwg = nM * nN; const long L = (long)i * G + c; if (L >= nwg) return false;
    int wgid = (int)L; { const int q = nwg / NXCD, r = nwg % NXCD, xcd = wgid % NXCD, off = wgid / NXCD; wgid = (xcd < r ? xcd * (q + 1) : r * (q + 1) + (xcd - r) * q) + off; }
    const int nig = WGM * nN, gid = wgid / nig, fm = gid * WGM, gsz = (nM - fm) < WGM ? (nM - fm) : WGM;
    pm = fm + ((wgid % nig) % gsz); pn = (wgid % nig) / gsz; return true;
}

template <int K, class Epi, class Sched>
__device__ __forceinline__ void gemm_phase(LAS unsigned char* lds, const int tid, const Sched& S, const Epi& E) {
    constexpr bool GA = Sched::GATHER;
    const int wid = __builtin_amdgcn_readfirstlane(tid >> 6), lane = tid & 63, wr = wid >> 2, wc = wid & 3, fr = lane & 15, fq = lane >> 4;
    constexpr int nt = K / BK;
    unsigned voffA[2], voffB[2];
#pragma unroll
    for (int i = 0; i < 2; ++i) { int R, C; stage_rc(tid * 16 + i * 8192, R, C); const int Rb = Epi::PERM ? ((R & ~31) + perm32(R & 31)) : R;
        voffA[i] = (unsigned)(R * K + C) * 2u; voffB[i] = (unsigned)(Rb * K + C) * 2u; }
    const size_t kstep = (size_t)(BK * 2);
    const size_t hstep = (size_t)HALF * K * 2;
    const unsigned rowb = (unsigned)K * 2u;
    const unsigned ldsw = (unsigned)wid * 1024u;
    const int aoff = lds_byte(wr * 64 + fr, fq * 8), boff = lds_byte(wc * 32 + fr, fq * 8);
#define PG8_SA(b, h) (((b) * 2 + (h)) * HTB)
#define PG8_SB(b, h) ((4 + (b) * 2 + (h)) * HTB)
#define PG8_STAGE(bufoff, gbase, voff) do { _Pragma("unroll") for (int _i = 0; _i < 2; ++_i) \
        __builtin_amdgcn_global_load_lds((const unsigned*)((const char*)(gbase) + (voff)[_i]), (LAS unsigned*)(lds + (bufoff) + ldsw + _i * 8192), 16, 0, 0); } while (0)
#define PG8_STAGE_A(bufoff, p, h, O) do { if constexpr (GA) { PG8_STAGE(bufoff, p, O[h]); } else { PG8_STAGE(bufoff, (p) + (h) * hstep, voffA); } } while (0)
#define PG8_LDA(dst, b, h) do { _Pragma("unroll") for (int m = 0; m < 4; ++m) _Pragma("unroll") for (int k = 0; k < 2; ++k) dst[m][k] = *(const LAS bf16x8*)(lds + PG8_SA(b, h) + aoff + m * 2048 + k * 1024); } while (0)
#define PG8_LDB(dst, b, h) do { _Pragma("unroll") for (int n = 0; n < 2; ++n) _Pragma("unroll") for (int k = 0; k < 2; ++k) dst[n][k] = *(const LAS bf16x8*)(lds + PG8_SB(b, h) + boff + n * 2048 + k * 1024); } while (0)
#define PG8_MMA(ai, bj, At, Bt) do { __builtin_amdgcn_s_setprio(1); _Pragma("unroll") for (int m = 0; m < 4; ++m) _Pragma("unroll") for (int n = 0; n < 2; ++n) _Pragma("unroll") for (int k = 0; k < 2; ++k) \
        acc[ai][bj][m][n] = __builtin_amdgcn_mfma_f32_16x16x32_bf16(Bt[n][k], At[m][k], acc[ai][bj][m][n], 0, 0, 0); __builtin_amdgcn_s_setprio(0); } while (0)
#define PG8_WAIT_V(n) asm volatile("s_waitcnt vmcnt(" #n ")" ::: "memory")
#define PG8_WAIT_L(n) asm volatile("s_waitcnt lgkmcnt(" #n ")" ::: "memory")
#define PG8_BAR __builtin_amdgcn_s_barrier()
#define PG8_SCHED __builtin_amdgcn_sched_barrier(0)
#define PG8_OFFS(u, o) do { if constexpr (GA) { _Pragma("unroll") for (int _h = 0; _h < 2; ++_h) _Pragma("unroll") for (int _i = 0; _i < 2; ++_i) { int R_, C_; stage_rc(tid * 16 + _i * 8192, R_, C_); \
        o[_h][_i] = (unsigned)S.a_row(u, _h * HALF + R_) * rowb + (unsigned)C_ * 2u; } } } while (0)
#define PG8_TRIP(a1, a2, b2, O1, O2) do { const char* a3 = (a2) + kstep; const char* b3 = (b2) + kstep; \
            PG8_LDB(B0, 0, 0); PG8_LDB(B1, 0, 1); PG8_SCHED; PG8_LDA(At, 0, 0); PG8_STAGE_A(PG8_SA(1, 1), a1, 1, O1); \
            PG8_WAIT_V(8); PG8_WAIT_L(0); PG8_BAR; PG8_MMA(0, 0, At, B0); PG8_MMA(0, 1, At, B1); PG8_BAR; PG8_SCHED; \
            PG8_LDA(At, 0, 1); PG8_STAGE(PG8_SB(0, 0), b2, voffB); PG8_STAGE(PG8_SB(0, 1), (b2) + hstep, voffB); PG8_STAGE_A(PG8_SA(0, 0), a2, 0, O2); \
            PG8_WAIT_V(8); PG8_WAIT_L(0); PG8_BAR; PG8_MMA(1, 0, At, B0); PG8_MMA(1, 1, At, B1); PG8_BAR; PG8_SCHED; \
            PG8_LDB(B0, 1, 0); PG8_LDB(B1, 1, 1); PG8_SCHED; PG8_LDA(At, 1, 0); PG8_STAGE_A(PG8_SA(0, 1), a2, 1, O2); \
            PG8_WAIT_V(8); PG8_WAIT_L(0); PG8_BAR; PG8_MMA(0, 0, At, B0); PG8_MMA(0, 1, At, B1); PG8_BAR; PG8_SCHED; \
            PG8_LDA(At, 1, 1); PG8_STAGE(PG8_SB(1, 0), b3, voffB); PG8_STAGE(PG8_SB(1, 1), b3 + hstep, voffB); PG8_STAGE_A(PG8_SA(1, 0), a3, 0, O2); \
            PG8_WAIT_V(8); PG8_WAIT_L(0); PG8_BAR; PG8_MMA(1, 0, At, B0); PG8_MMA(1, 1, At, B1); PG8_BAR; PG8_SCHED; } while (0)
    Unit cur, nxt; int ui = 0;
    if (!S.next(0, cur)) return;
    f32x4 acc[2][2][4][2];
#pragma unroll
    for (int a = 0; a < 2; ++a)
#pragma unroll
        for (int b = 0; b < 2; ++b)
#pragma unroll
            for (int m = 0; m < 4; ++m)
#pragma unroll
                for (int n = 0; n < 2; ++n) acc[a][b][m][n] = (f32x4){0.f, 0.f, 0.f, 0.f};
    bf16x8 At[4][2], B0[2][2], B1[2][2];
    unsigned cOff[2][2], nOff[2][2];
    PG8_OFFS(cur, cOff);
    const char* cA = S.a_tile(cur); const char* cB = S.b_tile(cur);
    PG8_STAGE(PG8_SB(0, 0), cB, voffB); PG8_STAGE(PG8_SB(0, 1), cB + hstep, voffB); PG8_STAGE_A(PG8_SA(0, 0), cA, 0, cOff); PG8_STAGE_A(PG8_SA(0, 1), cA, 1, cOff);
    if (wr == 1) PG8_BAR;
    PG8_WAIT_V(2); PG8_BAR;
    PG8_STAGE(PG8_SB(1, 0), cB + kstep, voffB); PG8_STAGE_A(PG8_SA(1, 0), cA + kstep, 0, cOff); PG8_STAGE(PG8_SB(1, 1), cB + hstep + kstep, voffB);
    PG8_WAIT_V(6); PG8_BAR;
    for (;;) {
        const bool has_next = S.next(ui + 1, nxt);
        const char* nA = cA; const char* nB = cB;
        if constexpr (GA) {
#pragma unroll
            for (int h = 0; h < 2; ++h)
#pragma unroll
                for (int i = 0; i < 2; ++i) nOff[h][i] = cOff[h][i]; }
        if (has_next) { PG8_OFFS(nxt, nOff); nA = S.a_tile(nxt); nB = S.b_tile(nxt); }
_Pragma("nounroll")
        for (int t = 0; t < nt; t += 2) { const bool last = (t == nt - 2);
            const char* a2 = last ? nA : cA + (size_t)(t + 2) * kstep; const char* b2 = last ? nB : cB + (size_t)(t + 2) * kstep;
            if constexpr (GA) { unsigned o2[2][2];
#pragma unroll
                for (int h = 0; h < 2; ++h)
#pragma unroll
                    for (int i = 0; i < 2; ++i) o2[h][i] = last ? nOff[h][i] : cOff[h][i];
                PG8_TRIP(cA + (size_t)(t + 1) * kstep, a2, b2, cOff, o2);
            } else { PG8_TRIP(cA + (size_t)(t + 1) * kstep, a2, b2, cOff, cOff); } }
        if (wr == 0) PG8_BAR;
        PG8_SCHED; E(acc, cur, wr, wc, fr, fq); PG8_SCHED;
        if (!has_next) break;
#pragma unroll
        for (int a = 0; a < 2; ++a)
#pragma unroll
            for (int b = 0; b < 2; ++b)
#pragma unroll
                for (int m = 0; m < 4; ++m)
#pragma unroll
                    for (int n = 0; n < 2; ++n) acc[a][b][m][n] = (f32x4){0.f, 0.f, 0.f, 0.f};
        cur = nxt; cA = nA; cB = nB; ++ui;
        if constexpr (GA) {
#pragma unroll
            for (int h = 0; h < 2; ++h)
#pragma unroll
                for (int i = 0; i < 2; ++i) cOff[h][i] = nOff[h][i]; }
        if (wr == 1) PG8_BAR;
    }
    PG8_WAIT_V(0);
    PG8_BAR;
#undef PG8_SA
#undef PG8_SB
#undef PG8_STAGE
#undef PG8_STAGE_A
#undef PG8_LDA
#undef PG8_LDB
#undef PG8_MMA
#undef PG8_WAIT_V
#undef PG8_WAIT_L
#undef PG8_BAR
#undef PG8_SCHED
#undef PG8_OFFS
#undef PG8_TRIP
}
}
using pg8::Unit;
typedef f32x4 AccT[2][2][4][2];

struct SchedDense {
    int nM, nN, G, c, K; const char* A; const char* Bt;
    __device__ __forceinline__ bool next(int i, Unit& u) const { int pm, pn; if (!pg8::static_tile(i, G, c, nM, nN, pm, pn)) return false;
        u.pm = pm; u.pn = pn; u.e = 0; u.nvalid = 256; u.arow0 = pm * 256; u.orow0 = pm * 256; u.gidx = nullptr; return true; }
    static constexpr bool GATHER = false;
    __device__ __forceinline__ const char* a_tile(const Unit& u) const { return A + (size_t)u.arow0 * K * 2; }
    __device__ __forceinline__ const char* b_tile(const Unit& u) const { return Bt + (size_t)u.pn * 256 * K * 2; }
    __device__ __forceinline__ int a_row(const Unit& u, int r) const { return u.arow0 + r; }
};
struct SchedRkv {
    int nM, nN, G, c; const char* xmix; const char* Wrkv; const char* L1;
    __device__ __forceinline__ bool next(int i, Unit& u) const { int pm, pn; if (!pg8::static_tile(i, G, c, nM, nN, pm, pn)) return false;
        u.pm = pm; u.pn = pn; u.e = 0; u.nvalid = 256; u.arow0 = pm * 256; u.orow0 = pm * 256; u.gidx = nullptr; return true; }
    static constexpr bool GATHER = false;
    __device__ __forceinline__ const char* a_tile(const Unit& u) const { const int grp = u.pn < 12 ? (u.pn >> 2) : (u.pn == 15 ? 2 : u.pn - 9); return xmix + ((size_t)grp * T + u.arow0) * D * 2; }
    __device__ __forceinline__ const char* b_tile(const Unit& u) const { return u.pn < 12 ? Wrkv + (size_t)u.pn * 256 * D * 2 : L1 + (size_t)(u.pn - 12) * 256 * D * 2; }
    __device__ __forceinline__ int a_row(const Unit& u, int r) const { return u.arow0 + r; }
};
struct SchedL2 {
    int nM, nN, G, c; const char* hl; const char* L2;
    __device__ __forceinline__ bool next(int i, Unit& u) const { int pm, pn; if (!pg8::static_tile(i, G, c, nM, nN, pm, pn)) return false;
        u.pm = pm; u.pn = pn & 3; u.e = pn >> 2; u.nvalid = 256; u.arow0 = pm * 256; u.orow0 = pm * 256; u.gidx = nullptr; return true; }
    static constexpr bool GATHER = false;
    __device__ __forceinline__ const char* a_tile(const Unit& u) const { return hl + ((size_t)u.e * T + u.arow0) * 256 * 2; }
    __device__ __forceinline__ const char* b_tile(const Unit& u) const { return L2 + ((size_t)u.e * 1024 + (size_t)u.pn * 256) * 256 * 2; }
    __device__ __forceinline__ int a_row(const Unit& u, int r) const { return u.arow0 + r; }
};
struct MoeTab { const LAS int* cnt; const LAS int* mtpref; const LAS int* hoff; };
__device__ __forceinline__ int moe_find_expert(const MoeTab& M, int m) { int e = 0;
_Pragma("nounroll")
    for (int k = 1; k < NEX; ++k) e = (M.mtpref[k] <= m) ? k : e;
    return __builtin_amdgcn_readfirstlane(e); }
struct SchedMoe1 {
    int G, c; MoeTab M; const char* xb; const char* Wgu; const int* toklist;
    __device__ __forceinline__ bool next(int i, Unit& u) const { const long L = (long)i * G + c; const int nun = M.mtpref[NEX] * 2; if (L >= nun) return false;
        const int m = (int)(L >> 1), e = moe_find_expert(M, m), mt = m - M.mtpref[e];
        u.pm = mt; u.pn = (int)(L & 1); u.e = e; u.arow0 = mt * 256; u.orow0 = M.hoff[e] + mt * 256;
        if (e < NE) { const int left = M.cnt[e] - mt * 256; u.nvalid = left < 256 ? left : 256; u.gidx = toklist + (size_t)e * T + mt * 256; } else { u.nvalid = 256; u.gidx = nullptr; }
        return true; }
    static constexpr bool GATHER = true;
    __device__ __forceinline__ const char* a_tile(const Unit&) const { return xb; }
    __device__ __forceinline__ const char* b_tile(const Unit& u) const { return Wgu + ((size_t)u.e * 512 + (size_t)u.pn * 256) * D * 2; }
    __device__ __forceinline__ int a_row(const Unit& u, int r) const { if (u.gidx) return r < u.nvalid ? u.gidx[r] : 0; return u.arow0 + r; }
};
struct SchedMoe2 {
    int G, c; MoeTab M; const char* hb; const char* Wd;
    __device__ __forceinline__ bool next(int i, Unit& u) const { const long L = (long)i * G + c; const int nun = M.mtpref[NEX] * 4; if (L >= nun) return false;
        const int m = (int)(L >> 2), e = moe_find_expert(M, m), mt = m - M.mtpref[e];
        u.pm = mt; u.pn = (int)(L & 3); u.e = e; u.nvalid = 256; u.arow0 = M.hoff[e] + mt * 256; u.orow0 = (e < NE) ? (M.hoff[e] + mt * 256) : mt * 256; u.gidx = nullptr; return true; }
    static constexpr bool GATHER = false;
    __device__ __forceinline__ const char* a_tile(const Unit& u) const { return hb + (size_t)u.arow0 * 256 * 2; }
    __device__ __forceinline__ const char* b_tile(const Unit& u) const { return Wd + ((size_t)u.e * 1024 + (size_t)u.pn * 256) * 256 * 2; }
    __device__ __forceinline__ int a_row(const Unit& u, int r) const { return u.arow0 + r; }
};

#define EPI_ARGS const AccT& acc, const Unit& u, int wr, int wc, int fr, int fq
struct EpiQKV { static constexpr bool PERM = true; bf16* Q; bf16* Kb; bf16* Vt;
    __device__ __forceinline__ void operator()(EPI_ARGS) const {
        const int row0 = u.orow0 + wr * 64 + fr, sec = u.pn >> 2, col0 = (u.pn & 3) * 256 + wc * 32 + 8 * fq;
        if (sec < 2) { bf16* base = sec == 0 ? Q : Kb; const float sc = sec == 0 ? 0.18033688011112042f : 1.0f;
#pragma unroll
            for (int ai = 0; ai < 2; ++ai)
#pragma unroll
                for (int m = 0; m < 4; ++m) { bf16* rowp = base + (size_t)(row0 + ai * 128 + m * 16) * D + col0;
#pragma unroll
                    for (int bj = 0; bj < 2; ++bj) { const f32x4 v0 = acc[ai][bj][m][0] * sc, v1 = acc[ai][bj][m][1] * sc; v4u w;
                        w.x = cvt_pk_bf16(v0[0], v0[1]); w.y = cvt_pk_bf16(v0[2], v0[3]); w.z = cvt_pk_bf16(v1[0], v1[1]); w.w = cvt_pk_bf16(v1[2], v1[3]); *(v4u*)(rowp + bj * 128) = w; } }
        } else {
#pragma unroll
            for (int ai = 0; ai < 2; ++ai)
#pragma unroll
                for (int m = 0; m < 4; ++m) { const int r = row0 + ai * 128 + m * 16, b = r >> 12, s = r & 4095;
#pragma unroll
                    for (int bj = 0; bj < 2; ++bj)
#pragma unroll
                        for (int n = 0; n < 2; ++n) { const f32x4 v = acc[ai][bj][m][n];
#pragma unroll
                            for (int j = 0; j < 4; j += 2) { const int c = col0 + bj * 128 + 4 * n + j, h = c >> 6, d = c & 63; const unsigned w = cvt_pk_bf16(v[j], v[j + 1]);
                                bf16* p = Vt + ((((size_t)(b * NH + h) * HD + d)) << 12) + s; p[0] = (bf16)(w & 0xffffu); p[SEQ] = (bf16)(w >> 16); } } }
        }
    }
};
struct EpiAdd { static constexpr bool PERM = false; float* out;
    __device__ __forceinline__ void operator()(EPI_ARGS) const {
        const int row0 = u.orow0 + wr * 64 + fr, col0 = u.pn * 256 + wc * 32 + 4 * fq;
#pragma unroll
        for (int ai = 0; ai < 2; ++ai)
#pragma unroll
            for (int m = 0; m < 4; ++m) { float* rowp = out + (size_t)(row0 + ai * 128 + m * 16) * D + col0;
#pragma unroll
                for (int bj = 0; bj < 2; ++bj)
#pragma unroll
                    for (int n = 0; n < 2; ++n) { f32x4* p = (f32x4*)(rowp + bj * 128 + n * 16); *p = *p + acc[ai][bj][m][n]; } }
    }
};
struct EpiLogits { static constexpr bool PERM = false; float* lg;
    __device__ __forceinline__ void operator()(EPI_ARGS) const {
        if (wc >= 2) return;
        const int row0 = u.orow0 + wr * 64 + fr, col0 = wc * 32 + 4 * fq;
#pragma unroll
        for (int ai = 0; ai < 2; ++ai)
#pragma unroll
            for (int m = 0; m < 4; ++m) { float* rowp = lg + (size_t)(row0 + ai * 128 + m * 16) * NE + col0;
#pragma unroll
                for (int n = 0; n < 2; ++n) *(f32x4*)(rowp + n * 16) = acc[ai][0][m][n]; }
    }
};
struct EpiSwiglu { static constexpr bool PERM = true; bf16* hb; bool dry;
    __device__ __forceinline__ void operator()(EPI_ARGS) const {
        const int row0 = u.orow0 + wr * 64 + fr, col0 = u.pn * 128 + wc * 32 + 8 * fq;
#pragma unroll
        for (int ai = 0; ai < 2; ++ai)
#pragma unroll
            for (int m = 0; m < 4; ++m) { bf16* rowp = hb + (size_t)(row0 + ai * 128 + m * 16) * DE + col0; float o[8];
#pragma unroll
                for (int n = 0; n < 2; ++n)
#pragma unroll
                    for (int j = 0; j < 4; ++j) { const float g = acc[ai][0][m][n][j], up = acc[ai][1][m][n][j]; o[4 * n + j] = g * sigmoidf_(g) * up; }
                v4u w; w.x = cvt_pk_bf16(o[0], o[1]); w.y = cvt_pk_bf16(o[2], o[3]); w.z = cvt_pk_bf16(o[4], o[5]); w.w = cvt_pk_bf16(o[6], o[7]); if (!dry) *(v4u*)rowp = w; }
    }
};
struct EpiMoeDown { static constexpr bool PERM = true; bf16* yb; float* out; bool dry;
    __device__ __forceinline__ void operator()(EPI_ARGS) const {
        const int row0 = u.orow0 + wr * 64 + fr, col0 = u.pn * 256 + wc * 32 + 8 * fq;
        if (dry) return;
        if (u.e < NE) {
#pragma unroll
            for (int ai = 0; ai < 2; ++ai)
#pragma unroll
                for (int m = 0; m < 4; ++m) { bf16* rowp = yb + (size_t)(row0 + ai * 128 + m * 16) * D + col0;
#pragma unroll
                    for (int bj = 0; bj < 2; ++bj) { const f32x4 v0 = acc[ai][bj][m][0], v1 = acc[ai][bj][m][1]; v4u w;
                        w.x = cvt_pk_bf16(v0[0], v0[1]); w.y = cvt_pk_bf16(v0[2], v0[3]); w.z = cvt_pk_bf16(v1[0], v1[1]); w.w = cvt_pk_bf16(v1[2], v1[3]); *(v4u*)(rowp + bj * 128) = w; } }
        } else {
#pragma unroll
            for (int ai = 0; ai < 2; ++ai)
#pragma unroll
                for (int m = 0; m < 4; ++m) { float* rowp = out + (size_t)(row0 + ai * 128 + m * 16) * D + col0;
#pragma unroll
                    for (int bj = 0; bj < 2; ++bj)
#pragma unroll
                        for (int n = 0; n < 2; ++n) { f32x4* p = (f32x4*)(rowp + bj * 128 + 4 * n); *p = *p + acc[ai][bj][m][n]; } }
        }
    }
};
struct EpiRkv { static constexpr bool PERM = true; unsigned char* ws; size_t voff;
    __device__ __forceinline__ void operator()(EPI_ARGS) const {
        const int row0 = u.orow0 + wr * 64 + fr;
        size_t boff; int ldc, colt, act = 0;
        if (u.pn < 12) { const int sec = u.pn >> 2; boff = WS_R; if (sec == 1) boff = WS_KK; if (sec == 2) boff = voff; ldc = D; colt = (u.pn & 3) * 256; }
        else { const int kind = u.pn - 12; boff = WS_HL + (size_t)kind * T * 256 * 2; ldc = 256; colt = 0; act = kind == 0 ? 1 : (kind == 2 ? 2 : 0); }
        bf16* base = (bf16*)(ws + boff);
        const int col0 = colt + wc * 32 + 8 * fq;
#pragma unroll
        for (int ai = 0; ai < 2; ++ai)
#pragma unroll
            for (int m = 0; m < 4; ++m) { bf16* rowp = base + (size_t)(row0 + ai * 128 + m * 16) * ldc + col0;
#pragma unroll
                for (int bj = 0; bj < 2; ++bj) { f32x4 v0 = acc[ai][bj][m][0], v1 = acc[ai][bj][m][1];
                    if (act == 1) {
#pragma unroll
                        for (int j = 0; j < 4; ++j) { v0[j] = 1.0f - 2.0f * fast_rcp(fast_exp(2.0f * v0[j]) + 1.0f); v1[j] = 1.0f - 2.0f * fast_rcp(fast_exp(2.0f * v1[j]) + 1.0f); } }
                    if (act == 2) {
#pragma unroll
                        for (int j = 0; j < 4; ++j) { v0[j] = sigmoidf_(v0[j]); v1[j] = sigmoidf_(v1[j]); } }
                    v4u w; w.x = cvt_pk_bf16(v0[0], v0[1]); w.y = cvt_pk_bf16(v0[2], v0[3]); w.z = cvt_pk_bf16(v1[0], v1[1]); w.w = cvt_pk_bf16(v1[2], v1[3]); *(v4u*)(rowp + bj * 128) = w; } }
    }
};
struct EpiL2 { static constexpr bool PERM = true; float* lw; bf16* ab; bf16* gb; bf16* vb; const bf16* vf; const float* w0; const float* a0; const float* v0;
    __device__ __forceinline__ void operator()(EPI_ARGS) const {
        const int row0 = u.orow0 + wr * 64 + fr, col0 = u.pn * 256 + wc * 32 + 8 * fq, kind = u.e;
#pragma unroll
        for (int ai = 0; ai < 2; ++ai)
#pragma unroll
            for (int m = 0; m < 4; ++m) { const size_t ro = (size_t)(row0 + ai * 128 + m * 16) * D + col0;
#pragma unroll
                for (int bj = 0; bj < 2; ++bj) { const size_t o = ro + bj * 128; const int c = col0 + bj * 128; float x[8];
#pragma unroll
                    for (int n = 0; n < 2; ++n)
#pragma unroll
                        for (int j = 0; j < 4; ++j) x[4 * n + j] = acc[ai][bj][m][n][j];
                    if (kind == 0) { const f32x4 b0 = *(const f32x4*)(w0 + c), b1 = *(const f32x4*)(w0 + c + 4); f32x4 r0, r1;
#pragma unroll
                        for (int j = 0; j < 8; ++j) { const float z = x[j] + (j < 4 ? b0[j & 3] : b1[j & 3]);
                            const float wl = fminf(z, 0.0f) - __logf(1.0f + fast_exp(-fabsf(z))) - 0.5f; const float v = -fast_exp(wl); if (j < 4) r0[j & 3] = v; else r1[j & 3] = v; }
                        *(f32x4*)(lw + o) = r0; *(f32x4*)(lw + o + 4) = r1;
                    } else if (kind == 1) { const f32x4 b0 = *(const f32x4*)(a0 + c), b1 = *(const f32x4*)(a0 + c + 4);
#pragma unroll
                        for (int j = 0; j < 8; ++j) x[j] = sigmoidf_(x[j] + (j < 4 ? b0[j & 3] : b1[j & 3]));
                        v4u w; w.x = cvt_pk_bf16(x[0], x[1]); w.y = cvt_pk_bf16(x[2], x[3]); w.z = cvt_pk_bf16(x[4], x[5]); w.w = cvt_pk_bf16(x[6], x[7]); *(v4u*)(ab + o) = w;
                    } else if (kind == 2) {
                        v4u w; w.x = cvt_pk_bf16(x[0], x[1]); w.y = cvt_pk_bf16(x[2], x[3]); w.z = cvt_pk_bf16(x[4], x[5]); w.w = cvt_pk_bf16(x[6], x[7]); *(v4u*)(gb + o) = w;
                    } else { const f32x4 b0 = *(const f32x4*)(v0 + c), b1 = *(const f32x4*)(v0 + c + 4); const v4u vv = *(const v4u*)(vb + o), ff = *(const v4u*)(vf + o); float y[8];
#pragma unroll
                        for (int j = 0; j < 8; ++j) { const unsigned wv = vv[j >> 1], wf = ff[j >> 1]; const float v = (j & 1) ? bfhi(wv) : bflo(wv), f = (j & 1) ? bfhi(wf) : bflo(wf);
                            const float gt = sigmoidf_(x[j] + (j < 4 ? b0[j & 3] : b1[j & 3])); y[j] = v + (f - v) * gt; }
                        v4u w; w.x = cvt_pk_bf16(y[0], y[1]); w.y = cvt_pk_bf16(y[2], y[3]); w.z = cvt_pk_bf16(y[4], y[5]); w.w = cvt_pk_bf16(y[6], y[7]); *(v4u*)(vb + o) = w; }
                } }
    }
};

typedef GAS unsigned gu32;
#define XB_TMO      128
#define XB_XCNT(j)  (256  + 64 * (j))
#define XB_XSUB(j)  (1280 + 64 * (j))
#define XB_XGEN(j)  (2304 + 64 * (j))
#define XB_TOP      3328
#define XB_TOPGEN   3392
#define XCD_BAR_WORDS 3456
#define XB_SPIN_CAP (1u << 23)
__device__ __forceinline__ unsigned xb_ld(unsigned* p)              { return __hip_atomic_load(p, __ATOMIC_RELAXED, __HIP_MEMORY_SCOPE_AGENT); }
__device__ __forceinline__ unsigned xb_add(unsigned* p, unsigned v) { return __hip_atomic_fetch_add(p, v, __ATOMIC_RELAXED, __HIP_MEMORY_SCOPE_AGENT); }
__device__ __forceinline__ unsigned xb_xcc_id() { return (unsigned)__builtin_amdgcn_s_getreg((3 << 11) | 20) & 0xFu; }
#define XB_SPIN(cond, bar) do { unsigned _sp = 0; while (cond) { __builtin_amdgcn_s_sleep(1); \
    if ((++_sp & 255u) == 0u) { if (xb_ld(&(bar)[XB_TMO])) break; if (_sp > XB_SPIN_CAP) { atomicAdd(&(bar)[XB_TMO], 1u); break; } } } } while (0)
struct XcdBarrier { unsigned* bar; unsigned x; volatile LAS unsigned* st; };
__device__ __forceinline__ XcdBarrier xcd_barrier_post(unsigned* bar, volatile LAS unsigned* st) {
    XcdBarrier b; b.bar = bar; b.x = xb_xcc_id(); b.st = st;
    if (threadIdx.x == 0) (void)xb_add(&bar[XB_XCNT(b.x)], 1u);
    return b;
}
__device__ __forceinline__ void xcd_barrier_complete(unsigned* bar, unsigned x, unsigned& nloc, unsigned& nx) {
    const unsigned G = gridDim.x * gridDim.y * gridDim.z;
    unsigned sum, cnt, mine, sp = 0u;
    for (;;) {
        sum = 0u; cnt = 0u; mine = 0u;
#pragma unroll
        for (unsigned j = 0; j < 16; ++j) { const unsigned c = xb_ld(&bar[XB_XCNT(j)]); sum += c; cnt += (c > 0u) ? 1u : 0u; mine = (j == x) ? c : mine; }
        if (sum == G) break;
        __builtin_amdgcn_s_sleep(1);
        if ((++sp & 255u) == 0u) { if (xb_ld(&bar[XB_TMO])) break; if (sp > XB_SPIN_CAP) { atomicAdd(&bar[XB_TMO], 1u); break; } }
    }
    nloc = mine > 0u ? mine : 1u; nx = cnt > 0u ? cnt : 1u;
}
__device__ __forceinline__ void xcd_barrier(const XcdBarrier& b) {
    asm volatile("s_waitcnt vmcnt(0)" ::: "memory");
    __syncthreads();
    if (threadIdx.x == 0) {
        unsigned long long bp = (unsigned long long)b.bar; unsigned bx = b.x;
        asm volatile("" : "+s"(bp), "+s"(bx));
        unsigned* bar = (unsigned*)(GAS unsigned*)bp;
        __builtin_amdgcn_s_waitcnt(0);
        unsigned nloc = b.st[0], nx = b.st[1];
        if (nloc == 0u) { xcd_barrier_complete(bar, bx, nloc, nx); b.st[0] = nloc; b.st[1] = nx; }
        const unsigned old = xb_add(&bar[XB_XSUB(bx)], 1u);
        const unsigned gen = old / nloc;
        if (old + 1u == (gen + 1u) * nloc) {
            __builtin_amdgcn_fence(__ATOMIC_RELEASE, "agent");
            asm volatile("s_waitcnt vmcnt(0)" ::: "memory");
            const unsigned og = xb_add(&bar[XB_TOP], 1u);
            const unsigned tg = og / nx;
            if (og + 1u == (tg + 1u) * nx) xb_add(&bar[XB_TOPGEN], 1u);
            else XB_SPIN(xb_ld(&bar[XB_TOPGEN]) == tg, bar);
            __builtin_amdgcn_fence(__ATOMIC_ACQUIRE, "agent");
            xb_add(&bar[XB_XGEN(bx)], 1u);
            asm volatile("s_waitcnt vmcnt(0)" ::: "memory");
        } else {
            XB_SPIN(xb_ld(&bar[XB_XGEN(bx)]) == gen, bar);
            __builtin_amdgcn_fence(__ATOMIC_ACQUIRE, "agent");
            asm volatile("s_waitcnt vmcnt(0)" ::: "memory");
        }
    }
    __syncthreads();
}

struct Args { const float* in[35]; float* out; unsigned char* ws; };
struct Frame {
    LAS unsigned char* lds; gu32* ctl; unsigned char* ws; float* out;
    int tid, lane, wave, vcu, G, gw, NGW;
};

__device__ __forceinline__ Frame phase_frame(const Frame& F) {
    Frame P = F; int lane; asm volatile("v_mbcnt_lo_u32_b32 %0, -1, 0\n\tv_mbcnt_hi_u32_b32 %0, -1, %0" : "=v"(lane)); int wave = F.wave;
    asm volatile("" : "+v"(lane), "+s"(wave)); P.lane = lane; P.wave = wave; P.tid = wave * 64 + lane; P.gw = P.vcu * NWAVES + wave; return P;
}
__device__ __forceinline__ const float* in_ptr(const Frame& F, int k) {
    const unsigned long long v = ((const LAS unsigned long long*)(F.lds + PTAB_OFF))[k];
    const unsigned lo = (unsigned)__builtin_amdgcn_readfirstlane((int)(unsigned)v), hi = (unsigned)__builtin_amdgcn_readfirstlane((int)(unsigned)(v >> 32));
    return (const float*)(GAS const float*)(((unsigned long long)hi << 32) | lo);
}
__device__ __forceinline__ void transpose_item(const float* W, int N, int k0, int n0, bf16* WT, size_t orow, int ldk, LAS float* scr, int lane) {
#pragma unroll 8
    for (int i = 0; i < 32; ++i) { const int kk = 2 * i + (lane >> 5); scr[kk * 33 + (lane & 31)] = W[(size_t)(k0 + kk) * N + n0 + (lane & 31)]; }
    LDS_WAIT(); asm volatile("" ::: "memory");
    const int c = lane & 7;
#pragma unroll
    for (int j = 0; j < 4; ++j) { const int n = (lane >> 3) + 8 * j; const LAS float* s = scr + (8 * c) * 33 + n;
        v4u o; o.x = cvt_pk_bf16(s[0 * 33], s[1 * 33]); o.y = cvt_pk_bf16(s[2 * 33], s[3 * 33]); o.z = cvt_pk_bf16(s[4 * 33], s[5 * 33]); o.w = cvt_pk_bf16(s[6 * 33], s[7 * 33]);
        *(v4u*)(WT + (orow + n) * ldk + k0 + 8 * c) = o; }
    LDS_WAIT(); asm volatile("" ::: "memory");
}
__device__ __forceinline__ void convert_plain(Frame& F, const float* W, int K, int N, bf16* WT, int row_off) {
    LAS float* scr = (LAS float*)(F.lds + F.wave * 16384);
    const int nblk = N / 32, nitems = (K / 64) * nblk;
    for (int it = F.gw; it < nitems; it += F.NGW) { const int kb = it / nblk, nb = it % nblk; transpose_item(W, N, 64 * kb, 32 * nb, WT, (size_t)row_off + 32 * nb, K, scr, F.lane); }
}
__device__ __forceinline__ void convert_small(Frame& F, const float* W, int K, int N, bf16* WT, int Np, int Kp) {
    const size_t tot = (size_t)Np * Kp;
    for (size_t i = (size_t)F.gw * 64 + F.lane; i < tot; i += (size_t)F.NGW * 64) { const int n = (int)(i / Kp), k = (int)(i % Kp);
        const float v = (k < K && n < N) ? W[(size_t)k * N + n] : 0.0f; WT[i] = (bf16)(cvt_pk_bf16(v, 0.0f) & 0xffffu); }
}
__device__ __forceinline__ void convert_moe(Frame& F, const float* wg, const float* wu, const float* wd, const float* sg, const float* su, const float* sd) {
    LAS float* scr = (LAS float*)(F.lds + F.wave * 16384);
    bf16* Wgu = (bf16*)(F.ws + WS_WGU); bf16* Wd = (bf16*)(F.ws + WS_WD);
    constexpr int PER = 128;
    const int total = NEX * 3 * PER;
    for (int it = F.gw; it < total; it += F.NGW) {
        const int e = it / (3 * PER), r = it % (3 * PER), which = r / PER, q = r % PER;
        if (which < 2) { const float* W = (e < NE) ? (which == 0 ? wg : wu) + (size_t)e * D * DE : (which == 0 ? sg : su);
            const int kb = q >> 3, nb = q & 7, n0 = 32 * nb; const size_t orow = (size_t)e * 512 + (n0 >> 7) * 256 + which * 128 + (n0 & 127);
            transpose_item(W, DE, 64 * kb, n0, Wgu, orow, D, scr, F.lane);
        } else { const float* W = (e < NE) ? wd + (size_t)e * DE * D : sd;
            const int kb = q >> 5, nb = q & 31, n0 = 32 * nb;
            transpose_item(W, D, 64 * kb, n0, Wd, (size_t)e * 1024 + n0, DE, scr, F.lane); }
    }
}

template <int MODE>
__device__ __forceinline__ void ln_phase(Frame& F, const float* src, const float* g, const float* bsh, bool final, const MoeTab& M) {
    float* out = F.out; bf16* xb = (bf16*)(F.ws + WS_XB);
    const bf16* yb = (const bf16*)(F.ws + WS_Y); const int2* tsel = (const int2*)(F.ws + WS_TSEL);
    f32x4 gv[4], bv[4];
    if (MODE != 2) {
#pragma unroll
        for (int j = 0; j < 4; ++j) { gv[j] = *(const f32x4*)(g + 256 * j + 4 * F.lane); bv[j] = *(const f32x4*)(bsh + 256 * j + 4 * F.lane); } }
    for (int row = F.gw; row < T; row += F.NGW) {
        const f32x4* xr = (const f32x4*)(src + (size_t)row * D) + F.lane;
        f32x4 v[4];
#pragma unroll
        for (int j = 0; j < 4; ++j) v[j] = xr[64 * j];
        if (MODE == 1) {
#pragma unroll
            for (int jj = 0; jj < TOPK; ++jj) { const int2 ts = tsel[(size_t)row * TOPK + jj]; const int e = ts.x >> 20, slot = ts.x & 0xfffff; const float gt = __int_as_float(ts.y);
                const bf16* yp = yb + (size_t)(M.hoff[e] + slot) * D + 4 * F.lane;
#pragma unroll
                for (int j = 0; j < 4; ++j) { const v2u w = *(const v2u*)(yp + 256 * j); v[j][0] += gt * bflo(w.x); v[j][1] += gt * bfhi(w.x); v[j][2] += gt * bflo(w.y); v[j][3] += gt * bfhi(w.y); } }
        }
        f32x4 o[4];
        if (MODE == 2) {
#pragma unroll
            for (int j = 0; j < 4; ++j) o[j] = v[j];
        } else {
            float s = 0.f;
#pragma unroll
            for (int j = 0; j < 4; ++j) s += (v[j][0] + v[j][1]) + (v[j][2] + v[j][3]);
            const float mean = wave_sum(s) * (1.0f / D); float s2 = 0.f;
#pragma unroll
            for (int j = 0; j < 4; ++j) { v[j] = v[j] - mean; s2 += (v[j][0] * v[j][0] + v[j][1] * v[j][1]) + (v[j][2] * v[j][2] + v[j][3] * v[j][3]); }
            const float rstd = 1.0f / sqrtf(wave_sum(s2) * (1.0f / D) + LN_EPS);
#pragma unroll
            for (int j = 0; j < 4; ++j) o[j] = v[j] * rstd * gv[j] + bv[j];
        }
        f32x4* orow = (f32x4*)(out + (size_t)row * D) + F.lane; v2u* brow = (v2u*)(xb + (size_t)row * D) + F.lane;
        const float sc = final ? 1.0f : ALPHA;
#pragma unroll
        for (int j = 0; j < 4; ++j) { orow[64 * j] = o[j] * sc; v2u w; w.x = cvt_pk_bf16(o[j][0], o[j][1]); w.y = cvt_pk_bf16(o[j][2], o[j][3]); brow[64 * j] = w; }
    }
}

__device__ __forceinline__ void moe_tables(Frame& F, int layer) {
    LAS int* cnt = (LAS int*)(F.lds + TAB_OFF); LAS int* mtp = cnt + 65; LAS int* hoff = mtp + 66;
    __syncthreads();
    if (F.tid < NE) cnt[F.tid] = (int)__hip_atomic_load(F.ctl + CW_CNT + (layer * 64 + F.tid) * 64, RLX_AGENT);
    if (F.tid == NE) cnt[NE] = T;
    __syncthreads();
    if (F.tid == 0) { int m = 0;
_Pragma("nounroll")
        for (int e = 0; e < NEX; ++e) { mtp[e] = m; hoff[e] = m * 256; m += (cnt[e] + 255) >> 8; } mtp[NEX] = m; hoff[NEX] = m * 256; }
    __syncthreads();
}

__device__ __forceinline__ void route_phase(Frame& F, int layer, const float* rbias) {
    const float* lg = (const float*)(F.ws + WS_LOGITS); int* toklist = (int*)(F.ws + WS_TOKLIST); int2* tsel = (int2*)(F.ws + WS_TSEL);
    LAS float* sw = (LAS float*)(F.lds + F.wave * 256);
    const float rb = rbias[F.lane];
    for (int row = F.gw; row < T; row += F.NGW) {
        const float sc = sigmoidf_(lg[(size_t)row * NE + F.lane]); const float bz = sc + rb;
        sw[F.lane] = bz; LDS_WAIT();
        float v[64];
#pragma unroll
        for (int q = 0; q < 16; ++q) { const f32x4 t = *(const LAS f32x4*)(sw + 4 * q); v[4 * q] = t[0]; v[4 * q + 1] = t[1]; v[4 * q + 2] = t[2]; v[4 * q + 3] = t[3]; }
        LDS_WAIT();
        float gs[8];
#pragma unroll
        for (int gi = 0; gi < 8; ++gi) { float m1 = -INFINITY, m2 = -INFINITY;
#pragma unroll
            for (int k = 0; k < 8; ++k) { const float x = v[8 * gi + k]; const bool a = x > m1; const float nm2 = a ? m1 : fmaxf(m2, x); m1 = a ? x : m1; m2 = nm2; }
            gs[gi] = m1 + m2; }
        unsigned keep = 0u;
#pragma unroll
        for (int gi = 0; gi < 8; ++gi) { int rank = 0;
#pragma unroll
            for (int g2 = 0; g2 < 8; ++g2) rank += (gs[g2] > gs[gi] || (gs[g2] == gs[gi] && g2 < gi)) ? 1 : 0;
            keep |= (rank < 4) ? (1u << gi) : 0u; }
        const bool kown = (keep >> (F.lane >> 3)) & 1u; int rank = 0;
#pragma unroll
        for (int e2 = 0; e2 < 64; ++e2) { const bool k2 = (keep >> (e2 >> 3)) & 1u; rank += (k2 && (v[e2] > bz || (v[e2] == bz && e2 < F.lane))) ? 1 : 0; }
        const bool sel = kown && rank < TOPK;
        const unsigned long long bal = __ballot(sel);
        const float ssum = wave_sum(sel ? sc : 0.0f);
        if (sel) { const int j = __popcll(bal & ((1ull << F.lane) - 1ull)); const float gate = sc / ssum * 2.5f;
            const unsigned slot = __hip_atomic_fetch_add(F.ctl + CW_CNT + (layer * 64 + F.lane) * 64, 1u, RLX_AGENT);
            toklist[(size_t)F.lane * T + slot] = row;
            if (j < TOPK) tsel[(size_t)row * TOPK + j] = make_int2((F.lane << 20) | (int)slot, __float_as_int(gate)); }
    }
}

__device__ __forceinline__ void mix_phase(Frame& F, const float* mix) {
    bf16* xm = (bf16*)(F.ws + WS_XMIX);
    for (int row = F.gw; row < T; row += F.NGW) {
        const f32x4* xr = (const f32x4*)(F.out + (size_t)row * D) + F.lane; const bool first = (row & (SEQ - 1)) == 0;
#pragma unroll
        for (int j = 0; j < 4; ++j) { const f32x4 x = xr[64 * j] * (1.0f / ALPHA); const f32x4 xp = first ? (f32x4){0.f, 0.f, 0.f, 0.f} : xr[64 * j - 256] * (1.0f / ALPHA); const f32x4 xx = xp - x;
#pragma unroll
            for (int i = 0; i < 6; ++i) { const f32x4 mv = *(const f32x4*)(mix + i * D + 256 * j + 4 * F.lane); const f32x4 o = x + xx * mv;
                v2u w; w.x = cvt_pk_bf16(o[0], o[1]); w.y = cvt_pk_bf16(o[2], o[3]); *((v2u*)(xm + ((size_t)i * T + row) * D) + 64 * j + F.lane) = w; } }
    }
}

__device__ __forceinline__ void kmean_phase(Frame& F) {
    const bf16* Kb = (const bf16*)(F.ws + WS_K); float* km = (float*)(F.ws + WS_KMEAN);
    for (int u = F.gw; u < NBATCH * NH * NMB; u += F.NGW) { const int bh = u >> 4, blk = u & 15, b = bh >> 4, h = bh & 15;
        const bf16* p = Kb + ((size_t)b * SEQ + blk * MBLK) * D + h * HD + F.lane; float s = 0.f;
#pragma unroll 16
        for (int r = 0; r < MBLK; ++r) s += bf1(p[(size_t)r * D]);
        km[(size_t)u * HD + F.lane] = s * (1.0f / MBLK); }
}
__device__ __forceinline__ void sel_phase(Frame& F) {
    const bf16* Q = (const bf16*)(F.ws + WS_Q); const float* km = (const float*)(F.ws + WS_KMEAN); unsigned short* maskb = (unsigned short*)(F.ws + WS_MASK);
    LAS float* kl = (LAS float*)F.lds;
    for (int u = F.vcu; u < NBATCH * NH * (SEQ / NTHREADS); u += F.G) { const int bh = u >> 3, ch = u & 7, b = bh >> 4, h = bh & 15;
        __syncthreads();
        for (int i = F.tid; i < NMB * HD; i += NTHREADS) kl[i] = km[(size_t)bh * NMB * HD + i];
        __syncthreads();
        const int qpos = ch * NTHREADS + F.tid, qblk = qpos >> 8;
        const v4u* qp = (const v4u*)(Q + ((size_t)b * SEQ + qpos) * D + h * HD); float q[64];
#pragma unroll
        for (int i = 0; i < 8; ++i) { const v4u w = qp[i];
#pragma unroll
            for (int k = 0; k < 4; ++k) { q[8 * i + 2 * k] = bflo(w[k]); q[8 * i + 2 * k + 1] = bfhi(w[k]); } }
        float v1 = -INFINITY, v2 = -INFINITY, v3 = -INFINITY; int i1 = -1, i2 = -1, i3 = -1;
        for (int j = 0; j < qblk; ++j) { float gsum = 0.f; const LAS f32x4* kr = (const LAS f32x4*)(kl + j * HD);
#pragma unroll
            for (int i = 0; i < 16; ++i) { const f32x4 kv = kr[i]; gsum += q[4 * i] * kv[0] + q[4 * i + 1] * kv[1] + q[4 * i + 2] * kv[2] + q[4 * i + 3] * kv[3]; }
            if (gsum > v1) { v3 = v2; i3 = i2; v2 = v1; i2 = i1; v1 = gsum; i1 = j; }
            else if (gsum > v2) { v3 = v2; i3 = i2; v2 = gsum; i2 = j; }
            else if (gsum > v3) { v3 = gsum; i3 = j; } }
        unsigned mk = 0u; if (i1 >= 0) mk |= 1u << i1; if (i2 >= 0) mk |= 1u << i2; if (i3 >= 0) mk |= 1u << i3;
        maskb[(size_t)bh * SEQ + qpos] = (unsigned short)mk; }
}
__device__ __forceinline__ float q4_max(float v) {
    auto a = __builtin_amdgcn_permlane16_swap(__float_as_uint(v), __float_as_uint(v), false, false); v = __builtin_fmaxf(__uint_as_float(a[0]), __uint_as_float(a[1]));
    auto b = __builtin_amdgcn_permlane32_swap(__float_as_uint(v), __float_as_uint(v), false, false); return __builtin_fmaxf(__uint_as_float(b[0]), __uint_as_float(b[1])); }
__device__ __forceinline__ float q4_sum(float v) {
    auto a = __builtin_amdgcn_permlane16_swap(__float_as_uint(v), __float_as_uint(v), false, false); v = __uint_as_float(a[0]) + __uint_as_float(a[1]);
    auto b = __builtin_amdgcn_permlane32_swap(__float_as_uint(v), __float_as_uint(v), false, false); return __uint_as_float(b[0]) + __uint_as_float(b[1]); }
__device__ __forceinline__ void attn_phase(Frame& F, const float* rel_bias) {
    const bf16* Q = (const bf16*)(F.ws + WS_Q); const bf16* Kb = (const bf16*)(F.ws + WS_K); const bf16* Vt = (const bf16*)(F.ws + WS_VT); bf16* O = (bf16*)(F.ws + WS_O);
    const unsigned short* maskb = (const unsigned short*)(F.ws + WS_MASK);
    constexpr int KRS = 144, VRS = 272, KB_ = 128 * KRS, TB = KB_ + 64 * VRS;
    LAS float* tbl = (LAS float*)(F.lds + 2 * TB);
    __syncthreads();
    for (int i = F.tid; i < NH * 129; i += NTHREADS) { const int h = i / 129, d = i % 129; tbl[h * 132 + d] = rel_bias[(int)T5_BUCKET[d] * NH + h] * 1.4426950408889634f; }
    __syncthreads();
    const int qi = F.lane & 15, g = F.lane >> 4; unsigned tcount = 0;
    for (int it = 0;; ++it) {
        int bh, blk;
        if (F.G == 256) { if (it >= 8) break; bh = F.vcu >> 1; blk = (F.vcu & 1) ? ((it & 1) ? 15 - it : it + 1) : ((it & 1) ? 16 - it : it); }
        else { const int L = it * F.G + F.vcu; if (L >= NBATCH * NH * NMB) break; bh = L >> 4; blk = L & 15; }
        const int b = bh >> 4, h = bh & 15;
        const int q0 = blk * MBLK + 32 * F.wave;
        bf16x8 qf[2][2]; unsigned qmask[2];
#pragma unroll
        for (int gp = 0; gp < 2; ++gp) { const int qpos = q0 + 16 * gp + qi; const size_t qrow = (size_t)b * SEQ + qpos; qmask[gp] = maskb[(size_t)bh * SEQ + qpos];
#pragma unroll
            for (int ks = 0; ks < 2; ++ks) qf[gp][ks] = *(const bf16x8*)(Q + qrow * D + h * HD + 32 * ks + 8 * g); }
        const LAS float* tblh = tbl + h * 132; const float bfar = tblh[128];
        float mref[2] = {0.f, 0.f}; f32x4 o[2][5];
#pragma unroll
        for (int gp = 0; gp < 2; ++gp)
#pragma unroll
            for (int dt = 0; dt < 5; ++dt) o[gp][dt] = (f32x4){0.f, 0.f, 0.f, 0.f};
        constexpr float THR = 8.0f;
        const bf16x8 ones = {0x3F80, 0x3F80, 0x3F80, 0x3F80, 0x3F80, 0x3F80, 0x3F80, 0x3F80};
        const int nst = 2 + 2 * blk;
        const int kkey = F.tid >> 3, kch = F.tid & 7;
        const int vd = F.tid >> 3, vch = F.tid & 7;
        const bf16* kbase = Kb + ((size_t)b * SEQ + kkey) * D + h * HD + 8 * kch;
        const bf16* vbase = Vt + (((size_t)bh * HD + vd) << 12) + 8 * vch;
        v4u kreg[2], vreg[2];
        { const int key0 = blk * MBLK; kreg[0] = *(const v4u*)(kbase + (size_t)key0 * D); kreg[1] = *(const v4u*)(kbase + (size_t)(key0 + 64) * D); vreg[0] = *(const v4u*)(vbase + key0); vreg[1] = *(const v4u*)(vbase + key0 + 64); }
        for (int n = 0; n < nst; ++n) {
            int jb, key0; if (n < 2) { jb = blk; key0 = blk * MBLK + 128 * n; } else { const int mm = n - 2; jb = blk - 1 - (mm >> 1); key0 = jb * MBLK + 128 * (mm & 1); }
            LAS unsigned char* buf = F.lds + (tcount & 1u) * TB; ++tcount;
            *(LAS v4u*)(buf + kkey * KRS + kch * 16) = kreg[0]; *(LAS v4u*)(buf + (kkey + 64) * KRS + kch * 16) = kreg[1];
            *(LAS v4u*)(buf + KB_ + vd * VRS + vch * 16) = vreg[0]; *(LAS v4u*)(buf + KB_ + vd * VRS + (vch + 8) * 16) = vreg[1];
            asm volatile("s_waitcnt lgkmcnt(0)" ::: "memory");
            if (n + 1 < nst) { const int n1 = n + 1; int k1; if (n1 < 2) k1 = blk * MBLK + 128 * n1; else { const int mm = n1 - 2; k1 = (blk - 1 - (mm >> 1)) * MBLK + 128 * (mm & 1); }
                kreg[0] = *(const v4u*)(kbase + (size_t)k1 * D); kreg[1] = *(const v4u*)(kbase + (size_t)(k1 + 64) * D); vreg[0] = *(const v4u*)(vbase + k1); vreg[1] = *(const v4u*)(vbase + k1 + 64); }
            asm volatile("s_barrier" ::: "memory");
            const bool own = (jb == blk), nearb = (jb >= blk - 1);
            if (own && 128 * n > 32 * F.wave + 31) continue;
            f32x4 s[2][8]; bool selb[2];
#pragma unroll
            for (int gp = 0; gp < 2; ++gp) { selb[gp] = (qmask[gp] >> jb) & 1u; const float c0 = (n == 0) ? 0.0f : (nearb ? -mref[gp] : (selb[gp] ? bfar - mref[gp] : -INFINITY));
#pragma unroll
                for (int kt = 0; kt < 8; ++kt) s[gp][kt] = (f32x4){c0, c0, c0, c0}; }
#pragma unroll
            for (int kt = 0; kt < 8; ++kt)
#pragma unroll
                for (int ks = 0; ks < 2; ++ks) { const bf16x8 a = *(const LAS bf16x8*)(buf + (16 * kt + qi) * KRS + 64 * ks + 16 * g);
                    s[0][kt] = __builtin_amdgcn_mfma_f32_16x16x32_bf16(a, qf[0][ks], s[0][kt], 0, 0, 0); s[1][kt] = __builtin_amdgcn_mfma_f32_16x16x32_bf16(a, qf[1][ks], s[1][kt], 0, 0, 0);
                    }
#pragma unroll
            for (int gp = 0; gp < 2; ++gp) {
                float mx = -INFINITY;
                if (nearb) {
                    const int qpos = q0 + 16 * gp + qi; const int dist0 = qpos - (key0 + 4 * g);
#pragma unroll
                    for (int kh = 0; kh < 4; ++kh) { float bz[2][4];
#pragma unroll
                        for (int k4 = 0; k4 < 2; ++k4)
#pragma unroll
                            for (int r = 0; r < 4; ++r) { const int dist = dist0 - (16 * (2 * kh + k4) + r); const int dd = dist < 0 ? 0 : (dist > 128 ? 128 : dist); bz[k4][r] = tblh[dd]; }
#pragma unroll
                        for (int k4 = 0; k4 < 2; ++k4) asm volatile("" : "+v"(bz[k4][0]), "+v"(bz[k4][1]), "+v"(bz[k4][2]), "+v"(bz[k4][3]));
#pragma unroll
                        for (int k4 = 0; k4 < 2; ++k4)
#pragma unroll
                            for (int r = 0; r < 4; ++r) { const int kt = 2 * kh + k4; const int dist = dist0 - (16 * kt + r);
                                const bool valid = own ? (dist >= 0) : selb[gp]; const float x = valid ? s[gp][kt][r] + bz[k4][r] : -INFINITY; s[gp][kt][r] = x; mx = __builtin_fmaxf(mx, x); } }
                } else {
#pragma unroll
                    for (int kt = 0; kt < 8; ++kt)
#pragma unroll
                        for (int r = 0; r < 4; ++r) mx = __builtin_fmaxf(mx, s[gp][kt][r]); }
                mx = q4_max(mx);
                if (n == 0) {
                    mref[gp] = mx;
#pragma unroll
                    for (int kt = 0; kt < 8; ++kt)
#pragma unroll
                        for (int r = 0; r < 4; ++r) s[gp][kt][r] -= mx;
                } else if (__any(mx > THR)) {
                    const float dl = __builtin_fmaxf(mx, 0.0f), f = __builtin_amdgcn_exp2f(-dl); mref[gp] += dl;
#pragma unroll
                    for (int kt = 0; kt < 8; ++kt)
#pragma unroll
                        for (int r = 0; r < 4; ++r) s[gp][kt][r] -= dl;
#pragma unroll
                    for (int dt = 0; dt < 5; ++dt) o[gp][dt] = o[gp][dt] * f; }
#pragma unroll
                for (int kt = 0; kt < 8; ++kt)
#pragma unroll
                    for (int r = 0; r < 4; ++r) s[gp][kt][r] = __builtin_amdgcn_exp2f(s[gp][kt][r]);
            }
#pragma unroll
            for (int k2 = 0; k2 < 4; ++k2) { bf16x8 pb[2][4];
#pragma unroll
                for (int gp = 0; gp < 2; ++gp) { v4u pw; pw.x = cvt_pk_bf16(s[gp][2 * k2][0], s[gp][2 * k2][1]); pw.y = cvt_pk_bf16(s[gp][2 * k2][2], s[gp][2 * k2][3]);
                    pw.z = cvt_pk_bf16(s[gp][2 * k2 + 1][0], s[gp][2 * k2 + 1][1]); pw.w = cvt_pk_bf16(s[gp][2 * k2 + 1][2], s[gp][2 * k2 + 1][3]); pb[gp][k2] = __builtin_bit_cast(bf16x8, pw); }
#pragma unroll
                for (int dt = 0; dt < 4; ++dt) { const LAS unsigned char* vp = buf + KB_ + (16 * dt + qi) * VRS + 64 * k2 + 8 * g; const v2u lo = *(const LAS v2u*)vp, hi = *(const LAS v2u*)(vp + 32);
                    v4u aw; aw.x = lo.x; aw.y = lo.y; aw.z = hi.x; aw.w = hi.y; const bf16x8 av = __builtin_bit_cast(bf16x8, aw);
                    o[0][dt] = __builtin_amdgcn_mfma_f32_16x16x32_bf16(av, pb[0][k2], o[0][dt], 0, 0, 0); o[1][dt] = __builtin_amdgcn_mfma_f32_16x16x32_bf16(av, pb[1][k2], o[1][dt], 0, 0, 0); }
                o[0][4] = __builtin_amdgcn_mfma_f32_16x16x32_bf16(ones, pb[0][k2], o[0][4], 0, 0, 0); o[1][4] = __builtin_amdgcn_mfma_f32_16x16x32_bf16(ones, pb[1][k2], o[1][4], 0, 0, 0); }
        }
#pragma unroll
        for (int gp = 0; gp < 2; ++gp) { const float inv = 1.0f / o[gp][4][0]; const size_t qrow = (size_t)b * SEQ + q0 + 16 * gp + qi;
#pragma unroll
            for (int dt = 0; dt < 4; ++dt) { v2u w; w.x = cvt_pk_bf16(o[gp][dt][0] * inv, o[gp][dt][1] * inv); w.y = cvt_pk_bf16(o[gp][dt][2] * inv, o[gp][dt][3] * inv); *(v2u*)(O + qrow * D + h * HD + 16 * dt + 4 * g) = w; } }
    }
    __syncthreads();
}

constexpr int SC = 32, NCHK = SEQ / SC;
constexpr size_t WS_PT = WS_S + 256 * MiB;
constexpr size_t WS_LT = 48 * MiB;
constexpr size_t WS_QT = WS_S + 576 * MiB;
constexpr size_t WS_YS2 = WS_S;
static_assert(WS_LT + 128 * MiB <= WS_VF && WS_QT + 64 * MiB <= WS_YG, "chunk operator buffers");
__device__ __forceinline__ float reduce8(float v) { v = dpp_add<0xB1>(v); v = dpp_add<0x4E>(v); v = dpp_add<0x141>(v); return v; }
template <int KS> __device__ __forceinline__ f32x4 mm_tile(const LAS unsigned char* X, int xs, int m0, const LAS unsigned char* Y, int ys, int n0, f32x4 acc, int qi, int g) {
#pragma unroll
    for (int ks = 0; ks < KS; ++ks) { const bf16x8 a = *(const LAS bf16x8*)(X + (m0 + qi) * xs + 64 * ks + 16 * g), b = *(const LAS bf16x8*)(Y + (n0 + qi) * ys + 64 * ks + 16 * g);
        acc = __builtin_amdgcn_mfma_f32_16x16x32_bf16(a, b, acc, 0, 0, 0); }
    return acc;
}
typedef short v4i16_t_ __attribute__((ext_vector_type(4)));
__device__ __forceinline__ bf16x8 frag_tr(const LAS unsigned char* Z, int zs, int kk0, int c0, int qi, int g) {
    const LAS unsigned char* p = Z + (kk0 + 8 * g + (qi >> 2)) * zs + (c0 + 4 * (qi & 3)) * 2;
    const v4i16_t_ lo = __builtin_amdgcn_ds_read_tr16_b64_v4i16((LAS v4i16_t_*)p), hi = __builtin_amdgcn_ds_read_tr16_b64_v4i16((LAS v4i16_t_*)(p + 4 * zs));
    return (bf16x8){lo[0], lo[1], lo[2], lo[3], hi[0], hi[1], hi[2], hi[3]};
}
template <int KS> __device__ __forceinline__ f32x4 mm_tile_xt(const LAS unsigned char* Z, int zs, int m0, const LAS unsigned char* Y, int ys, int n0, f32x4 acc, int qi, int g) {
#pragma unroll
    for (int ks = 0; ks < KS; ++ks) { const bf16x8 a = frag_tr(Z, zs, 32 * ks, m0, qi, g), b = *(const LAS bf16x8*)(Y + (n0 + qi) * ys + 64 * ks + 16 * g);
        acc = __builtin_amdgcn_mfma_f32_16x16x32_bf16(a, b, acc, 0, 0, 0); }
    return acc;
}
template <int KS> __device__ __forceinline__ f32x4 mm_tile_yt(const LAS unsigned char* X, int xs, int m0, const LAS unsigned char* Z, int zs, int n0, f32x4 acc, int qi, int g) {
#pragma unroll
    for (int ks = 0; ks < KS; ++ks) { const bf16x8 a = *(const LAS bf16x8*)(X + (m0 + qi) * xs + 64 * ks + 16 * g), b = frag_tr(Z, zs, 32 * ks, n0, qi, g);
        acc = __builtin_amdgcn_mfma_f32_16x16x32_bf16(a, b, acc, 0, 0, 0); }
    return acc;
}
__device__ __forceinline__ v2u pack4(const f32x4 v) { v2u w; w.x = cvt_pk_bf16(v[0], v[1]); w.y = cvt_pk_bf16(v[2], v[3]); return w; }
__device__ __forceinline__ void chunk_prep(Frame& F, const bf16* vbuf, const float* k_k, const float* k_a, const bool dry = false) {
    const bf16* rb = (const bf16*)(F.ws + WS_R); const bf16* kb = (const bf16*)(F.ws + WS_KK); const bf16* ab = (const bf16*)(F.ws + WS_A); const float* lw = (const float*)(F.ws + WS_LW);
    bf16* PTg = (bf16*)(F.ws + WS_PT); bf16* QTg = (bf16*)(F.ws + WS_QT); bf16* LTg = (bf16*)(F.ws + WS_LT); float* ys = (float*)(F.ws + WS_YS2);
    constexpr int RS = 144, TS_ = 80;
    constexpr int O_AT = 0, O_BT = 4608, O_KT = 9216, O_RT = 13824, O_VT = 18432, O_X2T = 23040, O_GT = 28160,
                  O_TM = 33280, O_NRBT = 35840, O_NAK = 38400, O_X1T = 40960, O_HT = 43520, O_NAB = 46080, O_WC = 50688, O_PK = 50944, O_CL = O_X2T;
    const int grp = F.wave >> 2, wg = F.wave & 3;
    LAS unsigned char* L = F.lds + grp * 65536;
    const int gt0 = F.tid & 255, st0 = gt0 >> 3, c80 = gt0 & 7;
    __syncthreads();
    for (int i = gt0; i < D; i += 256) { *(LAS float*)(L + O_PK + i * 4) = k_k[i]; *(LAS float*)(L + O_PK + 4096 + i * 4) = k_a[i]; }
    constexpr int NIT = (NBATCH * NH * NCHK) / (2 * 256);
    v4u pre_r, pre_k, pre_a, pre_v; f32x4 pre_l0, pre_l1;
#define CP_LOAD(it_) do { const int item_ = ((it_) * F.G + F.vcu) * 2 + grp, bh_ = item_ >> 7, ck_ = item_ & (NCHK - 1); \
        const size_t o_ = ((size_t)(bh_ >> 4) * SEQ + ck_ * SC + st0) * D + (bh_ & 15) * HD + 8 * c80; \
        pre_r = *(const v4u*)(rb + o_); pre_k = *(const v4u*)(kb + o_); pre_a = *(const v4u*)(ab + o_); pre_v = *(const v4u*)(vbuf + o_); pre_l0 = *(const f32x4*)(lw + o_); pre_l1 = *(const f32x4*)(lw + o_ + 4); } while (0)
    CP_LOAD(0);
    for (int it = 0; it < NIT; ++it) {
        const int item = (it * F.G + F.vcu) * 2 + grp, bh = item >> 7, ck = item & (NCHK - 1), b = bh >> 4, h = bh & 15, t0 = ck * SC;
        const size_t base = ((size_t)b * SEQ + t0) * D + h * HD;
        int lane_i = F.lane; asm volatile("" : "+v"(lane_i));
        const int gt = (wg << 6) | lane_i, qi = lane_i & 15, g = lane_i >> 4, st = gt >> 3, c8 = gt & 7;
        __syncthreads();
        float r8[8], al8[8], be8[8], kh8[8], v8[8];
        { const v4u wr_ = pre_r, wk = pre_k, wa = pre_a, wv = pre_v;
          const f32x4 l0 = pre_l0, l1 = pre_l1;
          const f32x4 kk0 = *(const LAS f32x4*)(L + O_PK + (h * HD + 8 * c8) * 4), kk1 = *(const LAS f32x4*)(L + O_PK + (h * HD + 8 * c8 + 4) * 4), ka0 = *(const LAS f32x4*)(L + O_PK + 4096 + (h * HD + 8 * c8) * 4), ka1 = *(const LAS f32x4*)(L + O_PK + 4096 + (h * HD + 8 * c8 + 4) * 4);
          float k8[8], a8[8], kk8[8]; float ss = 0.f;
#pragma unroll
          for (int j = 0; j < 8; ++j) { const unsigned xr = wr_[j >> 1], xk = wk[j >> 1], xa = wa[j >> 1], xv = wv[j >> 1];
              r8[j] = (j & 1) ? bfhi(xr) : bflo(xr); k8[j] = (j & 1) ? bfhi(xk) : bflo(xk); a8[j] = (j & 1) ? bfhi(xa) : bflo(xa); v8[j] = (j & 1) ? bfhi(xv) : bflo(xv);
              kk8[j] = k8[j] * (j < 4 ? kk0[j & 3] : kk1[j & 3]); ss += kk8[j] * kk8[j]; }
          ss = reduce8(ss); const float inv = 1.0f / fmaxf(sqrtf(ss), 1e-12f);
#pragma unroll
          for (int j = 0; j < 8; ++j) { const float kk = kk8[j] * inv; al8[j] = -kk; be8[j] = kk * a8[j]; kh8[j] = k8[j] * (1.0f + (a8[j] - 1.0f) * (j < 4 ? ka0[j & 3] : ka1[j & 3])); }
          *(LAS f32x4*)(L + O_CL + (st * 64 + 8 * c8) * 4) = l0; *(LAS f32x4*)(L + O_CL + (st * 64 + 8 * c8 + 4) * 4) = l1; }
        __syncthreads();
#if DRYCUT == 5
        if (dry) continue;
#endif
        if (gt < 64) { float cv[SC];
#pragma unroll
            for (int t = 0; t < SC; ++t) cv[t] = *(const LAS float*)(L + O_CL + (t * 64 + gt) * 4);
#pragma unroll
            for (int t = 1; t < SC; ++t) cv[t] += cv[t - 1];
#pragma unroll
            for (int t = 0; t < SC; ++t) *(LAS float*)(L + O_CL + (t * 64 + gt) * 4) = cv[t];
            *(LAS float*)(L + O_WC + gt * 4) = fast_exp(cv[SC - 1]); }
        __syncthreads();
#if DRYCUT == 6
        if (dry) continue;
#endif
        { float cl[8], cm[8];
          { const f32x4 c0 = *(const LAS f32x4*)(L + O_CL + (st * 64 + 8 * c8) * 4), c1 = *(const LAS f32x4*)(L + O_CL + (st * 64 + 8 * c8 + 4) * 4);
            f32x4 m0 = {0.f, 0.f, 0.f, 0.f}, m1 = {0.f, 0.f, 0.f, 0.f};
            if (st > 0) { m0 = *(const LAS f32x4*)(L + O_CL + ((st - 1) * 64 + 8 * c8) * 4); m1 = *(const LAS f32x4*)(L + O_CL + ((st - 1) * 64 + 8 * c8 + 4) * 4); }
#pragma unroll
            for (int j = 0; j < 4; ++j) { cl[j] = c0[j]; cl[4 + j] = c1[j]; cm[j] = m0[j]; cm[4 + j] = m1[j]; } }
          float at8[8], bt8[8], kt8[8], rt8[8];
#pragma unroll
          for (int j = 0; j < 8; ++j) { const float e1 = fast_exp(cl[j]), em = fast_exp(cm[j]), en = fast_exp(-cl[j]); at8[j] = al8[j] * em; bt8[j] = be8[j] * en; kt8[j] = kh8[j] * en; rt8[j] = r8[j] * e1; }
          v4u w; w.x = cvt_pk_bf16(at8[0], at8[1]); w.y = cvt_pk_bf16(at8[2], at8[3]); w.z = cvt_pk_bf16(at8[4], at8[5]); w.w = cvt_pk_bf16(at8[6], at8[7]); *(LAS v4u*)(L + O_AT + st * RS + 16 * c8) = w;
          w.x = cvt_pk_bf16(bt8[0], bt8[1]); w.y = cvt_pk_bf16(bt8[2], bt8[3]); w.z = cvt_pk_bf16(bt8[4], bt8[5]); w.w = cvt_pk_bf16(bt8[6], bt8[7]); *(LAS v4u*)(L + O_BT + st * RS + 16 * c8) = w;
          w.x = cvt_pk_bf16(kt8[0], kt8[1]); w.y = cvt_pk_bf16(kt8[2], kt8[3]); w.z = cvt_pk_bf16(kt8[4], kt8[5]); w.w = cvt_pk_bf16(kt8[6], kt8[7]); *(LAS v4u*)(L + O_KT + st * RS + 16 * c8) = w;
          w.x = cvt_pk_bf16(rt8[0], rt8[1]); w.y = cvt_pk_bf16(rt8[2], rt8[3]); w.z = cvt_pk_bf16(rt8[4], rt8[5]); w.w = cvt_pk_bf16(rt8[6], rt8[7]); *(LAS v4u*)(L + O_RT + st * RS + 16 * c8) = w;
          w.x = cvt_pk_bf16(v8[0], v8[1]); w.y = cvt_pk_bf16(v8[2], v8[3]); w.z = cvt_pk_bf16(v8[4], v8[5]); w.w = cvt_pk_bf16(v8[6], v8[7]); *(LAS v4u*)(L + O_VT + st * RS + 16 * c8) = w; }
        __syncthreads();
#if DRYCUT == 1
        if (dry) continue;
#endif
        { const int mt = wg >> 1, nt = wg & 1, n = 16 * nt + qi, m0 = 16 * mt + 4 * g; const f32x4 z = {0.f, 0.f, 0.f, 0.f};
          f32x4 c1 = mm_tile<2>(L + O_AT, RS, 16 * mt, L + O_BT, RS, 16 * nt, z, qi, g);
#pragma unroll
          for (int r = 0; r < 4; ++r) c1[r] = (n < m0 + r) ? c1[r] : 0.f;
          *(LAS f32x4*)(L + O_NAB + n * 144 + m0 * 4) = c1;
          f32x4 c2 = mm_tile<2>(L + O_BT, RS, 16 * mt, L + O_RT, RS, 16 * nt, z, qi, g);
#pragma unroll
          for (int r = 0; r < 4; ++r) c2[r] = (m0 + r <= n) ? c2[r] : 0.f;
          *(LAS v2u*)(L + O_NRBT + n * TS_ + m0 * 2) = pack4(c2);
          f32x4 c3 = mm_tile<2>(L + O_AT, RS, 16 * mt, L + O_KT, RS, 16 * nt, z, qi, g);
#pragma unroll
          for (int r = 0; r < 4; ++r) c3[r] = (n < m0 + r) ? c3[r] : 0.f;
          *(LAS v2u*)(L + O_NAK + n * TS_ + m0 * 2) = pack4(c3); }
        __syncthreads();
#if DRYCUT == 2
        if (dry) continue;
#endif
        if (wg == 0) { const int col = lane_i & 31; float x[SC];
#pragma unroll
            for (int s = SC - 1; s >= 0; --s) { float ac[4] = {(col == s) ? 1.0f : 0.0f, 0.f, 0.f, 0.f};
#pragma unroll
                for (int q4 = SC / 4 - 1; q4 >= (s + 1) >> 2; --q4) { const f32x4 nv = *(const LAS f32x4*)(L + O_NAB + s * 144 + q4 * 16);
#pragma unroll
                    for (int r = 3; r >= 0; --r) { const int t = 4 * q4 + r; if (t > s) ac[r] += nv[r] * x[t]; } }
                x[s] = (ac[0] + ac[1]) + (ac[2] + ac[3]); }
            if (lane_i < 32) {
#pragma unroll
                for (int s = 0; s < SC; ++s) *(LAS bf16*)(L + O_TM + s * TS_ + col * 2) = (bf16)(cvt_pk_bf16(x[s], 0.f) & 0xffffu); } }
        __syncthreads();
#if DRYCUT == 3
        if (dry) continue;
#endif
        { const f32x4 z = {0.f, 0.f, 0.f, 0.f};
          { const int mt = wg >> 1, nt = wg & 1; const f32x4 c = mm_tile<1>(L + O_TM, TS_, 16 * mt, L + O_NRBT, TS_, 16 * nt, z, qi, g); *(LAS v2u*)(L + O_X1T + (16 * nt + qi) * TS_ + (16 * mt + 4 * g) * 2) = pack4(c); }
#pragma unroll
          for (int q = 0; q < 2; ++q) { const int tix = wg * 2 + q, mt = tix >> 2, nt = tix & 3; const f32x4 c = mm_tile_yt<1>(L + O_TM, TS_, 16 * mt, L + O_BT, RS, 16 * nt, z, qi, g);
              *(LAS v2u*)(L + O_X2T + (16 * nt + qi) * TS_ + (16 * mt + 4 * g) * 2) = pack4(c); } }
        if (it + 1 < NIT) CP_LOAD(it + 1);
        __syncthreads();
        { const size_t cid = (size_t)bh * NCHK + ck;
#pragma unroll
          for (int q = 0; q < 2; ++q) { const int tix = wg * 2 + q, mt = tix >> 1, nt = tix & 1, t = 16 * nt + qi; const v2u rw = *(const LAS v2u*)(L + O_RT + t * RS + (16 * mt + 4 * g) * 2);
              f32x4 c = {bflo(rw.x), bfhi(rw.x), bflo(rw.y), bfhi(rw.y)}; c = mm_tile_xt<1>(L + O_AT, RS, 16 * mt, L + O_X1T, TS_, 16 * nt, c, qi, g);
              *(v2u*)(QTg + (cid * SC + t) * 64 + 16 * mt + 4 * g) = pack4(c); }
          { const int mt = wg >> 1, nt = wg & 1, n = 16 * nt + qi, m0 = 16 * mt + 4 * g; f32x4 c = mm_tile<2>(L + O_KT, RS, 16 * mt, L + O_RT, RS, 16 * nt, (f32x4){0.f, 0.f, 0.f, 0.f}, qi, g);
#pragma unroll
            for (int r = 0; r < 4; ++r) c[r] = (m0 + r <= n) ? c[r] : 0.f;
            c = mm_tile<1>(L + O_NAK, TS_, 16 * mt, L + O_X1T, TS_, 16 * nt, c, qi, g); *(LAS v2u*)(L + O_HT + n * TS_ + m0 * 2) = pack4(c); }
#pragma unroll
          for (int q = 0; q < 4; ++q) { const int mt = wg, nt = q, k = 16 * nt + qi, m0 = 16 * mt + 4 * g; f32x4 c = mm_tile_xt<1>(L + O_AT, RS, 16 * mt, L + O_X2T, TS_, 16 * nt, (f32x4){0.f, 0.f, 0.f, 0.f}, qi, g);
              const float wc = *(const LAS float*)(L + O_WC + k * 4);
#pragma unroll
              for (int r = 0; r < 4; ++r) c[r] = (c[r] + ((m0 + r == k) ? 1.0f : 0.0f)) * wc;
              *(v2u*)(PTg + (cid * 64 + k) * 64 + 16 * mt + 4 * g) = pack4(c); }
#pragma unroll
          for (int q = 0; q < 2; ++q) { const int tix = wg * 2 + q, mt = tix >> 2, nt = tix & 3, k = 16 * nt + qi, m0 = 16 * mt + 4 * g; f32x4 c;
#pragma unroll
              for (int r = 0; r < 4; ++r) c[r] = bf1(*(const LAS bf16*)(L + O_KT + (m0 + r) * RS + k * 2));
              c = mm_tile<1>(L + O_NAK, TS_, 16 * mt, L + O_X2T, TS_, 16 * nt, c, qi, g); const float wc = *(const LAS float*)(L + O_WC + k * 4);
              *(LAS v2u*)(L + O_GT + k * TS_ + m0 * 2) = pack4(c * wc); } }
        __syncthreads();
#if DRYCUT == 4
        if (dry) continue;
#endif
        { const size_t cid = (size_t)bh * NCHK + ck; const f32x4 z = {0.f, 0.f, 0.f, 0.f};
#pragma unroll
          for (int q = 0; q < 4; ++q) { const int mt = q, nt = wg; const f32x4 c = mm_tile_yt<1>(L + O_GT, TS_, 16 * mt, L + O_VT, RS, 16 * nt, z, qi, g);
              *(v2u*)(LTg + (((cid * 4 + nt) * 4 + mt) * 64 + lane_i) * 4) = pack4(c); }
#pragma unroll
          for (int q = 0; q < 2; ++q) { const int mt = q, nt = wg; const f32x4 c = mm_tile_yt<1>(L + O_HT, TS_, 16 * mt, L + O_VT, RS, 16 * nt, z, qi, g);
#pragma unroll
              for (int r = 0; r < 4; ++r) if (!dry) ys[base + (size_t)(16 * mt + 4 * g + r) * D + 16 * nt + qi] = c[r]; } }
    }
#undef CP_LOAD
    __syncthreads();
}
__device__ __forceinline__ void chunk_scan(Frame& F, const bool dry = false) {
    const bf16* PTg = (const bf16*)(F.ws + WS_PT); const bf16* QTg = (const bf16*)(F.ws + WS_QT); const bf16* LTg = (const bf16*)(F.ws + WS_LT); float* ys = (float*)(F.ws + WS_YS2);
    const int qi = F.lane & 15, g = F.lane >> 4, hs = F.wave >> 2, w = F.wave & 3, ty = w & 1, vy0 = 2 * (w >> 1);
    constexpr int SRS = 144, SBUF = 64 * SRS;
    LAS unsigned char* SL = F.lds + hs * 2 * SBUF;
    for (int u = F.vcu; u < NBATCH * NH / 2; u += F.G) {
        const int bh = 2 * u + hs, b = bh >> 4, h = bh & 15;
        __syncthreads();
        unsigned z_ = 0u; asm volatile("" : "+v"(z_));
        for (int i = F.lane; i < 16 * 64 / 8; i += 64) *(LAS v4u*)(SL + (16 * w + (i >> 3)) * SRS + (i & 7) * 16) = (v4u){z_, z_, z_, z_};
        __syncthreads();
        v4u pa0[2], qa0[2], pa1[2], qa1[2]; v2u lt0[4], lt1[4]; float yl0[2][4], yl1[2][4];
#define CS_LOAD(pa, qa, lt, yl, ck_) do { const size_t cid = (size_t)bh * NCHK + (ck_); \
        _Pragma("unroll") for (int ks = 0; ks < 2; ++ks) { pa[ks] = *(const v4u*)(PTg + (cid * 64 + 16 * w + qi) * 64 + 32 * ks + 8 * g); qa[ks] = *(const v4u*)(QTg + (cid * SC + 16 * ty + qi) * 64 + 32 * ks + 8 * g); } \
        _Pragma("unroll") for (int nt = 0; nt < 4; ++nt) lt[nt] = *(const v2u*)(LTg + (((cid * 4 + nt) * 4 + w) * 64 + F.lane) * 4); \
        _Pragma("unroll") for (int i_ = 0; i_ < 2; ++i_) { _Pragma("unroll") for (int r = 0; r < 4; ++r) yl[i_][r] = ys[((size_t)b * SEQ + (ck_) * SC + 16 * ty + 4 * g + r) * D + h * HD + 16 * (vy0 + i_) + qi]; } } while (0)
#define CS_STEP(pa, qa, lt, yl, ck_) do { const LAS unsigned char* Sc = SL + ((ck_) & 1) * SBUF; LAS unsigned char* Sn = SL + (((ck_) + 1) & 1) * SBUF; \
        bf16x8 bfr[4][2]; \
        _Pragma("unroll") for (int nt = 0; nt < 4; ++nt) { _Pragma("unroll") for (int ks = 0; ks < 2; ++ks) bfr[nt][ks] = *(const LAS bf16x8*)(Sc + (16 * nt + qi) * SRS + 64 * ks + 16 * g); } \
        f32x4 y_[2]; \
        _Pragma("unroll") for (int i_ = 0; i_ < 2; ++i_) { y_[i_] = (f32x4){yl[i_][0], yl[i_][1], yl[i_][2], yl[i_][3]}; \
            _Pragma("unroll") for (int ks = 0; ks < 2; ++ks) { const bf16x8 by_ = *(const LAS bf16x8*)(Sc + (16 * (vy0 + i_) + qi) * SRS + 64 * ks + 16 * g);     \
                y_[i_] = __builtin_amdgcn_mfma_f32_16x16x32_bf16(__builtin_bit_cast(bf16x8, qa[ks]), by_, y_[i_], 0, 0, 0); } } \
        _Pragma("unroll") for (int nt = 0; nt < 4; ++nt) { f32x4 sn = {bflo(lt[nt].x), bfhi(lt[nt].x), bflo(lt[nt].y), bfhi(lt[nt].y)}; \
            _Pragma("unroll") for (int ks = 0; ks < 2; ++ks) sn = __builtin_amdgcn_mfma_f32_16x16x32_bf16(__builtin_bit_cast(bf16x8, pa[ks]), bfr[nt][ks], sn, 0, 0, 0); \
            *(LAS v2u*)(Sn + (16 * nt + qi) * SRS + (16 * w + 4 * g) * 2) = pack4(sn); } \
        __builtin_amdgcn_sched_barrier(0); \
        if ((ck_) + 2 < NCHK && !(DRYCUT == 7 && dry)) CS_LOAD(pa, qa, lt, yl, (ck_) + 2); \
        __builtin_amdgcn_sched_barrier(0);              \
        _Pragma("unroll") for (int i_ = 0; i_ < 2; ++i_) { _Pragma("unroll") for (int r = 0; r < 4; ++r) { if (!dry) ys[((size_t)b * SEQ + (ck_) * SC + 16 * ty + 4 * g + r) * D + h * HD + 16 * (vy0 + i_) + qi] = y_[i_][r]; } } \
        asm volatile("s_waitcnt lgkmcnt(0)\n\ts_barrier" ::: "memory");        \
        __builtin_amdgcn_sched_barrier(0); } while (0)
        CS_LOAD(pa0, qa0, lt0, yl0, 0); CS_LOAD(pa1, qa1, lt1, yl1, 1);
#pragma unroll 8
        for (int ck = 0; ck < NCHK; ck += 2) { CS_STEP(pa0, qa0, lt0, yl0, ck); CS_STEP(pa1, qa1, lt1, yl1, ck + 1); }
#undef CS_STEP
#undef CS_LOAD
    }
    __syncthreads();
}
__device__ __forceinline__ void post_phase(Frame& F, const bf16* vbuf, const float* k_a, const float* r_k, const float* gn_g, const float* gn_b) {
    const bf16* rb = (const bf16*)(F.ws + WS_R); const bf16* kb = (const bf16*)(F.ws + WS_KK); const bf16* ab = (const bf16*)(F.ws + WS_A); const bf16* gb = (const bf16*)(F.ws + WS_G);
    const float* ys = (const float*)(F.ws + WS_YS2); bf16* yg = (bf16*)(F.ws + WS_YG);
    for (int row = F.gw; row < T; row += F.NGW) {
#pragma unroll
        for (int j = 0; j < 4; ++j) { const size_t o = (size_t)row * D + 256 * j + 4 * F.lane; const int cc = 256 * j + 4 * F.lane;
            const f32x4 y = *(const f32x4*)(ys + o); const v2u wr_ = *(const v2u*)(rb + o), wk = *(const v2u*)(kb + o), wa = *(const v2u*)(ab + o), wv = *(const v2u*)(vbuf + o), wg = *(const v2u*)(gb + o);
            const f32x4 r4 = {bflo(wr_.x), bfhi(wr_.x), bflo(wr_.y), bfhi(wr_.y)}, k4 = {bflo(wk.x), bfhi(wk.x), bflo(wk.y), bfhi(wk.y)}, a4 = {bflo(wa.x), bfhi(wa.x), bflo(wa.y), bfhi(wa.y)};
            const f32x4 v4 = {bflo(wv.x), bfhi(wv.x), bflo(wv.y), bfhi(wv.y)}, g4 = {bflo(wg.x), bfhi(wg.x), bflo(wg.y), bfhi(wg.y)};
            const f32x4 kav = *(const f32x4*)(k_a + cc), rkv = *(const f32x4*)(r_k + cc), gg = *(const f32x4*)(gn_g + cc), gbv = *(const f32x4*)(gn_b + cc);
            const float mean = reduce16((y[0] + y[1]) + (y[2] + y[3])) * (1.0f / HD); const f32x4 dy = y - mean;
            const float var = reduce16((dy[0] * dy[0] + dy[1] * dy[1]) + (dy[2] * dy[2] + dy[3] * dy[3])) * (1.0f / HD); const float rstd = 1.0f / sqrtf(var + GN_EPS);
            const f32x4 kh = k4 * (1.0f + (a4 - 1.0f) * kav); const f32x4 pr = r4 * kh * rkv; const float rk = reduce16((pr[0] + pr[1]) + (pr[2] + pr[3]));
            const f32x4 res = (dy * rstd * gg + gbv + v4 * rk) * g4;
            v2u w; w.x = cvt_pk_bf16(res[0], res[1]); w.y = cvt_pk_bf16(res[2], res[3]); *(v2u*)(yg + o) = w; }
    }
}

__global__ void __launch_bounds__(NTHREADS, 2) fwd_kernel(Args args) {
    extern __shared__ __attribute__((aligned(16))) unsigned char lds_raw[];
    Frame F;
    F.lds = (LAS unsigned char*)lds_raw; F.ws = args.ws; F.out = args.out; F.ctl = (gu32*)(args.ws + WS_CTL);
    F.tid = 0; F.lane = 0; F.wave = __builtin_amdgcn_readfirstlane((int)threadIdx.x >> 6);
    F.G = gridDim.x; { const int bx = blockIdx.x; F.vcu = (F.G % 8 == 0) ? (bx % 8) * (F.G / 8) + bx / 8 : bx; }
    F.gw = F.vcu * NWAVES + F.wave; F.NGW = F.G * NWAVES;
    for (int i = threadIdx.x; i < (LDS_BYTES - MISC_OFF) / 4; i += NTHREADS) ((LAS unsigned*)(F.lds + MISC_OFF))[i] = 0u;
    __syncthreads();
    XcdBarrier bar = xcd_barrier_post((unsigned*)(F.ctl + CW_BAR), (volatile LAS unsigned*)(F.lds + MISC_OFF) + 8);
#define GRID_BAR() xcd_barrier(bar)
    if (threadIdx.x < 35) ((LAS unsigned long long*)(F.lds + PTAB_OFF))[threadIdx.x] = (unsigned long long)args.in[threadIdx.x];
    __syncthreads();
#define IN(k) in_ptr(F, (k))
    unsigned char* ws = args.ws;
    MoeTab MT; MT.cnt = (const LAS int*)(F.lds + TAB_OFF); MT.mtpref = MT.cnt + 65; MT.hoff = MT.mtpref + 66;

#if EN_P0
    { Frame P = phase_frame(F);
    ln_phase<2>(P, IN(0), nullptr, nullptr, false, MT);
    for (int j = 0; j < 2; ++j) {
        convert_plain(P, IN(1) + (size_t)j * D * 3 * D, D, 3 * D, (bf16*)(ws + WS_WQKV) + (size_t)j * 3 * D * D, 0);
        convert_plain(P, IN(2) + (size_t)j * D * D, D, D, (bf16*)(ws + WS_WOA) + (size_t)j * D * D, 0);
        for (int s = 0; s < 3; ++s) convert_plain(P, IN(5) + ((size_t)j * 3 + s) * D * D, D, D, (bf16*)(ws + WS_WRKV) + (size_t)j * 3 * D * D, s * D);
        convert_plain(P, IN(22) + (size_t)j * D * D, D, D, (bf16*)(ws + WS_WOB) + (size_t)j * D * D, 0);
        bf16* L1 = (bf16*)(ws + WS_L1) + (size_t)j * 4 * 256 * D; bf16* L2 = (bf16*)(ws + WS_L2) + (size_t)j * 4 * D * 256;
        convert_small(P, IN(7) + (size_t)j * D * 64, D, 64, L1, 256, D);
        convert_small(P, IN(10) + (size_t)j * D * 64, D, 64, L1 + 256 * D, 256, D);
        convert_small(P, IN(15) + (size_t)j * D * 160, D, 160, L1 + 2 * 256 * D, 256, D);
        convert_small(P, IN(8) + (size_t)j * 64 * D, 64, D, L2, D, 256);
        convert_small(P, IN(11) + (size_t)j * 64 * D, 64, D, L2 + D * 256, D, 256);
        convert_small(P, IN(16) + (size_t)j * 160 * D, 160, D, L2 + 2 * D * 256, D, 256);
        if (j == 1) { convert_small(P, IN(13), D, 32, L1 + 3 * 256 * D, 256, D); convert_small(P, IN(14), 32, D, L2 + 3 * D * 256, D, 256); }
    }
    for (int i = 0; i < DEPTH; ++i) convert_small(P, IN(23) + (size_t)i * D * NE, D, NE, (bf16*)(ws + WS_WR) + (size_t)i * 256 * D, 256, D);
    }
#endif
    GRID_BAR();

#define PH_BEGIN { Frame P = phase_frame(F);
#define PH_END } GRID_BAR();
    for (int i = 0; i < DEPTH; ++i) {
        const int j = i >> 1;
        if ((i & 1) == 0) {
            PH_BEGIN
#if EN_QKV
              SchedDense S{T / 256, 12, P.G, (int)blockIdx.x, D, (const char*)(ws + WS_XB), (const char*)(ws + WS_WQKV) + (size_t)j * 3 * D * D * 2};
              EpiQKV E{(bf16*)(ws + WS_Q), (bf16*)(ws + WS_K), (bf16*)(ws + WS_VT)};
              for (int rep = 0; rep < REP_QKV; ++rep) pg8::gemm_phase<D>(P.lds, P.tid, S, E);
#endif
            PH_END
            PH_BEGIN
#if EN_KMEAN
            kmean_phase(P);
#endif
            PH_END
            PH_BEGIN
#if EN_SEL
            sel_phase(P);
#endif
            PH_END
            PH_BEGIN
#if EN_ATTN
            for (int rep = 0; rep < REP_ATTN; ++rep) attn_phase(P, IN(3));
#endif
            PH_END
            PH_BEGIN
#if EN_OPA
              SchedDense S{T / 256, 4, P.G, (int)blockIdx.x, D, (const char*)(ws + WS_O), (const char*)(ws + WS_WOA) + (size_t)j * D * D * 2};
              EpiAdd E{P.out};
              pg8::gemm_phase<D>(P.lds, P.tid, S, E);
#endif
            PH_END
        } else {
            const size_t voff = (j == 0 ? WS_VF : WS_V);
            PH_BEGIN
#if EN_MIX
            for (int rep = 0; rep < REP_MIX; ++rep) mix_phase(P, IN(4) + (size_t)j * 6 * D);
#endif
            PH_END
            PH_BEGIN
#if EN_RKV
              SchedRkv S{T / 256, j == 0 ? 15 : 16, P.G, (int)blockIdx.x, (const char*)(ws + WS_XMIX), (const char*)(ws + WS_WRKV) + (size_t)j * 3 * D * D * 2, (const char*)(ws + WS_L1) + (size_t)j * 4 * 256 * D * 2};
              EpiRkv E{ws, voff};
              pg8::gemm_phase<D>(P.lds, P.tid, S, E);
#endif
            PH_END
            PH_BEGIN
#if EN_L2
              SchedL2 S{T / 256, j == 0 ? 12 : 16, P.G, (int)blockIdx.x, (const char*)(ws + WS_HL), (const char*)(ws + WS_L2) + (size_t)j * 4 * D * 256 * 2};
              EpiL2 E{(float*)(ws + WS_LW), (bf16*)(ws + WS_A), (bf16*)(ws + WS_G), (bf16*)(ws + voff), (const bf16*)(ws + WS_VF), IN(6) + j * D, IN(9) + j * D, IN(12)};
              pg8::gemm_phase<256>(P.lds, P.tid, S, E);
#endif
            PH_END
            PH_BEGIN
#if EN_SCAN
            for (int rep = 0; rep < REP_SCAN; ++rep) chunk_prep(P, (const bf16*)(ws + voff), IN(17) + j * D, IN(18) + j * D, rep + 1 < REP_SCAN);
#endif
            PH_END
            PH_BEGIN
#if EN_SCANB
            for (int rep = 0; rep < REP_SCANB; ++rep) chunk_scan(P, rep + 1 < REP_SCANB);
#endif
            PH_END
            PH_BEGIN
#if EN_POST
#ifdef DBG_POST_COPY
            { const v4u* s_ = (const v4u*)(ws + WS_A); v4u* d_ = (v4u*)(ws + WS_YG); for (size_t q = (size_t)P.gw * 64 + P.lane; q < (size_t)T * D / 8; q += (size_t)P.NGW * 64) d_[q] = s_[q]; }
#else
            post_phase(P, (const bf16*)(ws + voff), IN(18) + j * D, IN(19) + j * D, IN(20) + j * D, IN(21) + j * D);
#endif
#endif
            PH_END
            PH_BEGIN
#if EN_OPB
              SchedDense S{T / 256, 4, P.G, (int)blockIdx.x, D, (const char*)(ws + WS_YG), (const char*)(ws + WS_WOB) + (size_t)j * D * D * 2};
              EpiAdd E{P.out};
              pg8::gemm_phase<D>(P.lds, P.tid, S, E);
#endif
            PH_END
        }
        PH_BEGIN
#if EN_LN1
        ln_phase<0>(P, P.out, IN(31) + i * D, IN(32) + i * D, false, MT);
#endif
#if EN_CVT
        for (int rep = 0; rep < REP_CVT; ++rep) convert_moe(P, IN(25) + (size_t)i * NE * D * DE, IN(26) + (size_t)i * NE * D * DE, IN(27) + (size_t)i * NE * DE * D, IN(28) + (size_t)i * D * DE, IN(29) + (size_t)i * D * DE, IN(30) + (size_t)i * DE * D);
#endif
        PH_END
        PH_BEGIN
#if EN_ROUTER
          SchedDense S{T / 256, 1, P.G, (int)blockIdx.x, D, (const char*)(ws + WS_XB), (const char*)(ws + WS_WR) + (size_t)i * 256 * D * 2};
          EpiLogits E{(float*)(ws + WS_LOGITS)};
          pg8::gemm_phase<D>(P.lds, P.tid, S, E);
#endif
        PH_END
        PH_BEGIN
#if EN_ROUTE
        route_phase(P, i, IN(24) + i * NE);
#endif
        PH_END
        PH_BEGIN
        moe_tables(P, i);
#if EN_G1
          SchedMoe1 S{P.G, P.vcu, MT, (const char*)(ws + WS_XB), (const char*)(ws + WS_WGU), (const int*)(ws + WS_TOKLIST)};
          _Pragma("nounroll") for (int rep = 0; rep < REP_G1; ++rep) { EpiSwiglu E{(bf16*)(ws + WS_H), rep + 1 < REP_G1}; pg8::gemm_phase<D>(P.lds, P.tid, S, E); }
#endif
        PH_END
        PH_BEGIN
#if EN_G2
          SchedMoe2 S{P.G, P.vcu, MT, (const char*)(ws + WS_H), (const char*)(ws + WS_WD)};
          _Pragma("nounroll") for (int rep = 0; rep < REP_G2; ++rep) { EpiMoeDown E{(bf16*)(ws + WS_Y), P.out, rep + 1 < REP_G2}; pg8::gemm_phase<DE>(P.lds, P.tid, S, E); }
#endif
        PH_END
        { Frame P = phase_frame(F);
#if EN_LN2
        ln_phase<1>(P, P.out, IN(33) + i * D, IN(34) + i * D, i == DEPTH - 1, MT);
#endif
        }
        if (i + 1 < DEPTH) GRID_BAR();
    }
#undef IN
#undef GRID_BAR
}

extern "C" void kernel_launch(void* const* d_in, const int* in_sizes, int n_in, void* d_out, int out_size, void* d_ws, size_t ws_size, hipStream_t stream) {
    static int grid = 0;
    if (grid == 0) {
        if (n_in != 35 || out_size != T * D || ws_size < WS_END) { fprintf(stderr, "kernel_launch: unexpected shapes (n_in %d, out %d, ws %zu)\n", n_in, out_size, ws_size); grid = -1; return; }
        int dev = 0, cus = 0, per_cu = 0;
        if (hipGetDevice(&dev) != hipSuccess || hipDeviceGetAttribute(&cus, hipDeviceAttributeMultiprocessorCount, dev) != hipSuccess) { grid = -1; return; }
        if (hipFuncSetAttribute((const void*)fwd_kernel, hipFuncAttributeMaxDynamicSharedMemorySize, LDS_BYTES) != hipSuccess) { fprintf(stderr, "kernel_launch: hipFuncSetAttribute failed\n"); grid = -1; return; }
        if (hipOccupancyMaxActiveBlocksPerMultiprocessor(&per_cu, (const void*)fwd_kernel, NTHREADS, LDS_BYTES) != hipSuccess || per_cu < 1) { fprintf(stderr, "kernel_launch: occupancy query says %d\n", per_cu); }
        (void)hipGetLastError();
        grid = cus;
    }
    if (grid < 0) return;
    if (hipMemsetAsync((char*)d_ws + WS_CTL, 0, CTL_ZERO_BYTES, stream) != hipSuccess) return;
    Args a{};
    for (int i = 0; i < 35; ++i) a.in[i] = (const float*)d_in[i];
    a.out = (float*)d_out; a.ws = (unsigned char*)d_ws;
    hipLaunchKernelGGL(fwd_kernel, dim3(grid), dim3(NTHREADS), LDS_BYTES, stream, a);
}
```

```cpp
#include <hip/hip_runtime.h>
#include <cstdio>
#include <cstdint>

#define GAS __attribute__((address_space(1)))
#define LAS __attribute__((address_space(3)))
typedef unsigned short bf16;
typedef unsigned v4u __attribute__((ext_vector_type(4)));
typedef unsigned v2u __attribute__((ext_vector_type(2)));
typedef float f32x4 __attribute__((ext_vector_type(4)));
typedef float f32x2 __attribute__((ext_vector_type(2)));
typedef short bf16x8 __attribute__((ext_vector_type(8)));
typedef short bf16x4 __attribute__((ext_vector_type(4)));

#ifndef EN_DEFAULT
#define EN_DEFAULT 1
#endif
#ifndef REP_SCAN
#define REP_SCAN 1
#endif
#ifndef EN_SCANB
#define EN_SCANB EN_DEFAULT
#endif
#ifndef DRYCUT
#define DRYCUT 0
#endif
#ifndef REP_SCANB
#define REP_SCANB 1
#endif
#ifndef REP_ATTN
#define REP_ATTN 1
#endif
#ifndef ATTN_PROBE
#define ATTN_PROBE 1
#endif
#ifndef REP_G1
#define REP_G1 1
#endif
#ifndef REP_G2
#define REP_G2 1
#endif
#ifndef REP_CVT
#define REP_CVT 1
#endif
#ifndef REP_MIX
#define REP_MIX 1
#endif
#ifndef REP_QKV
#define REP_QKV 1
#endif
#ifndef EN_P0
#define EN_P0 EN_DEFAULT
#endif
#ifndef EN_QKV
#define EN_QKV EN_DEFAULT
#endif
#ifndef EN_KMEAN
#define EN_KMEAN EN_DEFAULT
#endif
#ifndef EN_SEL
#define EN_SEL EN_DEFAULT
#endif
#ifndef EN_ATTN
#define EN_ATTN EN_DEFAULT
#endif
#ifndef EN_OPA
#define EN_OPA EN_DEFAULT
#endif
#ifndef EN_MIX
#define EN_MIX EN_DEFAULT
#endif
#ifndef EN_RKV
#define EN_RKV EN_DEFAULT
#endif
#ifndef EN_L2
#define EN_L2 EN_DEFAULT
#endif
#ifndef EN_SCAN
#define EN_SCAN EN_DEFAULT
#endif
#ifndef EN_POST
#define EN_POST EN_DEFAULT
#endif
#ifndef EN_OPB
#define EN_OPB EN_DEFAULT
#endif
#ifndef EN_LN1
#define EN_LN1 EN_DEFAULT
#endif
#ifndef EN_CVT
#define EN_CVT EN_DEFAULT
#endif
#ifndef EN_ROUTER
#define EN_ROUTER EN_DEFAULT
#endif
#ifndef EN_ROUTE
#define EN_ROUTE EN_DEFAULT
#endif
#ifndef EN_G1
#define EN_G1 EN_DEFAULT
#endif
#ifndef EN_G2
#define EN_G2 EN_DEFAULT
#endif
#ifndef EN_LN2
#define EN_LN2 EN_DEFAULT
#endif
constexpr int D = 1024, NBATCH = 8, SEQ = 4096, T = NBATCH * SEQ, NH = 16, HD = 64, DEPTH = 4;
constexpr int NE = 64, TOPK = 8, DE = 256, NEX = NE + 1;
constexpr int MBLK = 256, NMB = SEQ / MBLK;
constexpr float ALPHA = 1.6817928305074290f;
constexpr float LN_EPS = 1e-5f, GN_EPS = 64e-5f;
constexpr int NWAVES = 8, NTHREADS = 512;

constexpr size_t MiB = 1u << 20;
constexpr size_t WS_CTL = 0, CTL_ZERO_BYTES = 1 * MiB;
constexpr size_t WS_WR = 1 * MiB;
constexpr size_t WS_KMEAN = 3 * MiB;
constexpr size_t WS_MASK = 4 * MiB;
constexpr size_t WS_TSEL = 5 * MiB;
constexpr size_t WS_WQKV = 8 * MiB;
constexpr size_t WS_WOA = 20 * MiB;
constexpr size_t WS_WRKV = 24 * MiB;
constexpr size_t WS_WOB = 36 * MiB;
constexpr size_t WS_L1 = 40 * MiB;
constexpr size_t WS_L2 = 44 * MiB;
constexpr size_t WS_WGU = 48 * MiB;
constexpr size_t WS_WD = 113 * MiB;
constexpr size_t WS_XB = 146 * MiB;
constexpr size_t WS_VF = 210 * MiB;
constexpr size_t WS_S = 274 * MiB;
constexpr size_t WS_LOGITS = WS_S;
constexpr size_t WS_TOKLIST = WS_S + 8 * MiB;
constexpr size_t WS_H = WS_S + 16 * MiB;
constexpr size_t WS_Y = WS_S + 168 * MiB;
constexpr size_t WS_Q = WS_S, WS_K = WS_S + 64 * MiB, WS_VT = WS_S + 128 * MiB, WS_O = WS_S + 192 * MiB;
constexpr size_t WS_XMIX = WS_S;
constexpr size_t WS_R = WS_S + 384 * MiB, WS_KK = WS_S + 448 * MiB, WS_V = WS_S + 512 * MiB;
constexpr size_t WS_HL = WS_S + 576 * MiB;
constexpr size_t WS_LW = WS_S;
constexpr size_t WS_A = WS_S + 128 * MiB, WS_G = WS_S + 192 * MiB;
constexpr size_t WS_YS = WS_S + 256 * MiB;
constexpr size_t WS_YG = WS_S + 640 * MiB;
constexpr size_t WS_END = 1024 * MiB;
static_assert(WS_Y + (size_t)278528 * 2048 <= WS_END && WS_YG + 64 * MiB <= WS_END, "d_ws map");

constexpr int CW_TMO = 0;
constexpr int CW_BAR = 4096;
constexpr int CW_CNT = 8192;

constexpr int RING_BYTES = 131072;
constexpr int MISC_OFF = RING_BYTES;
constexpr int TAB_OFF = MISC_OFF + 256;
constexpr int PTAB_OFF = MISC_OFF + 2048;
constexpr int LDS_BYTES = 147456;

#define RLX_AGENT __ATOMIC_RELAXED, __HIP_MEMORY_SCOPE_AGENT
#define LDS_WAIT() asm volatile("s_waitcnt lgkmcnt(0)" ::: "memory")
#define VM_WAIT() asm volatile("s_waitcnt vmcnt(0)" ::: "memory")
typedef float f32x2_t_ __attribute__((ext_vector_type(2))); typedef __bf16 bf16x2_t_ __attribute__((ext_vector_type(2)));
__device__ __forceinline__ unsigned cvt_pk_bf16(float lo, float hi) { const f32x2_t_ v = {lo, hi}; const bf16x2_t_ b = __builtin_convertvector(v, bf16x2_t_); return __builtin_bit_cast(unsigned, b); }
__device__ __forceinline__ float bflo(unsigned w) { return __uint_as_float(w << 16); }
__device__ __forceinline__ float bfhi(unsigned w) { return __uint_as_float(w & 0xffff0000u); }
__device__ __forceinline__ float bf1(bf16 b) { return __uint_as_float(((unsigned)b) << 16); }
__device__ __forceinline__ float fast_exp(float x) { return __builtin_amdgcn_exp2f(x * 1.4426950408889634f); }
__device__ __forceinline__ float fast_rcp(float x) { return __builtin_amdgcn_rcpf(x); }
__device__ __forceinline__ float sigmoidf_(float x) { return fast_rcp(1.0f + fast_exp(-x)); }
template <int CTRL> __device__ __forceinline__ float dpp_add(float v) {
    const int t = __builtin_amdgcn_update_dpp(0, __float_as_int(v), CTRL, 0xf, 0xf, true);
    return v + __int_as_float(t);
}
template <int CTRL> __device__ __forceinline__ float dpp_max(float v) {
    const int t = __builtin_amdgcn_update_dpp(__float_as_int(v), __float_as_int(v), CTRL, 0xf, 0xf, false);
    return __builtin_fmaxf(v, __int_as_float(t));
}
__device__ __forceinline__ float reduce16(float v) {
    v = dpp_add<0xB1>(v); v = dpp_add<0x4E>(v); v = dpp_add<0x141>(v); v = dpp_add<0x140>(v);
    return v;
}
__device__ __forceinline__ float max8(float v) { v = dpp_max<0xB1>(v); v = dpp_max<0x4E>(v); v = dpp_max<0x141>(v); return v; }
__device__ __forceinline__ float q4_max(float v) {
    auto a = __builtin_amdgcn_permlane16_swap(__float_as_uint(v), __float_as_uint(v), false, false); v = __builtin_fmaxf(__uint_as_float(a[0]), __uint_as_float(a[1]));
    auto b = __builtin_amdgcn_permlane32_swap(__float_as_uint(v), __float_as_uint(v), false, false); return __builtin_fmaxf(__uint_as_float(b[0]), __uint_as_float(b[1])); }
__device__ __forceinline__ float q4_sum(float v) {
    auto a = __builtin_amdgcn_permlane16_swap(__float_as_uint(v), __float_as_uint(v), false, false); v = __uint_as_float(a[0]) + __uint_as_float(a[1]);
    auto b = __builtin_amdgcn_permlane32_swap(__float_as_uint(v), __float_as_uint(v), false, false); return __uint_as_float(b[0]) + __uint_as_float(b[1]); }
__device__ __forceinline__ float wave_sum(float v) { return q4_sum(reduce16(v)); }
__device__ __forceinline__ float wave_max(float v) { return q4_max(dpp_max<0x140>(max8(v))); }
__device__ const unsigned char T5_BUCKET[129] = {
    0, 1, 2, 3, 4, 5, 6, 7, 8, 9, 10, 11, 12, 13, 14, 15, 16, 16, 16, 17, 17, 18, 18, 18, 19, 19, 19, 20, 20, 20, 20, 21, 21, 21, 21, 22, 22, 22, 22, 22, 23, 23, 23, 23, 23, 23, 24, 24, 24,
    24, 24, 24, 25, 25, 25, 25, 25, 25, 25, 26, 26, 26, 26, 26, 26, 26, 26, 27, 27, 27, 27, 27, 27, 27, 27, 27, 27, 28, 28, 28, 28, 28, 28, 28, 28, 28, 28, 29, 29, 29, 29, 29, 29, 29, 29, 29, 29,
    29, 29, 30, 30, 30, 30, 30, 30, 30, 30, 30, 30, 30, 30, 30, 30, 31, 31, 31, 31, 31, 31, 31, 31, 31, 31, 31, 31, 31, 31, 31, 31};

namespace pg8 {
constexpr int BM = 256, BK = 64, HALF = 128, HTB = HALF * BK * 2, STAGE_BYTES = 8 * HTB, NXCD = 8, WGM = 8;
__host__ __device__ __forceinline__ int lds_byte(int r, int c) { const int st = (r >> 4) * 2 + (c >> 5), rr = r & 15, cc = c & 31, ob = rr * 64 + cc * 2; return st * 1024 + (ob ^ (((ob >> 9) & 1) << 5)); }
__host__ __device__ __forceinline__ void stage_rc(int b, int& R, int& C) { const int st = b / 1024, sb = b % 1024, swz = sb ^ (((sb >> 9) & 1) << 5); R = (st >> 1) * 16 + swz / 64; C = (st & 1) * 32 + (swz % 64) / 2; }
__host__ __device__ __forceinline__ int perm32(int rho) { const int n = rho >> 4, i = rho & 15; return 8 * (i >> 2) + 4 * n + (i & 3); }

struct Unit { int pm, pn, e, nvalid, arow0, orow0; const int* gidx; };

__device__ __forceinline__ bool static_tile(int i, int G, int c, int nM, int nN, int& pm, int& pn) {
    const int nwg = nM * nN; const long L = (long)i * G + c; if (L >= nwg) return false;
    int wgid = (int)L;
    if (((nwg | nM) & 7) == 0) {
        wgid = (wgid & 7) * (nwg >> 3) + (wgid >> 3); const int nig = WGM * nN, gid = wgid / nig, r = wgid - gid * nig; pm = gid * WGM + (r & 7); pn = r >> 3; return true; }
    { const int q = nwg / NXCD, r = nwg % NXCD, xcd = wgid % NXCD, off = wgid / NXCD; wgid = (xcd < r ? xcd * (q + 1) : r * (q + 1) + (xcd - r) * q) + off; }
    const int nig = WGM * nN, gid = wgid / nig, fm = gid * WGM, gsz = (nM - fm) < WGM ? (nM - fm) : WGM;
    pm = fm + ((wgid % nig) % gsz); pn = (wgid % nig) / gsz; return true;
}

template <int K, class Epi, class Sched>
__device__ __forceinline__ void gemm_phase(LAS unsigned char* lds, const int tid, const Sched& S, const Epi& E) {
    constexpr bool GA = Sched::GATHER;
    const int wid = __builtin_amdgcn_readfirstlane(tid >> 6), lane = tid & 63, wr = wid >> 2, wc = wid & 3, fr = lane & 15, fq = lane >> 4;
    constexpr int nt = K / BK;
    unsigned voffA[2], voffB[2];
#pragma unroll
    for (int i = 0; i < 2; ++i) { int R, C; stage_rc(tid * 16 + i * 8192, R, C); const int Rb = Epi::PERM ? ((R & ~31) + perm32(R & 31)) : R;
        voffA[i] = (unsigned)(R * K + C) * 2u; voffB[i] = (unsigned)(Rb * K + C) * 2u; }
    const size_t kstep = (size_t)(BK * 2);
    const size_t hstep = (size_t)HALF * K * 2;
    const unsigned rowb = (unsigned)K * 2u;
    const unsigned ldsw = (unsigned)wid * 1024u;
    const int aoff = lds_byte(wr * 64 + fr, fq * 8), boff = lds_byte(wc * 32 + fr, fq * 8);
#define PG8_SA(b, h) (((b) * 2 + (h)) * HTB)
#define PG8_SB(b, h) ((4 + (b) * 2 + (h)) * HTB)
#define PG8_STAGE(bufoff, gbase, voff) do { _Pragma("unroll") for (int _i = 0; _i < 2; ++_i) \
        __builtin_amdgcn_global_load_lds((const unsigned*)((const char*)(gbase) + (voff)[_i]), (LAS unsigned*)(lds + (bufoff) + ldsw + _i * 8192), 16, 0, 0); } while (0)
#define PG8_STAGE_A(bufoff, p, h, O) do { if constexpr (GA) { PG8_STAGE(bufoff, p, O[h]); } else { PG8_STAGE(bufoff, (p) + (h) * hstep, voffA); } } while (0)
#define PG8_LDA(dst, b, h) do { _Pragma("unroll") for (int m = 0; m < 4; ++m) _Pragma("unroll") for (int k = 0; k < 2; ++k) dst[m][k] = *(const LAS bf16x8*)(lds + PG8_SA(b, h) + aoff + m * 2048 + k * 1024); } while (0)
#define PG8_LDB(dst, b, h) do { _Pragma("unroll") for (int n = 0; n < 2; ++n) _Pragma("unroll") for (int k = 0; k < 2; ++k) dst[n][k] = *(const LAS bf16x8*)(lds + PG8_SB(b, h) + boff + n * 2048 + k * 1024); } while (0)
#define PG8_MMA(ai, bj, At, Bt) do { __builtin_amdgcn_s_setprio(1); _Pragma("unroll") for (int m = 0; m < 4; ++m) _Pragma("unroll") for (int n = 0; n < 2; ++n) _Pragma("unroll") for (int k = 0; k < 2; ++k) \
        acc[ai][bj][m][n] = __builtin_amdgcn_mfma_f32_16x16x32_bf16(Bt[n][k], At[m][k], acc[ai][bj][m][n], 0, 0, 0); __builtin_amdgcn_s_setprio(0); } while (0)
#define PG8_WAIT_V(n) asm volatile("s_waitcnt vmcnt(" #n ")" ::: "memory")
#define PG8_WAIT_L(n) asm volatile("s_waitcnt lgkmcnt(" #n ")" ::: "memory")
#define PG8_BAR __builtin_amdgcn_s_barrier()
#define PG8_SCHED __builtin_amdgcn_sched_barrier(0)
#define PG8_OFFS(u, o) do { if constexpr (GA) { _Pragma("unroll") for (int _h = 0; _h < 2; ++_h) _Pragma("unroll") for (int _i = 0; _i < 2; ++_i) { int R_, C_; stage_rc(tid * 16 + _i * 8192, R_, C_); \
        o[_h][_i] = (unsigned)S.a_row(u, _h * HALF + R_) * rowb + (unsigned)C_ * 2u; } } } while (0)
#define PG8_TRIP(a1, a2, b2, O1, O2) do { const char* a3 = (a2) + kstep; const char* b3 = (b2) + kstep; \
            PG8_LDB(B0, 0, 0); PG8_LDB(B1, 0, 1); PG8_SCHED; PG8_LDA(At, 0, 0); PG8_STAGE_A(PG8_SA(1, 1), a1, 1, O1); \
            PG8_WAIT_V(8); PG8_WAIT_L(0); PG8_BAR; PG8_MMA(0, 0, At, B0); PG8_MMA(0, 1, At, B1); PG8_BAR; PG8_SCHED; \
            PG8_LDA(At, 0, 1); PG8_STAGE(PG8_SB(0, 0), b2, voffB); PG8_STAGE(PG8_SB(0, 1), (b2) + hstep, voffB); PG8_STAGE_A(PG8_SA(0, 0), a2, 0, O2); \
            PG8_WAIT_V(8); PG8_WAIT_L(0); PG8_BAR; PG8_MMA(1, 0, At, B0); PG8_MMA(1, 1, At, B1); PG8_BAR; PG8_SCHED; \
            PG8_LDB(B0, 1, 0); PG8_LDB(B1, 1, 1); PG8_SCHED; PG8_LDA(At, 1, 0); PG8_STAGE_A(PG8_SA(0, 1), a2, 1, O2); \
            PG8_WAIT_V(8); PG8_WAIT_L(0); PG8_BAR; PG8_MMA(0, 0, At, B0); PG8_MMA(0, 1, At, B1); PG8_BAR; PG8_SCHED; \
            PG8_LDA(At, 1, 1); PG8_STAGE(PG8_SB(1, 0), b3, voffB); PG8_STAGE(PG8_SB(1, 1), b3 + hstep, voffB); PG8_STAGE_A(PG8_SA(1, 0), a3, 0, O2); \
            PG8_WAIT_V(8); PG8_WAIT_L(0); PG8_BAR; PG8_MMA(1, 0, At, B0); PG8_MMA(1, 1, At, B1); PG8_BAR; PG8_SCHED; } while (0)
    Unit cur, nxt; int ui = 0;
    if (!S.next(0, cur)) return;
    f32x4 acc[2][2][4][2];
#pragma unroll
    for (int a = 0; a < 2; ++a)
#pragma unroll
        for (int b = 0; b < 2; ++b)
#pragma unroll
            for (int m = 0; m < 4; ++m)
#pragma unroll
                for (int n = 0; n < 2; ++n) acc[a][b][m][n] = (f32x4){0.f, 0.f, 0.f, 0.f};
    bf16x8 At[4][2], B0[2][2], B1[2][2];
    unsigned cOff[2][2], nOff[2][2];
    PG8_OFFS(cur, cOff);
    const char* cA = S.a_tile(cur); const char* cB = S.b_tile(cur);
    PG8_STAGE(PG8_SB(0, 0), cB, voffB); PG8_STAGE(PG8_SB(0, 1), cB + hstep, voffB); PG8_STAGE_A(PG8_SA(0, 0), cA, 0, cOff); PG8_STAGE_A(PG8_SA(0, 1), cA, 1, cOff);
    if (wr == 1) PG8_BAR;
    PG8_WAIT_V(2); PG8_BAR;
    PG8_STAGE(PG8_SB(1, 0), cB + kstep, voffB); PG8_STAGE_A(PG8_SA(1, 0), cA + kstep, 0, cOff); PG8_STAGE(PG8_SB(1, 1), cB + hstep + kstep, voffB);
    PG8_WAIT_V(6); PG8_BAR;
    for (;;) {
        const bool has_next = S.next(ui + 1, nxt);
        const char* nA = cA; const char* nB = cB;
        if constexpr (GA) {
#pragma unroll
            for (int h = 0; h < 2; ++h)
#pragma unroll
                for (int i = 0; i < 2; ++i) nOff[h][i] = cOff[h][i]; }
        if (has_next) { PG8_OFFS(nxt, nOff); nA = S.a_tile(nxt); nB = S.b_tile(nxt); }
_Pragma("nounroll")
        for (int t = 0; t < nt; t += 2) { const bool last = (t == nt - 2);
            const char* a2 = last ? nA : cA + (size_t)(t + 2) * kstep; const char* b2 = last ? nB : cB + (size_t)(t + 2) * kstep;
            if constexpr (GA) { unsigned o2[2][2];
#pragma unroll
                for (int h = 0; h < 2; ++h)
#pragma unroll
                    for (int i = 0; i < 2; ++i) o2[h][i] = last ? nOff[h][i] : cOff[h][i];
                PG8_TRIP(cA + (size_t)(t + 1) * kstep, a2, b2, cOff, o2);
            } else { PG8_TRIP(cA + (size_t)(t + 1) * kstep, a2, b2, cOff, cOff); } }
        if (wr == 0) PG8_BAR;
        PG8_SCHED; E(acc, cur, wr, wc, fr, fq); PG8_SCHED;
        if (!has_next) break;
#pragma unroll
        for (int a = 0; a < 2; ++a)
#pragma unroll
            for (int b = 0; b < 2; ++b)
#pragma unroll
                for (int m = 0; m < 4; ++m)
#pragma unroll
                    for (int n = 0; n < 2; ++n) acc[a][b][m][n] = (f32x4){0.f, 0.f, 0.f, 0.f};
        cur = nxt; cA = nA; cB = nB; ++ui;
        if constexpr (GA) {
#pragma unroll
            for (int h = 0; h < 2; ++h)
#pragma unroll
                for (int i = 0; i < 2; ++i) cOff[h][i] = nOff[h][i]; }
        if (wr == 1) PG8_BAR;
    }
    PG8_WAIT_V(0);
    PG8_BAR;
#undef PG8_SA
#undef PG8_SB
#undef PG8_STAGE
#undef PG8_STAGE_A
#undef PG8_LDA
#undef PG8_LDB
#undef PG8_MMA
#undef PG8_WAIT_V
#undef PG8_WAIT_L
#undef PG8_BAR
#undef PG8_SCHED
#undef PG8_OFFS
#undef PG8_TRIP
}
}
using pg8::Unit;
typedef f32x4 AccT[2][2][4][2];

struct SchedDense {
    int nM, nN, G, c, K; const char* A; const char* Bt;
    __device__ __forceinline__ bool next(int i, Unit& u) const { int pm, pn; if (!pg8::static_tile(i, G, c, nM, nN, pm, pn)) return false;
        u.pm = pm; u.pn = pn; u.e = 0; u.nvalid = 256; u.arow0 = pm * 256; u.orow0 = pm * 256; u.gidx = nullptr; return true; }
    static constexpr bool GATHER = false;
    __device__ __forceinline__ const char* a_tile(const Unit& u) const { return A + (size_t)u.arow0 * K * 2; }
    __device__ __forceinline__ const char* b_tile(const Unit& u) const { return Bt + (size_t)u.pn * 256 * K * 2; }
    __device__ __forceinline__ int a_row(const Unit& u, int r) const { return u.arow0 + r; }
};
struct SchedRkv {
    int nM, nN, G, c; const char* xmix; const char* Wrkv; const char* L1;
    __device__ __forceinline__ bool next(int i, Unit& u) const { int pm, pn; if (!pg8::static_tile(i, G, c, nM, nN, pm, pn)) return false;
        u.pm = pm; u.pn = pn; u.e = 0; u.nvalid = 256; u.arow0 = pm * 256; u.orow0 = pm * 256; u.gidx = nullptr; return true; }
    static constexpr bool GATHER = false;
    __device__ __forceinline__ const char* a_tile(const Unit& u) const { const int grp = u.pn < 12 ? (u.pn >> 2) : (u.pn == 15 ? 2 : u.pn - 9); return xmix + ((size_t)grp * T + u.arow0) * D * 2; }
    __device__ __forceinline__ const char* b_tile(const Unit& u) const { return u.pn < 12 ? Wrkv + (size_t)u.pn * 256 * D * 2 : L1 + (size_t)(u.pn - 12) * 256 * D * 2; }
    __device__ __forceinline__ int a_row(const Unit& u, int r) const { return u.arow0 + r; }
};
struct SchedL2 {
    int nM, nN, G, c; const char* hl; const char* L2;
    __device__ __forceinline__ bool next(int i, Unit& u) const { int pm, pn; if (!pg8::static_tile(i, G, c, nM, nN, pm, pn)) return false;
        u.pm = pm; u.pn = pn & 3; u.e = pn >> 2; u.nvalid = 256; u.arow0 = pm * 256; u.orow0 = pm * 256; u.gidx = nullptr; return true; }
    static constexpr bool GATHER = false;
    __device__ __forceinline__ const char* a_tile(const Unit& u) const { return hl + ((size_t)u.e * T + u.arow0) * 256 * 2; }
    __device__ __forceinline__ const char* b_tile(const Unit& u) const { return L2 + ((size_t)u.e * 1024 + (size_t)u.pn * 256) * 256 * 2; }
    __device__ __forceinline__ int a_row(const Unit& u, int r) const { return u.arow0 + r; }
};
struct MoeTab { const LAS int* cnt; const LAS int* mtpref; const LAS int* hoff; };
__device__ __forceinline__ int moe_find_expert(const MoeTab& M, int m, int& hint) { int e = hint;
_Pragma("nounroll")
    while (e + 1 < NEX && M.mtpref[e + 1] <= m) ++e;
    e = __builtin_amdgcn_readfirstlane(e); hint = e; return e; }
struct SchedMoe1 {
    int G, c; MoeTab M; const char* xb; const char* Wgu; const int* toklist; mutable int eh;
    __device__ __forceinline__ bool next(int i, Unit& u) const { const long L = (long)i * G + c; const int nun = M.mtpref[NEX] * 2; if (L >= nun) return false;
        const int m = (int)(L >> 1), e = moe_find_expert(M, m, eh), mt = m - M.mtpref[e];
        u.pm = mt; u.pn = (int)(L & 1); u.e = e; u.arow0 = mt * 256; u.orow0 = M.hoff[e] + mt * 256;
        if (e < NE) { const int left = M.cnt[e] - mt * 256; u.nvalid = left < 256 ? left : 256; u.gidx = toklist + (size_t)e * T + mt * 256; } else { u.nvalid = 256; u.gidx = nullptr; }
        return true; }
    static constexpr bool GATHER = true;
    __device__ __forceinline__ const char* a_tile(const Unit&) const { return xb; }
    __device__ __forceinline__ const char* b_tile(const Unit& u) const { return Wgu + ((size_t)u.e * 512 + (size_t)u.pn * 256) * D * 2; }
    __device__ __forceinline__ int a_row(const Unit& u, int r) const { if (u.gidx) return r < u.nvalid ? u.gidx[r] : 0; return u.arow0 + r; }
};
struct SchedMoe2 {
    int G, c; MoeTab M; const char* hb; const char* Wd; mutable int eh;
    __device__ __forceinline__ bool next(int i, Unit& u) const { const long L = (long)i * G + c; const int nun = M.mtpref[NEX] * 4; if (L >= nun) return false;
        const int m = (int)(L >> 2), e = moe_find_expert(M, m, eh), mt = m - M.mtpref[e];
        u.pm = mt; u.pn = (int)(L & 3); u.e = e; u.nvalid = 256; u.arow0 = M.hoff[e] + mt * 256; u.orow0 = (e < NE) ? (M.hoff[e] + mt * 256) : mt * 256; u.gidx = nullptr; return true; }
    static constexpr bool GATHER = false;
    __device__ __forceinline__ const char* a_tile(const Unit& u) const { return hb + (size_t)u.arow0 * 256 * 2; }
    __device__ __forceinline__ const char* b_tile(const Unit& u) const { return Wd + ((size_t)u.e * 1024 + (size_t)u.pn * 256) * 256 * 2; }
    __device__ __forceinline__ int a_row(const Unit& u, int r) const { return u.arow0 + r; }
};

#define EPI_ARGS const AccT& acc, const Unit& u, int wr, int wc, int fr, int fq
struct EpiQKV { static constexpr bool PERM = true; bf16* Q; bf16* Kb; bf16* Vt;
    __device__ __forceinline__ void operator()(EPI_ARGS) const {
        const int row0 = u.orow0 + wr * 64 + fr, sec = u.pn >> 2, col0 = (u.pn & 3) * 256 + wc * 32 + 8 * fq;
        if (sec < 2) { bf16* base = sec == 0 ? Q : Kb; const float sc = sec == 0 ? 0.18033688011112042f : 1.0f;
#pragma unroll
            for (int ai = 0; ai < 2; ++ai)
#pragma unroll
                for (int m = 0; m < 4; ++m) { bf16* rowp = base + (size_t)(row0 + ai * 128 + m * 16) * D + col0;
#pragma unroll
                    for (int bj = 0; bj < 2; ++bj) { const f32x4 v0 = acc[ai][bj][m][0] * sc, v1 = acc[ai][bj][m][1] * sc; v4u w;
                        w.x = cvt_pk_bf16(v0[0], v0[1]); w.y = cvt_pk_bf16(v0[2], v0[3]); w.z = cvt_pk_bf16(v1[0], v1[1]); w.w = cvt_pk_bf16(v1[2], v1[3]); *(v4u*)(rowp + bj * 128) = w; } }
        } else {
#pragma unroll
            for (int ai = 0; ai < 2; ++ai)
#pragma unroll
                for (int m = 0; m < 4; ++m) { const int r = row0 + ai * 128 + m * 16, b = r >> 12, s = r & 4095;
#pragma unroll
                    for (int bj = 0; bj < 2; ++bj)
#pragma unroll
                        for (int n = 0; n < 2; ++n) { const f32x4 v = acc[ai][bj][m][n];
#pragma unroll
                            for (int j = 0; j < 4; j += 2) { const int c = col0 + bj * 128 + 4 * n + j, h = c >> 6, d = c & 63; const unsigned w = cvt_pk_bf16(v[j], v[j + 1]);
                                bf16* p = Vt + ((((size_t)(b * NH + h) * HD + d)) << 12) + s; p[0] = (bf16)(w & 0xffffu); p[SEQ] = (bf16)(w >> 16); } } }
        }
    }
};
struct EpiAdd { static constexpr bool PERM = false; float* out;
    __device__ __forceinline__ void operator()(EPI_ARGS) const {
        const int row0 = u.orow0 + wr * 64 + fr, col0 = u.pn * 256 + wc * 32 + 4 * fq;
#pragma unroll
        for (int ai = 0; ai < 2; ++ai)
#pragma unroll
            for (int m = 0; m < 4; ++m) { float* rowp = out + (size_t)(row0 + ai * 128 + m * 16) * D + col0;
#pragma unroll
                for (int bj = 0; bj < 2; ++bj)
#pragma unroll
                    for (int n = 0; n < 2; ++n) { f32x4* p = (f32x4*)(rowp + bj * 128 + n * 16); *p = *p + acc[ai][bj][m][n]; } }
    }
};
struct EpiLogits { static constexpr bool PERM = false; float* lg;
    __device__ __forceinline__ void operator()(EPI_ARGS) const {
        if (wc >= 2) return;
        const int row0 = u.orow0 + wr * 64 + fr, col0 = wc * 32 + 4 * fq;
#pragma unroll
        for (int ai = 0; ai < 2; ++ai)
#pragma unroll
            for (int m = 0; m < 4; ++m) { float* rowp = lg + (size_t)(row0 + ai * 128 + m * 16) * NE + col0;
#pragma unroll
                for (int n = 0; n < 2; ++n) *(f32x4*)(rowp + n * 16) = acc[ai][0][m][n]; }
    }
};
struct EpiSwiglu { static constexpr bool PERM = true; bf16* hb; bool dry;
    __device__ __forceinline__ void operator()(EPI_ARGS) const {
        const int row0 = u.orow0 + wr * 64 + fr, col0 = u.pn * 128 + wc * 32 + 8 * fq;
#pragma unroll
        for (int ai = 0; ai < 2; ++ai)
#pragma unroll
            for (int m = 0; m < 4; ++m) { bf16* rowp = hb + (size_t)(row0 + ai * 128 + m * 16) * DE + col0; float o[8];
#pragma unroll
                for (int n = 0; n < 2; ++n)
#pragma unroll
                    for (int j = 0; j < 4; ++j) { const float g = acc[ai][0][m][n][j], up = acc[ai][1][m][n][j]; o[4 * n + j] = g * sigmoidf_(g) * up; }
                v4u w; w.x = cvt_pk_bf16(o[0], o[1]); w.y = cvt_pk_bf16(o[2], o[3]); w.z = cvt_pk_bf16(o[4], o[5]); w.w = cvt_pk_bf16(o[6], o[7]); if (!dry) *(v4u*)rowp = w; }
    }
};
struct EpiMoeDown { static constexpr bool PERM = true; bf16* yb; float* out; bool dry;
    __device__ __forceinline__ void operator()(EPI_ARGS) const {
        const int row0 = u.orow0 + wr * 64 + fr, col0 = u.pn * 256 + wc * 32 + 8 * fq;
        if (dry) return;
        if (u.e < NE) {
#pragma unroll
            for (int ai = 0; ai < 2; ++ai)
#pragma unroll
                for (int m = 0; m < 4; ++m) { bf16* rowp = yb + (size_t)(row0 + ai * 128 + m * 16) * D + col0;
#pragma unroll
                    for (int bj = 0; bj < 2; ++bj) { const f32x4 v0 = acc[ai][bj][m][0], v1 = acc[ai][bj][m][1]; v4u w;
                        w.x = cvt_pk_bf16(v0[0], v0[1]); w.y = cvt_pk_bf16(v0[2], v0[3]); w.z = cvt_pk_bf16(v1[0], v1[1]); w.w = cvt_pk_bf16(v1[2], v1[3]); *(v4u*)(rowp + bj * 128) = w; } }
        } else {
#pragma unroll
            for (int ai = 0; ai < 2; ++ai)
#pragma unroll
                for (int m = 0; m < 4; ++m) { float* rowp = out + (size_t)(row0 + ai * 128 + m * 16) * D + col0;
#pragma unroll
                    for (int bj = 0; bj < 2; ++bj)
#pragma unroll
                        for (int n = 0; n < 2; ++n) { f32x4* p = (f32x4*)(rowp + bj * 128 + 4 * n); *p = *p + acc[ai][bj][m][n]; } }
        }
    }
};
struct EpiRkv { static constexpr bool PERM = true; unsigned char* ws; size_t voff;
    __device__ __forceinline__ void operator()(EPI_ARGS) const {
        const int row0 = u.orow0 + wr * 64 + fr;
        size_t boff; int ldc, colt, act = 0;
        if (u.pn < 12) { const int sec = u.pn >> 2; boff = WS_R; if (sec == 1) boff = WS_KK; if (sec == 2) boff = voff; ldc = D; colt = (u.pn & 3) * 256; }
        else { const int kind = u.pn - 12; boff = WS_HL + (size_t)kind * T * 256 * 2; ldc = 256; colt = 0; act = kind == 0 ? 1 : (kind == 2 ? 2 : 0); }
        bf16* base = (bf16*)(ws + boff);
        const int col0 = colt + wc * 32 + 8 * fq;
#pragma unroll
        for (int ai = 0; ai < 2; ++ai)
#pragma unroll
            for (int m = 0; m < 4; ++m) { bf16* rowp = base + (size_t)(row0 + ai * 128 + m * 16) * ldc + col0;
#pragma unroll
                for (int bj = 0; bj < 2; ++bj) { f32x4 v0 = acc[ai][bj][m][0], v1 = acc[ai][bj][m][1];
                    if (act == 1) {
#pragma unroll
                        for (int j = 0; j < 4; ++j) { v0[j] = 1.0f - 2.0f * fast_rcp(fast_exp(2.0f * v0[j]) + 1.0f); v1[j] = 1.0f - 2.0f * fast_rcp(fast_exp(2.0f * v1[j]) + 1.0f); } }
                    if (act == 2) {
#pragma unroll
                        for (int j = 0; j < 4; ++j) { v0[j] = sigmoidf_(v0[j]); v1[j] = sigmoidf_(v1[j]); } }
                    v4u w; w.x = cvt_pk_bf16(v0[0], v0[1]); w.y = cvt_pk_bf16(v0[2], v0[3]); w.z = cvt_pk_bf16(v1[0], v1[1]); w.w = cvt_pk_bf16(v1[2], v1[3]); *(v4u*)(rowp + bj * 128) = w; } }
    }
};
struct EpiL2 { static constexpr bool PERM = true; float* lw; bf16* ab; bf16* gb; bf16* vb; const bf16* vf; const float* w0; const float* a0; const float* v0;
    __device__ __forceinline__ void operator()(EPI_ARGS) const {
        const int row0 = u.orow0 + wr * 64 + fr, col0 = u.pn * 256 + wc * 32 + 8 * fq, kind = u.e;
#pragma unroll
        for (int ai = 0; ai < 2; ++ai)
#pragma unroll
            for (int m = 0; m < 4; ++m) { const size_t ro = (size_t)(row0 + ai * 128 + m * 16) * D + col0;
#pragma unroll
                for (int bj = 0; bj < 2; ++bj) { const size_t o = ro + bj * 128; const int c = col0 + bj * 128; float x[8];
#pragma unroll
                    for (int n = 0; n < 2; ++n)
#pragma unroll
                        for (int j = 0; j < 4; ++j) x[4 * n + j] = acc[ai][bj][m][n][j];
                    if (kind == 0) { const f32x4 b0 = *(const f32x4*)(w0 + c), b1 = *(const f32x4*)(w0 + c + 4); f32x4 r0, r1;
#pragma unroll
                        for (int j = 0; j < 8; ++j) { const float z = x[j] + (j < 4 ? b0[j & 3] : b1[j & 3]); if (j < 4) r0[j & 3] = z; else r1[j & 3] = z; }
                        *(f32x4*)(lw + o) = r0; *(f32x4*)(lw + o + 4) = r1;
                    } else if (kind == 1) { const f32x4 b0 = *(const f32x4*)(a0 + c), b1 = *(const f32x4*)(a0 + c + 4);
#pragma unroll
                        for (int j = 0; j < 8; ++j) x[j] = sigmoidf_(x[j] + (j < 4 ? b0[j & 3] : b1[j & 3]));
                        v4u w; w.x = cvt_pk_bf16(x[0], x[1]); w.y = cvt_pk_bf16(x[2], x[3]); w.z = cvt_pk_bf16(x[4], x[5]); w.w = cvt_pk_bf16(x[6], x[7]); *(v4u*)(ab + o) = w;
                    } else if (kind == 2) {
                        v4u w; w.x = cvt_pk_bf16(x[0], x[1]); w.y = cvt_pk_bf16(x[2], x[3]); w.z = cvt_pk_bf16(x[4], x[5]); w.w = cvt_pk_bf16(x[6], x[7]); *(v4u*)(gb + o) = w;
                    } else { const f32x4 b0 = *(const f32x4*)(v0 + c), b1 = *(const f32x4*)(v0 + c + 4); const v4u vv = *(const v4u*)(vb + o), ff = *(const v4u*)(vf + o); float y[8];
#pragma unroll
                        for (int j = 0; j < 8; ++j) { const unsigned wv = vv[j >> 1], wf = ff[j >> 1]; const float v = (j & 1) ? bfhi(wv) : bflo(wv), f = (j & 1) ? bfhi(wf) : bflo(wf);
                            const float gt = sigmoidf_(x[j] + (j < 4 ? b0[j & 3] : b1[j & 3])); y[j] = v + (f - v) * gt; }
                        v4u w; w.x = cvt_pk_bf16(y[0], y[1]); w.y = cvt_pk_bf16(y[2], y[3]); w.z = cvt_pk_bf16(y[4], y[5]); w.w = cvt_pk_bf16(y[6], y[7]); *(v4u*)(vb + o) = w; }
                } }
    }
};

typedef GAS unsigned gu32;
#define XB_TMO      128
#define XB_XCNT(j)  (256  + 64 * (j))
#define XB_XSUB(j)  (1280 + 64 * (j))
#define XB_XGEN(j)  (2304 + 64 * (j))
#define XB_TOP      3328
#define XB_TOPGEN   3392
#define XCD_BAR_WORDS 3456
#define XB_SPIN_CAP (1u << 23)
__device__ __forceinline__ unsigned xb_ld(unsigned* p)              { return __hip_atomic_load(p, __ATOMIC_RELAXED, __HIP_MEMORY_SCOPE_AGENT); }
__device__ __forceinline__ unsigned xb_add(unsigned* p, unsigned v) { return __hip_atomic_fetch_add(p, v, __ATOMIC_RELAXED, __HIP_MEMORY_SCOPE_AGENT); }
__device__ __forceinline__ unsigned xb_xcc_id() { return (unsigned)__builtin_amdgcn_s_getreg((3 << 11) | 20) & 0xFu; }
#define XB_SPIN(cond, bar) do { unsigned _sp = 0; while (cond) { __builtin_amdgcn_s_sleep(1); \
    if ((++_sp & 255u) == 0u) { if (xb_ld(&(bar)[XB_TMO])) break; if (_sp > XB_SPIN_CAP) { atomicAdd(&(bar)[XB_TMO], 1u); break; } } } } while (0)
struct XcdBarrier { unsigned* bar; unsigned x; volatile LAS unsigned* st; };
__device__ __forceinline__ XcdBarrier xcd_barrier_post(unsigned* bar, volatile LAS unsigned* st) {
    XcdBarrier b; b.bar = bar; b.x = xb_xcc_id(); b.st = st;
    if (threadIdx.x == 0) (void)xb_add(&bar[XB_XCNT(b.x)], 1u);
    return b;
}
__device__ __forceinline__ void xcd_barrier_complete(unsigned* bar, unsigned x, unsigned& nloc, unsigned& nx) {
    const unsigned G = gridDim.x * gridDim.y * gridDim.z;
    unsigned sum, cnt, mine, sp = 0u;
    for (;;) {
        sum = 0u; cnt = 0u; mine = 0u;
#pragma unroll
        for (unsigned j = 0; j < 16; ++j) { const unsigned c = xb_ld(&bar[XB_XCNT(j)]); sum += c; cnt += (c > 0u) ? 1u : 0u; mine = (j == x) ? c : mine; }
        if (sum == G) break;
        __builtin_amdgcn_s_sleep(1);
        if ((++sp & 255u) == 0u) { if (xb_ld(&bar[XB_TMO])) break; if (sp > XB_SPIN_CAP) { atomicAdd(&bar[XB_TMO], 1u); break; } }
    }
    nloc = mine > 0u ? mine : 1u; nx = cnt > 0u ? cnt : 1u;
}
__device__ __forceinline__ void xcd_barrier(const XcdBarrier& b) {
    asm volatile("s_waitcnt vmcnt(0)" ::: "memory");
    __syncthreads();
    if (threadIdx.x == 0) {
        unsigned long long bp = (unsigned long long)b.bar; unsigned bx = b.x;
        asm volatile("" : "+s"(bp), "+s"(bx));
        unsigned* bar = (unsigned*)(GAS unsigned*)bp;
        __builtin_amdgcn_s_waitcnt(0);
        unsigned nloc = b.st[0], nx = b.st[1];
        if (nloc == 0u) { xcd_barrier_complete(bar, bx, nloc, nx); b.st[0] = nloc; b.st[1] = nx; }
        const unsigned old = xb_add(&bar[XB_XSUB(bx)], 1u);
        const unsigned gen = old / nloc;
        if (old + 1u == (gen + 1u) * nloc) {
            __builtin_amdgcn_fence(__ATOMIC_RELEASE, "agent");
            asm volatile("s_waitcnt vmcnt(0)" ::: "memory");
            const unsigned og = xb_add(&bar[XB_TOP], 1u);
            const unsigned tg = og / nx;
            if (og + 1u == (tg + 1u) * nx) xb_add(&bar[XB_TOPGEN], 1u);
            else XB_SPIN(xb_ld(&bar[XB_TOPGEN]) == tg, bar);
            __builtin_amdgcn_fence(__ATOMIC_ACQUIRE, "agent");
            xb_add(&bar[XB_XGEN(bx)], 1u);
            asm volatile("s_waitcnt vmcnt(0)" ::: "memory");
        } else {
            XB_SPIN(xb_ld(&bar[XB_XGEN(bx)]) == gen, bar);
            __builtin_amdgcn_fence(__ATOMIC_ACQUIRE, "agent");
            asm volatile("s_waitcnt vmcnt(0)" ::: "memory");
        }
    }
    __syncthreads();
}

struct Args { const float* in[35]; float* out; unsigned char* ws; };
struct Frame {
    LAS unsigned char* lds; gu32* ctl; unsigned char* ws; float* out;
    int tid, lane, wave, vcu, G, gw, NGW;
};

__device__ __forceinline__ Frame phase_frame(const Frame& F) {
    Frame P = F; int lane; asm volatile("v_mbcnt_lo_u32_b32 %0, -1, 0\n\tv_mbcnt_hi_u32_b32 %0, -1, %0" : "=v"(lane)); int wave = F.wave;
    asm volatile("" : "+v"(lane), "+s"(wave)); P.lane = lane; P.wave = wave; P.tid = wave * 64 + lane; P.gw = P.vcu * NWAVES + wave; return P;
}
__device__ __forceinline__ const float* in_ptr(const Frame& F, int k) {
    const unsigned long long v = ((const LAS unsigned long long*)(F.lds + PTAB_OFF))[k];
    const unsigned lo = (unsigned)__builtin_amdgcn_readfirstlane((int)(unsigned)v), hi = (unsigned)__builtin_amdgcn_readfirstlane((int)(unsigned)(v >> 32));
    return (const float*)(GAS const float*)(((unsigned long long)hi << 32) | lo);
}
__device__ __forceinline__ void transpose_item(const float* W, int N, int k0, int n0, bf16* WT, size_t orow, int ldk, LAS float* scr, int lane) {
#pragma unroll 8
    for (int i = 0; i < 32; ++i) { const int kk = 2 * i + (lane >> 5); scr[kk * 33 + (lane & 31)] = W[(size_t)(k0 + kk) * N + n0 + (lane & 31)]; }
    LDS_WAIT(); asm volatile("" ::: "memory");
    const int c = lane & 7;
#pragma unroll
    for (int j = 0; j < 4; ++j) { const int n = (lane >> 3) + 8 * j; const LAS float* s = scr + (8 * c) * 33 + n;
        v4u o; o.x = cvt_pk_bf16(s[0 * 33], s[1 * 33]); o.y = cvt_pk_bf16(s[2 * 33], s[3 * 33]); o.z = cvt_pk_bf16(s[4 * 33], s[5 * 33]); o.w = cvt_pk_bf16(s[6 * 33], s[7 * 33]);
        *(v4u*)(WT + (orow + n) * ldk + k0 + 8 * c) = o; }
    LDS_WAIT(); asm volatile("" ::: "memory");
}
__device__ __forceinline__ void convert_plain(Frame& F, const float* W, int K, int N, bf16* WT, int row_off) {
    LAS float* scr = (LAS float*)(F.lds + F.wave * 16384);
    const int nblk = N / 32, nitems = (K / 64) * nblk;
    for (int it = F.gw; it < nitems; it += F.NGW) { const int kb = it / nblk, nb = it % nblk; transpose_item(W, N, 64 * kb, 32 * nb, WT, (size_t)row_off + 32 * nb, K, scr, F.lane); }
}
__device__ __forceinline__ void convert_small(Frame& F, const float* W, int K, int N, bf16* WT, int Np, int Kp) {
    const size_t tot = (size_t)Np * Kp;
    for (size_t i = (size_t)F.gw * 64 + F.lane; i < tot; i += (size_t)F.NGW * 64) { const int n = (int)(i / Kp), k = (int)(i % Kp);
        const float v = (k < K && n < N) ? W[(size_t)k * N + n] : 0.0f; WT[i] = (bf16)(cvt_pk_bf16(v, 0.0f) & 0xffffu); }
}
__device__ __forceinline__ void convert_moe(Frame& F, const float* wg, const float* wu, const float* wd, const float* sg, const float* su, const float* sd) {
    LAS float* scr = (LAS float*)(F.lds + F.wave * 16384);
    bf16* Wgu = (bf16*)(F.ws + WS_WGU); bf16* Wd = (bf16*)(F.ws + WS_WD);
    constexpr int PER = 128;
    const int total = NEX * 3 * PER;
    for (int it = F.gw; it < total; it += F.NGW) {
        const int e = it / (3 * PER), r = it % (3 * PER), which = r / PER, q = r % PER;
        if (which < 2) { const float* W = (e < NE) ? (which == 0 ? wg : wu) + (size_t)e * D * DE : (which == 0 ? sg : su);
            const int kb = q >> 3, nb = q & 7, n0 = 32 * nb; const size_t orow = (size_t)e * 512 + (n0 >> 7) * 256 + which * 128 + (n0 & 127);
            transpose_item(W, DE, 64 * kb, n0, Wgu, orow, D, scr, F.lane);
        } else { const float* W = (e < NE) ? wd + (size_t)e * DE * D : sd;
            const int kb = q >> 5, nb = q & 31, n0 = 32 * nb;
            transpose_item(W, D, 64 * kb, n0, Wd, (size_t)e * 1024 + n0, DE, scr, F.lane); }
    }
}

template <int MODE>
__device__ __forceinline__ void ln_phase(Frame& F, const float* src, const float* g, const float* bsh, bool final, const MoeTab& M) {
    float* out = F.out; bf16* xb = (bf16*)(F.ws + WS_XB);
    const bf16* yb = (const bf16*)(F.ws + WS_Y); const int2* tsel = (const int2*)(F.ws + WS_TSEL);
    f32x4 gv[4], bv[4];
    if (MODE != 2) {
#pragma unroll
        for (int j = 0; j < 4; ++j) { const int c = 512 * (j >> 1) + 8 * F.lane + 4 * (j & 1); gv[j] = *(const f32x4*)(g + c); bv[j] = *(const f32x4*)(bsh + c); } }
    for (int row = F.gw; row < T; row += F.NGW) {
        const float* xr = src + (size_t)row * D + 8 * F.lane;
        f32x4 v[4];
#pragma unroll
        for (int j = 0; j < 4; ++j) v[j] = *(const f32x4*)(xr + 512 * (j >> 1) + 4 * (j & 1));
        if (MODE == 1) {
#pragma unroll
            for (int jj = 0; jj < TOPK; ++jj) { const int2 ts = tsel[(size_t)row * TOPK + jj]; const int e = ts.x >> 20, slot = ts.x & 0xfffff; const float gt = __int_as_float(ts.y);
                const bf16* yp = yb + (size_t)(M.hoff[e] + slot) * D + 8 * F.lane;
#pragma unroll
                for (int jh = 0; jh < 2; ++jh) { const v4u w = *(const v4u*)(yp + 512 * jh);
                    v[2 * jh][0] += gt * bflo(w.x); v[2 * jh][1] += gt * bfhi(w.x); v[2 * jh][2] += gt * bflo(w.y); v[2 * jh][3] += gt * bfhi(w.y);
                    v[2 * jh + 1][0] += gt * bflo(w.z); v[2 * jh + 1][1] += gt * bfhi(w.z); v[2 * jh + 1][2] += gt * bflo(w.w); v[2 * jh + 1][3] += gt * bfhi(w.w); } }
        }
        f32x4 o[4];
        if (MODE == 2) {
#pragma unroll
            for (int j = 0; j < 4; ++j) o[j] = v[j];
        } else {
            float s = 0.f;
#pragma unroll
            for (int j = 0; j < 4; ++j) s += (v[j][0] + v[j][1]) + (v[j][2] + v[j][3]);
            const float mean = wave_sum(s) * (1.0f / D); float s2 = 0.f;
#pragma unroll
            for (int j = 0; j < 4; ++j) { v[j] = v[j] - mean; s2 += (v[j][0] * v[j][0] + v[j][1] * v[j][1]) + (v[j][2] * v[j][2] + v[j][3] * v[j][3]); }
            const float rstd = 1.0f / sqrtf(wave_sum(s2) * (1.0f / D) + LN_EPS);
#pragma unroll
            for (int j = 0; j < 4; ++j) o[j] = v[j] * rstd * gv[j] + bv[j];
        }
        float* orow = out + (size_t)row * D + 8 * F.lane; bf16* brow = xb + (size_t)row * D + 8 * F.lane;
        const float sc = final ? 1.0f : ALPHA;
#pragma unroll
        for (int jh = 0; jh < 2; ++jh) { *(f32x4*)(orow + 512 * jh) = o[2 * jh] * sc; *(f32x4*)(orow + 512 * jh + 4) = o[2 * jh + 1] * sc;
            v4u w; w.x = cvt_pk_bf16(o[2 * jh][0], o[2 * jh][1]); w.y = cvt_pk_bf16(o[2 * jh][2], o[2 * jh][3]); w.z = cvt_pk_bf16(o[2 * jh + 1][0], o[2 * jh + 1][1]); w.w = cvt_pk_bf16(o[2 * jh + 1][2], o[2 * jh + 1][3]);
            *(v4u*)(brow + 512 * jh) = w; }
    }
}

__device__ __forceinline__ void moe_tables(Frame& F, int layer) {
    LAS int* cnt = (LAS int*)(F.lds + TAB_OFF); LAS int* mtp = cnt + 65; LAS int* hoff = mtp + 66;
    __syncthreads();
    if (F.tid < NE) cnt[F.tid] = (int)__hip_atomic_load(F.ctl + CW_CNT + (layer * 64 + F.tid) * 64, RLX_AGENT);
    if (F.tid == NE) cnt[NE] = T;
    __syncthreads();
    if (F.tid == 0) { int m = 0;
_Pragma("nounroll")
        for (int e = 0; e < NEX; ++e) { mtp[e] = m; hoff[e] = m * 256; m += (cnt[e] + 255) >> 8; } mtp[NEX] = m; hoff[NEX] = m * 256; }
    __syncthreads();
}

__device__ __forceinline__ void route_phase(Frame& F, int layer, const float* rbias) {
    const float* lg = (const float*)(F.ws + WS_LOGITS); int* toklist = (int*)(F.ws + WS_TOKLIST); int2* tsel = (int2*)(F.ws + WS_TSEL);
    LAS float* sw = (LAS float*)(F.lds + F.wave * 256);
    const float rb = rbias[F.lane];
    for (int row = F.gw; row < T; row += F.NGW) {
        const float sc = sigmoidf_(lg[(size_t)row * NE + F.lane]); const float bz = sc + rb;
        sw[F.lane] = bz; LDS_WAIT();
        float v[64];
#pragma unroll
        for (int q = 0; q < 16; ++q) { const f32x4 t = *(const LAS f32x4*)(sw + 4 * q); v[4 * q] = t[0]; v[4 * q + 1] = t[1]; v[4 * q + 2] = t[2]; v[4 * q + 3] = t[3]; }
        LDS_WAIT();
        float gs[8];
#pragma unroll
        for (int gi = 0; gi < 8; ++gi) { float m1 = -INFINITY, m2 = -INFINITY;
#pragma unroll
            for (int k = 0; k < 8; ++k) { const float x = v[8 * gi + k]; const bool a = x > m1; const float nm2 = a ? m1 : fmaxf(m2, x); m1 = a ? x : m1; m2 = nm2; }
            gs[gi] = m1 + m2; }
        unsigned keep = 0u;
#pragma unroll
        for (int gi = 0; gi < 8; ++gi) { int rank = 0;
#pragma unroll
            for (int g2 = 0; g2 < 8; ++g2) rank += (gs[g2] > gs[gi] || (gs[g2] == gs[gi] && g2 < gi)) ? 1 : 0;
            keep |= (rank < 4) ? (1u << gi) : 0u; }
        const bool kown = (keep >> (F.lane >> 3)) & 1u; int rank = 0;
#pragma unroll
        for (int e2 = 0; e2 < 64; ++e2) { const bool k2 = (keep >> (e2 >> 3)) & 1u; rank += (k2 && (v[e2] > bz || (v[e2] == bz && e2 < F.lane))) ? 1 : 0; }
        const bool sel = kown && rank < TOPK;
        const unsigned long long bal = __ballot(sel);
        const float ssum = wave_sum(sel ? sc : 0.0f);
        if (sel) { const int j = __popcll(bal & ((1ull << F.lane) - 1ull)); const float gate = sc / ssum * 2.5f;
            const unsigned slot = __hip_atomic_fetch_add(F.ctl + CW_CNT + (layer * 64 + F.lane) * 64, 1u, RLX_AGENT);
            toklist[(size_t)F.lane * T + slot] = row;
            if (j < TOPK) tsel[(size_t)row * TOPK + j] = make_int2((F.lane << 20) | (int)slot, __float_as_int(gate)); }
    }
}

__device__ __forceinline__ void ln1_route_phase(Frame& F, const float* g, const float* bsh, int layer, const float* rbias) {
    float* out = F.out; bf16* xb = (bf16*)(F.ws + WS_XB);
    const unsigned char* WrT = F.ws + WS_WR + (size_t)layer * 256 * D * 2;
    int* toklist = (int*)(F.ws + WS_TOKLIST); int2* tsel = (int2*)(F.ws + WS_TSEL);
    f32x4 gv[4], bv[4];
#pragma unroll
    for (int j = 0; j < 4; ++j) { const int c = 512 * (j >> 1) + 8 * F.lane + 4 * (j & 1); gv[j] = *(const f32x4*)(g + c); bv[j] = *(const f32x4*)(bsh + c); }
    const float rb = rbias[F.lane];
    const int qi = F.lane & 15, gq = F.lane >> 4;
    constexpr int NBAT = T / 16;
    for (int b0 = 0; b0 < NBAT; b0 += F.NGW) {
        const int batch = b0 + F.gw; const bool act = batch < NBAT;
        __syncthreads();
#pragma unroll
        for (int q = 0; q < 16; ++q) { const int hr = F.wave * 16 + q, e = hr >> 1, half = hr & 1; const int c = (64 * half + F.lane) ^ (e & 15);
            __builtin_amdgcn_global_load_lds((const unsigned*)(WrT + (size_t)e * 2048 + 16 * c), (LAS unsigned*)(F.lds + e * 2048 + 1024 * half), 16, 0, 0); }
        if (act) {
_Pragma("nounroll")
            for (int i = 0; i < 16; ++i) { const int row = 16 * batch + i;
                const float* xr = out + (size_t)row * D + 8 * F.lane;
                f32x4 v[4];
#pragma unroll
                for (int j = 0; j < 4; ++j) v[j] = *(const f32x4*)(xr + 512 * (j >> 1) + 4 * (j & 1));
                float s = 0.f;
#pragma unroll
                for (int j = 0; j < 4; ++j) s += (v[j][0] + v[j][1]) + (v[j][2] + v[j][3]);
                const float mean = wave_sum(s) * (1.0f / D); float s2 = 0.f;
#pragma unroll
                for (int j = 0; j < 4; ++j) { v[j] = v[j] - mean; s2 += (v[j][0] * v[j][0] + v[j][1] * v[j][1]) + (v[j][2] * v[j][2] + v[j][3] * v[j][3]); }
                const float rstd = 1.0f / sqrtf(wave_sum(s2) * (1.0f / D) + LN_EPS);
                f32x4 o[4];
#pragma unroll
                for (int j = 0; j < 4; ++j) o[j] = v[j] * rstd * gv[j] + bv[j];
                float* orow = out + (size_t)row * D + 8 * F.lane; bf16* brow = xb + (size_t)row * D + 8 * F.lane;
#pragma unroll
                for (int jh = 0; jh < 2; ++jh) { *(f32x4*)(orow + 512 * jh) = o[2 * jh] * ALPHA; *(f32x4*)(orow + 512 * jh + 4) = o[2 * jh + 1] * ALPHA;
                    v4u w; w.x = cvt_pk_bf16(o[2 * jh][0], o[2 * jh][1]); w.y = cvt_pk_bf16(o[2 * jh][2], o[2 * jh][3]); w.z = cvt_pk_bf16(o[2 * jh + 1][0], o[2 * jh + 1][1]); w.w = cvt_pk_bf16(o[2 * jh + 1][2], o[2 * jh + 1][3]);
                    *(v4u*)(brow + 512 * jh) = w; }
            }
        }
        VM_WAIT(); __syncthreads();
        f32x4 acc[4];
#pragma unroll
        for (int t = 0; t < 4; ++t) acc[t] = (f32x4){0.f, 0.f, 0.f, 0.f};
        if (act) { const bf16* xrow = xb + (size_t)(16 * batch + qi) * D + 8 * gq;
#pragma unroll 8
            for (int ks = 0; ks < 32; ++ks) { const bf16x8 bfr = *(const bf16x8*)(xrow + 32 * ks);
#pragma unroll
                for (int t = 0; t < 4; ++t) { const bf16x8 a = *(const LAS bf16x8*)(F.lds + (16 * t + qi) * 2048 + 16 * ((4 * ks + gq) ^ qi)); acc[t] = __builtin_amdgcn_mfma_f32_16x16x32_bf16(a, bfr, acc[t], 0, 0, 0); } } }
        __syncthreads();
        if (act) { LAS float* lg = (LAS float*)(F.lds + F.wave * 16384);
#pragma unroll
            for (int t = 0; t < 4; ++t) *(LAS f32x4*)(lg + qi * 64 + 16 * t + 4 * gq) = acc[t];
            LDS_WAIT();
            int cnt = 0;
_Pragma("nounroll")
            for (int i = 0; i < 16; ++i) { LAS float* sw = lg + 64 * i;
                const float sc = sigmoidf_(sw[F.lane]); const float bz = sc + rb;
                const float m1 = max8(bz);
                const unsigned long long bm = __ballot(bz == m1);
                const unsigned gb = (unsigned)(bm >> (F.lane & 56)) & 0xffu;
                const bool isf = (unsigned)(F.lane & 7) == (unsigned)__builtin_ctz(gb);
                const float m2 = max8(isf ? -INFINITY : bz);
                const float gsum = m1 + m2; const int grp = F.lane >> 3; int grank = 0;
#pragma unroll
                for (int g2 = 0; g2 < 8; ++g2) { const float s = __int_as_float(__builtin_amdgcn_readlane(__float_as_int(gsum), 8 * g2)); grank += (s > gsum || (s == gsum && g2 < grp)) ? 1 : 0; }
                float x = (grank < 4) ? bz : -INFINITY; bool sel = false;
#pragma unroll
                for (int r8 = 0; r8 < TOPK; ++r8) { const float m = wave_max(x); const unsigned long long bx = __ballot(x == m); const int first = (int)__builtin_ctzll(bx);
                    if (F.lane == first) { sel = true; x = -INFINITY; } }
                const float ssum = wave_sum(sel ? sc : 0.0f);
                sw[F.lane] = sel ? sc / ssum * 2.5f : -1.0f; cnt += sel ? 1 : 0; }
            unsigned slot = 0; if (cnt > 0) slot = __hip_atomic_fetch_add(F.ctl + CW_CNT + (layer * 64 + F.lane) * 64, (unsigned)cnt, RLX_AGENT);
            LDS_WAIT();
_Pragma("nounroll")
            for (int i = 0; i < 16; ++i) { const float gate = lg[64 * i + F.lane]; const bool sel = gate >= 0.0f; const int row = 16 * batch + i;
                const unsigned long long bal = __ballot(sel);
                if (sel) { const int j = __popcll(bal & ((1ull << F.lane) - 1ull));
                    toklist[(size_t)F.lane * T + slot] = row;
                    if (j < TOPK) tsel[(size_t)row * TOPK + j] = make_int2((F.lane << 20) | (int)slot, __float_as_int(gate));
                    ++slot; } }
            LDS_WAIT();
        }
    }
}

__device__ __forceinline__ void mix_phase(Frame& F, const float* mix) {
    bf16* xm = (bf16*)(F.ws + WS_XMIX);
    for (int row = F.gw; row < T; row += F.NGW) {
        const float* xr = F.out + (size_t)row * D + 8 * F.lane; const bool first = (row & (SEQ - 1)) == 0;
#pragma unroll
        for (int jh = 0; jh < 2; ++jh) { f32x4 x[2], xx[2];
#pragma unroll
            for (int q = 0; q < 2; ++q) { x[q] = *(const f32x4*)(xr + 512 * jh + 4 * q) * (1.0f / ALPHA); const f32x4 xp = first ? (f32x4){0.f, 0.f, 0.f, 0.f} : *(const f32x4*)(xr + 512 * jh + 4 * q - D) * (1.0f / ALPHA); xx[q] = xp - x[q]; }
#pragma unroll
            for (int i = 0; i < 6; ++i) { const float* mp = mix + i * D + 512 * jh + 8 * F.lane; const f32x4 o0 = x[0] + xx[0] * *(const f32x4*)mp, o1 = x[1] + xx[1] * *(const f32x4*)(mp + 4);
                v4u w; w.x = cvt_pk_bf16(o0[0], o0[1]); w.y = cvt_pk_bf16(o0[2], o0[3]); w.z = cvt_pk_bf16(o1[0], o1[1]); w.w = cvt_pk_bf16(o1[2], o1[3]);
                *(v4u*)(xm + ((size_t)i * T + row) * D + 512 * jh + 8 * F.lane) = w; } }
    }
}
__device__ __forceinline__ void kmean_phase(Frame& F) {
    const bf16* Kb = (const bf16*)(F.ws + WS_K); float* km = (float*)(F.ws + WS_KMEAN);
    for (int u = F.gw; u < NBATCH * NH * NMB; u += F.NGW) { const int bh = u >> 4, blk = u & 15, b = bh >> 4, h = bh & 15;
        const bf16* p = Kb + ((size_t)b * SEQ + blk * MBLK) * D + h * HD + F.lane; float s = 0.f;
#pragma unroll 16
        for (int r = 0; r < MBLK; ++r) s += bf1(p[(size_t)r * D]);
        km[(size_t)u * HD + F.lane] = s * (1.0f / MBLK); }
}
__device__ __forceinline__ void sel_phase(Frame& F) {
    const bf16* Q = (const bf16*)(F.ws + WS_Q); const float* km = (const float*)(F.ws + WS_KMEAN); unsigned short* maskb = (unsigned short*)(F.ws + WS_MASK);
    LAS float* kl = (LAS float*)F.lds;
    for (int u = F.vcu; u < NBATCH * NH * (SEQ / NTHREADS); u += F.G) { const int bh = u >> 3, ch = u & 7, b = bh >> 4, h = bh & 15;
        __syncthreads();
        for (int i = F.tid; i < NMB * HD; i += NTHREADS) kl[i] = km[(size_t)bh * NMB * HD + i];
        __syncthreads();
        const int qpos = ch * NTHREADS + F.tid, qblk = qpos >> 8;
        const v4u* qp = (const v4u*)(Q + ((size_t)b * SEQ + qpos) * D + h * HD); float q[64];
#pragma unroll
        for (int i = 0; i < 8; ++i) { const v4u w = qp[i];
#pragma unroll
            for (int k = 0; k < 4; ++k) { q[8 * i + 2 * k] = bflo(w[k]); q[8 * i + 2 * k + 1] = bfhi(w[k]); } }
        float v1 = -INFINITY, v2 = -INFINITY, v3 = -INFINITY; int i1 = -1, i2 = -1, i3 = -1;
        for (int j = 0; j < qblk; ++j) { float gsum = 0.f; const LAS f32x4* kr = (const LAS f32x4*)(kl + j * HD);
#pragma unroll
            for (int i = 0; i < 16; ++i) { const f32x4 kv = kr[i]; gsum += q[4 * i] * kv[0] + q[4 * i + 1] * kv[1] + q[4 * i + 2] * kv[2] + q[4 * i + 3] * kv[3]; }
            if (gsum > v1) { v3 = v2; i3 = i2; v2 = v1; i2 = i1; v1 = gsum; i1 = j; }
            else if (gsum > v2) { v3 = v2; i3 = i2; v2 = gsum; i2 = j; }
            else if (gsum > v3) { v3 = gsum; i3 = j; } }
        unsigned mk = 0u; if (i1 >= 0) mk |= 1u << i1; if (i2 >= 0) mk |= 1u << i2; if (i3 >= 0) mk |= 1u << i3;
        maskb[(size_t)bh * SEQ + qpos] = (unsigned short)mk; }
}
template <int probe> __device__ __forceinline__ void attn_phase(Frame& F, const float* rel_bias) {
    const bf16* Q = (const bf16*)(F.ws + WS_Q); const bf16* Kb = (const bf16*)(F.ws + WS_K); const bf16* Vt = (const bf16*)(F.ws + WS_VT); bf16* O = (bf16*)(F.ws + WS_O);
    const unsigned short* maskb = (const unsigned short*)(F.ws + WS_MASK);
    constexpr int KRS = 144, VRS = 272, KB_ = 128 * KRS, TB = KB_ + 64 * VRS;
    LAS float* tbl = (LAS float*)(F.lds + 2 * TB);
    __syncthreads();
    for (int i = F.tid; i < NH * 129; i += NTHREADS) { const int h = i / 129, d = i % 129; tbl[h * 132 + d] = rel_bias[(int)T5_BUCKET[d] * NH + h] * 1.4426950408889634f; }
    __syncthreads();
    const int qi = F.lane & 15, g = F.lane >> 4; unsigned tcount = 0;
    for (int it = 0;; ++it) {
        int bh, blk;
        if (F.G == 256) { if (it >= 8) break; bh = F.vcu >> 1; blk = (F.vcu & 1) ? ((it & 1) ? 15 - it : it + 1) : ((it & 1) ? 16 - it : it); }
        else { const int L = it * F.G + F.vcu; if (L >= NBATCH * NH * NMB) break; bh = L >> 4; blk = L & 15; }
        const int b = bh >> 4, h = bh & 15;
        const int q0 = blk * MBLK + 32 * F.wave;
        bf16x8 qf[2][2]; unsigned qmask[2];
#pragma unroll
        for (int gp = 0; gp < 2; ++gp) { const int qpos = q0 + 16 * gp + qi; const size_t qrow = (size_t)b * SEQ + qpos; qmask[gp] = maskb[(size_t)bh * SEQ + qpos];
#pragma unroll
            for (int ks = 0; ks < 2; ++ks) qf[gp][ks] = *(const bf16x8*)(Q + qrow * D + h * HD + 32 * ks + 8 * g); }
        const LAS float* tblh = tbl + h * 132; const float bfar = tblh[128];
        float mref[2] = {0.f, 0.f}; f32x4 o[2][5];
#pragma unroll
        for (int gp = 0; gp < 2; ++gp)
#pragma unroll
            for (int dt = 0; dt < 5; ++dt) o[gp][dt] = (f32x4){0.f, 0.f, 0.f, 0.f};
        constexpr float THR = 8.0f;
        const bf16x8 ones = {0x3F80, 0x3F80, 0x3F80, 0x3F80, 0x3F80, 0x3F80, 0x3F80, 0x3F80};
        const int nst = 2 + 2 * blk;
        const int kkey = F.tid >> 3, kch = F.tid & 7;
        const int vd = F.tid >> 3, vch = F.tid & 7;
        const bf16* kbase = Kb + ((size_t)b * SEQ + kkey) * D + h * HD + 8 * kch;
        const bf16* vbase = Vt + (((size_t)bh * HD + vd) << 12) + 8 * vch;
        v4u kreg[2], vreg[2];
        { const int key0 = blk * MBLK; kreg[0] = *(const v4u*)(kbase + (size_t)key0 * D); kreg[1] = *(const v4u*)(kbase + (size_t)(key0 + 64) * D); vreg[0] = *(const v4u*)(vbase + key0); vreg[1] = *(const v4u*)(vbase + key0 + 64); }
        for (int n = 0; n < nst; ++n) {
            int jb, key0; if (n < 2) { jb = blk; key0 = blk * MBLK + 128 * n; } else { const int mm = n - 2; jb = blk - 1 - (mm >> 1); key0 = jb * MBLK + 128 * (mm & 1); }
            LAS unsigned char* buf = F.lds + (tcount & 1u) * TB; ++tcount;
            *(LAS v4u*)(buf + kkey * KRS + kch * 16) = kreg[0]; *(LAS v4u*)(buf + (kkey + 64) * KRS + kch * 16) = kreg[1];
            *(LAS v4u*)(buf + KB_ + vd * VRS + vch * 16) = vreg[0]; *(LAS v4u*)(buf + KB_ + vd * VRS + (vch + 8) * 16) = vreg[1];
            asm volatile("s_waitcnt lgkmcnt(0)" ::: "memory");
            if (n + 1 < nst) { const int n1 = n + 1; int k1; if (n1 < 2) k1 = blk * MBLK + 128 * n1; else { const int mm = n1 - 2; k1 = (blk - 1 - (mm >> 1)) * MBLK + 128 * (mm & 1); }
                kreg[0] = *(const v4u*)(kbase + (size_t)k1 * D); kreg[1] = *(const v4u*)(kbase + (size_t)(k1 + 64) * D); vreg[0] = *(const v4u*)(vbase + k1); vreg[1] = *(const v4u*)(vbase + k1 + 64); }
            asm volatile("s_barrier" ::: "memory");
            const bool own = (jb == blk), nearb = (jb >= blk - 1);
            if (probe == 2) continue;
            if (own && 128 * n > 32 * F.wave + 31) continue;
            f32x4 s[2][8]; bool selb[2];
#pragma unroll
            for (int gp = 0; gp < 2; ++gp) { selb[gp] = (qmask[gp] >> jb) & 1u; const float c0 = (n == 0) ? 0.0f : (nearb ? -mref[gp] : (selb[gp] ? bfar - mref[gp] : -INFINITY));
#pragma unroll
                for (int kt = 0; kt < 8; ++kt) s[gp][kt] = (f32x4){c0, c0, c0, c0}; }
#pragma unroll
            for (int kt = 0; kt < 8; ++kt)
#pragma unroll
                for (int ks = 0; ks < 2; ++ks) { if (probe == 4) break; const bf16x8 a = *(const LAS bf16x8*)(buf + (16 * kt + qi) * KRS + 64 * ks + 16 * g);
                    s[0][kt] = __builtin_amdgcn_mfma_f32_16x16x32_bf16(a, qf[0][ks], s[0][kt], 0, 0, 0); s[1][kt] = __builtin_amdgcn_mfma_f32_16x16x32_bf16(a, qf[1][ks], s[1][kt], 0, 0, 0);
                    }
#pragma unroll
            for (int gp = 0; gp < 2; ++gp) { if (probe == 3) break;
                float mx = -INFINITY;
                if (nearb) {
                    const int qpos = q0 + 16 * gp + qi; const int dist0 = qpos - (key0 + 4 * g);
#pragma unroll
                    for (int kh = 0; kh < 4; ++kh) { float bz[2][4];
#pragma unroll
                        for (int k4 = 0; k4 < 2; ++k4)
#pragma unroll
                            for (int r = 0; r < 4; ++r) { const int dist = dist0 - (16 * (2 * kh + k4) + r); const int dd = dist < 0 ? 0 : (dist > 128 ? 128 : dist); bz[k4][r] = tblh[dd]; }
#pragma unroll
                        for (int k4 = 0; k4 < 2; ++k4) asm volatile("" : "+v"(bz[k4][0]), "+v"(bz[k4][1]), "+v"(bz[k4][2]), "+v"(bz[k4][3]));
#pragma unroll
                        for (int k4 = 0; k4 < 2; ++k4)
#pragma unroll
                            for (int r = 0; r < 4; ++r) { const int kt = 2 * kh + k4; const int dist = dist0 - (16 * kt + r);
                                const bool valid = own ? (dist >= 0) : selb[gp]; const float x = valid ? s[gp][kt][r] + bz[k4][r] : -INFINITY; s[gp][kt][r] = x; mx = __builtin_fmaxf(mx, x); } }
                } else {
#pragma unroll
                    for (int kt = 0; kt < 8; ++kt)
#pragma unroll
                        for (int r = 0; r < 4; ++r) mx = __builtin_fmaxf(mx, s[gp][kt][r]); }
                mx = q4_max(mx);
                if (n == 0) {
                    mref[gp] = mx;
#pragma unroll
                    for (int kt = 0; kt < 8; ++kt)
#pragma unroll
                        for (int r = 0; r < 4; ++r) s[gp][kt][r] -= mx;
                } else if (__any(mx > THR)) {
                    const float dl = __builtin_fmaxf(mx, 0.0f), f = __builtin_amdgcn_exp2f(-dl); mref[gp] += dl;
#pragma unroll
                    for (int kt = 0; kt < 8; ++kt)
#pragma unroll
                        for (int r = 0; r < 4; ++r) s[gp][kt][r] -= dl;
#pragma unroll
                    for (int dt = 0; dt < 5; ++dt) o[gp][dt] = o[gp][dt] * f; }
#pragma unroll
                for (int kt = 0; kt < 8; ++kt)
#pragma unroll
                    for (int r = 0; r < 4; ++r) s[gp][kt][r] = __builtin_amdgcn_exp2f(s[gp][kt][r]);
            }
#pragma unroll
            for (int k2 = 0; k2 < 4; ++k2) { if (probe == 5) break; bf16x8 pb[2][4];
#pragma unroll
                for (int gp = 0; gp < 2; ++gp) { v4u pw; pw.x = cvt_pk_bf16(s[gp][2 * k2][0], s[gp][2 * k2][1]); pw.y = cvt_pk_bf16(s[gp][2 * k2][2], s[gp][2 * k2][3]);
                    pw.z = cvt_pk_bf16(s[gp][2 * k2 + 1][0], s[gp][2 * k2 + 1][1]); pw.w = cvt_pk_bf16(s[gp][2 * k2 + 1][2], s[gp][2 * k2 + 1][3]); pb[gp][k2] = __builtin_bit_cast(bf16x8, pw); }
#pragma unroll
                for (int dt = 0; dt < 4; ++dt) { const LAS unsigned char* vp = buf + KB_ + (16 * dt + qi) * VRS + 64 * k2 + 8 * g; const v2u lo = *(const LAS v2u*)vp, hi = *(const LAS v2u*)(vp + 32);
                    v4u aw; aw.x = lo.x; aw.y = lo.y; aw.z = hi.x; aw.w = hi.y; const bf16x8 av = __builtin_bit_cast(bf16x8, aw);
                    o[0][dt] = __builtin_amdgcn_mfma_f32_16x16x32_bf16(av, pb[0][k2], o[0][dt], 0, 0, 0); o[1][dt] = __builtin_amdgcn_mfma_f32_16x16x32_bf16(av, pb[1][k2], o[1][dt], 0, 0, 0); }
                o[0][4] = __builtin_amdgcn_mfma_f32_16x16x32_bf16(ones, pb[0][k2], o[0][4], 0, 0, 0); o[1][4] = __builtin_amdgcn_mfma_f32_16x16x32_bf16(ones, pb[1][k2], o[1][4], 0, 0, 0); }
        }
#pragma unroll
        for (int gp = 0; gp < 2; ++gp) { const float inv = 1.0f / o[gp][4][0]; const size_t qrow = (size_t)b * SEQ + q0 + 16 * gp + qi;
#pragma unroll
            for (int dt = 0; dt < 4; ++dt) { v2u w; w.x = cvt_pk_bf16(o[gp][dt][0] * inv, o[gp][dt][1] * inv); w.y = cvt_pk_bf16(o[gp][dt][2] * inv, o[gp][dt][3] * inv); *(v2u*)(O + qrow * D + h * HD + 16 * dt + 4 * g) = w; } }
    }
    __syncthreads();
}

constexpr int SC = 32, NCHK = SEQ / SC;
constexpr size_t WS_PT = WS_S + 256 * MiB;
constexpr size_t WS_LT = 48 * MiB;
constexpr size_t WS_QT = WS_S + 576 * MiB;
constexpr size_t WS_YS2 = WS_S;
static_assert(WS_LT + 128 * MiB <= WS_VF && WS_QT + 64 * MiB <= WS_YG, "chunk operator buffers");
__device__ __forceinline__ float reduce8(float v) { v = dpp_add<0xB1>(v); v = dpp_add<0x4E>(v); v = dpp_add<0x141>(v); return v; }
template <int KS> __device__ __forceinline__ f32x4 mm_tile(const LAS unsigned char* X, int xs, int m0, const LAS unsigned char* Y, int ys, int n0, f32x4 acc, int qi, int g) {
#pragma unroll
    for (int ks = 0; ks < KS; ++ks) { const bf16x8 a = *(const LAS bf16x8*)(X + (m0 + qi) * xs + 64 * ks + 16 * g), b = *(const LAS bf16x8*)(Y + (n0 + qi) * ys + 64 * ks + 16 * g);
        acc = __builtin_amdgcn_mfma_f32_16x16x32_bf16(a, b, acc, 0, 0, 0); }
    return acc;
}
typedef short v4i16_t_ __attribute__((ext_vector_type(4)));
__device__ __forceinline__ bf16x8 frag_tr(const LAS unsigned char* Z, int zs, int kk0, int c0, int qi, int g) {
    const LAS unsigned char* p = Z + (kk0 + 8 * g + (qi >> 2)) * zs + (c0 + 4 * (qi & 3)) * 2;
    const v4i16_t_ lo = __builtin_amdgcn_ds_read_tr16_b64_v4i16((LAS v4i16_t_*)p), hi = __builtin_amdgcn_ds_read_tr16_b64_v4i16((LAS v4i16_t_*)(p + 4 * zs));
    return (bf16x8){lo[0], lo[1], lo[2], lo[3], hi[0], hi[1], hi[2], hi[3]};
}
template <int KS> __device__ __forceinline__ f32x4 mm_tile_xt(const LAS unsigned char* Z, int zs, int m0, const LAS unsigned char* Y, int ys, int n0, f32x4 acc, int qi, int g) {
#pragma unroll
    for (int ks = 0; ks < KS; ++ks) { const bf16x8 a = frag_tr(Z, zs, 32 * ks, m0, qi, g), b = *(const LAS bf16x8*)(Y + (n0 + qi) * ys + 64 * ks + 16 * g);
        acc = __builtin_amdgcn_mfma_f32_16x16x32_bf16(a, b, acc, 0, 0, 0); }
    return acc;
}
template <int KS> __device__ __forceinline__ f32x4 mm_tile_yt(const LAS unsigned char* X, int xs, int m0, const LAS unsigned char* Z, int zs, int n0, f32x4 acc, int qi, int g) {
#pragma unroll
    for (int ks = 0; ks < KS; ++ks) { const bf16x8 a = *(const LAS bf16x8*)(X + (m0 + qi) * xs + 64 * ks + 16 * g), b = frag_tr(Z, zs, 32 * ks, n0, qi, g);
        acc = __builtin_amdgcn_mfma_f32_16x16x32_bf16(a, b, acc, 0, 0, 0); }
    return acc;
}
__device__ __forceinline__ v2u pack4(const f32x4 v) { v2u w; w.x = cvt_pk_bf16(v[0], v[1]); w.y = cvt_pk_bf16(v[2], v[3]); return w; }
__device__ __forceinline__ void chunk_prep(Frame& F, const bf16* vbuf, const float* k_k, const float* k_a, const bool dry = false) {
    const bf16* rb = (const bf16*)(F.ws + WS_R); const bf16* kb = (const bf16*)(F.ws + WS_KK); const bf16* ab = (const bf16*)(F.ws + WS_A); const float* lw = (const float*)(F.ws + WS_LW);
    bf16* PTg = (bf16*)(F.ws + WS_PT); bf16* QTg = (bf16*)(F.ws + WS_QT); bf16* LTg = (bf16*)(F.ws + WS_LT); float* ys = (float*)(F.ws + WS_YS2);
    constexpr int RS = 144, TS_ = 80;
    constexpr int O_AT = 0, O_BT = 4608, O_KT = 9216, O_RT = 13824, O_VT = 18432, O_X2T = 23040, O_GT = 28160,
                  O_TM = 33280, O_NRBT = 35840, O_NAK = 38400, O_X1T = 40960, O_HT = 43520, O_NAB = 46080, O_WC = 50688, O_PK = 50944, O_CL = O_X2T;
    const int grp = F.wave >> 2, wg = F.wave & 3;
    LAS unsigned char* L = F.lds + grp * 65536;
    const int gt0 = F.tid & 255, st0 = gt0 >> 3, c80 = gt0 & 7;
    __syncthreads();
    for (int i = gt0; i < D; i += 256) { *(LAS float*)(L + O_PK + i * 4) = k_k[i]; *(LAS float*)(L + O_PK + 4096 + i * 4) = k_a[i]; }
    constexpr int NIT = (NBATCH * NH * NCHK) / (2 * 256);
    v4u pre_r, pre_k, pre_a, pre_v; f32x4 pre_l0, pre_l1;
#define CP_LOAD(it_) do { const int item_ = ((it_) * F.G + F.vcu) * 2 + grp, bh_ = item_ >> 7, ck_ = item_ & (NCHK - 1); \
        const size_t o_ = ((size_t)(bh_ >> 4) * SEQ + ck_ * SC + st0) * D + (bh_ & 15) * HD + 8 * c80; \
        pre_r = *(const v4u*)(rb + o_); pre_k = *(const v4u*)(kb + o_); pre_a = *(const v4u*)(ab + o_); pre_v = *(const v4u*)(vbuf + o_); pre_l0 = *(const f32x4*)(lw + o_); pre_l1 = *(const f32x4*)(lw + o_ + 4); } while (0)
    CP_LOAD(0);
    for (int it = 0; it < NIT; ++it) {
        const int item = (it * F.G + F.vcu) * 2 + grp, bh = item >> 7, ck = item & (NCHK - 1), b = bh >> 4, h = bh & 15, t0 = ck * SC;
        const size_t base = ((size_t)b * SEQ + t0) * D + h * HD;
        int lane_i = F.lane; asm volatile("" : "+v"(lane_i));
        const int gt = (wg << 6) | lane_i, qi = lane_i & 15, g = lane_i >> 4, st = gt >> 3, c8 = gt & 7;
        __syncthreads();
        float r8[8], al8[8], be8[8], kh8[8], v8[8];
        { const v4u wr_ = pre_r, wk = pre_k, wa = pre_a, wv = pre_v;
          f32x4 l0 = pre_l0, l1 = pre_l1;
#pragma unroll
          for (int j = 0; j < 4; ++j) { { const float z = l0[j]; l0[j] = -fast_exp(fminf(z, 0.0f) - __logf(1.0f + fast_exp(-fabsf(z))) - 0.5f); } { const float z = l1[j]; l1[j] = -fast_exp(fminf(z, 0.0f) - __logf(1.0f + fast_exp(-fabsf(z))) - 0.5f); } }
          const f32x4 kk0 = *(const LAS f32x4*)(L + O_PK + (h * HD + 8 * c8) * 4), kk1 = *(const LAS f32x4*)(L + O_PK + (h * HD + 8 * c8 + 4) * 4), ka0 = *(const LAS f32x4*)(L + O_PK + 4096 + (h * HD + 8 * c8) * 4), ka1 = *(const LAS f32x4*)(L + O_PK + 4096 + (h * HD + 8 * c8 + 4) * 4);
          float k8[8], a8[8], kk8[8]; float ss = 0.f;
#pragma unroll
          for (int j = 0; j < 8; ++j) { const unsigned xr = wr_[j >> 1], xk = wk[j >> 1], xa = wa[j >> 1], xv = wv[j >> 1];
              r8[j] = (j & 1) ? bfhi(xr) : bflo(xr); k8[j] = (j & 1) ? bfhi(xk) : bflo(xk); a8[j] = (j & 1) ? bfhi(xa) : bflo(xa); v8[j] = (j & 1) ? bfhi(xv) : bflo(xv);
              kk8[j] = k8[j] * (j < 4 ? kk0[j & 3] : kk1[j & 3]); ss += kk8[j] * kk8[j]; }
          ss = reduce8(ss); const float inv = 1.0f / fmaxf(sqrtf(ss), 1e-12f);
#pragma unroll
          for (int j = 0; j < 8; ++j) { const float kk = kk8[j] * inv; al8[j] = -kk; be8[j] = kk * a8[j]; kh8[j] = k8[j] * (1.0f + (a8[j] - 1.0f) * (j < 4 ? ka0[j & 3] : ka1[j & 3])); }
          *(LAS f32x4*)(L + O_CL + (st * 64 + 8 * c8) * 4) = l0; *(LAS f32x4*)(L + O_CL + (st * 64 + 8 * c8 + 4) * 4) = l1; }
        __syncthreads();
#if DRYCUT == 5
        if (dry) continue;
#endif
        if (gt < 64) { float cv[SC];
#pragma unroll
            for (int t = 0; t < SC; ++t) cv[t] = *(const LAS float*)(L + O_CL + (t * 64 + gt) * 4);
#pragma unroll
            for (int t = 1; t < SC; ++t) cv[t] += cv[t - 1];
#pragma unroll
            for (int t = 0; t < SC; ++t) *(LAS float*)(L + O_CL + (t * 64 + gt) * 4) = cv[t];
            *(LAS float*)(L + O_WC + gt * 4) = fast_exp(cv[SC - 1]); }
        __syncthreads();
#if DRYCUT == 6
        if (dry) continue;
#endif
        { float cl[8], cm[8];
          { const f32x4 c0 = *(const LAS f32x4*)(L + O_CL + (st * 64 + 8 * c8) * 4), c1 = *(const LAS f32x4*)(L + O_CL + (st * 64 + 8 * c8 + 4) * 4);
            f32x4 m0 = {0.f, 0.f, 0.f, 0.f}, m1 = {0.f, 0.f, 0.f, 0.f};
            if (st > 0) { m0 = *(const LAS f32x4*)(L + O_CL + ((st - 1) * 64 + 8 * c8) * 4); m1 = *(const LAS f32x4*)(L + O_CL + ((st - 1) * 64 + 8 * c8 + 4) * 4); }
#pragma unroll
            for (int j = 0; j < 4; ++j) { cl[j] = c0[j]; cl[4 + j] = c1[j]; cm[j] = m0[j]; cm[4 + j] = m1[j]; } }
          float at8[8], bt8[8], kt8[8], rt8[8];
#pragma unroll
          for (int j = 0; j < 8; ++j) { const float e1 = fast_exp(cl[j]), em = fast_exp(cm[j]), en = fast_exp(-cl[j]); at8[j] = al8[j] * em; bt8[j] = be8[j] * en; kt8[j] = kh8[j] * en; rt8[j] = r8[j] * e1; }
          v4u w; w.x = cvt_pk_bf16(at8[0], at8[1]); w.y = cvt_pk_bf16(at8[2], at8[3]); w.z = cvt_pk_bf16(at8[4], at8[5]); w.w = cvt_pk_bf16(at8[6], at8[7]); *(LAS v4u*)(L + O_AT + st * RS + 16 * c8) = w;
          w.x = cvt_pk_bf16(bt8[0], bt8[1]); w.y = cvt_pk_bf16(bt8[2], bt8[3]); w.z = cvt_pk_bf16(bt8[4], bt8[5]); w.w = cvt_pk_bf16(bt8[6], bt8[7]); *(LAS v4u*)(L + O_BT + st * RS + 16 * c8) = w;
          w.x = cvt_pk_bf16(kt8[0], kt8[1]); w.y = cvt_pk_bf16(kt8[2], kt8[3]); w.z = cvt_pk_bf16(kt8[4], kt8[5]); w.w = cvt_pk_bf16(kt8[6], kt8[7]); *(LAS v4u*)(L + O_KT + st * RS + 16 * c8) = w;
          w.x = cvt_pk_bf16(rt8[0], rt8[1]); w.y = cvt_pk_bf16(rt8[2], rt8[3]); w.z = cvt_pk_bf16(rt8[4], rt8[5]); w.w = cvt_pk_bf16(rt8[6], rt8[7]); *(LAS v4u*)(L + O_RT + st * RS + 16 * c8) = w;
          w.x = cvt_pk_bf16(v8[0], v8[1]); w.y = cvt_pk_bf16(v8[2], v8[3]); w.z = cvt_pk_bf16(v8[4], v8[5]); w.w = cvt_pk_bf16(v8[6], v8[7]); *(LAS v4u*)(L + O_VT + st * RS + 16 * c8) = w; }
        __syncthreads();
#if DRYCUT == 1
        if (dry) continue;
#endif
        { const int mt = wg >> 1, nt = wg & 1, n = 16 * nt + qi, m0 = 16 * mt + 4 * g; const f32x4 z = {0.f, 0.f, 0.f, 0.f};
          f32x4 c1 = mm_tile<2>(L + O_AT, RS, 16 * mt, L + O_BT, RS, 16 * nt, z, qi, g);
#pragma unroll
          for (int r = 0; r < 4; ++r) c1[r] = (n < m0 + r) ? c1[r] : 0.f;
          *(LAS f32x4*)(L + O_NAB + n * 144 + m0 * 4) = c1;
          f32x4 c2 = mm_tile<2>(L + O_BT, RS, 16 * mt, L + O_RT, RS, 16 * nt, z, qi, g);
#pragma unroll
          for (int r = 0; r < 4; ++r) c2[r] = (m0 + r <= n) ? c2[r] : 0.f;
          *(LAS v2u*)(L + O_NRBT + n * TS_ + m0 * 2) = pack4(c2);
          f32x4 c3 = mm_tile<2>(L + O_AT, RS, 16 * mt, L + O_KT, RS, 16 * nt, z, qi, g);
#pragma unroll
          for (int r = 0; r < 4; ++r) c3[r] = (n < m0 + r) ? c3[r] : 0.f;
          *(LAS v2u*)(L + O_NAK + n * TS_ + m0 * 2) = pack4(c3); }
        __syncthreads();
#if DRYCUT == 2
        if (dry) continue;
#endif
        if (wg == 0) { const int col = lane_i & 31; float x[SC];
#pragma unroll
            for (int s = SC - 1; s >= 0; --s) { float ac[4] = {(col == s) ? 1.0f : 0.0f, 0.f, 0.f, 0.f};
#pragma unroll
                for (int q4 = SC / 4 - 1; q4 >= (s + 1) >> 2; --q4) { const f32x4 nv = *(const LAS f32x4*)(L + O_NAB + s * 144 + q4 * 16);
#pragma unroll
                    for (int r = 3; r >= 0; --r) { const int t = 4 * q4 + r; if (t > s) ac[r] += nv[r] * x[t]; } }
                x[s] = (ac[0] + ac[1]) + (ac[2] + ac[3]); }
            if (lane_i < 32) {
#pragma unroll
                for (int s = 0; s < SC; ++s) *(LAS bf16*)(L + O_TM + s * TS_ + col * 2) = (bf16)(cvt_pk_bf16(x[s], 0.f) & 0xffffu); } }
        __syncthreads();
#if DRYCUT == 3
        if (dry) continue;
#endif
        { const f32x4 z = {0.f, 0.f, 0.f, 0.f};
          { const int mt = wg >> 1, nt = wg & 1; const f32x4 c = mm_tile<1>(L + O_TM, TS_, 16 * mt, L + O_NRBT, TS_, 16 * nt, z, qi, g); *(LAS v2u*)(L + O_X1T + (16 * nt + qi) * TS_ + (16 * mt + 4 * g) * 2) = pack4(c); }
#pragma unroll
          for (int q = 0; q < 2; ++q) { const int tix = wg * 2 + q, mt = tix >> 2, nt = tix & 3; const f32x4 c = mm_tile_yt<1>(L + O_TM, TS_, 16 * mt, L + O_BT, RS, 16 * nt, z, qi, g);
              *(LAS v2u*)(L + O_X2T + (16 * nt + qi) * TS_ + (16 * mt + 4 * g) * 2) = pack4(c); } }
        if (it + 1 < NIT) CP_LOAD(it + 1);
        __syncthreads();
        { const size_t cid = (size_t)bh * NCHK + ck;
#pragma unroll
          for (int q = 0; q < 2; ++q) { const int tix = wg * 2 + q, mt = tix >> 1, nt = tix & 1, t = 16 * nt + qi; const v2u rw = *(const LAS v2u*)(L + O_RT + t * RS + (16 * mt + 4 * g) * 2);
              f32x4 c = {bflo(rw.x), bfhi(rw.x), bflo(rw.y), bfhi(rw.y)}; c = mm_tile_xt<1>(L + O_AT, RS, 16 * mt, L + O_X1T, TS_, 16 * nt, c, qi, g);
              *(v2u*)(QTg + (cid * SC + t) * 64 + 16 * mt + 4 * g) = pack4(c); }
          { const int mt = wg >> 1, nt = wg & 1, n = 16 * nt + qi, m0 = 16 * mt + 4 * g; f32x4 c = mm_tile<2>(L + O_KT, RS, 16 * mt, L + O_RT, RS, 16 * nt, (f32x4){0.f, 0.f, 0.f, 0.f}, qi, g);
#pragma unroll
            for (int r = 0; r < 4; ++r) c[r] = (m0 + r <= n) ? c[r] : 0.f;
            c = mm_tile<1>(L + O_NAK, TS_, 16 * mt, L + O_X1T, TS_, 16 * nt, c, qi, g); *(LAS v2u*)(L + O_HT + n * TS_ + m0 * 2) = pack4(c); }
#pragma unroll
          for (int q = 0; q < 4; ++q) { const int mt = wg, nt = q, k = 16 * nt + qi, m0 = 16 * mt + 4 * g; f32x4 c = mm_tile_xt<1>(L + O_AT, RS, 16 * mt, L + O_X2T, TS_, 16 * nt, (f32x4){0.f, 0.f, 0.f, 0.f}, qi, g);
              const float wc = *(const LAS float*)(L + O_WC + k * 4);
#pragma unroll
              for (int r = 0; r < 4; ++r) c[r] = (c[r] + ((m0 + r == k) ? 1.0f : 0.0f)) * wc;
              *(v2u*)(PTg + (cid * 64 + k) * 64 + 16 * mt + 4 * g) = pack4(c); }
#pragma unroll
          for (int q = 0; q < 2; ++q) { const int tix = wg * 2 + q, mt = tix >> 2, nt = tix & 3, k = 16 * nt + qi, m0 = 16 * mt + 4 * g; f32x4 c;
#pragma unroll
              for (int r = 0; r < 4; ++r) c[r] = bf1(*(const LAS bf16*)(L + O_KT + (m0 + r) * RS + k * 2));
              c = mm_tile<1>(L + O_NAK, TS_, 16 * mt, L + O_X2T, TS_, 16 * nt, c, qi, g); const float wc = *(const LAS float*)(L + O_WC + k * 4);
              *(LAS v2u*)(L + O_GT + k * TS_ + m0 * 2) = pack4(c * wc); } }
        __syncthreads();
#if DRYCUT == 4
        if (dry) continue;
#endif
        { const size_t cid = (size_t)bh * NCHK + ck; const f32x4 z = {0.f, 0.f, 0.f, 0.f};
#pragma unroll
          for (int q = 0; q < 4; ++q) { const int mt = q, nt = wg; const f32x4 c = mm_tile_yt<1>(L + O_GT, TS_, 16 * mt, L + O_VT, RS, 16 * nt, z, qi, g);
              *(v2u*)(LTg + (((cid * 4 + nt) * 4 + mt) * 64 + lane_i) * 4) = pack4(c); }
#pragma unroll
          for (int q = 0; q < 2; ++q) { const int mt = q, nt = wg; const f32x4 c = mm_tile_yt<1>(L + O_HT, TS_, 16 * mt, L + O_VT, RS, 16 * nt, z, qi, g);
#pragma unroll
              for (int r = 0; r < 4; ++r) if (!dry) ys[base + (size_t)(16 * mt + 4 * g + r) * D + 16 * nt + qi] = c[r]; } }
    }
#undef CP_LOAD
    __syncthreads();
}
__device__ __forceinline__ void chunk_scan(Frame& F, const bool dry = false) {
    const bf16* PTg = (const bf16*)(F.ws + WS_PT); const bf16* QTg = (const bf16*)(F.ws + WS_QT); const bf16* LTg = (const bf16*)(F.ws + WS_LT); float* ys = (float*)(F.ws + WS_YS2);
    const int qi = F.lane & 15, g = F.lane >> 4, w = F.wave & 3, ty = w & 1, vy0 = 2 * (w >> 1);
    constexpr int SRS = 144, SBUF = 64 * SRS;
    LAS unsigned char* SL = F.lds;
    for (int bh = F.vcu; bh < NBATCH * NH; bh += F.G) {
        const int b = bh >> 4, h = bh & 15;
        __syncthreads();
        if (F.wave >= 4) { __syncthreads();
            for (int ck = 0; ck < NCHK; ++ck) asm volatile("s_barrier" ::: "memory");
            continue; }
        unsigned z_ = 0u; asm volatile("" : "+v"(z_));
        for (int i = F.lane; i < 16 * 64 / 8; i += 64) *(LAS v4u*)(SL + (16 * w + (i >> 3)) * SRS + (i & 7) * 16) = (v4u){z_, z_, z_, z_};
        __syncthreads();
        v4u pa0[2], qa0[2], pa1[2], qa1[2], pa2[2], qa2[2], pa3[2], qa3[2]; v2u lt0[4], lt1[4], lt2[4], lt3[4]; float yl0[2][4], yl1[2][4], yl2[2][4], yl3[2][4];
#define CS_LOAD(pa, qa, lt, yl, ck_) do { const size_t cid = (size_t)bh * NCHK + (ck_); \
        _Pragma("unroll") for (int ks = 0; ks < 2; ++ks) { pa[ks] = *(const v4u*)(PTg + (cid * 64 + 16 * w + qi) * 64 + 32 * ks + 8 * g); qa[ks] = *(const v4u*)(QTg + (cid * SC + 16 * ty + qi) * 64 + 32 * ks + 8 * g); } \
        _Pragma("unroll") for (int nt = 0; nt < 4; ++nt) lt[nt] = *(const v2u*)(LTg + (((cid * 4 + nt) * 4 + w) * 64 + F.lane) * 4); \
        _Pragma("unroll") for (int i_ = 0; i_ < 2; ++i_) { _Pragma("unroll") for (int r = 0; r < 4; ++r) yl[i_][r] = ys[((size_t)b * SEQ + (ck_) * SC + 16 * ty + 4 * g + r) * D + h * HD + 16 * (vy0 + i_) + qi]; } } while (0)
#define CS_STEP(pa, qa, lt, yl, ck_) do { const LAS unsigned char* Sc = SL + ((ck_) & 1) * SBUF; LAS unsigned char* Sn = SL + (((ck_) + 1) & 1) * SBUF; \
        bf16x8 bfr[4][2]; \
        _Pragma("unroll") for (int nt = 0; nt < 4; ++nt) { _Pragma("unroll") for (int ks = 0; ks < 2; ++ks) bfr[nt][ks] = *(const LAS bf16x8*)(Sc + (16 * nt + qi) * SRS + 64 * ks + 16 * g); } \
        f32x4 y_[2]; \
        _Pragma("unroll") for (int i_ = 0; i_ < 2; ++i_) { y_[i_] = (f32x4){yl[i_][0], yl[i_][1], yl[i_][2], yl[i_][3]}; \
            _Pragma("unroll") for (int ks = 0; ks < 2; ++ks) { const bf16x8 by_ = *(const LAS bf16x8*)(Sc + (16 * (vy0 + i_) + qi) * SRS + 64 * ks + 16 * g);     \
                y_[i_] = __builtin_amdgcn_mfma_f32_16x16x32_bf16(__builtin_bit_cast(bf16x8, qa[ks]), by_, y_[i_], 0, 0, 0); } } \
        _Pragma("unroll") for (int nt = 0; nt < 4; ++nt) { f32x4 sn = {bflo(lt[nt].x), bfhi(lt[nt].x), bflo(lt[nt].y), bfhi(lt[nt].y)}; \
            _Pragma("unroll") for (int ks = 0; ks < 2; ++ks) sn = __builtin_amdgcn_mfma_f32_16x16x32_bf16(__builtin_bit_cast(bf16x8, pa[ks]), bfr[nt][ks], sn, 0, 0, 0); \
            *(LAS v2u*)(Sn + (16 * nt + qi) * SRS + (16 * w + 4 * g) * 2) = pack4(sn); } \
        __builtin_amdgcn_sched_barrier(0); \
        if ((ck_) + 4 < NCHK && !(DRYCUT == 7 && dry)) CS_LOAD(pa, qa, lt, yl, (ck_) + 4); \
        __builtin_amdgcn_sched_barrier(0);              \
        _Pragma("unroll") for (int i_ = 0; i_ < 2; ++i_) { _Pragma("unroll") for (int r = 0; r < 4; ++r) { if (!dry) ys[((size_t)b * SEQ + (ck_) * SC + 16 * ty + 4 * g + r) * D + h * HD + 16 * (vy0 + i_) + qi] = y_[i_][r]; } } \
        asm volatile("s_waitcnt lgkmcnt(0)\n\ts_barrier" ::: "memory");        \
        __builtin_amdgcn_sched_barrier(0); } while (0)
        CS_LOAD(pa0, qa0, lt0, yl0, 0); CS_LOAD(pa1, qa1, lt1, yl1, 1); CS_LOAD(pa2, qa2, lt2, yl2, 2); CS_LOAD(pa3, qa3, lt3, yl3, 3);
#pragma unroll 4
        for (int ck = 0; ck < NCHK; ck += 4) { CS_STEP(pa0, qa0, lt0, yl0, ck); CS_STEP(pa1, qa1, lt1, yl1, ck + 1); CS_STEP(pa2, qa2, lt2, yl2, ck + 2); CS_STEP(pa3, qa3, lt3, yl3, ck + 3); }
#undef CS_STEP
#undef CS_LOAD
    }
    __syncthreads();
}
__device__ __forceinline__ void post_phase(Frame& F, const bf16* vbuf, const float* k_a, const float* r_k, const float* gn_g, const float* gn_b) {
    const bf16* rb = (const bf16*)(F.ws + WS_R); const bf16* kb = (const bf16*)(F.ws + WS_KK); const bf16* ab = (const bf16*)(F.ws + WS_A); const bf16* gb = (const bf16*)(F.ws + WS_G);
    const float* ys = (const float*)(F.ws + WS_YS2); bf16* yg = (bf16*)(F.ws + WS_YG);
    for (int row = F.gw; row < T; row += F.NGW) {
#pragma unroll
        for (int j = 0; j < 4; ++j) { const size_t o = (size_t)row * D + 256 * j + 4 * F.lane; const int cc = 256 * j + 4 * F.lane;
            const f32x4 y = *(const f32x4*)(ys + o); const v2u wr_ = *(const v2u*)(rb + o), wk = *(const v2u*)(kb + o), wa = *(const v2u*)(ab + o), wv = *(const v2u*)(vbuf + o), wg = *(const v2u*)(gb + o);
            const f32x4 r4 = {bflo(wr_.x), bfhi(wr_.x), bflo(wr_.y), bfhi(wr_.y)}, k4 = {bflo(wk.x), bfhi(wk.x), bflo(wk.y), bfhi(wk.y)}, a4 = {bflo(wa.x), bfhi(wa.x), bflo(wa.y), bfhi(wa.y)};
            const f32x4 v4 = {bflo(wv.x), bfhi(wv.x), bflo(wv.y), bfhi(wv.y)}, g4 = {bflo(wg.x), bfhi(wg.x), bflo(wg.y), bfhi(wg.y)};
            const f32x4 kav = *(const f32x4*)(k_a + cc), rkv = *(const f32x4*)(r_k + cc), gg = *(const f32x4*)(gn_g + cc), gbv = *(const f32x4*)(gn_b + cc);
            const float mean = reduce16((y[0] + y[1]) + (y[2] + y[3])) * (1.0f / HD); const f32x4 dy = y - mean;
            const float var = reduce16((dy[0] * dy[0] + dy[1] * dy[1]) + (dy[2] * dy[2] + dy[3] * dy[3])) * (1.0f / HD); const float rstd = 1.0f / sqrtf(var + GN_EPS);
            const f32x4 kh = k4 * (1.0f + (a4 - 1.0f) * kav); const f32x4 pr = r4 * kh * rkv; const float rk = reduce16((pr[0] + pr[1]) + (pr[2] + pr[3]));
            const f32x4 res = (dy * rstd * gg + gbv + v4 * rk) * g4;
            v2u w; w.x = cvt_pk_bf16(res[0], res[1]); w.y = cvt_pk_bf16(res[2], res[3]); *(v2u*)(yg + o) = w; }
    }
}

__global__ void __launch_bounds__(NTHREADS, 2) fwd_kernel(Args args) {
    extern __shared__ __attribute__((aligned(16))) unsigned char lds_raw[];
    Frame F;
    F.lds = (LAS unsigned char*)lds_raw; F.ws = args.ws; F.out = args.out; F.ctl = (gu32*)(args.ws + WS_CTL);
    F.tid = 0; F.lane = 0; F.wave = __builtin_amdgcn_readfirstlane((int)threadIdx.x >> 6);
    F.G = gridDim.x; { const int bx = blockIdx.x; F.vcu = (F.G % 8 == 0) ? (bx % 8) * (F.G / 8) + bx / 8 : bx; }
    F.gw = F.vcu * NWAVES + F.wave; F.NGW = F.G * NWAVES;
    for (int i = threadIdx.x; i < (LDS_BYTES - MISC_OFF) / 4; i += NTHREADS) ((LAS unsigned*)(F.lds + MISC_OFF))[i] = 0u;
    __syncthreads();
    XcdBarrier bar = xcd_barrier_post((unsigned*)(F.ctl + CW_BAR), (volatile LAS unsigned*)(F.lds + MISC_OFF) + 8);
#define GRID_BAR() xcd_barrier(bar)
    if (threadIdx.x < 35) ((LAS unsigned long long*)(F.lds + PTAB_OFF))[threadIdx.x] = (unsigned long long)args.in[threadIdx.x];
    __syncthreads();
#define IN(k) in_ptr(F, (k))
    unsigned char* ws = args.ws;
    MoeTab MT; MT.cnt = (const LAS int*)(F.lds + TAB_OFF); MT.mtpref = MT.cnt + 65; MT.hoff = MT.mtpref + 66;

#if EN_P0
    { Frame P = phase_frame(F);
    ln_phase<2>(P, IN(0), nullptr, nullptr, false, MT);
    for (int j = 0; j < 2; ++j) {
        convert_plain(P, IN(1) + (size_t)j * D * 3 * D, D, 3 * D, (bf16*)(ws + WS_WQKV) + (size_t)j * 3 * D * D, 0);
        convert_plain(P, IN(2) + (size_t)j * D * D, D, D, (bf16*)(ws + WS_WOA) + (size_t)j * D * D, 0);
        for (int s = 0; s < 3; ++s) convert_plain(P, IN(5) + ((size_t)j * 3 + s) * D * D, D, D, (bf16*)(ws + WS_WRKV) + (size_t)j * 3 * D * D, s * D);
        convert_plain(P, IN(22) + (size_t)j * D * D, D, D, (bf16*)(ws + WS_WOB) + (size_t)j * D * D, 0);
        bf16* L1 = (bf16*)(ws + WS_L1) + (size_t)j * 4 * 256 * D; bf16* L2 = (bf16*)(ws + WS_L2) + (size_t)j * 4 * D * 256;
        convert_small(P, IN(7) + (size_t)j * D * 64, D, 64, L1, 256, D);
        convert_small(P, IN(10) + (size_t)j * D * 64, D, 64, L1 + 256 * D, 256, D);
        convert_small(P, IN(15) + (size_t)j * D * 160, D, 160, L1 + 2 * 256 * D, 256, D);
        convert_small(P, IN(8) + (size_t)j * 64 * D, 64, D, L2, D, 256);
        convert_small(P, IN(11) + (size_t)j * 64 * D, 64, D, L2 + D * 256, D, 256);
        convert_small(P, IN(16) + (size_t)j * 160 * D, 160, D, L2 + 2 * D * 256, D, 256);
        if (j == 1) { convert_small(P, IN(13), D, 32, L1 + 3 * 256 * D, 256, D); convert_small(P, IN(14), 32, D, L2 + 3 * D * 256, D, 256); }
    }
    for (int i = 0; i < DEPTH; ++i) convert_small(P, IN(23) + (size_t)i * D * NE, D, NE, (bf16*)(ws + WS_WR) + (size_t)i * 256 * D, 256, D);
    }
#endif
    GRID_BAR();

#define PH_BEGIN { Frame P = phase_frame(F);
#define PH_END } GRID_BAR();
    for (int i = 0; i < DEPTH; ++i) {
        const int j = i >> 1;
        if ((i & 1) == 0) {
            PH_BEGIN
#if EN_QKV
              SchedDense S{T / 256, 12, P.G, (int)blockIdx.x, D, (const char*)(ws + WS_XB), (const char*)(ws + WS_WQKV) + (size_t)j * 3 * D * D * 2};
              EpiQKV E{(bf16*)(ws + WS_Q), (bf16*)(ws + WS_K), (bf16*)(ws + WS_VT)};
              for (int rep = 0; rep < REP_QKV; ++rep) pg8::gemm_phase<D>(P.lds, P.tid, S, E);
#endif
            PH_END
            PH_BEGIN
#if EN_KMEAN
            kmean_phase(P);
#endif
            PH_END
            PH_BEGIN
#if EN_SEL
            sel_phase(P);
#endif
            PH_END
#if REP_ATTN > 1
            PH_BEGIN
            attn_phase<ATTN_PROBE>(P, IN(3));
            PH_END
#endif
            PH_BEGIN
#if EN_ATTN
            attn_phase<0>(P, IN(3));
#endif
            PH_END
            PH_BEGIN
#if EN_OPA
              SchedDense S{T / 256, 4, P.G, (int)blockIdx.x, D, (const char*)(ws + WS_O), (const char*)(ws + WS_WOA) + (size_t)j * D * D * 2};
              EpiAdd E{P.out};
              pg8::gemm_phase<D>(P.lds, P.tid, S, E);
#endif
            PH_END
        } else {
            const size_t voff = (j == 0 ? WS_VF : WS_V);
            PH_BEGIN
#if EN_MIX
            for (int rep = 0; rep < REP_MIX; ++rep) mix_phase(P, IN(4) + (size_t)j * 6 * D);
#endif
            PH_END
            PH_BEGIN
#if EN_RKV
              SchedRkv S{T / 256, j == 0 ? 15 : 16, P.G, (int)blockIdx.x, (const char*)(ws + WS_XMIX), (const char*)(ws + WS_WRKV) + (size_t)j * 3 * D * D * 2, (const char*)(ws + WS_L1) + (size_t)j * 4 * 256 * D * 2};
              EpiRkv E{ws, voff};
              pg8::gemm_phase<D>(P.lds, P.tid, S, E);
#endif
            PH_END
            PH_BEGIN
#if EN_L2
              SchedL2 S{T / 256, j == 0 ? 12 : 16, P.G, (int)blockIdx.x, (const char*)(ws + WS_HL), (const char*)(ws + WS_L2) + (size_t)j * 4 * D * 256 * 2};
              EpiL2 E{(float*)(ws + WS_LW), (bf16*)(ws + WS_A), (bf16*)(ws + WS_G), (bf16*)(ws + voff), (const bf16*)(ws + WS_VF), IN(6) + j * D, IN(9) + j * D, IN(12)};
              pg8::gemm_phase<256>(P.lds, P.tid, S, E);
#endif
            PH_END
            PH_BEGIN
#if EN_SCAN
            for (int rep = 0; rep < REP_SCAN; ++rep) chunk_prep(P, (const bf16*)(ws + voff), IN(17) + j * D, IN(18) + j * D, rep + 1 < REP_SCAN);
#endif
            PH_END
            PH_BEGIN
#if EN_SCANB
            for (int rep = 0; rep < REP_SCANB; ++rep) chunk_scan(P, rep + 1 < REP_SCANB);
#endif
            PH_END
            PH_BEGIN
#if EN_POST
#ifdef DBG_POST_COPY
            { const v4u* s_ = (const v4u*)(ws + WS_A); v4u* d_ = (v4u*)(ws + WS_YG); for (size_t q = (size_t)P.gw * 64 + P.lane; q < (size_t)T * D / 8; q += (size_t)P.NGW * 64) d_[q] = s_[q]; }
#else
            post_phase(P, (const bf16*)(ws + voff), IN(18) + j * D, IN(19) + j * D, IN(20) + j * D, IN(21) + j * D);
#endif
#endif
            PH_END
            PH_BEGIN
#if EN_OPB
              SchedDense S{T / 256, 4, P.G, (int)blockIdx.x, D, (const char*)(ws + WS_YG), (const char*)(ws + WS_WOB) + (size_t)j * D * D * 2};
              EpiAdd E{P.out};
              pg8::gemm_phase<D>(P.lds, P.tid, S, E);
#endif
            PH_END
        }
        PH_BEGIN
#if EN_LN1
        ln1_route_phase(P, IN(31) + i * D, IN(32) + i * D, i, IN(24) + i * NE);
#endif
#if EN_CVT
        for (int rep = 0; rep < REP_CVT; ++rep) convert_moe(P, IN(25) + (size_t)i * NE * D * DE, IN(26) + (size_t)i * NE * D * DE, IN(27) + (size_t)i * NE * DE * D, IN(28) + (size_t)i * D * DE, IN(29) + (size_t)i * D * DE, IN(30) + (size_t)i * DE * D);
#endif
        PH_END
        PH_BEGIN
        moe_tables(P, i);
#if EN_G1
          SchedMoe1 S{P.G, P.vcu, MT, (const char*)(ws + WS_XB), (const char*)(ws + WS_WGU), (const int*)(ws + WS_TOKLIST), 0};
          _Pragma("nounroll") for (int rep = 0; rep < REP_G1; ++rep) { EpiSwiglu E{(bf16*)(ws + WS_H), rep + 1 < REP_G1}; pg8::gemm_phase<D>(P.lds, P.tid, S, E); }
#endif
        PH_END
        PH_BEGIN
#if EN_G2
          SchedMoe2 S{P.G, P.vcu, MT, (const char*)(ws + WS_H), (const char*)(ws + WS_WD), 0};
          _Pragma("nounroll") for (int rep = 0; rep < REP_G2; ++rep) { EpiMoeDown E{(bf16*)(ws + WS_Y), P.out, rep + 1 < REP_G2}; pg8::gemm_phase<DE>(P.lds, P.tid, S, E); }
#endif
        PH_END
        { Frame P = phase_frame(F);
#if EN_LN2
        ln_phase<1>(P, P.out, IN(33) + i * D, IN(34) + i * D, i == DEPTH - 1, MT);
#endif
        }
        if (i + 1 < DEPTH) GRID_BAR();
    }
#undef IN
#undef GRID_BAR
}

extern "C" void kernel_launch(void* const* d_in, const int* in_sizes, int n_in, void* d_out, int out_size, void* d_ws, size_t ws_size, hipStream_t stream) {
    static int grid = 0;
    if (grid == 0) {
        if (n_in != 35 || out_size != T * D || ws_size < WS_END) { fprintf(stderr, "kernel_launch: unexpected shapes (n_in %d, out %d, ws %zu)\n", n_in, out_size, ws_size); grid = -1; return; }
        int dev = 0, cus = 0, per_cu = 0;
        if (hipGetDevice(&dev) != hipSuccess || hipDeviceGetAttribute(&cus, hipDeviceAttributeMultiprocessorCount, dev) != hipSuccess) { grid = -1; return; }
        if (hipFuncSetAttribute((const void*)fwd_kernel, hipFuncAttributeMaxDynamicSharedMemorySize, LDS_BYTES) != hipSuccess) { fprintf(stderr, "kernel_launch: hipFuncSetAttribute failed\n"); grid = -1; return; }
        if (hipOccupancyMaxActiveBlocksPerMultiprocessor(&per_cu, (const void*)fwd_kernel, NTHREADS, LDS_BYTES) != hipSuccess || per_cu < 1) { fprintf(stderr, "kernel_launch: occupancy query says %d\n", per_cu); }
        (void)hipGetLastError();
        grid = cus;
    }
    if (grid < 0) return;
    if (hipMemsetAsync((char*)d_ws + WS_CTL, 0, CTL_ZERO_BYTES, stream) != hipSuccess) return;
    Args a{};
    for (int i = 0; i < 35; ++i) a.in[i] = (const float*)d_in[i];
    a.out = (float*)d_out; a.ws = (unsigned char*)d_ws;
    hipLaunchKernelGGL(fwd_kernel, dim3(grid), dim3(NTHREADS), LDS_BYTES, stream, a);
}
```

```cpp
#include <hip/hip_runtime.h>
#include <cstdio>
#include <cstdint>

#define GAS __attribute__((address_space(1)))
#define LAS __attribute__((address_space(3)))
typedef unsigned short bf16;
typedef unsigned v4u __attribute__((ext_vector_type(4)));
typedef unsigned v2u __attribute__((ext_vector_type(2)));
typedef float f32x4 __attribute__((ext_vector_type(4)));
typedef float f32x2 __attribute__((ext_vector_type(2)));
typedef short bf16x8 __attribute__((ext_vector_type(8)));
typedef short bf16x4 __attribute__((ext_vector_type(4)));

#ifndef EN_DEFAULT
#define EN_DEFAULT 1
#endif
#ifndef REP_SCAN
#define REP_SCAN 1
#endif
#ifndef EN_SCANB
#define EN_SCANB EN_DEFAULT
#endif
#ifndef DRYCUT
#define DRYCUT 0
#endif
#ifndef REP_SCANB
#define REP_SCANB 1
#endif
#ifndef REP_ATTN
#define REP_ATTN 1
#endif
#ifndef ATTN_PROBE
#define ATTN_PROBE 1
#endif
#ifndef REP_G1
#define REP_G1 1
#endif
#ifndef REP_G2
#define REP_G2 1
#endif
#ifndef REP_CVT
#define REP_CVT 1
#endif
#ifndef REP_MIX
#define REP_MIX 1
#endif
#ifndef REP_QKV
#define REP_QKV 1
#endif
#ifndef EN_P0
#define EN_P0 EN_DEFAULT
#endif
#ifndef EN_QKV
#define EN_QKV EN_DEFAULT
#endif
#ifndef EN_KMEAN
#define EN_KMEAN EN_DEFAULT
#endif
#ifndef EN_SEL
#define EN_SEL EN_DEFAULT
#endif
#ifndef EN_ATTN
#define EN_ATTN EN_DEFAULT
#endif
#ifndef EN_OPA
#define EN_OPA EN_DEFAULT
#endif
#ifndef EN_MIX
#define EN_MIX EN_DEFAULT
#endif
#ifndef EN_RKV
#define EN_RKV EN_DEFAULT
#endif
#ifndef EN_L2
#define EN_L2 EN_DEFAULT
#endif
#ifndef EN_SCAN
#define EN_SCAN EN_DEFAULT
#endif
#ifndef EN_POST
#define EN_POST EN_DEFAULT
#endif
#ifndef EN_OPB
#define EN_OPB EN_DEFAULT
#endif
#ifndef EN_LN1
#define EN_LN1 EN_DEFAULT
#endif
#ifndef EN_CVT
#define EN_CVT EN_DEFAULT
#endif
#ifndef EN_ROUTER
#define EN_ROUTER EN_DEFAULT
#endif
#ifndef EN_ROUTE
#define EN_ROUTE EN_DEFAULT
#endif
#ifndef EN_G1
#define EN_G1 EN_DEFAULT
#endif
#ifndef EN_G2
#define EN_G2 EN_DEFAULT
#endif
#ifndef EN_LN2
#define EN_LN2 EN_DEFAULT
#endif
constexpr int D = 1024, NBATCH = 8, SEQ = 4096, T = NBATCH * SEQ, NH = 16, HD = 64, DEPTH = 4;
constexpr int NE = 64, TOPK = 8, DE = 256, NEX = NE + 1;
constexpr int MBLK = 256, NMB = SEQ / MBLK;
constexpr float ALPHA = 1.6817928305074290f;
constexpr float LN_EPS = 1e-5f, GN_EPS = 64e-5f;
constexpr int NWAVES = 8, NTHREADS = 512;

constexpr size_t MiB = 1u << 20;
constexpr size_t WS_CTL = 0, CTL_ZERO_BYTES = 1 * MiB;
constexpr size_t WS_WR = 1 * MiB;
constexpr size_t WS_KMEAN = 3 * MiB;
constexpr size_t WS_MASK = 4 * MiB;
constexpr size_t WS_TSEL = 5 * MiB;
constexpr size_t WS_WQKV = 8 * MiB;
constexpr size_t WS_WOA = 20 * MiB;
constexpr size_t WS_WRKV = 24 * MiB;
constexpr size_t WS_WOB = 36 * MiB;
constexpr size_t WS_L1 = 40 * MiB;
constexpr size_t WS_L2 = 44 * MiB;
constexpr size_t WS_WGU = 48 * MiB;
constexpr size_t WS_WD = 113 * MiB;
constexpr size_t WS_XB = 146 * MiB;
constexpr size_t WS_VF = 210 * MiB;
constexpr size_t WS_S = 274 * MiB;
constexpr size_t WS_LOGITS = WS_S;
constexpr size_t WS_TOKLIST = WS_S + 8 * MiB;
constexpr size_t WS_H = WS_S + 16 * MiB;
constexpr size_t WS_Y = WS_S + 168 * MiB;
constexpr size_t WS_Q = WS_S, WS_K = WS_S + 64 * MiB, WS_VT = WS_S + 128 * MiB, WS_O = WS_S + 192 * MiB;
constexpr size_t WS_XMIX = WS_S;
constexpr size_t WS_R = WS_S + 384 * MiB, WS_KK = WS_S + 448 * MiB, WS_V = WS_S + 512 * MiB;
constexpr size_t WS_HL = WS_S + 576 * MiB;
constexpr size_t WS_LW = WS_S;
constexpr size_t WS_A = WS_S + 128 * MiB, WS_G = WS_S + 192 * MiB;
constexpr size_t WS_YS = WS_S + 256 * MiB;
constexpr size_t WS_YG = WS_S + 640 * MiB;
constexpr size_t WS_END = 1024 * MiB;
static_assert(WS_Y + (size_t)278528 * 2048 <= WS_END && WS_YG + 64 * MiB <= WS_END, "d_ws map");

constexpr int CW_TMO = 0;
constexpr int CW_BAR = 4096;
constexpr int CW_CNT = 8192;

constexpr int RING_BYTES = 131072;
constexpr int MISC_OFF = RING_BYTES;
constexpr int TAB_OFF = MISC_OFF + 256;
constexpr int PTAB_OFF = MISC_OFF + 2048;
constexpr int LDS_BYTES = 147456;

#define RLX_AGENT __ATOMIC_RELAXED, __HIP_MEMORY_SCOPE_AGENT
#define LDS_WAIT() asm volatile("s_waitcnt lgkmcnt(0)" ::: "memory")
#define VM_WAIT() asm volatile("s_waitcnt vmcnt(0)" ::: "memory")
typedef float f32x2_t_ __attribute__((ext_vector_type(2))); typedef __bf16 bf16x2_t_ __attribute__((ext_vector_type(2)));
__device__ __forceinline__ unsigned cvt_pk_bf16(float lo, float hi) { const f32x2_t_ v = {lo, hi}; const bf16x2_t_ b = __builtin_convertvector(v, bf16x2_t_); return __builtin_bit_cast(unsigned, b); }
__device__ __forceinline__ float bflo(unsigned w) { return __uint_as_float(w << 16); }
__device__ __forceinline__ float bfhi(unsigned w) { return __uint_as_float(w & 0xffff0000u); }
__device__ __forceinline__ float bf1(bf16 b) { return __uint_as_float(((unsigned)b) << 16); }
__device__ __forceinline__ float fast_exp(float x) { return __builtin_amdgcn_exp2f(x * 1.4426950408889634f); }
__device__ __forceinline__ float fast_rcp(float x) { return __builtin_amdgcn_rcpf(x); }
__device__ __forceinline__ float sigmoidf_(float x) { return fast_rcp(1.0f + fast_exp(-x)); }
template <int CTRL> __device__ __forceinline__ float dpp_add(float v) {
    const int t = __builtin_amdgcn_update_dpp(0, __float_as_int(v), CTRL, 0xf, 0xf, true);
    return v + __int_as_float(t);
}
template <int CTRL> __device__ __forceinline__ float dpp_max(float v) {
    const int t = __builtin_amdgcn_update_dpp(__float_as_int(v), __float_as_int(v), CTRL, 0xf, 0xf, false);
    return __builtin_fmaxf(v, __int_as_float(t));
}
__device__ __forceinline__ float reduce16(float v) {
    v = dpp_add<0xB1>(v); v = dpp_add<0x4E>(v); v = dpp_add<0x141>(v); v = dpp_add<0x140>(v);
    return v;
}
__device__ __forceinline__ float max8(float v) { v = dpp_max<0xB1>(v); v = dpp_max<0x4E>(v); v = dpp_max<0x141>(v); return v; }
__device__ __forceinline__ float q4_max(float v) {
    auto a = __builtin_amdgcn_permlane16_swap(__float_as_uint(v), __float_as_uint(v), false, false); v = __builtin_fmaxf(__uint_as_float(a[0]), __uint_as_float(a[1]));
    auto b = __builtin_amdgcn_permlane32_swap(__float_as_uint(v), __float_as_uint(v), false, false); return __builtin_fmaxf(__uint_as_float(b[0]), __uint_as_float(b[1])); }
__device__ __forceinline__ float q4_sum(float v) {
    auto a = __builtin_amdgcn_permlane16_swap(__float_as_uint(v), __float_as_uint(v), false, false); v = __uint_as_float(a[0]) + __uint_as_float(a[1]);
    auto b = __builtin_amdgcn_permlane32_swap(__float_as_uint(v), __float_as_uint(v), false, false); return __uint_as_float(b[0]) + __uint_as_float(b[1]); }
__device__ __forceinline__ float wave_sum(float v) { return q4_sum(reduce16(v)); }
__device__ __forceinline__ float wave_max(float v) { return q4_max(dpp_max<0x140>(max8(v))); }
__device__ const unsigned char T5_BUCKET[129] = {
    0, 1, 2, 3, 4, 5, 6, 7, 8, 9, 10, 11, 12, 13, 14, 15, 16, 16, 16, 17, 17, 18, 18, 18, 19, 19, 19, 20, 20, 20, 20, 21, 21, 21, 21, 22, 22, 22, 22, 22, 23, 23, 23, 23, 23, 23, 24, 24, 24,
    24, 24, 24, 25, 25, 25, 25, 25, 25, 25, 26, 26, 26, 26, 26, 26, 26, 26, 27, 27, 27, 27, 27, 27, 27, 27, 27, 27, 28, 28, 28, 28, 28, 28, 28, 28, 28, 28, 29, 29, 29, 29, 29, 29, 29, 29, 29, 29,
    29, 29, 30, 30, 30, 30, 30, 30, 30, 30, 30, 30, 30, 30, 30, 30, 31, 31, 31, 31, 31, 31, 31, 31, 31, 31, 31, 31, 31, 31, 31, 31};

namespace pg8 {
constexpr int BM = 256, BK = 64, HALF = 128, HTB = HALF * BK * 2, STAGE_BYTES = 8 * HTB, NXCD = 8, WGM = 8;
__host__ __device__ __forceinline__ int lds_byte(int r, int c) { const int st = (r >> 4) * 2 + (c >> 5), rr = r & 15, cc = c & 31, ob = rr * 64 + cc * 2; return st * 1024 + (ob ^ (((ob >> 9) & 1) << 5)); }
__host__ __device__ __forceinline__ void stage_rc(int b, int& R, int& C) { const int st = b / 1024, sb = b % 1024, swz = sb ^ (((sb >> 9) & 1) << 5); R = (st >> 1) * 16 + swz / 64; C = (st & 1) * 32 + (swz % 64) / 2; }
__host__ __device__ __forceinline__ int perm32(int rho) { const int n = rho >> 4, i = rho & 15; return 8 * (i >> 2) + 4 * n + (i & 3); }

struct Unit { int pm, pn, e, nvalid, arow0, orow0; const int* gidx; };

__device__ __forceinline__ bool static_tile(int i, int G, int c, int nM, int nN, int& pm, int& pn) {
    const int nwg = nM * nN; const long L = (long)i * G + c; if (L >= nwg) return false;
    int wgid = (int)L;
    if (((nwg | nM) & 7) == 0) {
        wgid = (wgid & 7) * (nwg >> 3) + (wgid >> 3); const int nig = WGM * nN, gid = wgid / nig, r = wgid - gid * nig; pm = gid * WGM + (r & 7); pn = r >> 3; return true; }
    { const int q = nwg / NXCD, r = nwg % NXCD, xcd = wgid % NXCD, off = wgid / NXCD; wgid = (xcd < r ? xcd * (q + 1) : r * (q + 1) + (xcd - r) * q) + off; }
    const int nig = WGM * nN, gid = wgid / nig, fm = gid * WGM, gsz = (nM - fm) < WGM ? (nM - fm) : WGM;
    pm = fm + ((wgid % nig) % gsz); pn = (wgid % nig) / gsz; return true;
}

template <int K, class Epi, class Sched>
__device__ __forceinline__ void gemm_phase(LAS unsigned char* lds, const int tid, const Sched& S, const Epi& E) {
    constexpr bool GA = Sched::GATHER;
    const int wid = __builtin_amdgcn_readfirstlane(tid >> 6), lane = tid & 63, wr = wid >> 2, wc = wid & 3, fr = lane & 15, fq = lane >> 4;
    constexpr int nt = K / BK;
    unsigned voffA[2], voffB[2];
#pragma unroll
    for (int i = 0; i < 2; ++i) { int R, C; stage_rc(tid * 16 + i * 8192, R, C); const int Rb = Epi::PERM ? ((R & ~31) + perm32(R & 31)) : R;
        voffA[i] = (unsigned)(R * K + C) * 2u; voffB[i] = (unsigned)(Rb * K + C) * 2u; }
    const size_t kstep = (size_t)(BK * 2);
    const size_t hstep = (size_t)HALF * K * 2;
    const unsigned rowb = (unsigned)K * 2u;
    const unsigned ldsw = (unsigned)wid * 1024u;
    const int aoff = lds_byte(wr * 64 + fr, fq * 8), boff = lds_byte(wc * 32 + fr, fq * 8);
#define PG8_SA(b, h) (((b) * 2 + (h)) * HTB)
#define PG8_SB(b, h) ((4 + (b) * 2 + (h)) * HTB)
#define PG8_STAGE(bufoff, gbase, voff) do { _Pragma("unroll") for (int _i = 0; _i < 2; ++_i) \
        __builtin_amdgcn_global_load_lds((const unsigned*)((const char*)(gbase) + (voff)[_i]), (LAS unsigned*)(lds + (bufoff) + ldsw + _i * 8192), 16, 0, 0); } while (0)
#define PG8_STAGE_A(bufoff, p, h, O) do { if constexpr (GA) { PG8_STAGE(bufoff, p, O[h]); } else { PG8_STAGE(bufoff, (p) + (h) * hstep, voffA); } } while (0)
#define PG8_LDA(dst, b, h) do { _Pragma("unroll") for (int m = 0; m < 4; ++m) _Pragma("unroll") for (int k = 0; k < 2; ++k) dst[m][k] = *(const LAS bf16x8*)(lds + PG8_SA(b, h) + aoff + m * 2048 + k * 1024); } while (0)
#define PG8_LDB(dst, b, h) do { _Pragma("unroll") for (int n = 0; n < 2; ++n) _Pragma("unroll") for (int k = 0; k < 2; ++k) dst[n][k] = *(const LAS bf16x8*)(lds + PG8_SB(b, h) + boff + n * 2048 + k * 1024); } while (0)
#define PG8_MMA(ai, bj, At, Bt) do { __builtin_amdgcn_s_setprio(1); _Pragma("unroll") for (int m = 0; m < 4; ++m) _Pragma("unroll") for (int n = 0; n < 2; ++n) _Pragma("unroll") for (int k = 0; k < 2; ++k) \
        acc[ai][bj][m][n] = __builtin_amdgcn_mfma_f32_16x16x32_bf16(Bt[n][k], At[m][k], acc[ai][bj][m][n], 0, 0, 0); __builtin_amdgcn_s_setprio(0); } while (0)
#define PG8_WAIT_V(n) asm volatile("s_waitcnt vmcnt(" #n ")" ::: "memory")
#define PG8_WAIT_L(n) asm volatile("s_waitcnt lgkmcnt(" #n ")" ::: "memory")
#define PG8_BAR __builtin_amdgcn_s_barrier()
#define PG8_SCHED __builtin_amdgcn_sched_barrier(0)
#define PG8_OFFS(u, o) do { if constexpr (GA) { _Pragma("unroll") for (int _h = 0; _h < 2; ++_h) _Pragma("unroll") for (int _i = 0; _i < 2; ++_i) { int R_, C_; stage_rc(tid * 16 + _i * 8192, R_, C_); \
        o[_h][_i] = (unsigned)S.a_row(u, _h * HALF + R_) * rowb + (unsigned)C_ * 2u; } } } while (0)
#define PG8_TRIP(a1, a2, b2, O1, O2) do { const char* a3 = (a2) + kstep; const char* b3 = (b2) + kstep; \
            PG8_LDB(B0, 0, 0); PG8_LDB(B1, 0, 1); PG8_SCHED; PG8_LDA(At, 0, 0); PG8_STAGE_A(PG8_SA(1, 1), a1, 1, O1); \
            PG8_WAIT_V(8); PG8_WAIT_L(0); PG8_BAR; PG8_MMA(0, 0, At, B0); PG8_MMA(0, 1, At, B1); PG8_BAR; PG8_SCHED; \
            PG8_LDA(At, 0, 1); PG8_STAGE(PG8_SB(0, 0), b2, voffB); PG8_STAGE(PG8_SB(0, 1), (b2) + hstep, voffB); PG8_STAGE_A(PG8_SA(0, 0), a2, 0, O2); \
            PG8_WAIT_V(8); PG8_WAIT_L(0); PG8_BAR; PG8_MMA(1, 0, At, B0); PG8_MMA(1, 1, At, B1); PG8_BAR; PG8_SCHED; \
            PG8_LDB(B0, 1, 0); PG8_LDB(B1, 1, 1); PG8_SCHED; PG8_LDA(At, 1, 0); PG8_STAGE_A(PG8_SA(0, 1), a2, 1, O2); \
            PG8_WAIT_V(8); PG8_WAIT_L(0); PG8_BAR; PG8_MMA(0, 0, At, B0); PG8_MMA(0, 1, At, B1); PG8_BAR; PG8_SCHED; \
            PG8_LDA(At, 1, 1); PG8_STAGE(PG8_SB(1, 0), b3, voffB); PG8_STAGE(PG8_SB(1, 1), b3 + hstep, voffB); PG8_STAGE_A(PG8_SA(1, 0), a3, 0, O2); \
            PG8_WAIT_V(8); PG8_WAIT_L(0); PG8_BAR; PG8_MMA(1, 0, At, B0); PG8_MMA(1, 1, At, B1); PG8_BAR; PG8_SCHED; } while (0)
    Unit cur, nxt; int ui = 0;
    if (!S.next(0, cur)) return;
    f32x4 acc[2][2][4][2];
#pragma unroll
    for (int a = 0; a < 2; ++a)
#pragma unroll
        for (int b = 0; b < 2; ++b)
#pragma unroll
            for (int m = 0; m < 4; ++m)
#pragma unroll
                for (int n = 0; n < 2; ++n) acc[a][b][m][n] = (f32x4){0.f, 0.f, 0.f, 0.f};
    bf16x8 At[4][2], B0[2][2], B1[2][2];
    unsigned cOff[2][2], nOff[2][2];
    PG8_OFFS(cur, cOff);
    const char* cA = S.a_tile(cur); const char* cB = S.b_tile(cur);
    PG8_STAGE(PG8_SB(0, 0), cB, voffB); PG8_STAGE(PG8_SB(0, 1), cB + hstep, voffB); PG8_STAGE_A(PG8_SA(0, 0), cA, 0, cOff); PG8_STAGE_A(PG8_SA(0, 1), cA, 1, cOff);
    if (wr == 1) PG8_BAR;
    PG8_WAIT_V(2); PG8_BAR;
    PG8_STAGE(PG8_SB(1, 0), cB + kstep, voffB); PG8_STAGE_A(PG8_SA(1, 0), cA + kstep, 0, cOff); PG8_STAGE(PG8_SB(1, 1), cB + hstep + kstep, voffB);
    PG8_WAIT_V(6); PG8_BAR;
    for (;;) {
        const bool has_next = S.next(ui + 1, nxt);
        const char* nA = cA; const char* nB = cB;
        if constexpr (GA) {
#pragma unroll
            for (int h = 0; h < 2; ++h)
#pragma unroll
                for (int i = 0; i < 2; ++i) nOff[h][i] = cOff[h][i]; }
        if (has_next) { PG8_OFFS(nxt, nOff); nA = S.a_tile(nxt); nB = S.b_tile(nxt); }
_Pragma("nounroll")
        for (int t = 0; t < nt; t += 2) { const bool last = (t == nt - 2);
            const char* a2 = last ? nA : cA + (size_t)(t + 2) * kstep; const char* b2 = last ? nB : cB + (size_t)(t + 2) * kstep;
            if constexpr (GA) { unsigned o2[2][2];
#pragma unroll
                for (int h = 0; h < 2; ++h)
#pragma unroll
                    for (int i = 0; i < 2; ++i) o2[h][i] = last ? nOff[h][i] : cOff[h][i];
                PG8_TRIP(cA + (size_t)(t + 1) * kstep, a2, b2, cOff, o2);
            } else { PG8_TRIP(cA + (size_t)(t + 1) * kstep, a2, b2, cOff, cOff); } }
        if (wr == 0) PG8_BAR;
        PG8_SCHED; E(acc, cur, wr, wc, fr, fq); PG8_SCHED;
        if (!has_next) break;
#pragma unroll
        for (int a = 0; a < 2; ++a)
#pragma unroll
            for (int b = 0; b < 2; ++b)
#pragma unroll
                for (int m = 0; m < 4; ++m)
#pragma unroll
                    for (int n = 0; n < 2; ++n) acc[a][b][m][n] = (f32x4){0.f, 0.f, 0.f, 0.f};
        cur = nxt; cA = nA; cB = nB; ++ui;
        if constexpr (GA) {
#pragma unroll
            for (int h = 0; h < 2; ++h)
#pragma unroll
                for (int i = 0; i < 2; ++i) cOff[h][i] = nOff[h][i]; }
        if (wr == 1) PG8_BAR;
    }
    PG8_WAIT_V(0);
    PG8_BAR;
#undef PG8_SA
#undef PG8_SB
#undef PG8_STAGE
#undef PG8_STAGE_A
#undef PG8_LDA
#undef PG8_LDB
#undef PG8_MMA
#undef PG8_WAIT_V
#undef PG8_WAIT_L
#undef PG8_BAR
#undef PG8_SCHED
#undef PG8_OFFS
#undef PG8_TRIP
}
}
using pg8::Unit;
typedef f32x4 AccT[2][2][4][2];

struct SchedDense {
    int nM, nN, G, c, K; const char* A; const char* Bt;
    __device__ __forceinline__ bool next(int i, Unit& u) const { int pm, pn; if (!pg8::static_tile(i, G, c, nM, nN, pm, pn)) return false;
        u.pm = pm; u.pn = pn; u.e = 0; u.nvalid = 256; u.arow0 = pm * 256; u.orow0 = pm * 256; u.gidx = nullptr; return true; }
    static constexpr bool GATHER = false;
    __device__ __forceinline__ const char* a_tile(const Unit& u) const { return A + (size_t)u.arow0 * K * 2; }
    __device__ __forceinline__ const char* b_tile(const Unit& u) const { return Bt + (size_t)u.pn * 256 * K * 2; }
    __device__ __forceinline__ int a_row(const Unit& u, int r) const { return u.arow0 + r; }
};
struct SchedRkv {
    int nM, nN, G, c; const char* xmix; const char* Wrkv; const char* L1;
    __device__ __forceinline__ bool next(int i, Unit& u) const { int pm, pn; if (!pg8::static_tile(i, G, c, nM, nN, pm, pn)) return false;
        u.pm = pm; u.pn = pn; u.e = 0; u.nvalid = 256; u.arow0 = pm * 256; u.orow0 = pm * 256; u.gidx = nullptr; return true; }
    static constexpr bool GATHER = false;
    __device__ __forceinline__ const char* a_tile(const Unit& u) const { const int grp = u.pn < 12 ? (u.pn >> 2) : (u.pn == 15 ? 2 : u.pn - 9); return xmix + ((size_t)grp * T + u.arow0) * D * 2; }
    __device__ __forceinline__ const char* b_tile(const Unit& u) const { return u.pn < 12 ? Wrkv + (size_t)u.pn * 256 * D * 2 : L1 + (size_t)(u.pn - 12) * 256 * D * 2; }
    __device__ __forceinline__ int a_row(const Unit& u, int r) const { return u.arow0 + r; }
};
struct SchedL2 {
    int nM, nN, G, c; const char* hl; const char* L2;
    __device__ __forceinline__ bool next(int i, Unit& u) const { int pm, pn; if (!pg8::static_tile(i, G, c, nM, nN, pm, pn)) return false;
        u.pm = pm; u.pn = pn & 3; u.e = pn >> 2; u.nvalid = 256; u.arow0 = pm * 256; u.orow0 = pm * 256; u.gidx = nullptr; return true; }
    static constexpr bool GATHER = false;
    __device__ __forceinline__ const char* a_tile(const Unit& u) const { return hl + ((size_t)u.e * T + u.arow0) * 256 * 2; }
    __device__ __forceinline__ const char* b_tile(const Unit& u) const { return L2 + ((size_t)u.e * 1024 + (size_t)u.pn * 256) * 256 * 2; }
    __device__ __forceinline__ int a_row(const Unit& u, int r) const { return u.arow0 + r; }
};
struct MoeTab { const LAS int* cnt; const LAS int* mtpref; const LAS int* hoff; };
__device__ __forceinline__ int moe_find_expert(const MoeTab& M, int m, int& hint) { int e = hint;
_Pragma("nounroll")
    while (e + 1 < NEX && M.mtpref[e + 1] <= m) ++e;
    e = __builtin_amdgcn_readfirstlane(e); hint = e; return e; }
struct SchedMoe1 {
    int G, c; MoeTab M; const char* xb; const char* Wgu; const int* toklist; mutable int eh;
    __device__ __forceinline__ bool next(int i, Unit& u) const { const long L = (long)i * G + c; const int nun = M.mtpref[NEX] * 2; if (L >= nun) return false;
        const int m = (int)(L >> 1), e = moe_find_expert(M, m, eh), mt = m - M.mtpref[e];
        u.pm = mt; u.pn = (int)(L & 1); u.e = e; u.arow0 = mt * 256; u.orow0 = M.hoff[e] + mt * 256;
        if (e < NE) { const int left = M.cnt[e] - mt * 256; u.nvalid = left < 256 ? left : 256; u.gidx = toklist + (size_t)e * T + mt * 256; } else { u.nvalid = 256; u.gidx = nullptr; }
        return true; }
    static constexpr bool GATHER = true;
    __device__ __forceinline__ const char* a_tile(const Unit&) const { return xb; }
    __device__ __forceinline__ const char* b_tile(const Unit& u) const { return Wgu + ((size_t)u.e * 512 + (size_t)u.pn * 256) * D * 2; }
    __device__ __forceinline__ int a_row(const Unit& u, int r) const { if (u.gidx) return r < u.nvalid ? u.gidx[r] : 0; return u.arow0 + r; }
};
struct SchedMoe2 {
    int G, c; MoeTab M; const char* hb; const char* Wd; mutable int eh;
    __device__ __forceinline__ bool next(int i, Unit& u) const { const long L = (long)i * G + c; const int nun = M.mtpref[NEX] * 4; if (L >= nun) return false;
        const int m = (int)(L >> 2), e = moe_find_expert(M, m, eh), mt = m - M.mtpref[e];
        u.pm = mt; u.pn = (int)(L & 3); u.e = e; u.nvalid = 256; u.arow0 = M.hoff[e] + mt * 256; u.orow0 = (e < NE) ? (M.hoff[e] + mt * 256) : mt * 256; u.gidx = nullptr; return true; }
    static constexpr bool GATHER = false;
    __device__ __forceinline__ const char* a_tile(const Unit& u) const { return hb + (size_t)u.arow0 * 256 * 2; }
    __device__ __forceinline__ const char* b_tile(const Unit& u) const { return Wd + ((size_t)u.e * 1024 + (size_t)u.pn * 256) * 256 * 2; }
    __device__ __forceinline__ int a_row(const Unit& u, int r) const { return u.arow0 + r; }
};

#define EPI_ARGS const AccT& acc, const Unit& u, int wr, int wc, int fr, int fq
struct EpiQKV { static constexpr bool PERM = true; bf16* Q; bf16* Kb; bf16* Vt;
    __device__ __forceinline__ void operator()(EPI_ARGS) const {
        const int row0 = u.orow0 + wr * 64 + fr, sec = u.pn >> 2, col0 = (u.pn & 3) * 256 + wc * 32 + 8 * fq;
        if (sec < 2) { bf16* base = sec == 0 ? Q : Kb; const float sc = sec == 0 ? 0.18033688011112042f : 1.0f;
#pragma unroll
            for (int ai = 0; ai < 2; ++ai)
#pragma unroll
                for (int m = 0; m < 4; ++m) { bf16* rowp = base + (size_t)(row0 + ai * 128 + m * 16) * D + col0;
#pragma unroll
                    for (int bj = 0; bj < 2; ++bj) { const f32x4 v0 = acc[ai][bj][m][0] * sc, v1 = acc[ai][bj][m][1] * sc; v4u w;
                        w.x = cvt_pk_bf16(v0[0], v0[1]); w.y = cvt_pk_bf16(v0[2], v0[3]); w.z = cvt_pk_bf16(v1[0], v1[1]); w.w = cvt_pk_bf16(v1[2], v1[3]); *(v4u*)(rowp + bj * 128) = w; } }
        } else {
#pragma unroll
            for (int ai = 0; ai < 2; ++ai)
#pragma unroll
                for (int m = 0; m < 4; ++m) { const int r = row0 + ai * 128 + m * 16, b = r >> 12, s = r & 4095;
#pragma unroll
                    for (int bj = 0; bj < 2; ++bj)
#pragma unroll
                        for (int n = 0; n < 2; ++n) { const f32x4 v = acc[ai][bj][m][n];
#pragma unroll
                            for (int j = 0; j < 4; j += 2) { const int c = col0 + bj * 128 + 4 * n + j, h = c >> 6, d = c & 63; const unsigned w = cvt_pk_bf16(v[j], v[j + 1]);
                                bf16* p = Vt + ((((size_t)(b * NH + h) * HD + d)) << 12) + s; p[0] = (bf16)(w & 0xffffu); p[SEQ] = (bf16)(w >> 16); } } }
        }
    }
};
struct EpiAdd { static constexpr bool PERM = false; float* out;
    __device__ __forceinline__ void operator()(EPI_ARGS) const {
        const int row0 = u.orow0 + wr * 64 + fr, col0 = u.pn * 256 + wc * 32 + 4 * fq;
#pragma unroll
        for (int ai = 0; ai < 2; ++ai)
#pragma unroll
            for (int m = 0; m < 4; ++m) { float* rowp = out + (size_t)(row0 + ai * 128 + m * 16) * D + col0;
#pragma unroll
                for (int bj = 0; bj < 2; ++bj)
#pragma unroll
                    for (int n = 0; n < 2; ++n) { f32x4* p = (f32x4*)(rowp + bj * 128 + n * 16); *p = *p + acc[ai][bj][m][n]; } }
    }
};
struct EpiLogits { static constexpr bool PERM = false; float* lg;
    __device__ __forceinline__ void operator()(EPI_ARGS) const {
        if (wc >= 2) return;
        const int row0 = u.orow0 + wr * 64 + fr, col0 = wc * 32 + 4 * fq;
#pragma unroll
        for (int ai = 0; ai < 2; ++ai)
#pragma unroll
            for (int m = 0; m < 4; ++m) { float* rowp = lg + (size_t)(row0 + ai * 128 + m * 16) * NE + col0;
#pragma unroll
                for (int n = 0; n < 2; ++n) *(f32x4*)(rowp + n * 16) = acc[ai][0][m][n]; }
    }
};
struct EpiSwiglu { static constexpr bool PERM = true; bf16* hb; bool dry;
    __device__ __forceinline__ void operator()(EPI_ARGS) const {
        const int row0 = u.orow0 + wr * 64 + fr, col0 = u.pn * 128 + wc * 32 + 8 * fq;
#pragma unroll
        for (int ai = 0; ai < 2; ++ai)
#pragma unroll
            for (int m = 0; m < 4; ++m) { bf16* rowp = hb + (size_t)(row0 + ai * 128 + m * 16) * DE + col0; float o[8];
#pragma unroll
                for (int n = 0; n < 2; ++n)
#pragma unroll
                    for (int j = 0; j < 4; ++j) { const float g = acc[ai][0][m][n][j], up = acc[ai][1][m][n][j]; o[4 * n + j] = g * sigmoidf_(g) * up; }
                v4u w; w.x = cvt_pk_bf16(o[0], o[1]); w.y = cvt_pk_bf16(o[2], o[3]); w.z = cvt_pk_bf16(o[4], o[5]); w.w = cvt_pk_bf16(o[6], o[7]); if (!dry) *(v4u*)rowp = w; }
    }
};
struct EpiMoeDown { static constexpr bool PERM = true; bf16* yb; float* out; bool dry;
    __device__ __forceinline__ void operator()(EPI_ARGS) const {
        const int row0 = u.orow0 + wr * 64 + fr, col0 = u.pn * 256 + wc * 32 + 8 * fq;
        if (dry) return;
        if (u.e < NE) {
#pragma unroll
            for (int ai = 0; ai < 2; ++ai)
#pragma unroll
                for (int m = 0; m < 4; ++m) { bf16* rowp = yb + (size_t)(row0 + ai * 128 + m * 16) * D + col0;
#pragma unroll
                    for (int bj = 0; bj < 2; ++bj) { const f32x4 v0 = acc[ai][bj][m][0], v1 = acc[ai][bj][m][1]; v4u w;
                        w.x = cvt_pk_bf16(v0[0], v0[1]); w.y = cvt_pk_bf16(v0[2], v0[3]); w.z = cvt_pk_bf16(v1[0], v1[1]); w.w = cvt_pk_bf16(v1[2], v1[3]); *(v4u*)(rowp + bj * 128) = w; } }
        } else {
#pragma unroll
            for (int ai = 0; ai < 2; ++ai)
#pragma unroll
                for (int m = 0; m < 4; ++m) { float* rowp = out + (size_t)(row0 + ai * 128 + m * 16) * D + col0;
#pragma unroll
                    for (int bj = 0; bj < 2; ++bj)
#pragma unroll
                        for (int n = 0; n < 2; ++n) { f32x4* p = (f32x4*)(rowp + bj * 128 + 4 * n); *p = *p + acc[ai][bj][m][n]; } }
        }
    }
};
struct EpiRkv { static constexpr bool PERM = true; unsigned char* ws; size_t voff;
    __device__ __forceinline__ void operator()(EPI_ARGS) const {
        const int row0 = u.orow0 + wr * 64 + fr;
        size_t boff; int ldc, colt, act = 0;
        if (u.pn < 12) { const int sec = u.pn >> 2; boff = WS_R; if (sec == 1) boff = WS_KK; if (sec == 2) boff = voff; ldc = D; colt = (u.pn & 3) * 256; }
        else { const int kind = u.pn - 12; boff = WS_HL + (size_t)kind * T * 256 * 2; ldc = 256; colt = 0; act = kind == 0 ? 1 : (kind == 2 ? 2 : 0); }
        bf16* base = (bf16*)(ws + boff);
        const int col0 = colt + wc * 32 + 8 * fq;
#pragma unroll
        for (int ai = 0; ai < 2; ++ai)
#pragma unroll
            for (int m = 0; m < 4; ++m) { bf16* rowp = base + (size_t)(row0 + ai * 128 + m * 16) * ldc + col0;
#pragma unroll
                for (int bj = 0; bj < 2; ++bj) { f32x4 v0 = acc[ai][bj][m][0], v1 = acc[ai][bj][m][1];
                    if (act == 1) {
#pragma unroll
                        for (int j = 0; j < 4; ++j) { v0[j] = 1.0f - 2.0f * fast_rcp(fast_exp(2.0f * v0[j]) + 1.0f); v1[j] = 1.0f - 2.0f * fast_rcp(fast_exp(2.0f * v1[j]) + 1.0f); } }
                    if (act == 2) {
#pragma unroll
                        for (int j = 0; j < 4; ++j) { v0[j] = sigmoidf_(v0[j]); v1[j] = sigmoidf_(v1[j]); } }
                    v4u w; w.x = cvt_pk_bf16(v0[0], v0[1]); w.y = cvt_pk_bf16(v0[2], v0[3]); w.z = cvt_pk_bf16(v1[0], v1[1]); w.w = cvt_pk_bf16(v1[2], v1[3]); *(v4u*)(rowp + bj * 128) = w; } }
    }
};
struct EpiL2 { static constexpr bool PERM = true; float* lw; bf16* ab; bf16* gb; bf16* vb; const bf16* vf; const float* w0; const float* a0; const float* v0;
    __device__ __forceinline__ void operator()(EPI_ARGS) const {
        const int row0 = u.orow0 + wr * 64 + fr, col0 = u.pn * 256 + wc * 32 + 8 * fq, kind = u.e;
#pragma unroll
        for (int ai = 0; ai < 2; ++ai)
#pragma unroll
            for (int m = 0; m < 4; ++m) { const size_t ro = (size_t)(row0 + ai * 128 + m * 16) * D + col0;
#pragma unroll
                for (int bj = 0; bj < 2; ++bj) { const size_t o = ro + bj * 128; const int c = col0 + bj * 128; float x[8];
#pragma unroll
                    for (int n = 0; n < 2; ++n)
#pragma unroll
                        for (int j = 0; j < 4; ++j) x[4 * n + j] = acc[ai][bj][m][n][j];
                    if (kind == 0) { const f32x4 b0 = *(const f32x4*)(w0 + c), b1 = *(const f32x4*)(w0 + c + 4); f32x4 r0, r1;
#pragma unroll
                        for (int j = 0; j < 8; ++j) { const float z = x[j] + (j < 4 ? b0[j & 3] : b1[j & 3]); if (j < 4) r0[j & 3] = z; else r1[j & 3] = z; }
                        *(f32x4*)(lw + o) = r0; *(f32x4*)(lw + o + 4) = r1;
                    } else if (kind == 1) { const f32x4 b0 = *(const f32x4*)(a0 + c), b1 = *(const f32x4*)(a0 + c + 4);
#pragma unroll
                        for (int j = 0; j < 8; ++j) x[j] = sigmoidf_(x[j] + (j < 4 ? b0[j & 3] : b1[j & 3]));
                        v4u w; w.x = cvt_pk_bf16(x[0], x[1]); w.y = cvt_pk_bf16(x[2], x[3]); w.z = cvt_pk_bf16(x[4], x[5]); w.w = cvt_pk_bf16(x[6], x[7]); *(v4u*)(ab + o) = w;
                    } else if (kind == 2) {
                        v4u w; w.x = cvt_pk_bf16(x[0], x[1]); w.y = cvt_pk_bf16(x[2], x[3]); w.z = cvt_pk_bf16(x[4], x[5]); w.w = cvt_pk_bf16(x[6], x[7]); *(v4u*)(gb + o) = w;
                    } else { const f32x4 b0 = *(const f32x4*)(v0 + c), b1 = *(const f32x4*)(v0 + c + 4); const v4u vv = *(const v4u*)(vb + o), ff = *(const v4u*)(vf + o); float y[8];
#pragma unroll
                        for (int j = 0; j < 8; ++j) { const unsigned wv = vv[j >> 1], wf = ff[j >> 1]; const float v = (j & 1) ? bfhi(wv) : bflo(wv), f = (j & 1) ? bfhi(wf) : bflo(wf);
                            const float gt = sigmoidf_(x[j] + (j < 4 ? b0[j & 3] : b1[j & 3])); y[j] = v + (f - v) * gt; }
                        v4u w; w.x = cvt_pk_bf16(y[0], y[1]); w.y = cvt_pk_bf16(y[2], y[3]); w.z = cvt_pk_bf16(y[4], y[5]); w.w = cvt_pk_bf16(y[6], y[7]); *(v4u*)(vb + o) = w; }
                } }
    }
};

typedef GAS unsigned gu32;
#define XB_TMO      128
#define XB_XCNT(j)  (256  + 64 * (j))
#define XB_XSUB(j)  (1280 + 64 * (j))
#define XB_XGEN(j)  (2304 + 64 * (j))
#define XB_TOP      3328
#define XB_TOPGEN   3392
#define XCD_BAR_WORDS 3456
#define XB_SPIN_CAP (1u << 23)
__device__ __forceinline__ unsigned xb_ld(unsigned* p)              { return __hip_atomic_load(p, __ATOMIC_RELAXED, __HIP_MEMORY_SCOPE_AGENT); }
__device__ __forceinline__ unsigned xb_add(unsigned* p, unsigned v) { return __hip_atomic_fetch_add(p, v, __ATOMIC_RELAXED, __HIP_MEMORY_SCOPE_AGENT); }
__device__ __forceinline__ unsigned xb_xcc_id() { return (unsigned)__builtin_amdgcn_s_getreg((3 << 11) | 20) & 0xFu; }
#define XB_SPIN(cond, bar) do { unsigned _sp = 0; while (cond) { __builtin_amdgcn_s_sleep(1); \
    if ((++_sp & 255u) == 0u) { if (xb_ld(&(bar)[XB_TMO])) break; if (_sp > XB_SPIN_CAP) { atomicAdd(&(bar)[XB_TMO], 1u); break; } } } } while (0)
struct XcdBarrier { unsigned* bar; unsigned x; volatile LAS unsigned* st; };
__device__ __forceinline__ XcdBarrier xcd_barrier_post(unsigned* bar, volatile LAS unsigned* st) {
    XcdBarrier b; b.bar = bar; b.x = xb_xcc_id(); b.st = st;
    if (threadIdx.x == 0) (void)xb_add(&bar[XB_XCNT(b.x)], 1u);
    return b;
}
__device__ __forceinline__ void xcd_barrier_complete(unsigned* bar, unsigned x, unsigned& nloc, unsigned& nx) {
    const unsigned G = gridDim.x * gridDim.y * gridDim.z;
    unsigned sum, cnt, mine, sp = 0u;
    for (;;) {
        sum = 0u; cnt = 0u; mine = 0u;
#pragma unroll
        for (unsigned j = 0; j < 16; ++j) { const unsigned c = xb_ld(&bar[XB_XCNT(j)]); sum += c; cnt += (c > 0u) ? 1u : 0u; mine = (j == x) ? c : mine; }
        if (sum == G) break;
        __builtin_amdgcn_s_sleep(1);
        if ((++sp & 255u) == 0u) { if (xb_ld(&bar[XB_TMO])) break; if (sp > XB_SPIN_CAP) { atomicAdd(&bar[XB_TMO], 1u); break; } }
    }
    nloc = mine > 0u ? mine : 1u; nx = cnt > 0u ? cnt : 1u;
}
__device__ __forceinline__ void xcd_barrier(const XcdBarrier& b) {
    asm volatile("s_waitcnt vmcnt(0)" ::: "memory");
    __syncthreads();
    if (threadIdx.x == 0) {
        unsigned long long bp = (unsigned long long)b.bar; unsigned bx = b.x;
        asm volatile("" : "+s"(bp), "+s"(bx));
        unsigned* bar = (unsigned*)(GAS unsigned*)bp;
        __builtin_amdgcn_s_waitcnt(0);
        unsigned nloc = b.st[0], nx = b.st[1];
        if (nloc == 0u) { xcd_barrier_complete(bar, bx, nloc, nx); b.st[0] = nloc; b.st[1] = nx; }
        const unsigned old = xb_add(&bar[XB_XSUB(bx)], 1u);
        const unsigned gen = old / nloc;
        if (old + 1u == (gen + 1u) * nloc) {
            __builtin_amdgcn_fence(__ATOMIC_RELEASE, "agent");
            asm volatile("s_waitcnt vmcnt(0)" ::: "memory");
            const unsigned og = xb_add(&bar[XB_TOP], 1u);
            const unsigned tg = og / nx;
            if (og + 1u == (tg + 1u) * nx) xb_add(&bar[XB_TOPGEN], 1u);
            else XB_SPIN(xb_ld(&bar[XB_TOPGEN]) == tg, bar);
            __builtin_amdgcn_fence(__ATOMIC_ACQUIRE, "agent");
            xb_add(&bar[XB_XGEN(bx)], 1u);
            asm volatile("s_waitcnt vmcnt(0)" ::: "memory");
        } else {
            XB_SPIN(xb_ld(&bar[XB_XGEN(bx)]) == gen, bar);
            __builtin_amdgcn_fence(__ATOMIC_ACQUIRE, "agent");
            asm volatile("s_waitcnt vmcnt(0)" ::: "memory");
        }
    }
    __syncthreads();
}

struct Args { const float* in[35]; float* out; unsigned char* ws; };
struct Frame {
    LAS unsigned char* lds; gu32* ctl; unsigned char* ws; float* out;
    int tid, lane, wave, vcu, G, gw, NGW;
};

__device__ __forceinline__ Frame phase_frame(const Frame& F) {
    Frame P = F; int lane; asm volatile("v_mbcnt_lo_u32_b32 %0, -1, 0\n\tv_mbcnt_hi_u32_b32 %0, -1, %0" : "=v"(lane)); int wave = F.wave;
    asm volatile("" : "+v"(lane), "+s"(wave)); P.lane = lane; P.wave = wave; P.tid = wave * 64 + lane; P.gw = P.vcu * NWAVES + wave; return P;
}
__device__ __forceinline__ const float* in_ptr(const Frame& F, int k) {
    const unsigned long long v = ((const LAS unsigned long long*)(F.lds + PTAB_OFF))[k];
    const unsigned lo = (unsigned)__builtin_amdgcn_readfirstlane((int)(unsigned)v), hi = (unsigned)__builtin_amdgcn_readfirstlane((int)(unsigned)(v >> 32));
    return (const float*)(GAS const float*)(((unsigned long long)hi << 32) | lo);
}
__device__ __forceinline__ void transpose_item(const float* W, int N, int k0, int n0, bf16* WT, size_t orow, int ldk, LAS float* scr, int lane) {
    f32x4 w[8];
#pragma unroll
    for (int i = 0; i < 8; ++i) w[i] = *(const f32x4*)(W + (size_t)(k0 + 8 * i + (lane >> 3)) * N + n0 + 4 * (lane & 7));
    __builtin_amdgcn_sched_barrier(0);
#pragma unroll
    for (int i = 0; i < 8; ++i) { LAS float* d = scr + (8 * i + (lane >> 3)) * 33 + 4 * (lane & 7); d[0] = w[i][0]; d[1] = w[i][1]; d[2] = w[i][2]; d[3] = w[i][3]; }
    LDS_WAIT(); asm volatile("" ::: "memory");
    const int c = lane & 7;
#pragma unroll
    for (int j = 0; j < 4; ++j) { const int n = (lane >> 3) + 8 * j; const LAS float* s = scr + (8 * c) * 33 + n;
        v4u o; o.x = cvt_pk_bf16(s[0 * 33], s[1 * 33]); o.y = cvt_pk_bf16(s[2 * 33], s[3 * 33]); o.z = cvt_pk_bf16(s[4 * 33], s[5 * 33]); o.w = cvt_pk_bf16(s[6 * 33], s[7 * 33]);
        *(v4u*)(WT + (orow + n) * ldk + k0 + 8 * c) = o; }
    LDS_WAIT(); asm volatile("" ::: "memory");
}
__device__ __forceinline__ void convert_plain(Frame& F, const float* W, int K, int N, bf16* WT, int row_off) {
    LAS float* scr = (LAS float*)(F.lds + F.wave * 16384);
    const int nblk = N / 32, nitems = (K / 64) * nblk;
    for (int it = F.gw; it < nitems; it += F.NGW) { const int kb = it / nblk, nb = it % nblk; transpose_item(W, N, 64 * kb, 32 * nb, WT, (size_t)row_off + 32 * nb, K, scr, F.lane); }
}
__device__ __forceinline__ void convert_small(Frame& F, const float* W, int K, int N, bf16* WT, int Np, int Kp) {
    const size_t tot = (size_t)Np * Kp;
    for (size_t i = (size_t)F.gw * 64 + F.lane; i < tot; i += (size_t)F.NGW * 64) { const int n = (int)(i / Kp), k = (int)(i % Kp);
        const float v = (k < K && n < N) ? W[(size_t)k * N + n] : 0.0f; WT[i] = (bf16)(cvt_pk_bf16(v, 0.0f) & 0xffffu); }
}
__device__ __forceinline__ void convert_moe(Frame& F, const float* wg, const float* wu, const float* wd, const float* sg, const float* su, const float* sd) {
    LAS float* scr = (LAS float*)(F.lds + F.wave * 16384);
    bf16* Wgu = (bf16*)(F.ws + WS_WGU); bf16* Wd = (bf16*)(F.ws + WS_WD);
    constexpr int PER = 128;
    const int total = NEX * 3 * PER;
    for (int it = F.gw; it < total; it += F.NGW) {
        const int e = it / (3 * PER), r = it % (3 * PER), which = r / PER, q = r % PER;
        if (which < 2) { const float* W = (e < NE) ? (which == 0 ? wg : wu) + (size_t)e * D * DE : (which == 0 ? sg : su);
            const int kb = q >> 3, nb = q & 7, n0 = 32 * nb; const size_t orow = (size_t)e * 512 + (n0 >> 7) * 256 + which * 128 + (n0 & 127);
            transpose_item(W, DE, 64 * kb, n0, Wgu, orow, D, scr, F.lane);
        } else { const float* W = (e < NE) ? wd + (size_t)e * DE * D : sd;
            const int kb = q >> 5, nb = q & 31, n0 = 32 * nb;
            transpose_item(W, D, 64 * kb, n0, Wd, (size_t)e * 1024 + n0, DE, scr, F.lane); }
    }
}

template <int MODE>
__device__ __forceinline__ void ln_phase(Frame& F, const float* src, const float* g, const float* bsh, bool final, const MoeTab& M) {
    float* out = F.out; bf16* xb = (bf16*)(F.ws + WS_XB);
    const bf16* yb = (const bf16*)(F.ws + WS_Y); const int2* tsel = (const int2*)(F.ws + WS_TSEL);
    f32x4 gv[4], bv[4];
    if (MODE != 2) {
#pragma unroll
        for (int j = 0; j < 4; ++j) { const int c = 512 * (j >> 1) + 8 * F.lane + 4 * (j & 1); gv[j] = *(const f32x4*)(g + c); bv[j] = *(const f32x4*)(bsh + c); } }
    for (int row = F.gw; row < T; row += F.NGW) {
        const float* xr = src + (size_t)row * D + 8 * F.lane;
        f32x4 v[4];
#pragma unroll
        for (int j = 0; j < 4; ++j) v[j] = *(const f32x4*)(xr + 512 * (j >> 1) + 4 * (j & 1));
        if (MODE == 1) {
#pragma unroll
            for (int jj = 0; jj < TOPK; ++jj) { const int2 ts = tsel[(size_t)row * TOPK + jj]; const int e = ts.x >> 20, slot = ts.x & 0xfffff; const float gt = __int_as_float(ts.y);
                const bf16* yp = yb + (size_t)(M.hoff[e] + slot) * D + 8 * F.lane;
#pragma unroll
                for (int jh = 0; jh < 2; ++jh) { const v4u w = *(const v4u*)(yp + 512 * jh);
                    v[2 * jh][0] += gt * bflo(w.x); v[2 * jh][1] += gt * bfhi(w.x); v[2 * jh][2] += gt * bflo(w.y); v[2 * jh][3] += gt * bfhi(w.y);
                    v[2 * jh + 1][0] += gt * bflo(w.z); v[2 * jh + 1][1] += gt * bfhi(w.z); v[2 * jh + 1][2] += gt * bflo(w.w); v[2 * jh + 1][3] += gt * bfhi(w.w); } }
        }
        f32x4 o[4];
        if (MODE == 2) {
#pragma unroll
            for (int j = 0; j < 4; ++j) o[j] = v[j];
        } else {
            float s = 0.f;
#pragma unroll
            for (int j = 0; j < 4; ++j) s += (v[j][0] + v[j][1]) + (v[j][2] + v[j][3]);
            const float mean = wave_sum(s) * (1.0f / D); float s2 = 0.f;
#pragma unroll
            for (int j = 0; j < 4; ++j) { v[j] = v[j] - mean; s2 += (v[j][0] * v[j][0] + v[j][1] * v[j][1]) + (v[j][2] * v[j][2] + v[j][3] * v[j][3]); }
            const float rstd = 1.0f / sqrtf(wave_sum(s2) * (1.0f / D) + LN_EPS);
#pragma unroll
            for (int j = 0; j < 4; ++j) o[j] = v[j] * rstd * gv[j] + bv[j];
        }
        float* orow = out + (size_t)row * D + 8 * F.lane; bf16* brow = xb + (size_t)row * D + 8 * F.lane;
        const float sc = final ? 1.0f : ALPHA;
#pragma unroll
        for (int jh = 0; jh < 2; ++jh) { *(f32x4*)(orow + 512 * jh) = o[2 * jh] * sc; *(f32x4*)(orow + 512 * jh + 4) = o[2 * jh + 1] * sc;
            v4u w; w.x = cvt_pk_bf16(o[2 * jh][0], o[2 * jh][1]); w.y = cvt_pk_bf16(o[2 * jh][2], o[2 * jh][3]); w.z = cvt_pk_bf16(o[2 * jh + 1][0], o[2 * jh + 1][1]); w.w = cvt_pk_bf16(o[2 * jh + 1][2], o[2 * jh + 1][3]);
            *(v4u*)(brow + 512 * jh) = w; }
    }
}

__device__ __forceinline__ void ln2_phase(Frame& F, const float* g, const float* bsh, bool final, const MoeTab& M) {
    float* out = F.out; bf16* xb = (bf16*)(F.ws + WS_XB);
    const bf16* yb = (const bf16*)(F.ws + WS_Y); const int4* tsel4 = (const int4*)(F.ws + WS_TSEL);
    f32x4 gv[4], bv[4];
#pragma unroll
    for (int j = 0; j < 4; ++j) { const int c = 512 * (j >> 1) + 8 * F.lane + 4 * (j & 1); gv[j] = *(const f32x4*)(g + c); bv[j] = *(const f32x4*)(bsh + c); }
    const float sc = final ? 1.0f : ALPHA;
    constexpr int NBAT = T / 16;
    for (int batch = F.gw; batch < NBAT; batch += F.NGW) {
        const int row0 = 16 * batch;
        const int4 tsv = tsel4[(size_t)row0 * 4 + F.lane];
        f32x4 xv[4]; v4u yw[TOPK][2];
#define LN2_ISSUE(I_) do { const int i_ = (I_); const float* xr = out + (size_t)(row0 + i_) * D + 8 * F.lane; \
            _Pragma("unroll") for (int j = 0; j < 4; ++j) xv[j] = *(const f32x4*)(xr + 512 * (j >> 1) + 4 * (j & 1)); \
            _Pragma("unroll") for (int jj = 0; jj < TOPK; ++jj) { const int tx = __builtin_amdgcn_readlane((jj & 1) ? tsv.z : tsv.x, 4 * i_ + (jj >> 1)); const int e = tx >> 20, slot = tx & 0xfffff; \
                const bf16* yp = yb + (size_t)(M.hoff[e] + slot) * D + 8 * F.lane; yw[jj][0] = *(const v4u*)yp; yw[jj][1] = *(const v4u*)(yp + 512); } } while (0)
        LN2_ISSUE(0);
_Pragma("nounroll")
        for (int i = 0; i < 16; ++i) {
            f32x4 v[4];
#pragma unroll
            for (int j = 0; j < 4; ++j) v[j] = xv[j];
#pragma unroll
            for (int jj = 0; jj < TOPK; ++jj) { const float gt = __int_as_float(__builtin_amdgcn_readlane((jj & 1) ? tsv.w : tsv.y, 4 * i + (jj >> 1)));
#pragma unroll
                for (int jh = 0; jh < 2; ++jh) { const v4u w = yw[jj][jh];
                    v[2 * jh][0] += gt * bflo(w.x); v[2 * jh][1] += gt * bfhi(w.x); v[2 * jh][2] += gt * bflo(w.y); v[2 * jh][3] += gt * bfhi(w.y);
                    v[2 * jh + 1][0] += gt * bflo(w.z); v[2 * jh + 1][1] += gt * bfhi(w.z); v[2 * jh + 1][2] += gt * bflo(w.w); v[2 * jh + 1][3] += gt * bfhi(w.w); } }
            __builtin_amdgcn_sched_barrier(0);
            LN2_ISSUE(i + 1 < 16 ? i + 1 : 15);
            __builtin_amdgcn_sched_barrier(0);
            float s = 0.f;
#pragma unroll
            for (int j = 0; j < 4; ++j) s += (v[j][0] + v[j][1]) + (v[j][2] + v[j][3]);
            const float mean = wave_sum(s) * (1.0f / D); float s2 = 0.f;
#pragma unroll
            for (int j = 0; j < 4; ++j) { v[j] = v[j] - mean; s2 += (v[j][0] * v[j][0] + v[j][1] * v[j][1]) + (v[j][2] * v[j][2] + v[j][3] * v[j][3]); }
            const float rstd = 1.0f / sqrtf(wave_sum(s2) * (1.0f / D) + LN_EPS);
            f32x4 o[4];
#pragma unroll
            for (int j = 0; j < 4; ++j) o[j] = v[j] * rstd * gv[j] + bv[j];
            float* orow = out + (size_t)(row0 + i) * D + 8 * F.lane; bf16* brow = xb + (size_t)(row0 + i) * D + 8 * F.lane;
#pragma unroll
            for (int jh = 0; jh < 2; ++jh) { *(f32x4*)(orow + 512 * jh) = o[2 * jh] * sc; *(f32x4*)(orow + 512 * jh + 4) = o[2 * jh + 1] * sc;
                v4u w; w.x = cvt_pk_bf16(o[2 * jh][0], o[2 * jh][1]); w.y = cvt_pk_bf16(o[2 * jh][2], o[2 * jh][3]); w.z = cvt_pk_bf16(o[2 * jh + 1][0], o[2 * jh + 1][1]); w.w = cvt_pk_bf16(o[2 * jh + 1][2], o[2 * jh + 1][3]);
                *(v4u*)(brow + 512 * jh) = w; }
        }
#undef LN2_ISSUE
    }
}

__device__ __forceinline__ void moe_tables(Frame& F, int layer) {
    LAS int* cnt = (LAS int*)(F.lds + TAB_OFF); LAS int* mtp = cnt + 65; LAS int* hoff = mtp + 66;
    __syncthreads();
    if (F.tid < NE) cnt[F.tid] = (int)__hip_atomic_load(F.ctl + CW_CNT + (layer * 64 + F.tid) * 64, RLX_AGENT);
    if (F.tid == NE) cnt[NE] = T;
    __syncthreads();
    if (F.tid == 0) { int m = 0;
_Pragma("nounroll")
        for (int e = 0; e < NEX; ++e) { mtp[e] = m; hoff[e] = m * 256; m += (cnt[e] + 255) >> 8; } mtp[NEX] = m; hoff[NEX] = m * 256; }
    __syncthreads();
}

__device__ __forceinline__ void route_phase(Frame& F, int layer, const float* rbias) {
    const float* lg = (const float*)(F.ws + WS_LOGITS); int* toklist = (int*)(F.ws + WS_TOKLIST); int2* tsel = (int2*)(F.ws + WS_TSEL);
    LAS float* sw = (LAS float*)(F.lds + F.wave * 256);
    const float rb = rbias[F.lane];
    for (int row = F.gw; row < T; row += F.NGW) {
        const float sc = sigmoidf_(lg[(size_t)row * NE + F.lane]); const float bz = sc + rb;
        sw[F.lane] = bz; LDS_WAIT();
        float v[64];
#pragma unroll
        for (int q = 0; q < 16; ++q) { const f32x4 t = *(const LAS f32x4*)(sw + 4 * q); v[4 * q] = t[0]; v[4 * q + 1] = t[1]; v[4 * q + 2] = t[2]; v[4 * q + 3] = t[3]; }
        LDS_WAIT();
        float gs[8];
#pragma unroll
        for (int gi = 0; gi < 8; ++gi) { float m1 = -INFINITY, m2 = -INFINITY;
#pragma unroll
            for (int k = 0; k < 8; ++k) { const float x = v[8 * gi + k]; const bool a = x > m1; const float nm2 = a ? m1 : fmaxf(m2, x); m1 = a ? x : m1; m2 = nm2; }
            gs[gi] = m1 + m2; }
        unsigned keep = 0u;
#pragma unroll
        for (int gi = 0; gi < 8; ++gi) { int rank = 0;
#pragma unroll
            for (int g2 = 0; g2 < 8; ++g2) rank += (gs[g2] > gs[gi] || (gs[g2] == gs[gi] && g2 < gi)) ? 1 : 0;
            keep |= (rank < 4) ? (1u << gi) : 0u; }
        const bool kown = (keep >> (F.lane >> 3)) & 1u; int rank = 0;
#pragma unroll
        for (int e2 = 0; e2 < 64; ++e2) { const bool k2 = (keep >> (e2 >> 3)) & 1u; rank += (k2 && (v[e2] > bz || (v[e2] == bz && e2 < F.lane))) ? 1 : 0; }
        const bool sel = kown && rank < TOPK;
        const unsigned long long bal = __ballot(sel);
        const float ssum = wave_sum(sel ? sc : 0.0f);
        if (sel) { const int j = __popcll(bal & ((1ull << F.lane) - 1ull)); const float gate = sc / ssum * 2.5f;
            const unsigned slot = __hip_atomic_fetch_add(F.ctl + CW_CNT + (layer * 64 + F.lane) * 64, 1u, RLX_AGENT);
            toklist[(size_t)F.lane * T + slot] = row;
            if (j < TOPK) tsel[(size_t)row * TOPK + j] = make_int2((F.lane << 20) | (int)slot, __float_as_int(gate)); }
    }
}

__device__ __forceinline__ void ln1_route_phase(Frame& F, const float* g, const float* bsh, int layer, const float* rbias) {
    float* out = F.out; bf16* xb = (bf16*)(F.ws + WS_XB);
    const unsigned char* WrT = F.ws + WS_WR + (size_t)layer * 256 * D * 2;
    int* toklist = (int*)(F.ws + WS_TOKLIST); int2* tsel = (int2*)(F.ws + WS_TSEL);
    f32x4 gv[4], bv[4];
#pragma unroll
    for (int j = 0; j < 4; ++j) { const int c = 512 * (j >> 1) + 8 * F.lane + 4 * (j & 1); gv[j] = *(const f32x4*)(g + c); bv[j] = *(const f32x4*)(bsh + c); }
    const float rb = rbias[F.lane];
    const int qi = F.lane & 15, gq = F.lane >> 4;
    constexpr int NBAT = T / 16;
    for (int b0 = 0; b0 < NBAT; b0 += F.NGW) {
        const int batch = b0 + F.gw; const bool act = batch < NBAT;
        __syncthreads();
#pragma unroll
        for (int q = 0; q < 16; ++q) { const int hr = F.wave * 16 + q, e = hr >> 1, half = hr & 1; const int c = (64 * half + F.lane) ^ (e & 15);
            __builtin_amdgcn_global_load_lds((const unsigned*)(WrT + (size_t)e * 2048 + 16 * c), (LAS unsigned*)(F.lds + e * 2048 + 1024 * half), 16, 0, 0); }
        if (act) {
_Pragma("nounroll")
            for (int i = 0; i < 16; ++i) { const int row = 16 * batch + i;
                const float* xr = out + (size_t)row * D + 8 * F.lane;
                f32x4 v[4];
#pragma unroll
                for (int j = 0; j < 4; ++j) v[j] = *(const f32x4*)(xr + 512 * (j >> 1) + 4 * (j & 1));
                float s = 0.f;
#pragma unroll
                for (int j = 0; j < 4; ++j) s += (v[j][0] + v[j][1]) + (v[j][2] + v[j][3]);
                const float mean = wave_sum(s) * (1.0f / D); float s2 = 0.f;
#pragma unroll
                for (int j = 0; j < 4; ++j) { v[j] = v[j] - mean; s2 += (v[j][0] * v[j][0] + v[j][1] * v[j][1]) + (v[j][2] * v[j][2] + v[j][3] * v[j][3]); }
                const float rstd = 1.0f / sqrtf(wave_sum(s2) * (1.0f / D) + LN_EPS);
                f32x4 o[4];
#pragma unroll
                for (int j = 0; j < 4; ++j) o[j] = v[j] * rstd * gv[j] + bv[j];
                float* orow = out + (size_t)row * D + 8 * F.lane; bf16* brow = xb + (size_t)row * D + 8 * F.lane;
#pragma unroll
                for (int jh = 0; jh < 2; ++jh) { *(f32x4*)(orow + 512 * jh) = o[2 * jh] * ALPHA; *(f32x4*)(orow + 512 * jh + 4) = o[2 * jh + 1] * ALPHA;
                    v4u w; w.x = cvt_pk_bf16(o[2 * jh][0], o[2 * jh][1]); w.y = cvt_pk_bf16(o[2 * jh][2], o[2 * jh][3]); w.z = cvt_pk_bf16(o[2 * jh + 1][0], o[2 * jh + 1][1]); w.w = cvt_pk_bf16(o[2 * jh + 1][2], o[2 * jh + 1][3]);
                    *(v4u*)(brow + 512 * jh) = w; }
            }
        }
        VM_WAIT(); __syncthreads();
        f32x4 acc[4];
#pragma unroll
        for (int t = 0; t < 4; ++t) acc[t] = (f32x4){0.f, 0.f, 0.f, 0.f};
        if (act) { const bf16* xrow = xb + (size_t)(16 * batch + qi) * D + 8 * gq;
#pragma unroll
            for (int k0 = 0; k0 < 32; k0 += 16) { bf16x8 bfr[16];
#pragma unroll
                for (int ks = 0; ks < 16; ++ks) bfr[ks] = *(const bf16x8*)(xrow + 32 * (k0 + ks));
                __builtin_amdgcn_sched_barrier(0);
#pragma unroll
                for (int ks = 0; ks < 16; ++ks)
#pragma unroll
                    for (int t = 0; t < 4; ++t) { const bf16x8 a = *(const LAS bf16x8*)(F.lds + (16 * t + qi) * 2048 + 16 * ((4 * (k0 + ks) + gq) ^ qi)); acc[t] = __builtin_amdgcn_mfma_f32_16x16x32_bf16(a, bfr[ks], acc[t], 0, 0, 0); }
                __builtin_amdgcn_sched_barrier(0); } }
        __syncthreads();
        if (act) { LAS float* lg = (LAS float*)(F.lds + F.wave * 16384);
#pragma unroll
            for (int t = 0; t < 4; ++t) *(LAS f32x4*)(lg + qi * 64 + 16 * t + 4 * gq) = acc[t];
            LDS_WAIT();
            int cnt = 0;
_Pragma("nounroll")
            for (int i = 0; i < 16; ++i) { LAS float* sw = lg + 64 * i;
                const float sc = sigmoidf_(sw[F.lane]); const float bz = sc + rb;
                const float m1 = max8(bz);
                const unsigned long long bm = __ballot(bz == m1);
                const unsigned gb = (unsigned)(bm >> (F.lane & 56)) & 0xffu;
                const bool isf = (unsigned)(F.lane & 7) == (unsigned)__builtin_ctz(gb);
                const float m2 = max8(isf ? -INFINITY : bz);
                const float gsum = m1 + m2; const int grp = F.lane >> 3; int grank = 0;
#pragma unroll
                for (int g2 = 0; g2 < 8; ++g2) { const float s = __int_as_float(__builtin_amdgcn_readlane(__float_as_int(gsum), 8 * g2)); grank += (s > gsum || (s == gsum && g2 < grp)) ? 1 : 0; }
                float x = (grank < 4) ? bz : -INFINITY; bool sel = false;
#pragma unroll
                for (int r8 = 0; r8 < TOPK; ++r8) { const float m = wave_max(x); const unsigned long long bx = __ballot(x == m); const int first = (int)__builtin_ctzll(bx);
                    if (F.lane == first) { sel = true; x = -INFINITY; } }
                const float ssum = wave_sum(sel ? sc : 0.0f);
                sw[F.lane] = sel ? sc / ssum * 2.5f : -1.0f; cnt += sel ? 1 : 0; }
            unsigned slot = 0; if (cnt > 0) slot = __hip_atomic_fetch_add(F.ctl + CW_CNT + (layer * 64 + F.lane) * 64, (unsigned)cnt, RLX_AGENT);
            LDS_WAIT();
_Pragma("nounroll")
            for (int i = 0; i < 16; ++i) { const float gate = lg[64 * i + F.lane]; const bool sel = gate >= 0.0f; const int row = 16 * batch + i;
                const unsigned long long bal = __ballot(sel);
                if (sel) { const int j = __popcll(bal & ((1ull << F.lane) - 1ull));
                    toklist[(size_t)F.lane * T + slot] = row;
                    if (j < TOPK) tsel[(size_t)row * TOPK + j] = make_int2((F.lane << 20) | (int)slot, __float_as_int(gate));
                    ++slot; } }
            LDS_WAIT();
        }
    }
}

__device__ __forceinline__ void mix_phase(Frame& F, const float* mix) {
    bf16* xm = (bf16*)(F.ws + WS_XMIX);
    f32x4 mc[6][2][2];
#pragma unroll
    for (int i = 0; i < 6; ++i)
#pragma unroll
        for (int jh = 0; jh < 2; ++jh)
#pragma unroll
            for (int q = 0; q < 2; ++q) mc[i][jh][q] = *(const f32x4*)(mix + i * D + 512 * jh + 8 * F.lane + 4 * q);
    constexpr int NBAT = T / 16;
    for (int batch = F.gw; batch < NBAT; batch += F.NGW) {
        const int row0 = 16 * batch; const float* xr = F.out + (size_t)row0 * D + 8 * F.lane; const bool first = (row0 & (SEQ - 1)) == 0;
        f32x4 xp[2][2], xc[2][2];
#pragma unroll
        for (int jh = 0; jh < 2; ++jh)
#pragma unroll
            for (int q = 0; q < 2; ++q) { xc[jh][q] = *(const f32x4*)(xr + 512 * jh + 4 * q); xp[jh][q] = *(const f32x4*)(xr + (first ? 0 : -D) + 512 * jh + 4 * q) * (first ? 0.0f : 1.0f / ALPHA); }
_Pragma("nounroll")
        for (int i = 0; i < 16; ++i) { const float* xnp = xr + (size_t)(i + 1 < 16 ? i + 1 : 15) * D; f32x4 xn[2][2];
#pragma unroll
            for (int jh = 0; jh < 2; ++jh)
#pragma unroll
                for (int q = 0; q < 2; ++q) xn[jh][q] = *(const f32x4*)(xnp + 512 * jh + 4 * q);
            bf16* orow = xm + (size_t)(row0 + i) * D + 8 * F.lane;
#pragma unroll
            for (int jh = 0; jh < 2; ++jh) { const f32x4 x0 = xc[jh][0] * (1.0f / ALPHA), x1 = xc[jh][1] * (1.0f / ALPHA); const f32x4 d0 = xp[jh][0] - x0, d1 = xp[jh][1] - x1;
#pragma unroll
                for (int k = 0; k < 6; ++k) { const f32x4 o0 = x0 + d0 * mc[k][jh][0], o1 = x1 + d1 * mc[k][jh][1];
                    v4u w; w.x = cvt_pk_bf16(o0[0], o0[1]); w.y = cvt_pk_bf16(o0[2], o0[3]); w.z = cvt_pk_bf16(o1[0], o1[1]); w.w = cvt_pk_bf16(o1[2], o1[3]);
                    *(v4u*)(orow + (size_t)k * T * D + 512 * jh) = w; }
                xp[jh][0] = x0; xp[jh][1] = x1; xc[jh][0] = xn[jh][0]; xc[jh][1] = xn[jh][1]; }
        }
    }
}
__device__ __forceinline__ void kmean_phase(Frame& F) {
    const bf16* Kb = (const bf16*)(F.ws + WS_K); float* km = (float*)(F.ws + WS_KMEAN);
    for (int u = F.gw; u < NBATCH * NH * NMB; u += F.NGW) { const int bh = u >> 4, blk = u & 15, b = bh >> 4, h = bh & 15;
        const bf16* p = Kb + ((size_t)b * SEQ + blk * MBLK + (F.lane >> 3)) * D + h * HD + 8 * (F.lane & 7); float s[8];
#pragma unroll
        for (int i = 0; i < 8; ++i) s[i] = 0.f;
#pragma unroll
        for (int r0 = 0; r0 < MBLK / 8; r0 += 16) { v4u w[16];
#pragma unroll
            for (int r = 0; r < 16; ++r) w[r] = *(const v4u*)(p + (size_t)(8 * (r0 + r)) * D);
            __builtin_amdgcn_sched_barrier(0);
#pragma unroll
            for (int r = 0; r < 16; ++r) { s[0] += bflo(w[r].x); s[1] += bfhi(w[r].x); s[2] += bflo(w[r].y); s[3] += bfhi(w[r].y); s[4] += bflo(w[r].z); s[5] += bfhi(w[r].z); s[6] += bflo(w[r].w); s[7] += bfhi(w[r].w); }
            __builtin_amdgcn_sched_barrier(0); }
#pragma unroll
        for (int i = 0; i < 8; ++i) s[i] = q4_sum(dpp_add<0x128>(s[i])) * (1.0f / MBLK);
        if (F.lane < 8) { float* o = km + (size_t)u * HD + 8 * F.lane; *(f32x4*)o = (f32x4){s[0], s[1], s[2], s[3]}; *(f32x4*)(o + 4) = (f32x4){s[4], s[5], s[6], s[7]}; } }
}
__device__ __forceinline__ void sel_phase(Frame& F) {
    const bf16* Q = (const bf16*)(F.ws + WS_Q); const float* km = (const float*)(F.ws + WS_KMEAN); unsigned short* maskb = (unsigned short*)(F.ws + WS_MASK);
    LAS float* kl = (LAS float*)F.lds;
    for (int u = F.vcu; u < NBATCH * NH * (SEQ / NTHREADS); u += F.G) { const int bh = u >> 3, ch = u & 7, b = bh >> 4, h = bh & 15;
        __syncthreads();
        for (int i = F.tid; i < NMB * HD; i += NTHREADS) kl[i] = km[(size_t)bh * NMB * HD + i];
        __syncthreads();
        const int qpos = ch * NTHREADS + F.tid, qblk = qpos >> 8;
        const v4u* qp = (const v4u*)(Q + ((size_t)b * SEQ + qpos) * D + h * HD); float q[64];
#pragma unroll
        for (int i = 0; i < 8; ++i) { const v4u w = qp[i];
#pragma unroll
            for (int k = 0; k < 4; ++k) { q[8 * i + 2 * k] = bflo(w[k]); q[8 * i + 2 * k + 1] = bfhi(w[k]); } }
        float v1 = -INFINITY, v2 = -INFINITY, v3 = -INFINITY; int i1 = -1, i2 = -1, i3 = -1;
        for (int j = 0; j < qblk; ++j) { float gsum = 0.f; const LAS f32x4* kr = (const LAS f32x4*)(kl + j * HD);
#pragma unroll
            for (int i = 0; i < 16; ++i) { const f32x4 kv = kr[i]; gsum += q[4 * i] * kv[0] + q[4 * i + 1] * kv[1] + q[4 * i + 2] * kv[2] + q[4 * i + 3] * kv[3]; }
            if (gsum > v1) { v3 = v2; i3 = i2; v2 = v1; i2 = i1; v1 = gsum; i1 = j; }
            else if (gsum > v2) { v3 = v2; i3 = i2; v2 = gsum; i2 = j; }
            else if (gsum > v3) { v3 = gsum; i3 = j; } }
        unsigned mk = 0u; if (i1 >= 0) mk |= 1u << i1; if (i2 >= 0) mk |= 1u << i2; if (i3 >= 0) mk |= 1u << i3;
        maskb[(size_t)bh * SEQ + qpos] = (unsigned short)mk; }
}
template <int probe> __device__ __forceinline__ void attn_phase(Frame& F, const float* rel_bias) {
    const bf16* Q = (const bf16*)(F.ws + WS_Q); const bf16* Kb = (const bf16*)(F.ws + WS_K); const bf16* Vt = (const bf16*)(F.ws + WS_VT); bf16* O = (bf16*)(F.ws + WS_O);
    const unsigned short* maskb = (const unsigned short*)(F.ws + WS_MASK);
    constexpr int KRS = 144, VRS = 272, KB_ = 128 * KRS, TB = KB_ + 64 * VRS;
    LAS float* tbl = (LAS float*)(F.lds + 2 * TB);
    __syncthreads();
    for (int i = F.tid; i < NH * 129; i += NTHREADS) { const int h = i / 129, d = i % 129; tbl[h * 132 + d] = rel_bias[(int)T5_BUCKET[d] * NH + h] * 1.4426950408889634f; }
    __syncthreads();
    const int qi = F.lane & 15, g = F.lane >> 4; unsigned tcount = 0;
    for (int it = 0;; ++it) {
        int bh, blk;
        if (F.G == 256) { if (it >= 8) break; bh = F.vcu >> 1; blk = (F.vcu & 1) ? ((it & 1) ? 15 - it : it + 1) : ((it & 1) ? 16 - it : it); }
        else { const int L = it * F.G + F.vcu; if (L >= NBATCH * NH * NMB) break; bh = L >> 4; blk = L & 15; }
        const int b = bh >> 4, h = bh & 15;
        const int q0 = blk * MBLK + 32 * F.wave;
        bf16x8 qf[2][2]; unsigned qmask[2];
#pragma unroll
        for (int gp = 0; gp < 2; ++gp) { const int qpos = q0 + 16 * gp + qi; const size_t qrow = (size_t)b * SEQ + qpos; qmask[gp] = maskb[(size_t)bh * SEQ + qpos];
#pragma unroll
            for (int ks = 0; ks < 2; ++ks) qf[gp][ks] = *(const bf16x8*)(Q + qrow * D + h * HD + 32 * ks + 8 * g); }
        const LAS float* tblh = tbl + h * 132; const float bfar = tblh[128];
        float mref[2] = {0.f, 0.f}; f32x4 o[2][5];
#pragma unroll
        for (int gp = 0; gp < 2; ++gp)
#pragma unroll
            for (int dt = 0; dt < 5; ++dt) o[gp][dt] = (f32x4){0.f, 0.f, 0.f, 0.f};
        constexpr float THR = 8.0f;
        const bf16x8 ones = {0x3F80, 0x3F80, 0x3F80, 0x3F80, 0x3F80, 0x3F80, 0x3F80, 0x3F80};
        const int nst = 2 + 2 * blk;
        const int kkey = F.tid >> 3, kch = F.tid & 7;
        const int vd = F.tid >> 3, vch = F.tid & 7;
        const bf16* kbase = Kb + ((size_t)b * SEQ + kkey) * D + h * HD + 8 * kch;
        const bf16* vbase = Vt + (((size_t)bh * HD + vd) << 12) + 8 * vch;
        v4u kreg[2], vreg[2];
        { const int key0 = blk * MBLK; kreg[0] = *(const v4u*)(kbase + (size_t)key0 * D); kreg[1] = *(const v4u*)(kbase + (size_t)(key0 + 64) * D); vreg[0] = *(const v4u*)(vbase + key0); vreg[1] = *(const v4u*)(vbase + key0 + 64); }
        for (int n = 0; n < nst; ++n) {
            int jb, key0; if (n < 2) { jb = blk; key0 = blk * MBLK + 128 * n; } else { const int mm = n - 2; jb = blk - 1 - (mm >> 1); key0 = jb * MBLK + 128 * (mm & 1); }
            LAS unsigned char* buf = F.lds + (tcount & 1u) * TB; ++tcount;
            *(LAS v4u*)(buf + kkey * KRS + kch * 16) = kreg[0]; *(LAS v4u*)(buf + (kkey + 64) * KRS + kch * 16) = kreg[1];
            *(LAS v4u*)(buf + KB_ + vd * VRS + vch * 16) = vreg[0]; *(LAS v4u*)(buf + KB_ + vd * VRS + (vch + 8) * 16) = vreg[1];
            asm volatile("s_waitcnt lgkmcnt(0)" ::: "memory");
            if (n + 1 < nst) { const int n1 = n + 1; int k1; if (n1 < 2) k1 = blk * MBLK + 128 * n1; else { const int mm = n1 - 2; k1 = (blk - 1 - (mm >> 1)) * MBLK + 128 * (mm & 1); }
                kreg[0] = *(const v4u*)(kbase + (size_t)k1 * D); kreg[1] = *(const v4u*)(kbase + (size_t)(k1 + 64) * D); vreg[0] = *(const v4u*)(vbase + k1); vreg[1] = *(const v4u*)(vbase + k1 + 64); }
            asm volatile("s_barrier" ::: "memory");
            const bool own = (jb == blk), nearb = (jb >= blk - 1);
            if (probe == 2) continue;
            if (own && 128 * n > 32 * F.wave + 31) continue;
            f32x4 s[2][8]; bool selb[2];
#pragma unroll
            for (int gp = 0; gp < 2; ++gp) { selb[gp] = (qmask[gp] >> jb) & 1u; const float c0 = (n == 0) ? 0.0f : (nearb ? -mref[gp] : (selb[gp] ? bfar - mref[gp] : -INFINITY));
#pragma unroll
                for (int kt = 0; kt < 8; ++kt) s[gp][kt] = (f32x4){c0, c0, c0, c0}; }
#pragma unroll
            for (int kt = 0; kt < 8; ++kt)
#pragma unroll
                for (int ks = 0; ks < 2; ++ks) { if (probe == 4) break; const bf16x8 a = *(const LAS bf16x8*)(buf + (16 * kt + qi) * KRS + 64 * ks + 16 * g);
                    s[0][kt] = __builtin_amdgcn_mfma_f32_16x16x32_bf16(a, qf[0][ks], s[0][kt], 0, 0, 0); s[1][kt] = __builtin_amdgcn_mfma_f32_16x16x32_bf16(a, qf[1][ks], s[1][kt], 0, 0, 0);
                    }
#pragma unroll
            for (int gp = 0; gp < 2; ++gp) { if (probe == 3) break;
                float mx = -INFINITY;
                if (nearb) {
                    const int qpos = q0 + 16 * gp + qi; const int dist0 = qpos - (key0 + 4 * g);
#pragma unroll
                    for (int kh = 0; kh < 4; ++kh) { float bz[2][4];
#pragma unroll
                        for (int k4 = 0; k4 < 2; ++k4)
#pragma unroll
                            for (int r = 0; r < 4; ++r) { const int dist = dist0 - (16 * (2 * kh + k4) + r); const int dd = dist < 0 ? 0 : (dist > 128 ? 128 : dist); bz[k4][r] = tblh[dd]; }
#pragma unroll
                        for (int k4 = 0; k4 < 2; ++k4) asm volatile("" : "+v"(bz[k4][0]), "+v"(bz[k4][1]), "+v"(bz[k4][2]), "+v"(bz[k4][3]));
#pragma unroll
                        for (int k4 = 0; k4 < 2; ++k4)
#pragma unroll
                            for (int r = 0; r < 4; ++r) { const int kt = 2 * kh + k4; const int dist = dist0 - (16 * kt + r);
                                const bool valid = own ? (dist >= 0) : selb[gp]; const float x = valid ? s[gp][kt][r] + bz[k4][r] : -INFINITY; s[gp][kt][r] = x; mx = __builtin_fmaxf(mx, x); } }
                } else {
#pragma unroll
                    for (int kt = 0; kt < 8; ++kt)
#pragma unroll
                        for (int r = 0; r < 4; ++r) mx = __builtin_fmaxf(mx, s[gp][kt][r]); }
                mx = q4_max(mx);
                if (n == 0) {
                    mref[gp] = mx;
#pragma unroll
                    for (int kt = 0; kt < 8; ++kt)
#pragma unroll
                        for (int r = 0; r < 4; ++r) s[gp][kt][r] -= mx;
                } else if (__any(mx > THR)) {
                    const float dl = __builtin_fmaxf(mx, 0.0f), f = __builtin_amdgcn_exp2f(-dl); mref[gp] += dl;
#pragma unroll
                    for (int kt = 0; kt < 8; ++kt)
#pragma unroll
                        for (int r = 0; r < 4; ++r) s[gp][kt][r] -= dl;
#pragma unroll
                    for (int dt = 0; dt < 5; ++dt) o[gp][dt] = o[gp][dt] * f; }
#pragma unroll
                for (int kt = 0; kt < 8; ++kt)
#pragma unroll
                    for (int r = 0; r < 4; ++r) s[gp][kt][r] = __builtin_amdgcn_exp2f(s[gp][kt][r]);
            }
#pragma unroll
            for (int k2 = 0; k2 < 4; ++k2) { if (probe == 5) break; bf16x8 pb[2][4];
#pragma unroll
                for (int gp = 0; gp < 2; ++gp) { v4u pw; pw.x = cvt_pk_bf16(s[gp][2 * k2][0], s[gp][2 * k2][1]); pw.y = cvt_pk_bf16(s[gp][2 * k2][2], s[gp][2 * k2][3]);
                    pw.z = cvt_pk_bf16(s[gp][2 * k2 + 1][0], s[gp][2 * k2 + 1][1]); pw.w = cvt_pk_bf16(s[gp][2 * k2 + 1][2], s[gp][2 * k2 + 1][3]); pb[gp][k2] = __builtin_bit_cast(bf16x8, pw); }
#pragma unroll
                for (int dt = 0; dt < 4; ++dt) { const LAS unsigned char* vp = buf + KB_ + (16 * dt + qi) * VRS + 64 * k2 + 8 * g; const v2u lo = *(const LAS v2u*)vp, hi = *(const LAS v2u*)(vp + 32);
                    v4u aw; aw.x = lo.x; aw.y = lo.y; aw.z = hi.x; aw.w = hi.y; const bf16x8 av = __builtin_bit_cast(bf16x8, aw);
                    o[0][dt] = __builtin_amdgcn_mfma_f32_16x16x32_bf16(av, pb[0][k2], o[0][dt], 0, 0, 0); o[1][dt] = __builtin_amdgcn_mfma_f32_16x16x32_bf16(av, pb[1][k2], o[1][dt], 0, 0, 0); }
                o[0][4] = __builtin_amdgcn_mfma_f32_16x16x32_bf16(ones, pb[0][k2], o[0][4], 0, 0, 0); o[1][4] = __builtin_amdgcn_mfma_f32_16x16x32_bf16(ones, pb[1][k2], o[1][4], 0, 0, 0); }
        }
#pragma unroll
        for (int gp = 0; gp < 2; ++gp) { const float inv = 1.0f / o[gp][4][0]; const size_t qrow = (size_t)b * SEQ + q0 + 16 * gp + qi;
#pragma unroll
            for (int dt = 0; dt < 4; ++dt) { v2u w; w.x = cvt_pk_bf16(o[gp][dt][0] * inv, o[gp][dt][1] * inv); w.y = cvt_pk_bf16(o[gp][dt][2] * inv, o[gp][dt][3] * inv); *(v2u*)(O + qrow * D + h * HD + 16 * dt + 4 * g) = w; } }
    }
    __syncthreads();
}

constexpr int SC = 32, NCHK = SEQ / SC;
constexpr size_t WS_PT = WS_S + 256 * MiB;
constexpr size_t WS_LT = 48 * MiB;
constexpr size_t WS_QT = WS_S + 576 * MiB;
constexpr size_t WS_YS2 = WS_S;
static_assert(WS_LT + 128 * MiB <= WS_VF && WS_QT + 64 * MiB <= WS_YG, "chunk operator buffers");
__device__ __forceinline__ float reduce8(float v) { v = dpp_add<0xB1>(v); v = dpp_add<0x4E>(v); v = dpp_add<0x141>(v); return v; }
template <int KS> __device__ __forceinline__ f32x4 mm_tile(const LAS unsigned char* X, int xs, int m0, const LAS unsigned char* Y, int ys, int n0, f32x4 acc, int qi, int g) {
#pragma unroll
    for (int ks = 0; ks < KS; ++ks) { const bf16x8 a = *(const LAS bf16x8*)(X + (m0 + qi) * xs + 64 * ks + 16 * g), b = *(const LAS bf16x8*)(Y + (n0 + qi) * ys + 64 * ks + 16 * g);
        acc = __builtin_amdgcn_mfma_f32_16x16x32_bf16(a, b, acc, 0, 0, 0); }
    return acc;
}
typedef short v4i16_t_ __attribute__((ext_vector_type(4)));
__device__ __forceinline__ bf16x8 frag_tr(const LAS unsigned char* Z, int zs, int kk0, int c0, int qi, int g) {
    const LAS unsigned char* p = Z + (kk0 + 8 * g + (qi >> 2)) * zs + (c0 + 4 * (qi & 3)) * 2;
    const v4i16_t_ lo = __builtin_amdgcn_ds_read_tr16_b64_v4i16((LAS v4i16_t_*)p), hi = __builtin_amdgcn_ds_read_tr16_b64_v4i16((LAS v4i16_t_*)(p + 4 * zs));
    return (bf16x8){lo[0], lo[1], lo[2], lo[3], hi[0], hi[1], hi[2], hi[3]};
}
template <int KS> __device__ __forceinline__ f32x4 mm_tile_xt(const LAS unsigned char* Z, int zs, int m0, const LAS unsigned char* Y, int ys, int n0, f32x4 acc, int qi, int g) {
#pragma unroll
    for (int ks = 0; ks < KS; ++ks) { const bf16x8 a = frag_tr(Z, zs, 32 * ks, m0, qi, g), b = *(const LAS bf16x8*)(Y + (n0 + qi) * ys + 64 * ks + 16 * g);
        acc = __builtin_amdgcn_mfma_f32_16x16x32_bf16(a, b, acc, 0, 0, 0); }
    return acc;
}
template <int KS> __device__ __forceinline__ f32x4 mm_tile_yt(const LAS unsigned char* X, int xs, int m0, const LAS unsigned char* Z, int zs, int n0, f32x4 acc, int qi, int g) {
#pragma unroll
    for (int ks = 0; ks < KS; ++ks) { const bf16x8 a = *(const LAS bf16x8*)(X + (m0 + qi) * xs + 64 * ks + 16 * g), b = frag_tr(Z, zs, 32 * ks, n0, qi, g);
        acc = __builtin_amdgcn_mfma_f32_16x16x32_bf16(a, b, acc, 0, 0, 0); }
    return acc;
}
__device__ __forceinline__ v2u pack4(const f32x4 v) { v2u w; w.x = cvt_pk_bf16(v[0], v[1]); w.y = cvt_pk_bf16(v[2], v[3]); return w; }
__device__ __forceinline__ void chunk_prep(Frame& F, const bf16* vbuf, const float* k_k, const float* k_a, const bool dry = false) {
    const bf16* rb = (const bf16*)(F.ws + WS_R); const bf16* kb = (const bf16*)(F.ws + WS_KK); const bf16* ab = (const bf16*)(F.ws + WS_A); const float* lw = (const float*)(F.ws + WS_LW);
    bf16* PTg = (bf16*)(F.ws + WS_PT); bf16* QTg = (bf16*)(F.ws + WS_QT); bf16* LTg = (bf16*)(F.ws + WS_LT); float* ys = (float*)(F.ws + WS_YS2);
    constexpr int RS = 144, TS_ = 80;
    constexpr int O_AT = 0, O_BT = 4608, O_KT = 9216, O_RT = 13824, O_VT = 18432, O_X2T = 23040, O_GT = 28160,
                  O_TM = 33280, O_NRBT = 35840, O_NAK = 38400, O_X1T = 40960, O_HT = 43520, O_NAB = 46080, O_WC = 50688, O_PK = 50944, O_CL = O_X2T;
    const int grp = F.wave >> 2, wg = F.wave & 3;
    LAS unsigned char* L = F.lds + grp * 65536;
    const int gt0 = F.tid & 255, st0 = gt0 >> 3, c80 = gt0 & 7;
    __syncthreads();
    for (int i = gt0; i < D; i += 256) { *(LAS float*)(L + O_PK + i * 4) = k_k[i]; *(LAS float*)(L + O_PK + 4096 + i * 4) = k_a[i]; }
    constexpr int NIT = (NBATCH * NH * NCHK) / (2 * 256);
    v4u pre_r, pre_k, pre_a, pre_v; f32x4 pre_l0, pre_l1;
#define CP_LOAD(it_) do { const int item_ = ((it_) * F.G + F.vcu) * 2 + grp, bh_ = item_ >> 7, ck_ = item_ & (NCHK - 1); \
        const size_t o_ = ((size_t)(bh_ >> 4) * SEQ + ck_ * SC + st0) * D + (bh_ & 15) * HD + 8 * c80; \
        pre_r = *(const v4u*)(rb + o_); pre_k = *(const v4u*)(kb + o_); pre_a = *(const v4u*)(ab + o_); pre_v = *(const v4u*)(vbuf + o_); pre_l0 = *(const f32x4*)(lw + o_); pre_l1 = *(const f32x4*)(lw + o_ + 4); } while (0)
    CP_LOAD(0);
    for (int it = 0; it < NIT; ++it) {
        const int item = (it * F.G + F.vcu) * 2 + grp, bh = item >> 7, ck = item & (NCHK - 1), b = bh >> 4, h = bh & 15, t0 = ck * SC;
        const size_t base = ((size_t)b * SEQ + t0) * D + h * HD;
        int lane_i = F.lane; asm volatile("" : "+v"(lane_i));
        const int gt = (wg << 6) | lane_i, qi = lane_i & 15, g = lane_i >> 4, st = gt >> 3, c8 = gt & 7;
        __syncthreads();
        float r8[8], al8[8], be8[8], kh8[8], v8[8];
        { const v4u wr_ = pre_r, wk = pre_k, wa = pre_a, wv = pre_v;
          f32x4 l0 = pre_l0, l1 = pre_l1;
#pragma unroll
          for (int j = 0; j < 4; ++j) { { const float z = l0[j]; l0[j] = -fast_exp(fminf(z, 0.0f) - __logf(1.0f + fast_exp(-fabsf(z))) - 0.5f); } { const float z = l1[j]; l1[j] = -fast_exp(fminf(z, 0.0f) - __logf(1.0f + fast_exp(-fabsf(z))) - 0.5f); } }
          const f32x4 kk0 = *(const LAS f32x4*)(L + O_PK + (h * HD + 8 * c8) * 4), kk1 = *(const LAS f32x4*)(L + O_PK + (h * HD + 8 * c8 + 4) * 4), ka0 = *(const LAS f32x4*)(L + O_PK + 4096 + (h * HD + 8 * c8) * 4), ka1 = *(const LAS f32x4*)(L + O_PK + 4096 + (h * HD + 8 * c8 + 4) * 4);
          float k8[8], a8[8], kk8[8]; float ss = 0.f;
#pragma unroll
          for (int j = 0; j < 8; ++j) { const unsigned xr = wr_[j >> 1], xk = wk[j >> 1], xa = wa[j >> 1], xv = wv[j >> 1];
              r8[j] = (j & 1) ? bfhi(xr) : bflo(xr); k8[j] = (j & 1) ? bfhi(xk) : bflo(xk); a8[j] = (j & 1) ? bfhi(xa) : bflo(xa); v8[j] = (j & 1) ? bfhi(xv) : bflo(xv);
              kk8[j] = k8[j] * (j < 4 ? kk0[j & 3] : kk1[j & 3]); ss += kk8[j] * kk8[j]; }
          ss = reduce8(ss); const float inv = 1.0f / fmaxf(sqrtf(ss), 1e-12f);
#pragma unroll
          for (int j = 0; j < 8; ++j) { const float kk = kk8[j] * inv; al8[j] = -kk; be8[j] = kk * a8[j]; kh8[j] = k8[j] * (1.0f + (a8[j] - 1.0f) * (j < 4 ? ka0[j & 3] : ka1[j & 3])); }
          *(LAS f32x4*)(L + O_CL + (st * 64 + 8 * c8) * 4) = l0; *(LAS f32x4*)(L + O_CL + (st * 64 + 8 * c8 + 4) * 4) = l1; }
        __syncthreads();
#if DRYCUT == 5
        if (dry) continue;
#endif
        if (gt < 64) { float cv[SC];
#pragma unroll
            for (int t = 0; t < SC; ++t) cv[t] = *(const LAS float*)(L + O_CL + (t * 64 + gt) * 4);
#pragma unroll
            for (int t = 1; t < SC; ++t) cv[t] += cv[t - 1];
#pragma unroll
            for (int t = 0; t < SC; ++t) *(LAS float*)(L + O_CL + (t * 64 + gt) * 4) = cv[t];
            *(LAS float*)(L + O_WC + gt * 4) = fast_exp(cv[SC - 1]); }
        __syncthreads();
#if DRYCUT == 6
        if (dry) continue;
#endif
        { float cl[8], cm[8];
          { const f32x4 c0 = *(const LAS f32x4*)(L + O_CL + (st * 64 + 8 * c8) * 4), c1 = *(const LAS f32x4*)(L + O_CL + (st * 64 + 8 * c8 + 4) * 4);
            f32x4 m0 = {0.f, 0.f, 0.f, 0.f}, m1 = {0.f, 0.f, 0.f, 0.f};
            if (st > 0) { m0 = *(const LAS f32x4*)(L + O_CL + ((st - 1) * 64 + 8 * c8) * 4); m1 = *(const LAS f32x4*)(L + O_CL + ((st - 1) * 64 + 8 * c8 + 4) * 4); }
#pragma unroll
            for (int j = 0; j < 4; ++j) { cl[j] = c0[j]; cl[4 + j] = c1[j]; cm[j] = m0[j]; cm[4 + j] = m1[j]; } }
          float at8[8], bt8[8], kt8[8], rt8[8];
#pragma unroll
          for (int j = 0; j < 8; ++j) { const float e1 = fast_exp(cl[j]), em = fast_exp(cm[j]), en = fast_exp(-cl[j]); at8[j] = al8[j] * em; bt8[j] = be8[j] * en; kt8[j] = kh8[j] * en; rt8[j] = r8[j] * e1; }
          v4u w; w.x = cvt_pk_bf16(at8[0], at8[1]); w.y = cvt_pk_bf16(at8[2], at8[3]); w.z = cvt_pk_bf16(at8[4], at8[5]); w.w = cvt_pk_bf16(at8[6], at8[7]); *(LAS v4u*)(L + O_AT + st * RS + 16 * c8) = w;
          w.x = cvt_pk_bf16(bt8[0], bt8[1]); w.y = cvt_pk_bf16(bt8[2], bt8[3]); w.z = cvt_pk_bf16(bt8[4], bt8[5]); w.w = cvt_pk_bf16(bt8[6], bt8[7]); *(LAS v4u*)(L + O_BT + st * RS + 16 * c8) = w;
          w.x = cvt_pk_bf16(kt8[0], kt8[1]); w.y = cvt_pk_bf16(kt8[2], kt8[3]); w.z = cvt_pk_bf16(kt8[4], kt8[5]); w.w = cvt_pk_bf16(kt8[6], kt8[7]); *(LAS v4u*)(L + O_KT + st * RS + 16 * c8) = w;
          w.x = cvt_pk_bf16(rt8[0], rt8[1]); w.y = cvt_pk_bf16(rt8[2], rt8[3]); w.z = cvt_pk_bf16(rt8[4], rt8[5]); w.w = cvt_pk_bf16(rt8[6], rt8[7]); *(LAS v4u*)(L + O_RT + st * RS + 16 * c8) = w;
          w.x = cvt_pk_bf16(v8[0], v8[1]); w.y = cvt_pk_bf16(v8[2], v8[3]); w.z = cvt_pk_bf16(v8[4], v8[5]); w.w = cvt_pk_bf16(v8[6], v8[7]); *(LAS v4u*)(L + O_VT + st * RS + 16 * c8) = w; }
        __syncthreads();
#if DRYCUT == 1
        if (dry) continue;
#endif
        { const int mt = wg >> 1, nt = wg & 1, n = 16 * nt + qi, m0 = 16 * mt + 4 * g; const f32x4 z = {0.f, 0.f, 0.f, 0.f};
          f32x4 c1 = mm_tile<2>(L + O_AT, RS, 16 * mt, L + O_BT, RS, 16 * nt, z, qi, g);
#pragma unroll
          for (int r = 0; r < 4; ++r) c1[r] = (n < m0 + r) ? c1[r] : 0.f;
          *(LAS f32x4*)(L + O_NAB + n * 144 + m0 * 4) = c1;
          f32x4 c2 = mm_tile<2>(L + O_BT, RS, 16 * mt, L + O_RT, RS, 16 * nt, z, qi, g);
#pragma unroll
          for (int r = 0; r < 4; ++r) c2[r] = (m0 + r <= n) ? c2[r] : 0.f;
          *(LAS v2u*)(L + O_NRBT + n * TS_ + m0 * 2) = pack4(c2);
          f32x4 c3 = mm_tile<2>(L + O_AT, RS, 16 * mt, L + O_KT, RS, 16 * nt, z, qi, g);
#pragma unroll
          for (int r = 0; r < 4; ++r) c3[r] = (n < m0 + r) ? c3[r] : 0.f;
          *(LAS v2u*)(L + O_NAK + n * TS_ + m0 * 2) = pack4(c3); }
        __syncthreads();
#if DRYCUT == 2
        if (dry) continue;
#endif
        if (wg == 0) { const int col = lane_i & 31; float x[SC];
#pragma unroll
            for (int s = SC - 1; s >= 0; --s) { float ac[4] = {(col == s) ? 1.0f : 0.0f, 0.f, 0.f, 0.f};
#pragma unroll
                for (int q4 = SC / 4 - 1; q4 >= (s + 1) >> 2; --q4) { const f32x4 nv = *(const LAS f32x4*)(L + O_NAB + s * 144 + q4 * 16);
#pragma unroll
                    for (int r = 3; r >= 0; --r) { const int t = 4 * q4 + r; if (t > s) ac[r] += nv[r] * x[t]; } }
                x[s] = (ac[0] + ac[1]) + (ac[2] + ac[3]); }
            if (lane_i < 32) {
#pragma unroll
                for (int s = 0; s < SC; ++s) *(LAS bf16*)(L + O_TM + s * TS_ + col * 2) = (bf16)(cvt_pk_bf16(x[s], 0.f) & 0xffffu); } }
        __syncthreads();
#if DRYCUT == 3
        if (dry) continue;
#endif
        { const f32x4 z = {0.f, 0.f, 0.f, 0.f};
          { const int mt = wg >> 1, nt = wg & 1; const f32x4 c = mm_tile<1>(L + O_TM, TS_, 16 * mt, L + O_NRBT, TS_, 16 * nt, z, qi, g); *(LAS v2u*)(L + O_X1T + (16 * nt + qi) * TS_ + (16 * mt + 4 * g) * 2) = pack4(c); }
#pragma unroll
          for (int q = 0; q < 2; ++q) { const int tix = wg * 2 + q, mt = tix >> 2, nt = tix & 3; const f32x4 c = mm_tile_yt<1>(L + O_TM, TS_, 16 * mt, L + O_BT, RS, 16 * nt, z, qi, g);
              *(LAS v2u*)(L + O_X2T + (16 * nt + qi) * TS_ + (16 * mt + 4 * g) * 2) = pack4(c); } }
        if (it + 1 < NIT) CP_LOAD(it + 1);
        __syncthreads();
        { const size_t cid = (size_t)bh * NCHK + ck;
#pragma unroll
          for (int q = 0; q < 2; ++q) { const int tix = wg * 2 + q, mt = tix >> 1, nt = tix & 1, t = 16 * nt + qi; const v2u rw = *(const LAS v2u*)(L + O_RT + t * RS + (16 * mt + 4 * g) * 2);
              f32x4 c = {bflo(rw.x), bfhi(rw.x), bflo(rw.y), bfhi(rw.y)}; c = mm_tile_xt<1>(L + O_AT, RS, 16 * mt, L + O_X1T, TS_, 16 * nt, c, qi, g);
              *(v2u*)(QTg + (cid * SC + t) * 64 + 16 * mt + 4 * g) = pack4(c); }
          { const int mt = wg >> 1, nt = wg & 1, n = 16 * nt + qi, m0 = 16 * mt + 4 * g; f32x4 c = mm_tile<2>(L + O_KT, RS, 16 * mt, L + O_RT, RS, 16 * nt, (f32x4){0.f, 0.f, 0.f, 0.f}, qi, g);
#pragma unroll
            for (int r = 0; r < 4; ++r) c[r] = (m0 + r <= n) ? c[r] : 0.f;
            c = mm_tile<1>(L + O_NAK, TS_, 16 * mt, L + O_X1T, TS_, 16 * nt, c, qi, g); *(LAS v2u*)(L + O_HT + n * TS_ + m0 * 2) = pack4(c); }
#pragma unroll
          for (int q = 0; q < 4; ++q) { const int mt = wg, nt = q, k = 16 * nt + qi, m0 = 16 * mt + 4 * g; f32x4 c = mm_tile_xt<1>(L + O_AT, RS, 16 * mt, L + O_X2T, TS_, 16 * nt, (f32x4){0.f, 0.f, 0.f, 0.f}, qi, g);
              const float wc = *(const LAS float*)(L + O_WC + k * 4);
#pragma unroll
              for (int r = 0; r < 4; ++r) c[r] = (c[r] + ((m0 + r == k) ? 1.0f : 0.0f)) * wc;
              *(v2u*)(PTg + (cid * 64 + k) * 64 + 16 * mt + 4 * g) = pack4(c); }
#pragma unroll
          for (int q = 0; q < 2; ++q) { const int tix = wg * 2 + q, mt = tix >> 2, nt = tix & 3, k = 16 * nt + qi, m0 = 16 * mt + 4 * g; f32x4 c;
#pragma unroll
              for (int r = 0; r < 4; ++r) c[r] = bf1(*(const LAS bf16*)(L + O_KT + (m0 + r) * RS + k * 2));
              c = mm_tile<1>(L + O_NAK, TS_, 16 * mt, L + O_X2T, TS_, 16 * nt, c, qi, g); const float wc = *(const LAS float*)(L + O_WC + k * 4);
              *(LAS v2u*)(L + O_GT + k * TS_ + m0 * 2) = pack4(c * wc); } }
        __syncthreads();
#if DRYCUT == 4
        if (dry) continue;
#endif
        { const size_t cid = (size_t)bh * NCHK + ck; const f32x4 z = {0.f, 0.f, 0.f, 0.f};
#pragma unroll
          for (int q = 0; q < 4; ++q) { const int mt = q, nt = wg; const f32x4 c = mm_tile_yt<1>(L + O_GT, TS_, 16 * mt, L + O_VT, RS, 16 * nt, z, qi, g);
              *(v2u*)(LTg + (((cid * 4 + nt) * 4 + mt) * 64 + lane_i) * 4) = pack4(c); }
#pragma unroll
          for (int q = 0; q < 2; ++q) { const int mt = q, nt = wg; const f32x4 c = mm_tile_yt<1>(L + O_HT, TS_, 16 * mt, L + O_VT, RS, 16 * nt, z, qi, g);
#pragma unroll
              for (int r = 0; r < 4; ++r) if (!dry) ys[base + (size_t)(16 * mt + 4 * g + r) * D + 16 * nt + qi] = c[r]; } }
    }
#undef CP_LOAD
    __syncthreads();
}
__device__ __forceinline__ void chunk_scan(Frame& F, const bool dry = false) {
    const bf16* PTg = (const bf16*)(F.ws + WS_PT); const bf16* QTg = (const bf16*)(F.ws + WS_QT); const bf16* LTg = (const bf16*)(F.ws + WS_LT); float* ys = (float*)(F.ws + WS_YS2);
    const int qi = F.lane & 15, g = F.lane >> 4, w = F.wave & 3, ty = w & 1, vy0 = 2 * (w >> 1);
    constexpr int SRS = 144, SBUF = 64 * SRS;
    LAS unsigned char* SL = F.lds;
    for (int bh = F.vcu; bh < NBATCH * NH; bh += F.G) {
        const int b = bh >> 4, h = bh & 15;
        __syncthreads();
        if (F.wave >= 4) { __syncthreads();
            for (int ck = 0; ck < NCHK; ++ck) asm volatile("s_barrier" ::: "memory");
            continue; }
        unsigned z_ = 0u; asm volatile("" : "+v"(z_));
        for (int i = F.lane; i < 16 * 64 / 8; i += 64) *(LAS v4u*)(SL + (16 * w + (i >> 3)) * SRS + (i & 7) * 16) = (v4u){z_, z_, z_, z_};
        __syncthreads();
        v4u pa0[2], qa0[2], pa1[2], qa1[2], pa2[2], qa2[2], pa3[2], qa3[2]; v2u lt0[4], lt1[4], lt2[4], lt3[4]; float yl0[2][4], yl1[2][4], yl2[2][4], yl3[2][4];
#define CS_LOAD(pa, qa, lt, yl, ck_) do { const size_t cid = (size_t)bh * NCHK + (ck_); \
        _Pragma("unroll") for (int ks = 0; ks < 2; ++ks) { pa[ks] = *(const v4u*)(PTg + (cid * 64 + 16 * w + qi) * 64 + 32 * ks + 8 * g); qa[ks] = *(const v4u*)(QTg + (cid * SC + 16 * ty + qi) * 64 + 32 * ks + 8 * g); } \
        _Pragma("unroll") for (int nt = 0; nt < 4; ++nt) lt[nt] = *(const v2u*)(LTg + (((cid * 4 + nt) * 4 + w) * 64 + F.lane) * 4); \
        _Pragma("unroll") for (int i_ = 0; i_ < 2; ++i_) { _Pragma("unroll") for (int r = 0; r < 4; ++r) yl[i_][r] = ys[((size_t)b * SEQ + (ck_) * SC + 16 * ty + 4 * g + r) * D + h * HD + 16 * (vy0 + i_) + qi]; } } while (0)
#define CS_STEP(pa, qa, lt, yl, ck_) do { const LAS unsigned char* Sc = SL + ((ck_) & 1) * SBUF; LAS unsigned char* Sn = SL + (((ck_) + 1) & 1) * SBUF; \
        bf16x8 bfr[4][2]; \
        _Pragma("unroll") for (int nt = 0; nt < 4; ++nt) { _Pragma("unroll") for (int ks = 0; ks < 2; ++ks) bfr[nt][ks] = *(const LAS bf16x8*)(Sc + (16 * nt + qi) * SRS + 64 * ks + 16 * g); } \
        f32x4 y_[2]; \
        _Pragma("unroll") for (int i_ = 0; i_ < 2; ++i_) { y_[i_] = (f32x4){yl[i_][0], yl[i_][1], yl[i_][2], yl[i_][3]}; \
            _Pragma("unroll") for (int ks = 0; ks < 2; ++ks) { const bf16x8 by_ = *(const LAS bf16x8*)(Sc + (16 * (vy0 + i_) + qi) * SRS + 64 * ks + 16 * g);     \
                y_[i_] = __builtin_amdgcn_mfma_f32_16x16x32_bf16(__builtin_bit_cast(bf16x8, qa[ks]), by_, y_[i_], 0, 0, 0); } } \
        _Pragma("unroll") for (int nt = 0; nt < 4; ++nt) { f32x4 sn = {bflo(lt[nt].x), bfhi(lt[nt].x), bflo(lt[nt].y), bfhi(lt[nt].y)}; \
            _Pragma("unroll") for (int ks = 0; ks < 2; ++ks) sn = __builtin_amdgcn_mfma_f32_16x16x32_bf16(__builtin_bit_cast(bf16x8, pa[ks]), bfr[nt][ks], sn, 0, 0, 0); \
            *(LAS v2u*)(Sn + (16 * nt + qi) * SRS + (16 * w + 4 * g) * 2) = pack4(sn); } \
        __builtin_amdgcn_sched_barrier(0); \
        if ((ck_) + 4 < NCHK && !(DRYCUT == 7 && dry)) CS_LOAD(pa, qa, lt, yl, (ck_) + 4); \
        __builtin_amdgcn_sched_barrier(0);              \
        _Pragma("unroll") for (int i_ = 0; i_ < 2; ++i_) { _Pragma("unroll") for (int r = 0; r < 4; ++r) { if (!dry) ys[((size_t)b * SEQ + (ck_) * SC + 16 * ty + 4 * g + r) * D + h * HD + 16 * (vy0 + i_) + qi] = y_[i_][r]; } } \
        asm volatile("s_waitcnt lgkmcnt(0)\n\ts_barrier" ::: "memory");        \
        __builtin_amdgcn_sched_barrier(0); } while (0)
        CS_LOAD(pa0, qa0, lt0, yl0, 0); CS_LOAD(pa1, qa1, lt1, yl1, 1); CS_LOAD(pa2, qa2, lt2, yl2, 2); CS_LOAD(pa3, qa3, lt3, yl3, 3);
#pragma unroll 4
        for (int ck = 0; ck < NCHK; ck += 4) { CS_STEP(pa0, qa0, lt0, yl0, ck); CS_STEP(pa1, qa1, lt1, yl1, ck + 1); CS_STEP(pa2, qa2, lt2, yl2, ck + 2); CS_STEP(pa3, qa3, lt3, yl3, ck + 3); }
#undef CS_STEP
#undef CS_LOAD
    }
    __syncthreads();
}
__device__ __forceinline__ void post_phase(Frame& F, const bf16* vbuf, const float* k_a, const float* r_k, const float* gn_g, const float* gn_b) {
    const bf16* rb = (const bf16*)(F.ws + WS_R); const bf16* kb = (const bf16*)(F.ws + WS_KK); const bf16* ab = (const bf16*)(F.ws + WS_A); const bf16* gb = (const bf16*)(F.ws + WS_G);
    const float* ys = (const float*)(F.ws + WS_YS2); bf16* yg = (bf16*)(F.ws + WS_YG);
    f32x4 kav[2][2], rkv[2][2], gg[2][2], gbv[2][2];
#pragma unroll
    for (int jh = 0; jh < 2; ++jh)
#pragma unroll
        for (int q = 0; q < 2; ++q) { const int cc = 512 * jh + 8 * F.lane + 4 * q; kav[jh][q] = *(const f32x4*)(k_a + cc); rkv[jh][q] = *(const f32x4*)(r_k + cc); gg[jh][q] = *(const f32x4*)(gn_g + cc); gbv[jh][q] = *(const f32x4*)(gn_b + cc); }
    for (int row = F.gw; row < T; row += F.NGW) {
        f32x4 y[2][2]; v4u wr_[2], wk[2], wa[2], wv[2], wg[2];
#pragma unroll
        for (int jh = 0; jh < 2; ++jh) { const size_t o = (size_t)row * D + 512 * jh + 8 * F.lane;
            y[jh][0] = *(const f32x4*)(ys + o); y[jh][1] = *(const f32x4*)(ys + o + 4); wr_[jh] = *(const v4u*)(rb + o); wk[jh] = *(const v4u*)(kb + o); wa[jh] = *(const v4u*)(ab + o); wv[jh] = *(const v4u*)(vbuf + o); wg[jh] = *(const v4u*)(gb + o); }
#pragma unroll
        for (int jh = 0; jh < 2; ++jh) { const size_t o = (size_t)row * D + 512 * jh + 8 * F.lane; v4u w;
            const f32x4 y0 = y[jh][0], y1 = y[jh][1];
            const float mean = reduce8(((y0[0] + y0[1]) + (y0[2] + y0[3])) + ((y1[0] + y1[1]) + (y1[2] + y1[3]))) * (1.0f / HD); const f32x4 dy0 = y0 - mean, dy1 = y1 - mean;
            const float var = reduce8(((dy0[0] * dy0[0] + dy0[1] * dy0[1]) + (dy0[2] * dy0[2] + dy0[3] * dy0[3])) + ((dy1[0] * dy1[0] + dy1[1] * dy1[1]) + (dy1[2] * dy1[2] + dy1[3] * dy1[3]))) * (1.0f / HD);
            const float rstd = 1.0f / sqrtf(var + GN_EPS);
            f32x4 pr[2], v4[2], g4[2];
#pragma unroll
            for (int q = 0; q < 2; ++q) { const unsigned r0 = q ? wr_[jh].z : wr_[jh].x, r1 = q ? wr_[jh].w : wr_[jh].y, k0 = q ? wk[jh].z : wk[jh].x, k1 = q ? wk[jh].w : wk[jh].y, a0 = q ? wa[jh].z : wa[jh].x, a1 = q ? wa[jh].w : wa[jh].y;
                const unsigned v0 = q ? wv[jh].z : wv[jh].x, v1 = q ? wv[jh].w : wv[jh].y, g0 = q ? wg[jh].z : wg[jh].x, g1 = q ? wg[jh].w : wg[jh].y;
                const f32x4 r4 = {bflo(r0), bfhi(r0), bflo(r1), bfhi(r1)}, k4 = {bflo(k0), bfhi(k0), bflo(k1), bfhi(k1)}, a4 = {bflo(a0), bfhi(a0), bflo(a1), bfhi(a1)};
                v4[q] = (f32x4){bflo(v0), bfhi(v0), bflo(v1), bfhi(v1)}; g4[q] = (f32x4){bflo(g0), bfhi(g0), bflo(g1), bfhi(g1)};
                const f32x4 kh = k4 * (1.0f + (a4 - 1.0f) * kav[jh][q]); pr[q] = r4 * kh * rkv[jh][q]; }
            const float rk = reduce8(((pr[0][0] + pr[0][1]) + (pr[0][2] + pr[0][3])) + ((pr[1][0] + pr[1][1]) + (pr[1][2] + pr[1][3])));
            const f32x4 res0 = (dy0 * rstd * gg[jh][0] + gbv[jh][0] + v4[0] * rk) * g4[0], res1 = (dy1 * rstd * gg[jh][1] + gbv[jh][1] + v4[1] * rk) * g4[1];
            w.x = cvt_pk_bf16(res0[0], res0[1]); w.y = cvt_pk_bf16(res0[2], res0[3]); w.z = cvt_pk_bf16(res1[0], res1[1]); w.w = cvt_pk_bf16(res1[2], res1[3]); *(v4u*)(yg + o) = w; }
    }
}

__global__ void __launch_bounds__(NTHREADS, 2) fwd_kernel(Args args) {
    extern __shared__ __attribute__((aligned(16))) unsigned char lds_raw[];
    Frame F;
    F.lds = (LAS unsigned char*)lds_raw; F.ws = args.ws; F.out = args.out; F.ctl = (gu32*)(args.ws + WS_CTL);
    F.tid = 0; F.lane = 0; F.wave = __builtin_amdgcn_readfirstlane((int)threadIdx.x >> 6);
    F.G = gridDim.x; { const int bx = blockIdx.x; F.vcu = (F.G % 8 == 0) ? (bx % 8) * (F.G / 8) + bx / 8 : bx; }
    F.gw = F.vcu * NWAVES + F.wave; F.NGW = F.G * NWAVES;
    for (int i = threadIdx.x; i < (LDS_BYTES - MISC_OFF) / 4; i += NTHREADS) ((LAS unsigned*)(F.lds + MISC_OFF))[i] = 0u;
    __syncthreads();
    XcdBarrier bar = xcd_barrier_post((unsigned*)(F.ctl + CW_BAR), (volatile LAS unsigned*)(F.lds + MISC_OFF) + 8);
#define GRID_BAR() xcd_barrier(bar)
    if (threadIdx.x < 35) ((LAS unsigned long long*)(F.lds + PTAB_OFF))[threadIdx.x] = (unsigned long long)args.in[threadIdx.x];
    __syncthreads();
#define IN(k) in_ptr(F, (k))
    unsigned char* ws = args.ws;
    MoeTab MT; MT.cnt = (const LAS int*)(F.lds + TAB_OFF); MT.mtpref = MT.cnt + 65; MT.hoff = MT.mtpref + 66;

#if EN_P0
    { Frame P = phase_frame(F);
    ln_phase<2>(P, IN(0), nullptr, nullptr, false, MT);
    for (int j = 0; j < 2; ++j) {
        convert_plain(P, IN(1) + (size_t)j * D * 3 * D, D, 3 * D, (bf16*)(ws + WS_WQKV) + (size_t)j * 3 * D * D, 0);
        convert_plain(P, IN(2) + (size_t)j * D * D, D, D, (bf16*)(ws + WS_WOA) + (size_t)j * D * D, 0);
        for (int s = 0; s < 3; ++s) convert_plain(P, IN(5) + ((size_t)j * 3 + s) * D * D, D, D, (bf16*)(ws + WS_WRKV) + (size_t)j * 3 * D * D, s * D);
        convert_plain(P, IN(22) + (size_t)j * D * D, D, D, (bf16*)(ws + WS_WOB) + (size_t)j * D * D, 0);
        bf16* L1 = (bf16*)(ws + WS_L1) + (size_t)j * 4 * 256 * D; bf16* L2 = (bf16*)(ws + WS_L2) + (size_t)j * 4 * D * 256;
        convert_small(P, IN(7) + (size_t)j * D * 64, D, 64, L1, 256, D);
        convert_small(P, IN(10) + (size_t)j * D * 64, D, 64, L1 + 256 * D, 256, D);
        convert_small(P, IN(15) + (size_t)j * D * 160, D, 160, L1 + 2 * 256 * D, 256, D);
        convert_small(P, IN(8) + (size_t)j * 64 * D, 64, D, L2, D, 256);
        convert_small(P, IN(11) + (size_t)j * 64 * D, 64, D, L2 + D * 256, D, 256);
        convert_small(P, IN(16) + (size_t)j * 160 * D, 160, D, L2 + 2 * D * 256, D, 256);
        if (j == 1) { convert_small(P, IN(13), D, 32, L1 + 3 * 256 * D, 256, D); convert_small(P, IN(14), 32, D, L2 + 3 * D * 256, D, 256); }
    }
    for (int i = 0; i < DEPTH; ++i) convert_small(P, IN(23) + (size_t)i * D * NE, D, NE, (bf16*)(ws + WS_WR) + (size_t)i * 256 * D, 256, D);
    }
#endif
    GRID_BAR();

#define PH_BEGIN { Frame P = phase_frame(F);
#define PH_END } GRID_BAR();
    for (int i = 0; i < DEPTH; ++i) {
        const int j = i >> 1;
        if ((i & 1) == 0) {
            PH_BEGIN
#if EN_QKV
              SchedDense S{T / 256, 12, P.G, (int)blockIdx.x, D, (const char*)(ws + WS_XB), (const char*)(ws + WS_WQKV) + (size_t)j * 3 * D * D * 2};
              EpiQKV E{(bf16*)(ws + WS_Q), (bf16*)(ws + WS_K), (bf16*)(ws + WS_VT)};
              _Pragma("nounroll") for (int rep = 0; rep < REP_QKV; ++rep) pg8::gemm_phase<D>(P.lds, P.tid, S, E);
#endif
            PH_END
            PH_BEGIN
#if EN_KMEAN
            kmean_phase(P);
#endif
            PH_END
            PH_BEGIN
#if EN_SEL
            sel_phase(P);
#endif
            PH_END
#if REP_ATTN > 1
            PH_BEGIN
            attn_phase<ATTN_PROBE>(P, IN(3));
            PH_END
#endif
            PH_BEGIN
#if EN_ATTN
            attn_phase<0>(P, IN(3));
#endif
            PH_END
            PH_BEGIN
#if EN_OPA
              SchedDense S{T / 256, 4, P.G, (int)blockIdx.x, D, (const char*)(ws + WS_O), (const char*)(ws + WS_WOA) + (size_t)j * D * D * 2};
              EpiAdd E{P.out};
              pg8::gemm_phase<D>(P.lds, P.tid, S, E);
#endif
            PH_END
        } else {
            const size_t voff = (j == 0 ? WS_VF : WS_V);
            PH_BEGIN
#if EN_MIX
            for (int rep = 0; rep < REP_MIX; ++rep) mix_phase(P, IN(4) + (size_t)j * 6 * D);
#endif
            PH_END
            PH_BEGIN
#if EN_RKV
              SchedRkv S{T / 256, j == 0 ? 15 : 16, P.G, (int)blockIdx.x, (const char*)(ws + WS_XMIX), (const char*)(ws + WS_WRKV) + (size_t)j * 3 * D * D * 2, (const char*)(ws + WS_L1) + (size_t)j * 4 * 256 * D * 2};
              EpiRkv E{ws, voff};
              pg8::gemm_phase<D>(P.lds, P.tid, S, E);
#endif
            PH_END
            PH_BEGIN
#if EN_L2
              SchedL2 S{T / 256, j == 0 ? 12 : 16, P.G, (int)blockIdx.x, (const char*)(ws + WS_HL), (const char*)(ws + WS_L2) + (size_t)j * 4 * D * 256 * 2};
              EpiL2 E{(float*)(ws + WS_LW), (bf16*)(ws + WS_A), (bf16*)(ws + WS_G), (bf16*)(ws + voff), (const bf16*)(ws + WS_VF), IN(6) + j * D, IN(9) + j * D, IN(12)};
              pg8::gemm_phase<256>(P.lds, P.tid, S, E);
#endif
            PH_END
            PH_BEGIN
#if EN_SCAN
            for (int rep = 0; rep < REP_SCAN; ++rep) chunk_prep(P, (const bf16*)(ws + voff), IN(17) + j * D, IN(18) + j * D, rep + 1 < REP_SCAN);
#endif
            PH_END
            PH_BEGIN
#if EN_SCANB
            for (int rep = 0; rep < REP_SCANB; ++rep) chunk_scan(P, rep + 1 < REP_SCANB);
#endif
            PH_END
            PH_BEGIN
#if EN_POST
#ifdef DBG_POST_COPY
            { const v4u* s_ = (const v4u*)(ws + WS_A); v4u* d_ = (v4u*)(ws + WS_YG); for (size_t q = (size_t)P.gw * 64 + P.lane; q < (size_t)T * D / 8; q += (size_t)P.NGW * 64) d_[q] = s_[q]; }
#else
            post_phase(P, (const bf16*)(ws + voff), IN(18) + j * D, IN(19) + j * D, IN(20) + j * D, IN(21) + j * D);
#endif
#endif
            PH_END
            PH_BEGIN
#if EN_OPB
              SchedDense S{T / 256, 4, P.G, (int)blockIdx.x, D, (const char*)(ws + WS_YG), (const char*)(ws + WS_WOB) + (size_t)j * D * D * 2};
              EpiAdd E{P.out};
              pg8::gemm_phase<D>(P.lds, P.tid, S, E);
#endif
            PH_END
        }
        PH_BEGIN
#if EN_LN1
        ln1_route_phase(P, IN(31) + i * D, IN(32) + i * D, i, IN(24) + i * NE);
#endif
#if EN_CVT
        for (int rep = 0; rep < REP_CVT; ++rep) convert_moe(P, IN(25) + (size_t)i * NE * D * DE, IN(26) + (size_t)i * NE * D * DE, IN(27) + (size_t)i * NE * DE * D, IN(28) + (size_t)i * D * DE, IN(29) + (size_t)i * D * DE, IN(30) + (size_t)i * DE * D);
#endif
        PH_END
        PH_BEGIN
        moe_tables(P, i);
#if EN_G1
          SchedMoe1 S{P.G, P.vcu, MT, (const char*)(ws + WS_XB), (const char*)(ws + WS_WGU), (const int*)(ws + WS_TOKLIST), 0};
          _Pragma("nounroll") for (int rep = 0; rep < REP_G1; ++rep) { EpiSwiglu E{(bf16*)(ws + WS_H), rep + 1 < REP_G1}; pg8::gemm_phase<D>(P.lds, P.tid, S, E); }
#endif
        PH_END
        PH_BEGIN
#if EN_G2
          SchedMoe2 S{P.G, P.vcu, MT, (const char*)(ws + WS_H), (const char*)(ws + WS_WD), 0};
          _Pragma("nounroll") for (int rep = 0; rep < REP_G2; ++rep) { EpiMoeDown E{(bf16*)(ws + WS_Y), P.out, rep + 1 < REP_G2}; pg8::gemm_phase<DE>(P.lds, P.tid, S, E); }
#endif
        PH_END
        { Frame P = phase_frame(F);
#if EN_LN2
        ln2_phase(P, IN(33) + i * D, IN(34) + i * D, i == DEPTH - 1, MT);
#endif
        }
        if (i + 1 < DEPTH) GRID_BAR();
    }
#undef IN
#undef GRID_BAR
}

extern "C" void kernel_launch(void* const* d_in, const int* in_sizes, int n_in, void* d_out, int out_size, void* d_ws, size_t ws_size, hipStream_t stream) {
    static int grid = 0;
    if (grid == 0) {
        if (n_in != 35 || out_size != T * D || ws_size < WS_END) { fprintf(stderr, "kernel_launch: unexpected shapes (n_in %d, out %d, ws %zu)\n", n_in, out_size, ws_size); grid = -1; return; }
        int dev = 0, cus = 0, per_cu = 0;
        if (hipGetDevice(&dev) != hipSuccess || hipDeviceGetAttribute(&cus, hipDeviceAttributeMultiprocessorCount, dev) != hipSuccess) { grid = -1; return; }
        if (hipFuncSetAttribute((const void*)fwd_kernel, hipFuncAttributeMaxDynamicSharedMemorySize, LDS_BYTES) != hipSuccess) { fprintf(stderr, "kernel_launch: hipFuncSetAttribute failed\n"); grid = -1; return; }
        if (hipOccupancyMaxActiveBlocksPerMultiprocessor(&per_cu, (const void*)fwd_kernel, NTHREADS, LDS_BYTES) != hipSuccess || per_cu < 1) { fprintf(stderr, "kernel_launch: occupancy query says %d\n", per_cu); }
        (void)hipGetLastError();
        grid = cus;
    }
    if (grid < 0) return;
    if (hipMemsetAsync((char*)d_ws + WS_CTL, 0, CTL_ZERO_BYTES, stream) != hipSuccess) return;
    Args a{};
    for (int i = 0; i < 35; ++i) a.in[i] = (const float*)d_in[i];
    a.out = (float*)d_out; a.ws = (unsigned char*)d_ws;
    hipLaunchKernelGGL(fwd_kernel, dim3(grid), dim3(NTHREADS), LDS_BYTES, stream, a);
}
```

```cpp
#include <hip/hip_runtime.h>
#include <cstdio>
#include <cstdint>

#define GAS __attribute__((address_space(1)))
#define LAS __attribute__((address_space(3)))
typedef unsigned short bf16;
typedef unsigned v4u __attribute__((ext_vector_type(4)));
typedef unsigned v2u __attribute__((ext_vector_type(2)));
typedef float f32x4 __attribute__((ext_vector_type(4)));
typedef float f32x2 __attribute__((ext_vector_type(2)));
typedef short bf16x8 __attribute__((ext_vector_type(8)));
typedef short bf16x4 __attribute__((ext_vector_type(4)));

#ifndef EN_DEFAULT
#define EN_DEFAULT 1
#endif
#ifndef REP_SCAN
#define REP_SCAN 1
#endif
#ifndef EN_SCANB
#define EN_SCANB EN_DEFAULT
#endif
#ifndef DRYCUT
#define DRYCUT 0
#endif
#ifndef REP_SCANB
#define REP_SCANB 1
#endif
#ifndef REP_ATTN
#define REP_ATTN 1
#endif
#ifndef G2_STAGGER
#define G2_STAGGER 0
#endif
#ifndef TIMING
#define TIMING 0
#endif
#ifndef TIMED_CLASS
#define TIMED_CLASS 2
#endif
#ifndef TIMED_MASK
#define TIMED_MASK 1
#endif
#ifndef TIMED_MULT
#define TIMED_MULT 16
#endif
#ifndef ATTN_PROBE
#define ATTN_PROBE 1
#endif
#ifndef REP_G1
#define REP_G1 1
#endif
#ifndef REP_G2
#define REP_G2 1
#endif
#ifndef REP_CVT
#define REP_CVT 1
#endif
#ifndef REP_MIX
#define REP_MIX 1
#endif
#ifndef REP_QKV
#define REP_QKV 1
#endif
#ifndef EN_P0
#define EN_P0 EN_DEFAULT
#endif
#ifndef EN_QKV
#define EN_QKV EN_DEFAULT
#endif
#ifndef EN_KMEAN
#define EN_KMEAN EN_DEFAULT
#endif
#ifndef EN_SEL
#define EN_SEL EN_DEFAULT
#endif
#ifndef EN_ATTN
#define EN_ATTN EN_DEFAULT
#endif
#ifndef EN_OPA
#define EN_OPA EN_DEFAULT
#endif
#ifndef EN_MIX
#define EN_MIX EN_DEFAULT
#endif
#ifndef EN_RKV
#define EN_RKV EN_DEFAULT
#endif
#ifndef EN_L2
#define EN_L2 EN_DEFAULT
#endif
#ifndef EN_SCAN
#define EN_SCAN EN_DEFAULT
#endif
#ifndef EN_POST
#define EN_POST EN_DEFAULT
#endif
#ifndef EN_OPB
#define EN_OPB EN_DEFAULT
#endif
#ifndef EN_LN1
#define EN_LN1 EN_DEFAULT
#endif
#ifndef EN_CVT
#define EN_CVT EN_DEFAULT
#endif
#ifndef EN_ROUTER
#define EN_ROUTER EN_DEFAULT
#endif
#ifndef EN_ROUTE
#define EN_ROUTE EN_DEFAULT
#endif
#ifndef EN_G1
#define EN_G1 EN_DEFAULT
#endif
#ifndef EN_G2
#define EN_G2 EN_DEFAULT
#endif
#ifndef EN_LN2
#define EN_LN2 EN_DEFAULT
#endif
constexpr int D = 1024, NBATCH = 8, SEQ = 4096, T = NBATCH * SEQ, NH = 16, HD = 64, DEPTH = 4;
constexpr int NE = 64, TOPK = 8, DE = 256, NEX = NE + 1;
constexpr int MBLK = 256, NMB = SEQ / MBLK;
constexpr float ALPHA = 1.6817928305074290f;
constexpr float LN_EPS = 1e-5f, GN_EPS = 64e-5f;
constexpr int NWAVES = 8, NTHREADS = 512;

constexpr size_t MiB = 1u << 20;
constexpr size_t WS_CTL = 0, CTL_ZERO_BYTES = 1 * MiB;
constexpr size_t WS_WR = 1 * MiB;
constexpr size_t WS_KMEAN = 3 * MiB;
constexpr size_t WS_MASK = 4 * MiB;
constexpr size_t WS_TSEL = 5 * MiB;
constexpr size_t WS_WQKV = 8 * MiB;
constexpr size_t WS_WOA = 20 * MiB;
constexpr size_t WS_WRKV = 24 * MiB;
constexpr size_t WS_WOB = 36 * MiB;
constexpr size_t WS_L1 = 40 * MiB;
constexpr size_t WS_L2 = 44 * MiB;
constexpr size_t WS_WGU = 48 * MiB;
constexpr size_t WS_WD = 113 * MiB;
constexpr size_t WS_XB = 146 * MiB;
constexpr size_t WS_VF = 210 * MiB;
constexpr size_t WS_S = 274 * MiB;
constexpr size_t WS_LOGITS = WS_S;
constexpr size_t WS_TOKLIST = WS_S + 8 * MiB;
constexpr size_t WS_H = WS_S + 16 * MiB;
constexpr size_t WS_Y = WS_S + 168 * MiB;
constexpr size_t WS_Q = WS_S, WS_K = WS_S + 64 * MiB, WS_VT = WS_S + 128 * MiB, WS_O = WS_S + 192 * MiB;
constexpr size_t WS_XMIX = WS_S;
constexpr size_t WS_R = WS_S + 384 * MiB, WS_KK = WS_S + 448 * MiB, WS_V = WS_S + 512 * MiB;
constexpr size_t WS_HL = WS_S + 576 * MiB;
constexpr size_t WS_LW = WS_S + 64 * MiB;
constexpr size_t WS_A = WS_S + 128 * MiB, WS_G = WS_S + 192 * MiB;
constexpr size_t WS_YS = WS_S + 256 * MiB;
constexpr size_t WS_YG = WS_S + 640 * MiB;
constexpr size_t WS_END = 1024 * MiB;
static_assert(WS_Y + (size_t)278528 * 2048 <= WS_END && WS_YG + 64 * MiB <= WS_END, "d_ws map");

constexpr int CW_TMO = 0;
constexpr int CW_BAR = 4096;
constexpr int CW_CNT = 8192;

constexpr int RING_BYTES = 131072;
constexpr int MISC_OFF = RING_BYTES;
constexpr int TAB_OFF = MISC_OFF + 256;
constexpr int PTAB_OFF = MISC_OFF + 2048;
constexpr int LDS_BYTES = 147456;

#define RLX_AGENT __ATOMIC_RELAXED, __HIP_MEMORY_SCOPE_AGENT
#define LDS_WAIT() asm volatile("s_waitcnt lgkmcnt(0)" ::: "memory")
#define VM_WAIT() asm volatile("s_waitcnt vmcnt(0)" ::: "memory")
typedef float f32x2_t_ __attribute__((ext_vector_type(2))); typedef __bf16 bf16x2_t_ __attribute__((ext_vector_type(2)));
__device__ __forceinline__ unsigned cvt_pk_bf16(float lo, float hi) { const f32x2_t_ v = {lo, hi}; const bf16x2_t_ b = __builtin_convertvector(v, bf16x2_t_); return __builtin_bit_cast(unsigned, b); }
__device__ __forceinline__ float bflo(unsigned w) { return __uint_as_float(w << 16); }
__device__ __forceinline__ float bfhi(unsigned w) { return __uint_as_float(w & 0xffff0000u); }
__device__ __forceinline__ float bf1(bf16 b) { return __uint_as_float(((unsigned)b) << 16); }
__device__ __forceinline__ float fast_exp(float x) { return __builtin_amdgcn_exp2f(x * 1.4426950408889634f); }
__device__ __forceinline__ float fast_rcp(float x) { return __builtin_amdgcn_rcpf(x); }
__device__ __forceinline__ float sigmoidf_(float x) { return fast_rcp(1.0f + fast_exp(-x)); }
template <int CTRL> __device__ __forceinline__ float dpp_add(float v) {
    const int t = __builtin_amdgcn_update_dpp(0, __float_as_int(v), CTRL, 0xf, 0xf, true);
    return v + __int_as_float(t);
}
template <int CTRL> __device__ __forceinline__ float dpp_max(float v) {
    const int t = __builtin_amdgcn_update_dpp(__float_as_int(v), __float_as_int(v), CTRL, 0xf, 0xf, false);
    return __builtin_fmaxf(v, __int_as_float(t));
}
__device__ __forceinline__ float reduce16(float v) {
    v = dpp_add<0xB1>(v); v = dpp_add<0x4E>(v); v = dpp_add<0x141>(v); v = dpp_add<0x140>(v);
    return v;
}
__device__ __forceinline__ float max8(float v) { v = dpp_max<0xB1>(v); v = dpp_max<0x4E>(v); v = dpp_max<0x141>(v); return v; }
__device__ __forceinline__ float q4_max(float v) {
    auto a = __builtin_amdgcn_permlane16_swap(__float_as_uint(v), __float_as_uint(v), false, false); v = __builtin_fmaxf(__uint_as_float(a[0]), __uint_as_float(a[1]));
    auto b = __builtin_amdgcn_permlane32_swap(__float_as_uint(v), __float_as_uint(v), false, false); return __builtin_fmaxf(__uint_as_float(b[0]), __uint_as_float(b[1])); }
__device__ __forceinline__ float q4_sum(float v) {
    auto a = __builtin_amdgcn_permlane16_swap(__float_as_uint(v), __float_as_uint(v), false, false); v = __uint_as_float(a[0]) + __uint_as_float(a[1]);
    auto b = __builtin_amdgcn_permlane32_swap(__float_as_uint(v), __float_as_uint(v), false, false); return __uint_as_float(b[0]) + __uint_as_float(b[1]); }
__device__ __forceinline__ float wave_sum(float v) { return q4_sum(reduce16(v)); }
__device__ __forceinline__ float wave_max(float v) { return q4_max(dpp_max<0x140>(max8(v))); }
__device__ const unsigned char T5_BUCKET[129] = {
    0, 1, 2, 3, 4, 5, 6, 7, 8, 9, 10, 11, 12, 13, 14, 15, 16, 16, 16, 17, 17, 18, 18, 18, 19, 19, 19, 20, 20, 20, 20, 21, 21, 21, 21, 22, 22, 22, 22, 22, 23, 23, 23, 23, 23, 23, 24, 24, 24,
    24, 24, 24, 25, 25, 25, 25, 25, 25, 25, 26, 26, 26, 26, 26, 26, 26, 26, 27, 27, 27, 27, 27, 27, 27, 27, 27, 27, 28, 28, 28, 28, 28, 28, 28, 28, 28, 28, 29, 29, 29, 29, 29, 29, 29, 29, 29, 29,
    29, 29, 30, 30, 30, 30, 30, 30, 30, 30, 30, 30, 30, 30, 30, 30, 31, 31, 31, 31, 31, 31, 31, 31, 31, 31, 31, 31, 31, 31, 31, 31};

namespace pg8 {
constexpr int BM = 256, BK = 64, HALF = 128, HTB = HALF * BK * 2, STAGE_BYTES = 8 * HTB, NXCD = 8, WGM = 8;
__host__ __device__ __forceinline__ int lds_byte(int r, int c) { const int st = (r >> 4) * 2 + (c >> 5), rr = r & 15, cc = c & 31, ob = rr * 64 + cc * 2; return st * 1024 + (ob ^ (((ob >> 9) & 1) << 5)); }
__host__ __device__ __forceinline__ void stage_rc(int b, int& R, int& C) { const int st = b / 1024, sb = b % 1024, swz = sb ^ (((sb >> 9) & 1) << 5); R = (st >> 1) * 16 + swz / 64; C = (st & 1) * 32 + (swz % 64) / 2; }
__host__ __device__ __forceinline__ int perm32(int rho) { const int n = rho >> 4, i = rho & 15; return 8 * (i >> 2) + 4 * n + (i & 3); }

struct Unit { int pm, pn, e, nvalid, arow0, orow0; const int* gidx; };

__device__ __forceinline__ bool static_tile(int i, int G, int c, int nM, int nN, int& pm, int& pn) {
    const int nwg = nM * nN; const long L = (long)i * G + c; if (L >= nwg) return false;
    int wgid = (int)L;
    if (((nwg | nM) & 7) == 0) {
        wgid = (wgid & 7) * (nwg >> 3) + (wgid >> 3); const int nig = WGM * nN, gid = wgid / nig, r = wgid - gid * nig; pm = gid * WGM + (r & 7); pn = r >> 3; return true; }
    { const int q = nwg / NXCD, r = nwg % NXCD, xcd = wgid % NXCD, off = wgid / NXCD; wgid = (xcd < r ? xcd * (q + 1) : r * (q + 1) + (xcd - r) * q) + off; }
    const int nig = WGM * nN, gid = wgid / nig, fm = gid * WGM, gsz = (nM - fm) < WGM ? (nM - fm) : WGM;
    pm = fm + ((wgid % nig) % gsz); pn = (wgid % nig) / gsz; return true;
}

template <int K, class Epi, class Sched>
__device__ __forceinline__ void gemm_phase(LAS unsigned char* lds, const int tid, const Sched& S, const Epi& E) {
    constexpr bool GA = Sched::GATHER;
    const int wid = __builtin_amdgcn_readfirstlane(tid >> 6), lane = tid & 63, wr = wid >> 2, wc = wid & 3, fr = lane & 15, fq = lane >> 4;
    constexpr int nt = K / BK;
    unsigned voffA[2], voffB[2];
#pragma unroll
    for (int i = 0; i < 2; ++i) { int R, C; stage_rc(tid * 16 + i * 8192, R, C); const int Rb = ((int)Epi::PERM == 2) ? (64 * (R >> 5) + 16 * ((R & 15) >> 2) + 4 * ((R >> 4) & 1) + (R & 3)) : (Epi::PERM ? ((R & ~31) + perm32(R & 31)) : R);
        voffA[i] = (unsigned)(R * K + C) * 2u; voffB[i] = (unsigned)(Rb * K + C) * 2u; }
    const size_t kstep = (size_t)(BK * 2);
    const size_t hstep = (size_t)HALF * K * 2;
    const size_t bhstep = ((int)Epi::PERM == 2) ? (size_t)8 * K * 2 : hstep;
    const unsigned rowb = (unsigned)K * 2u;
    const unsigned ldsw = (unsigned)wid * 1024u;
    const int aoff = lds_byte(wr * 64 + fr, fq * 8), boff = lds_byte(wc * 32 + fr, fq * 8);
#define PG8_SA(b, h) (((b) * 2 + (h)) * HTB)
#define PG8_SB(b, h) ((4 + (b) * 2 + (h)) * HTB)
#define PG8_STAGE(bufoff, gbase, voff) do { _Pragma("unroll") for (int _i = 0; _i < 2; ++_i) \
        __builtin_amdgcn_global_load_lds((const unsigned*)((const char*)(gbase) + (voff)[_i]), (LAS unsigned*)(lds + (bufoff) + ldsw + _i * 8192), 16, 0, 0); } while (0)
#define PG8_STAGE_A(bufoff, p, h, O) do { if constexpr (GA) { PG8_STAGE(bufoff, p, O[h]); } else { PG8_STAGE(bufoff, (p) + (h) * hstep, voffA); } } while (0)
#define PG8_LDA(dst, b, h) do { _Pragma("unroll") for (int m = 0; m < 4; ++m) _Pragma("unroll") for (int k = 0; k < 2; ++k) dst[m][k] = *(const LAS bf16x8*)(lds + PG8_SA(b, h) + aoff + m * 2048 + k * 1024); } while (0)
#define PG8_LDB(dst, b, h) do { _Pragma("unroll") for (int n = 0; n < 2; ++n) _Pragma("unroll") for (int k = 0; k < 2; ++k) dst[n][k] = *(const LAS bf16x8*)(lds + PG8_SB(b, h) + boff + n * 2048 + k * 1024); } while (0)
#define PG8_MMA(ai, bj, At, Bt) do { __builtin_amdgcn_s_setprio(1); _Pragma("unroll") for (int m = 0; m < 4; ++m) _Pragma("unroll") for (int n = 0; n < 2; ++n) _Pragma("unroll") for (int k = 0; k < 2; ++k) \
        acc[ai][bj][m][n] = __builtin_amdgcn_mfma_f32_16x16x32_bf16(Bt[n][k], At[m][k], acc[ai][bj][m][n], 0, 0, 0); __builtin_amdgcn_s_setprio(0); } while (0)
#define PG8_WAIT_V(n) asm volatile("s_waitcnt vmcnt(" #n ")" ::: "memory")
#define PG8_WAIT_L(n) asm volatile("s_waitcnt lgkmcnt(" #n ")" ::: "memory")
#define PG8_BAR __builtin_amdgcn_s_barrier()
#define PG8_SCHED __builtin_amdgcn_sched_barrier(0)
#define PG8_OFFS(u, o) do { if constexpr (GA) { _Pragma("unroll") for (int _h = 0; _h < 2; ++_h) _Pragma("unroll") for (int _i = 0; _i < 2; ++_i) { int R_, C_; stage_rc(tid * 16 + _i * 8192, R_, C_); \
        o[_h][_i] = (unsigned)S.a_row(u, _h * HALF + R_) * rowb + (unsigned)C_ * 2u; } } } while (0)
#define PG8_TRIP(a1, a2, b2, O1, O2) do { const char* a3 = (a2) + kstep; const char* b3 = (b2) + kstep; \
            PG8_LDB(B0, 0, 0); PG8_LDB(B1, 0, 1); PG8_SCHED; PG8_LDA(At, 0, 0); PG8_STAGE_A(PG8_SA(1, 1), a1, 1, O1); \
            PG8_WAIT_V(8); PG8_WAIT_L(0); PG8_BAR; PG8_MMA(0, 0, At, B0); PG8_MMA(0, 1, At, B1); PG8_BAR; PG8_SCHED; \
            PG8_LDA(At, 0, 1); PG8_STAGE(PG8_SB(0, 0), b2, voffB); PG8_STAGE(PG8_SB(0, 1), (b2) + bhstep, voffB); PG8_STAGE_A(PG8_SA(0, 0), a2, 0, O2); \
            PG8_WAIT_V(8); PG8_WAIT_L(0); PG8_BAR; PG8_MMA(1, 0, At, B0); PG8_MMA(1, 1, At, B1); PG8_BAR; PG8_SCHED; \
            PG8_LDB(B0, 1, 0); PG8_LDB(B1, 1, 1); PG8_SCHED; PG8_LDA(At, 1, 0); PG8_STAGE_A(PG8_SA(0, 1), a2, 1, O2); \
            PG8_WAIT_V(8); PG8_WAIT_L(0); PG8_BAR; PG8_MMA(0, 0, At, B0); PG8_MMA(0, 1, At, B1); PG8_BAR; PG8_SCHED; \
            PG8_LDA(At, 1, 1); PG8_STAGE(PG8_SB(1, 0), b3, voffB); PG8_STAGE(PG8_SB(1, 1), b3 + bhstep, voffB); PG8_STAGE_A(PG8_SA(1, 0), a3, 0, O2); \
            PG8_WAIT_V(8); PG8_WAIT_L(0); PG8_BAR; PG8_MMA(1, 0, At, B0); PG8_MMA(1, 1, At, B1); PG8_BAR; PG8_SCHED; } while (0)
    Unit cur, nxt; int ui = 0;
    if (!S.next(0, cur)) return;
    f32x4 acc[2][2][4][2];
#pragma unroll
    for (int a = 0; a < 2; ++a)
#pragma unroll
        for (int b = 0; b < 2; ++b)
#pragma unroll
            for (int m = 0; m < 4; ++m)
#pragma unroll
                for (int n = 0; n < 2; ++n) acc[a][b][m][n] = (f32x4){0.f, 0.f, 0.f, 0.f};
    bf16x8 At[4][2], B0[2][2], B1[2][2];
    unsigned cOff[2][2], nOff[2][2];
    PG8_OFFS(cur, cOff);
    const char* cA = S.a_tile(cur); const char* cB = S.b_tile(cur);
    PG8_STAGE(PG8_SB(0, 0), cB, voffB); PG8_STAGE(PG8_SB(0, 1), cB + bhstep, voffB); PG8_STAGE_A(PG8_SA(0, 0), cA, 0, cOff); PG8_STAGE_A(PG8_SA(0, 1), cA, 1, cOff);
    if (wr == 1) PG8_BAR;
    PG8_WAIT_V(2); PG8_BAR;
    PG8_STAGE(PG8_SB(1, 0), cB + kstep, voffB); PG8_STAGE_A(PG8_SA(1, 0), cA + kstep, 0, cOff); PG8_STAGE(PG8_SB(1, 1), cB + bhstep + kstep, voffB);
    PG8_WAIT_V(6); PG8_BAR;
    for (;;) {
        const bool has_next = S.next(ui + 1, nxt);
        const char* nA = cA; const char* nB = cB;
        if constexpr (GA) {
#pragma unroll
            for (int h = 0; h < 2; ++h)
#pragma unroll
                for (int i = 0; i < 2; ++i) nOff[h][i] = cOff[h][i]; }
        if (has_next) { PG8_OFFS(nxt, nOff); nA = S.a_tile(nxt); nB = S.b_tile(nxt); }
_Pragma("nounroll")
        for (int t = 0; t < nt; t += 2) { const bool last = (t == nt - 2);
            const char* a2 = last ? nA : cA + (size_t)(t + 2) * kstep; const char* b2 = last ? nB : cB + (size_t)(t + 2) * kstep;
            if constexpr (GA) { unsigned o2[2][2];
#pragma unroll
                for (int h = 0; h < 2; ++h)
#pragma unroll
                    for (int i = 0; i < 2; ++i) o2[h][i] = last ? nOff[h][i] : cOff[h][i];
                PG8_TRIP(cA + (size_t)(t + 1) * kstep, a2, b2, cOff, o2);
            } else { PG8_TRIP(cA + (size_t)(t + 1) * kstep, a2, b2, cOff, cOff); } }
        if (wr == 0) PG8_BAR;
        PG8_SCHED; E(acc, cur, wr, wc, fr, fq); PG8_SCHED;
        if (!has_next) break;
#pragma unroll
        for (int a = 0; a < 2; ++a)
#pragma unroll
            for (int b = 0; b < 2; ++b)
#pragma unroll
                for (int m = 0; m < 4; ++m)
#pragma unroll
                    for (int n = 0; n < 2; ++n) acc[a][b][m][n] = (f32x4){0.f, 0.f, 0.f, 0.f};
        cur = nxt; cA = nA; cB = nB; ++ui;
        if constexpr (GA) {
#pragma unroll
            for (int h = 0; h < 2; ++h)
#pragma unroll
                for (int i = 0; i < 2; ++i) cOff[h][i] = nOff[h][i]; }
        if (wr == 1) PG8_BAR;
    }
    PG8_WAIT_V(0);
    PG8_BAR;
#undef PG8_SA
#undef PG8_SB
#undef PG8_STAGE
#undef PG8_STAGE_A
#undef PG8_LDA
#undef PG8_LDB
#undef PG8_MMA
#undef PG8_WAIT_V
#undef PG8_WAIT_L
#undef PG8_BAR
#undef PG8_SCHED
#undef PG8_OFFS
#undef PG8_TRIP
}
}
using pg8::Unit;
typedef f32x4 AccT[2][2][4][2];

struct SchedDense {
    int nM, nN, G, c, K; const char* A; const char* Bt;
    __device__ __forceinline__ bool next(int i, Unit& u) const { int pm, pn; if (!pg8::static_tile(i, G, c, nM, nN, pm, pn)) return false;
        u.pm = pm; u.pn = pn; u.e = 0; u.nvalid = 256; u.arow0 = pm * 256; u.orow0 = pm * 256; u.gidx = nullptr; return true; }
    static constexpr bool GATHER = false;
    __device__ __forceinline__ const char* a_tile(const Unit& u) const { return A + (size_t)u.arow0 * K * 2; }
    __device__ __forceinline__ const char* b_tile(const Unit& u) const { return Bt + (size_t)u.pn * 256 * K * 2; }
    __device__ __forceinline__ int a_row(const Unit& u, int r) const { return u.arow0 + r; }
};
struct SchedRkv {
    int nM, nN, G, c; const char* xmix; const char* Wrkv; const char* L1;
    __device__ __forceinline__ bool next(int i, Unit& u) const { int pm, pn; if (!pg8::static_tile(i, G, c, nM, nN, pm, pn)) return false;
        u.pm = pm; u.pn = pn; u.e = 0; u.nvalid = 256; u.arow0 = pm * 256; u.orow0 = pm * 256; u.gidx = nullptr; return true; }
    static constexpr bool GATHER = false;
    __device__ __forceinline__ const char* a_tile(const Unit& u) const { const int grp = u.pn < 12 ? (u.pn >> 2) : (u.pn == 15 ? 2 : u.pn - 9); return xmix + ((size_t)grp * T + u.arow0) * D * 2; }
    __device__ __forceinline__ const char* b_tile(const Unit& u) const { return u.pn < 12 ? Wrkv + (size_t)u.pn * 256 * D * 2 : L1 + (size_t)(u.pn - 12) * 256 * D * 2; }
    __device__ __forceinline__ int a_row(const Unit& u, int r) const { return u.arow0 + r; }
};
struct SchedL2 {
    int nM, nN, G, c; const char* hl; const char* L2;
    __device__ __forceinline__ bool next(int i, Unit& u) const { int pm, pn; if (!pg8::static_tile(i, G, c, nM, nN, pm, pn)) return false;
        u.pm = pm; u.pn = pn & 3; u.e = pn >> 2; u.nvalid = 256; u.arow0 = pm * 256; u.orow0 = pm * 256; u.gidx = nullptr; return true; }
    static constexpr bool GATHER = false;
    __device__ __forceinline__ const char* a_tile(const Unit& u) const { return hl + ((size_t)u.e * T + u.arow0) * 256 * 2; }
    __device__ __forceinline__ const char* b_tile(const Unit& u) const { return L2 + ((size_t)u.e * 1024 + (size_t)u.pn * 256) * 256 * 2; }
    __device__ __forceinline__ int a_row(const Unit& u, int r) const { return u.arow0 + r; }
};
struct MoeTab { const LAS int* cnt; const LAS int* mtpref; const LAS int* hoff; };
__device__ __forceinline__ int moe_find_expert(const MoeTab& M, int m, int& hint) { int e = hint;
_Pragma("nounroll")
    while (e + 1 < NEX && M.mtpref[e + 1] <= m) ++e;
    e = __builtin_amdgcn_readfirstlane(e); hint = e; return e; }
struct SchedMoe1 {
    int G, c; MoeTab M; const char* xb; const char* Wgu; const int* toklist; mutable int eh;
    __device__ __forceinline__ bool next(int i, Unit& u) const { const long L = (long)i * G + c; const int nun = M.mtpref[NEX] * 2; if (L >= nun) return false;
        const int m = (int)(L >> 1), e = moe_find_expert(M, m, eh), mt = m - M.mtpref[e];
        u.pm = mt; u.pn = (int)(L & 1); u.e = e; u.arow0 = mt * 256; u.orow0 = M.hoff[e] + mt * 256;
        if (e < NE) { const int left = M.cnt[e] - mt * 256; u.nvalid = left < 256 ? left : 256; u.gidx = toklist + (size_t)e * T + mt * 256; } else { u.nvalid = 256; u.gidx = nullptr; }
        return true; }
    static constexpr bool GATHER = true;
    __device__ __forceinline__ const char* a_tile(const Unit&) const { return xb; }
    __device__ __forceinline__ const char* b_tile(const Unit& u) const { return Wgu + ((size_t)u.e * 512 + (size_t)u.pn * 256) * D * 2; }
    __device__ __forceinline__ int a_row(const Unit& u, int r) const { if (u.gidx) return r < u.nvalid ? u.gidx[r] : 0; return u.arow0 + r; }
};
struct SchedMoe2 {
    int G, c; MoeTab M; const char* hb; const char* Wd; mutable int eh;
    __device__ __forceinline__ bool next(int i, Unit& u) const { const long L = (long)i * G + c; const int nun = M.mtpref[NEX] * 4; if (L >= nun) return false;
        const int m = (int)(L >> 2), e = moe_find_expert(M, m, eh), mt = m - M.mtpref[e];
        u.pm = mt; u.pn = (int)(L & 3); u.e = e; u.nvalid = 256; u.arow0 = M.hoff[e] + mt * 256; u.orow0 = (e < NE) ? (M.hoff[e] + mt * 256) : mt * 256; u.gidx = nullptr; return true; }
    static constexpr bool GATHER = false;
    __device__ __forceinline__ const char* a_tile(const Unit& u) const { return hb + (size_t)u.arow0 * 256 * 2; }
    __device__ __forceinline__ const char* b_tile(const Unit& u) const { return Wd + ((size_t)u.e * 1024 + (size_t)u.pn * 256) * 256 * 2; }
    __device__ __forceinline__ int a_row(const Unit& u, int r) const { return u.arow0 + r; }
};

#define EPI_ARGS const AccT& acc, const Unit& u, int wr, int wc, int fr, int fq
struct EpiQKV { static constexpr bool PERM = true; bf16* Q; bf16* Kb; bf16* Vt;
    __device__ __forceinline__ void operator()(EPI_ARGS) const {
        const int row0 = u.orow0 + wr * 64 + fr, sec = u.pn >> 2, col0 = (u.pn & 3) * 256 + wc * 32 + 8 * fq;
        if (sec < 2) { bf16* base = sec == 0 ? Q : Kb; const float sc = sec == 0 ? 0.18033688011112042f : 1.0f;
#pragma unroll
            for (int ai = 0; ai < 2; ++ai)
#pragma unroll
                for (int m = 0; m < 4; ++m) { bf16* rowp = base + (size_t)(row0 + ai * 128 + m * 16) * D + col0;
#pragma unroll
                    for (int bj = 0; bj < 2; ++bj) { const f32x4 v0 = acc[ai][bj][m][0] * sc, v1 = acc[ai][bj][m][1] * sc; v4u w;
                        w.x = cvt_pk_bf16(v0[0], v0[1]); w.y = cvt_pk_bf16(v0[2], v0[3]); w.z = cvt_pk_bf16(v1[0], v1[1]); w.w = cvt_pk_bf16(v1[2], v1[3]); *(v4u*)(rowp + bj * 128) = w; } }
        } else {
#pragma unroll
            for (int ai = 0; ai < 2; ++ai)
#pragma unroll
                for (int m = 0; m < 4; ++m) { const int r = row0 + ai * 128 + m * 16, b = r >> 12, s = r & 4095;
#pragma unroll
                    for (int bj = 0; bj < 2; ++bj)
#pragma unroll
                        for (int n = 0; n < 2; ++n) { const f32x4 v = acc[ai][bj][m][n];
#pragma unroll
                            for (int j = 0; j < 4; j += 2) { const int c = col0 + bj * 128 + 4 * n + j, h = c >> 6, d = c & 63; const unsigned w = cvt_pk_bf16(v[j], v[j + 1]);
                                bf16* p = Vt + ((((size_t)(b * NH + h) * HD + d)) << 12) + s; p[0] = (bf16)(w & 0xffffu); p[SEQ] = (bf16)(w >> 16); } } }
        }
    }
};
struct EpiAdd { static constexpr bool PERM = true; bf16* ob; const bf16* xb;
    __device__ __forceinline__ void operator()(EPI_ARGS) const {
        const int row0 = u.orow0 + wr * 64 + fr, col0 = u.pn * 256 + wc * 32 + 8 * fq;
#pragma unroll
        for (int ai = 0; ai < 2; ++ai) { v4u t[4][2];
#pragma unroll
            for (int m = 0; m < 4; ++m) { const bf16* rowp = xb + (size_t)(row0 + ai * 128 + m * 16) * D + col0;
#pragma unroll
                for (int bj = 0; bj < 2; ++bj) t[m][bj] = *(const v4u*)(rowp + bj * 128); }
            __builtin_amdgcn_sched_barrier(0);
#pragma unroll
            for (int m = 0; m < 4; ++m) { bf16* rowp = ob + (size_t)(row0 + ai * 128 + m * 16) * D + col0;
#pragma unroll
                for (int bj = 0; bj < 2; ++bj) { const v4u w = t[m][bj]; const f32x4 x0 = {bflo(w.x), bfhi(w.x), bflo(w.y), bfhi(w.y)}, x1 = {bflo(w.z), bfhi(w.z), bflo(w.w), bfhi(w.w)};
                    const f32x4 s0 = x0 * ALPHA + acc[ai][bj][m][0], s1 = x1 * ALPHA + acc[ai][bj][m][1];
                    v4u o; o.x = cvt_pk_bf16(s0[0], s0[1]); o.y = cvt_pk_bf16(s0[2], s0[3]); o.z = cvt_pk_bf16(s1[0], s1[1]); o.w = cvt_pk_bf16(s1[2], s1[3]); *(v4u*)(rowp + bj * 128) = o; } }
            __builtin_amdgcn_sched_barrier(0); }
    }
};
struct EpiLogits { static constexpr bool PERM = false; float* lg;
    __device__ __forceinline__ void operator()(EPI_ARGS) const {
        if (wc >= 2) return;
        const int row0 = u.orow0 + wr * 64 + fr, col0 = wc * 32 + 4 * fq;
#pragma unroll
        for (int ai = 0; ai < 2; ++ai)
#pragma unroll
            for (int m = 0; m < 4; ++m) { float* rowp = lg + (size_t)(row0 + ai * 128 + m * 16) * NE + col0;
#pragma unroll
                for (int n = 0; n < 2; ++n) *(f32x4*)(rowp + n * 16) = acc[ai][0][m][n]; }
    }
};
struct EpiSwiglu { static constexpr bool PERM = true; bf16* hb; bool dry;
    __device__ __forceinline__ void operator()(EPI_ARGS) const {
        const int row0 = u.orow0 + wr * 64 + fr, col0 = u.pn * 128 + wc * 32 + 8 * fq;
#pragma unroll
        for (int ai = 0; ai < 2; ++ai)
#pragma unroll
            for (int m = 0; m < 4; ++m) { bf16* rowp = hb + (size_t)(row0 + ai * 128 + m * 16) * DE + col0; float o[8];
#pragma unroll
                for (int n = 0; n < 2; ++n)
#pragma unroll
                    for (int j = 0; j < 4; ++j) { const float g = acc[ai][0][m][n][j], up = acc[ai][1][m][n][j]; o[4 * n + j] = g * sigmoidf_(g) * up; }
                v4u w; w.x = cvt_pk_bf16(o[0], o[1]); w.y = cvt_pk_bf16(o[2], o[3]); w.z = cvt_pk_bf16(o[4], o[5]); w.w = cvt_pk_bf16(o[6], o[7]); if (!dry) *(v4u*)rowp = w; }
    }
};
constexpr int Y_SHARED0 = 278528, Y_ROWS = Y_SHARED0 + T;
constexpr size_t WS_YSC = WS_Y + (size_t)Y_ROWS * D;
static_assert(WS_YSC + (size_t)Y_ROWS * 4 * 4 <= WS_END, "fp8 y buffer");
struct EpiMoeDown { static constexpr int PERM = 2; unsigned char* ws; bool dry; LAS float* amx;
    __device__ __forceinline__ void operator()(EPI_ARGS) const {
        if (dry) return;
        const int rl0 = wr * 64 + fr, row0 = (u.e < NE ? u.orow0 : Y_SHARED0 + u.orow0) + rl0, col0 = u.pn * 256 + wc * 64 + 16 * fq;
        unsigned char* y8 = ws + WS_Y; float* ysc = (float*)(ws + WS_YSC);
        float am8[2][4];
#pragma unroll
        for (int ai = 0; ai < 2; ++ai)
#pragma unroll
            for (int m = 0; m < 4; ++m) { float am = 0.f;
#pragma unroll
                for (int bj = 0; bj < 2; ++bj)
#pragma unroll
                    for (int n = 0; n < 2; ++n) { const f32x4 v = acc[ai][bj][m][n]; am = __builtin_fmaxf(am, __builtin_fmaxf(__builtin_fmaxf(__builtin_fabsf(v[0]), __builtin_fabsf(v[1])), __builtin_fmaxf(__builtin_fabsf(v[2]), __builtin_fabsf(v[3])))); }
                am = q4_max(am);
                if (fq == 0) amx[(rl0 + ai * 128 + m * 16) * 4 + wc] = am; }
        asm volatile("s_waitcnt lgkmcnt(0)\n\ts_barrier" ::: "memory");
#pragma unroll
        for (int ai = 0; ai < 2; ++ai)
#pragma unroll
            for (int m = 0; m < 4; ++m) { const f32x4 t = *(const LAS f32x4*)(amx + (rl0 + ai * 128 + m * 16) * 4); am8[ai][m] = __builtin_fmaxf(__builtin_fmaxf(__builtin_fmaxf(t[0], t[1]), __builtin_fmaxf(t[2], t[3])), 1e-30f); }
#pragma unroll
        for (int ai = 0; ai < 2; ++ai)
#pragma unroll
            for (int m = 0; m < 4; ++m) { const size_t row = (size_t)(row0 + ai * 128 + m * 16); const float am = am8[ai][m];
                const float inv = 448.0f * fast_rcp(am) * 0.999f; unsigned wq[4];
#pragma unroll
                for (int bj = 0; bj < 2; ++bj)
#pragma unroll
                    for (int n = 0; n < 2; ++n) { const f32x4 v = acc[ai][bj][m][n]; int t = __builtin_amdgcn_cvt_pk_fp8_f32(v[0] * inv, v[1] * inv, 0, false); t = __builtin_amdgcn_cvt_pk_fp8_f32(v[2] * inv, v[3] * inv, t, true); wq[2 * bj + n] = (unsigned)t; }
                v4u w; w.x = wq[0]; w.y = wq[1]; w.z = wq[2]; w.w = wq[3]; *(v4u*)(y8 + row * D + col0) = w;
                if (wc == 0 && fq == 0) ysc[row * 4 + u.pn] = am * (1.0f / (448.0f * 0.999f)); }
    }
};
struct EpiRkv { static constexpr bool PERM = true; unsigned char* ws; size_t voff;
    __device__ __forceinline__ void operator()(EPI_ARGS) const {
        const int row0 = u.orow0 + wr * 64 + fr;
        size_t boff; int ldc, colt, act = 0;
        if (u.pn < 12) { const int sec = u.pn >> 2; boff = WS_R; if (sec == 1) boff = WS_KK; if (sec == 2) boff = voff; ldc = D; colt = (u.pn & 3) * 256; }
        else { const int kind = u.pn - 12; boff = WS_HL + (size_t)kind * T * 256 * 2; ldc = 256; colt = 0; act = kind == 0 ? 1 : (kind == 2 ? 2 : 0); }
        bf16* base = (bf16*)(ws + boff);
        const int col0 = colt + wc * 32 + 8 * fq;
#pragma unroll
        for (int ai = 0; ai < 2; ++ai)
#pragma unroll
            for (int m = 0; m < 4; ++m) { bf16* rowp = base + (size_t)(row0 + ai * 128 + m * 16) * ldc + col0;
#pragma unroll
                for (int bj = 0; bj < 2; ++bj) { f32x4 v0 = acc[ai][bj][m][0], v1 = acc[ai][bj][m][1];
                    if (act == 1) {
#pragma unroll
                        for (int j = 0; j < 4; ++j) { v0[j] = 1.0f - 2.0f * fast_rcp(fast_exp(2.0f * v0[j]) + 1.0f); v1[j] = 1.0f - 2.0f * fast_rcp(fast_exp(2.0f * v1[j]) + 1.0f); } }
                    if (act == 2) {
#pragma unroll
                        for (int j = 0; j < 4; ++j) { v0[j] = sigmoidf_(v0[j]); v1[j] = sigmoidf_(v1[j]); } }
                    v4u w; w.x = cvt_pk_bf16(v0[0], v0[1]); w.y = cvt_pk_bf16(v0[2], v0[3]); w.z = cvt_pk_bf16(v1[0], v1[1]); w.w = cvt_pk_bf16(v1[2], v1[3]); *(v4u*)(rowp + bj * 128) = w; } }
    }
};
struct EpiL2 { static constexpr bool PERM = true; bf16* lw; bf16* ab; bf16* gb; bf16* vb; const bf16* vf; const float* w0; const float* a0; const float* v0;
    __device__ __forceinline__ void operator()(EPI_ARGS) const {
        const int row0 = u.orow0 + wr * 64 + fr, col0 = u.pn * 256 + wc * 32 + 8 * fq, kind = u.e;
        if (kind == 3) {
#pragma unroll
            for (int ai = 0; ai < 2; ++ai) { v4u vv[4][2], ff[4][2];
#pragma unroll
                for (int m = 0; m < 4; ++m)
#pragma unroll
                    for (int bj = 0; bj < 2; ++bj) { const size_t o = (size_t)(row0 + ai * 128 + m * 16) * D + col0 + bj * 128; vv[m][bj] = *(const v4u*)(vb + o); ff[m][bj] = *(const v4u*)(vf + o); }
                __builtin_amdgcn_sched_barrier(0);
#pragma unroll
                for (int m = 0; m < 4; ++m)
#pragma unroll
                    for (int bj = 0; bj < 2; ++bj) { const size_t o = (size_t)(row0 + ai * 128 + m * 16) * D + col0 + bj * 128; const int c = col0 + bj * 128;
                        const f32x4 b0 = *(const f32x4*)(v0 + c), b1 = *(const f32x4*)(v0 + c + 4); float y[8];
#pragma unroll
                        for (int j = 0; j < 8; ++j) { const unsigned wv = vv[m][bj][j >> 1], wf = ff[m][bj][j >> 1]; const float v = (j & 1) ? bfhi(wv) : bflo(wv), f = (j & 1) ? bfhi(wf) : bflo(wf);
                            const float gt = sigmoidf_(acc[ai][bj][m][j >> 2][j & 3] + (j < 4 ? b0[j & 3] : b1[j & 3])); y[j] = v + (f - v) * gt; }
                        v4u w; w.x = cvt_pk_bf16(y[0], y[1]); w.y = cvt_pk_bf16(y[2], y[3]); w.z = cvt_pk_bf16(y[4], y[5]); w.w = cvt_pk_bf16(y[6], y[7]); *(v4u*)(vb + o) = w; }
                __builtin_amdgcn_sched_barrier(0); }
            return; }
#pragma unroll
        for (int ai = 0; ai < 2; ++ai)
#pragma unroll
            for (int m = 0; m < 4; ++m) { const size_t ro = (size_t)(row0 + ai * 128 + m * 16) * D + col0;
#pragma unroll
                for (int bj = 0; bj < 2; ++bj) { const size_t o = ro + bj * 128; const int c = col0 + bj * 128; float x[8];
#pragma unroll
                    for (int n = 0; n < 2; ++n)
#pragma unroll
                        for (int j = 0; j < 4; ++j) x[4 * n + j] = acc[ai][bj][m][n][j];
                    if (kind == 0) { const f32x4 b0 = *(const f32x4*)(w0 + c), b1 = *(const f32x4*)(w0 + c + 4); f32x4 r0, r1;
#pragma unroll
                        for (int j = 0; j < 8; ++j) { const float z = x[j] + (j < 4 ? b0[j & 3] : b1[j & 3]); if (j < 4) r0[j & 3] = z; else r1[j & 3] = z; }
                        { v4u w; w.x = cvt_pk_bf16(r0[0], r0[1]); w.y = cvt_pk_bf16(r0[2], r0[3]); w.z = cvt_pk_bf16(r1[0], r1[1]); w.w = cvt_pk_bf16(r1[2], r1[3]); *(v4u*)(lw + o) = w; }
                    } else if (kind == 1) { const f32x4 b0 = *(const f32x4*)(a0 + c), b1 = *(const f32x4*)(a0 + c + 4);
#pragma unroll
                        for (int j = 0; j < 8; ++j) x[j] = sigmoidf_(x[j] + (j < 4 ? b0[j & 3] : b1[j & 3]));
                        v4u w; w.x = cvt_pk_bf16(x[0], x[1]); w.y = cvt_pk_bf16(x[2], x[3]); w.z = cvt_pk_bf16(x[4], x[5]); w.w = cvt_pk_bf16(x[6], x[7]); *(v4u*)(ab + o) = w;
                    } else {
                        v4u w; w.x = cvt_pk_bf16(x[0], x[1]); w.y = cvt_pk_bf16(x[2], x[3]); w.z = cvt_pk_bf16(x[4], x[5]); w.w = cvt_pk_bf16(x[6], x[7]); *(v4u*)(gb + o) = w; }
                } }
    }
};

typedef GAS unsigned gu32;
#define XB_TMO      128
#define XB_XCNT(j)  (256  + 64 * (j))
#define XB_XSUB(j)  (1280 + 64 * (j))
#define XB_XGEN(j)  (2304 + 64 * (j))
#define XB_TOP      3328
#define XB_TOPGEN   3392
#define XCD_BAR_WORDS 3456
#define XB_SPIN_CAP (1u << 23)
__device__ __forceinline__ unsigned xb_ld(unsigned* p)              { return __hip_atomic_load(p, __ATOMIC_RELAXED, __HIP_MEMORY_SCOPE_AGENT); }
__device__ __forceinline__ unsigned xb_add(unsigned* p, unsigned v) { return __hip_atomic_fetch_add(p, v, __ATOMIC_RELAXED, __HIP_MEMORY_SCOPE_AGENT); }
__device__ __forceinline__ unsigned xb_xcc_id() { return (unsigned)__builtin_amdgcn_s_getreg((3 << 11) | 20) & 0xFu; }
#define XB_SPIN(cond, bar) do { unsigned _sp = 0; while (cond) { __builtin_amdgcn_s_sleep(1); \
    if ((++_sp & 255u) == 0u) { if (xb_ld(&(bar)[XB_TMO])) break; if (_sp > XB_SPIN_CAP) { atomicAdd(&(bar)[XB_TMO], 1u); break; } } } } while (0)
struct XcdBarrier { unsigned* bar; unsigned x; volatile LAS unsigned* st; };
__device__ __forceinline__ XcdBarrier xcd_barrier_post(unsigned* bar, volatile LAS unsigned* st) {
    XcdBarrier b; b.bar = bar; b.x = xb_xcc_id(); b.st = st;
    if (threadIdx.x == 0) (void)xb_add(&bar[XB_XCNT(b.x)], 1u);
    return b;
}
__device__ __forceinline__ void xcd_barrier_complete(unsigned* bar, unsigned x, unsigned& nloc, unsigned& nx) {
    const unsigned G = gridDim.x * gridDim.y * gridDim.z;
    unsigned sum, cnt, mine, sp = 0u;
    for (;;) {
        sum = 0u; cnt = 0u; mine = 0u;
#pragma unroll
        for (unsigned j = 0; j < 16; ++j) { const unsigned c = xb_ld(&bar[XB_XCNT(j)]); sum += c; cnt += (c > 0u) ? 1u : 0u; mine = (j == x) ? c : mine; }
        if (sum == G) break;
        __builtin_amdgcn_s_sleep(1);
        if ((++sp & 255u) == 0u) { if (xb_ld(&bar[XB_TMO])) break; if (sp > XB_SPIN_CAP) { atomicAdd(&bar[XB_TMO], 1u); break; } }
    }
    nloc = mine > 0u ? mine : 1u; nx = cnt > 0u ? cnt : 1u;
}
__device__ __forceinline__ void xcd_barrier(const XcdBarrier& b) {
    asm volatile("s_waitcnt vmcnt(0)" ::: "memory");
    __syncthreads();
    if (threadIdx.x == 0) {
        unsigned long long bp = (unsigned long long)b.bar; unsigned bx = b.x;
        asm volatile("" : "+s"(bp), "+s"(bx));
        unsigned* bar = (unsigned*)(GAS unsigned*)bp;
        __builtin_amdgcn_s_waitcnt(0);
        unsigned nloc = b.st[0], nx = b.st[1];
        if (nloc == 0u) { xcd_barrier_complete(bar, bx, nloc, nx); b.st[0] = nloc; b.st[1] = nx; }
        const unsigned old = xb_add(&bar[XB_XSUB(bx)], 1u);
        const unsigned gen = old / nloc;
        if (old + 1u == (gen + 1u) * nloc) {
            __builtin_amdgcn_fence(__ATOMIC_RELEASE, "agent");
            asm volatile("s_waitcnt vmcnt(0)" ::: "memory");
            const unsigned og = xb_add(&bar[XB_TOP], 1u);
            const unsigned tg = og / nx;
            if (og + 1u == (tg + 1u) * nx) xb_add(&bar[XB_TOPGEN], 1u);
            else XB_SPIN(xb_ld(&bar[XB_TOPGEN]) == tg, bar);
            __builtin_amdgcn_fence(__ATOMIC_ACQUIRE, "agent");
            xb_add(&bar[XB_XGEN(bx)], 1u);
            asm volatile("s_waitcnt vmcnt(0)" ::: "memory");
        } else {
            XB_SPIN(xb_ld(&bar[XB_XGEN(bx)]) == gen, bar);
            __builtin_amdgcn_fence(__ATOMIC_ACQUIRE, "agent");
            asm volatile("s_waitcnt vmcnt(0)" ::: "memory");
        }
    }
    __syncthreads();
}

struct Args { const float* in[35]; float* out; unsigned char* ws; };
struct Frame {
    LAS unsigned char* lds; gu32* ctl; unsigned char* ws; float* out;
    int tid, lane, wave, vcu, G, gw, NGW;
};

__device__ __forceinline__ Frame phase_frame(const Frame& F) {
    Frame P = F; int lane; asm volatile("v_mbcnt_lo_u32_b32 %0, -1, 0\n\tv_mbcnt_hi_u32_b32 %0, -1, %0" : "=v"(lane)); int wave = F.wave;
    asm volatile("" : "+v"(lane), "+s"(wave)); P.lane = lane; P.wave = wave; P.tid = wave * 64 + lane; P.gw = P.vcu * NWAVES + wave; return P;
}
__device__ __forceinline__ const float* in_ptr(const Frame& F, int k) {
    const unsigned long long v = ((const LAS unsigned long long*)(F.lds + PTAB_OFF))[k];
    const unsigned lo = (unsigned)__builtin_amdgcn_readfirstlane((int)(unsigned)v), hi = (unsigned)__builtin_amdgcn_readfirstlane((int)(unsigned)(v >> 32));
    return (const float*)(GAS const float*)(((unsigned long long)hi << 32) | lo);
}
__device__ __forceinline__ void transpose_item(const float* W, int N, int k0, int n0, bf16* WT, size_t orow, int ldk, LAS float* scr, int lane) {
    f32x4 w[8];
#pragma unroll
    for (int i = 0; i < 8; ++i) w[i] = *(const f32x4*)(W + (size_t)(k0 + 8 * i + (lane >> 3)) * N + n0 + 4 * (lane & 7));
    __builtin_amdgcn_sched_barrier(0);
#pragma unroll
    for (int i = 0; i < 8; ++i) { LAS float* d = scr + (8 * i + (lane >> 3)) * 33 + 4 * (lane & 7); d[0] = w[i][0]; d[1] = w[i][1]; d[2] = w[i][2]; d[3] = w[i][3]; }
    LDS_WAIT(); asm volatile("" ::: "memory");
    const int c = lane & 7;
#pragma unroll
    for (int j = 0; j < 4; ++j) { const int n = (lane >> 3) + 8 * j; const LAS float* s = scr + (8 * c) * 33 + n;
        v4u o; o.x = cvt_pk_bf16(s[0 * 33], s[1 * 33]); o.y = cvt_pk_bf16(s[2 * 33], s[3 * 33]); o.z = cvt_pk_bf16(s[4 * 33], s[5 * 33]); o.w = cvt_pk_bf16(s[6 * 33], s[7 * 33]);
        *(v4u*)(WT + (orow + n) * ldk + k0 + 8 * c) = o; }
    LDS_WAIT(); asm volatile("" ::: "memory");
}
__device__ __forceinline__ void convert_plain(Frame& F, const float* W, int K, int N, bf16* WT, int row_off) {
    LAS float* scr = (LAS float*)(F.lds + F.wave * 16384);
    const int nblk = N / 32, nitems = (K / 64) * nblk;
    for (int it = F.gw; it < nitems; it += F.NGW) { const int kb = it / nblk, nb = it % nblk; transpose_item(W, N, 64 * kb, 32 * nb, WT, (size_t)row_off + 32 * nb, K, scr, F.lane); }
}
struct SmallJob { const float* W; int K, N; bf16* WT; int Np, Kp; };
__device__ __forceinline__ void small_load(const Frame& F, const SmallJob& J, float (&v)[2]) {
    const size_t tot = (size_t)J.Np * J.Kp, step = (size_t)F.NGW * 64;
#pragma unroll
    for (int q = 0; q < 2; ++q) { const size_t i = (size_t)F.gw * 64 + F.lane + q * step; const int n = (int)(i / J.Kp), k = (int)(i % J.Kp); v[q] = (i < tot && k < J.K && n < J.N) ? J.W[(size_t)k * J.N + n] : 0.0f; }
}
__device__ __forceinline__ void small_store(const Frame& F, const SmallJob& J, const float (&v)[2]) {
    const size_t tot = (size_t)J.Np * J.Kp, step = (size_t)F.NGW * 64;
#pragma unroll
    for (int q = 0; q < 2; ++q) { const size_t i = (size_t)F.gw * 64 + F.lane + q * step; if (i < tot) J.WT[i] = (bf16)(cvt_pk_bf16(v[q], 0.0f) & 0xffffu); }
}
__device__ __forceinline__ void convert_small(Frame& F, const float* W, int K, int N, bf16* WT, int Np, int Kp);
__device__ __forceinline__ void convert_small4(Frame& F, const SmallJob& A, const SmallJob& B, const SmallJob& C, const SmallJob& E) {
    if ((size_t)F.NGW * 128 < (size_t)A.Np * A.Kp) { convert_small(F, A.W, A.K, A.N, A.WT, A.Np, A.Kp); convert_small(F, B.W, B.K, B.N, B.WT, B.Np, B.Kp); convert_small(F, C.W, C.K, C.N, C.WT, C.Np, C.Kp); convert_small(F, E.W, E.K, E.N, E.WT, E.Np, E.Kp); return; }
    float va[2], vb[2], vc[2], ve[2];
    small_load(F, A, va); small_load(F, B, vb); small_load(F, C, vc); small_load(F, E, ve);
    __builtin_amdgcn_sched_barrier(0);
    small_store(F, A, va); small_store(F, B, vb); small_store(F, C, vc); small_store(F, E, ve);
}
__device__ __forceinline__ void convert_small(Frame& F, const float* W, int K, int N, bf16* WT, int Np, int Kp) {
    const size_t tot = (size_t)Np * Kp, step = (size_t)F.NGW * 64;
    for (size_t i0 = (size_t)F.gw * 64 + F.lane; i0 < tot; i0 += 4 * step) { float v[4];
#pragma unroll
        for (int q = 0; q < 4; ++q) { const size_t i = i0 + q * step; const int n = (int)(i / Kp), k = (int)(i % Kp); v[q] = (i < tot && k < K && n < N) ? W[(size_t)k * N + n] : 0.0f; }
#pragma unroll
        for (int q = 0; q < 4; ++q) { const size_t i = i0 + q * step; if (i < tot) WT[i] = (bf16)(cvt_pk_bf16(v[q], 0.0f) & 0xffffu); } }
}
__device__ __forceinline__ void convert_moe(Frame& F, const float* wg, const float* wu, const float* wd, const float* sg, const float* su, const float* sd) {
    LAS float* scr = (LAS float*)(F.lds + F.wave * 16384);
    bf16* Wgu = (bf16*)(F.ws + WS_WGU); bf16* Wd = (bf16*)(F.ws + WS_WD);
    constexpr int PER = 128;
    const int total = NEX * 3 * PER;
    for (int it = F.gw; it < total; it += F.NGW) {
        const int e = it / (3 * PER), r = it % (3 * PER), which = r / PER, q = r % PER;
        if (which < 2) { const float* W = (e < NE) ? (which == 0 ? wg : wu) + (size_t)e * D * DE : (which == 0 ? sg : su);
            const int kb = q >> 3, nb = q & 7, n0 = 32 * nb; const size_t orow = (size_t)e * 512 + (n0 >> 7) * 256 + which * 128 + (n0 & 127);
            transpose_item(W, DE, 64 * kb, n0, Wgu, orow, D, scr, F.lane);
        } else { const float* W = (e < NE) ? wd + (size_t)e * DE * D : sd;
            const int kb = q >> 5, nb = q & 31, n0 = 32 * nb;
            transpose_item(W, D, 64 * kb, n0, Wd, (size_t)e * 1024 + n0, DE, scr, F.lane); }
    }
}

template <int MODE>
__device__ __forceinline__ void ln_phase(Frame& F, const float* src, const float* g, const float* bsh, bool final, const MoeTab& M) {
    float* out = F.out; bf16* xb = (bf16*)(F.ws + WS_XB);
    const bf16* yb = (const bf16*)(F.ws + WS_Y); const int2* tsel = (const int2*)(F.ws + WS_TSEL);
    f32x4 gv[4], bv[4];
    if (MODE != 2) {
#pragma unroll
        for (int j = 0; j < 4; ++j) { const int c = 512 * (j >> 1) + 8 * F.lane + 4 * (j & 1); gv[j] = *(const f32x4*)(g + c); bv[j] = *(const f32x4*)(bsh + c); } }
    for (int row = F.gw; row < T; row += F.NGW) {
        const float* xr = src + (size_t)row * D + 8 * F.lane;
        f32x4 v[4];
#pragma unroll
        for (int j = 0; j < 4; ++j) v[j] = *(const f32x4*)(xr + 512 * (j >> 1) + 4 * (j & 1));
        if (MODE == 1) {
#pragma unroll
            for (int jj = 0; jj < TOPK; ++jj) { const int2 ts = tsel[(size_t)row * TOPK + jj]; const int e = ts.x >> 20, slot = ts.x & 0xfffff; const float gt = __int_as_float(ts.y);
                const bf16* yp = yb + (size_t)(M.hoff[e] + slot) * D + 8 * F.lane;
#pragma unroll
                for (int jh = 0; jh < 2; ++jh) { const v4u w = *(const v4u*)(yp + 512 * jh);
                    v[2 * jh][0] += gt * bflo(w.x); v[2 * jh][1] += gt * bfhi(w.x); v[2 * jh][2] += gt * bflo(w.y); v[2 * jh][3] += gt * bfhi(w.y);
                    v[2 * jh + 1][0] += gt * bflo(w.z); v[2 * jh + 1][1] += gt * bfhi(w.z); v[2 * jh + 1][2] += gt * bflo(w.w); v[2 * jh + 1][3] += gt * bfhi(w.w); } }
        }
        f32x4 o[4];
        if (MODE == 2) {
#pragma unroll
            for (int j = 0; j < 4; ++j) o[j] = v[j];
        } else {
            float s = 0.f;
#pragma unroll
            for (int j = 0; j < 4; ++j) s += (v[j][0] + v[j][1]) + (v[j][2] + v[j][3]);
            const float mean = wave_sum(s) * (1.0f / D); float s2 = 0.f;
#pragma unroll
            for (int j = 0; j < 4; ++j) { v[j] = v[j] - mean; s2 += (v[j][0] * v[j][0] + v[j][1] * v[j][1]) + (v[j][2] * v[j][2] + v[j][3] * v[j][3]); }
            const float rstd = 1.0f / sqrtf(wave_sum(s2) * (1.0f / D) + LN_EPS);
#pragma unroll
            for (int j = 0; j < 4; ++j) o[j] = v[j] * rstd * gv[j] + bv[j];
        }
        float* orow = out + (size_t)row * D + 8 * F.lane; bf16* brow = xb + (size_t)row * D + 8 * F.lane;
        const float sc = final ? 1.0f : ALPHA;
#pragma unroll
        for (int jh = 0; jh < 2; ++jh) { if (MODE != 2) { *(f32x4*)(orow + 512 * jh) = o[2 * jh] * sc; *(f32x4*)(orow + 512 * jh + 4) = o[2 * jh + 1] * sc; }
            v4u w; w.x = cvt_pk_bf16(o[2 * jh][0], o[2 * jh][1]); w.y = cvt_pk_bf16(o[2 * jh][2], o[2 * jh][3]); w.z = cvt_pk_bf16(o[2 * jh + 1][0], o[2 * jh + 1][1]); w.w = cvt_pk_bf16(o[2 * jh + 1][2], o[2 * jh + 1][3]);
            *(v4u*)(brow + 512 * jh) = w; }
    }
}

__device__ __forceinline__ void cast_phase(Frame& F, const float* x) {
    bf16* xb = (bf16*)(F.ws + WS_XB);
    for (int r0 = 4 * F.gw; r0 < T; r0 += 4 * F.NGW) { f32x4 v[4][4];
#pragma unroll
        for (int r = 0; r < 4; ++r) { const float* xr = x + (size_t)(r0 + r) * D + 8 * F.lane;
#pragma unroll
            for (int j = 0; j < 4; ++j) v[r][j] = *(const f32x4*)(xr + 512 * (j >> 1) + 4 * (j & 1)); }
        __builtin_amdgcn_sched_barrier(0);
#pragma unroll
        for (int r = 0; r < 4; ++r) { bf16* brow = xb + (size_t)(r0 + r) * D + 8 * F.lane;
#pragma unroll
            for (int jh = 0; jh < 2; ++jh) { v4u w; w.x = cvt_pk_bf16(v[r][2 * jh][0], v[r][2 * jh][1]); w.y = cvt_pk_bf16(v[r][2 * jh][2], v[r][2 * jh][3]); w.z = cvt_pk_bf16(v[r][2 * jh + 1][0], v[r][2 * jh + 1][1]);
                w.w = cvt_pk_bf16(v[r][2 * jh + 1][2], v[r][2 * jh + 1][3]); *(v4u*)(brow + 512 * jh) = w; } }
        __builtin_amdgcn_sched_barrier(0); }
}
__device__ __forceinline__ void ln2_phase(Frame& F, const float* g, const float* bsh, bool final, const MoeTab& M) {
    float* out = F.out; bf16* xb = (bf16*)(F.ws + WS_XB);
    const unsigned char* y8 = F.ws + WS_Y; const float* ysc = (const float*)(F.ws + WS_YSC); const int4* tsel4 = (const int4*)(F.ws + WS_TSEL);
    f32x4 gv[4], bv[4];
#pragma unroll
    for (int j = 0; j < 4; ++j) { const int c = 512 * (j >> 1) + 8 * F.lane + 4 * (j & 1); gv[j] = *(const f32x4*)(g + c); bv[j] = *(const f32x4*)(bsh + c); }
    const float sc = final ? 1.0f : ALPHA;
    constexpr int NBAT = T / 16;
    for (int batch = F.gw; batch < NBAT; batch += F.NGW) {
        const int row0 = 16 * batch;
        const int4 tsv = tsel4[(size_t)row0 * 4 + F.lane];
        v4u xv[2]; v2u yw[TOPK + 1][2]; float ysv[TOPK + 1][2];
#define LN2_ISSUE(I_) do { const int i_ = (I_); const bf16* xr = xb + (size_t)(row0 + i_) * D + 8 * F.lane; \
            xv[0] = *(const v4u*)xr; xv[1] = *(const v4u*)(xr + 512); \
            { const size_t yr = (size_t)(Y_SHARED0 + row0 + i_); const unsigned char* yp = y8 + yr * D + 8 * F.lane; yw[TOPK][0] = *(const v2u*)yp; yw[TOPK][1] = *(const v2u*)(yp + 512); \
              ysv[TOPK][0] = ysc[yr * 4 + (F.lane >> 5)]; ysv[TOPK][1] = ysc[yr * 4 + 2 + (F.lane >> 5)]; } \
            _Pragma("unroll") for (int jj = 0; jj < TOPK; ++jj) { const int tx = __builtin_amdgcn_readlane((jj & 1) ? tsv.z : tsv.x, 4 * i_ + (jj >> 1)); const int e = tx >> 20, slot = tx & 0xfffff; \
                const size_t yr = (size_t)(M.hoff[e] + slot); const unsigned char* yp = y8 + yr * D + 8 * F.lane; yw[jj][0] = *(const v2u*)yp; yw[jj][1] = *(const v2u*)(yp + 512); \
                ysv[jj][0] = ysc[yr * 4 + (F.lane >> 5)]; ysv[jj][1] = ysc[yr * 4 + 2 + (F.lane >> 5)]; } } while (0)
        LN2_ISSUE(0);
_Pragma("nounroll")
        for (int i = 0; i < 16; ++i) {
            f32x4 v[4];
#pragma unroll
            for (int jh = 0; jh < 2; ++jh) { const v4u w = xv[jh]; v[2 * jh] = (f32x4){bflo(w.x), bfhi(w.x), bflo(w.y), bfhi(w.y)} * ALPHA; v[2 * jh + 1] = (f32x4){bflo(w.z), bfhi(w.z), bflo(w.w), bfhi(w.w)} * ALPHA; }
#pragma unroll
            for (int jj = 0; jj <= TOPK; ++jj) { const float gt = jj == TOPK ? 1.0f : __int_as_float(__builtin_amdgcn_readlane((jj & 1) ? tsv.w : tsv.y, 4 * i + (jj >> 1)));
#pragma unroll
                for (int jh = 0; jh < 2; ++jh) { const v2u w = yw[jj][jh]; const float gs_ = gt * ysv[jj][jh];
                    const auto p0 = __builtin_amdgcn_cvt_pk_f32_fp8((int)w.x, false), p1 = __builtin_amdgcn_cvt_pk_f32_fp8((int)w.x, true), p2 = __builtin_amdgcn_cvt_pk_f32_fp8((int)w.y, false), p3 = __builtin_amdgcn_cvt_pk_f32_fp8((int)w.y, true);
                    v[2 * jh][0] += gs_ * p0[0]; v[2 * jh][1] += gs_ * p0[1]; v[2 * jh][2] += gs_ * p1[0]; v[2 * jh][3] += gs_ * p1[1];
                    v[2 * jh + 1][0] += gs_ * p2[0]; v[2 * jh + 1][1] += gs_ * p2[1]; v[2 * jh + 1][2] += gs_ * p3[0]; v[2 * jh + 1][3] += gs_ * p3[1]; } }
            __builtin_amdgcn_sched_barrier(0);
            LN2_ISSUE(i + 1 < 16 ? i + 1 : 15);
            __builtin_amdgcn_sched_barrier(0);
            float s = 0.f;
#pragma unroll
            for (int j = 0; j < 4; ++j) s += (v[j][0] + v[j][1]) + (v[j][2] + v[j][3]);
            const float mean = wave_sum(s) * (1.0f / D); float s2 = 0.f;
#pragma unroll
            for (int j = 0; j < 4; ++j) { v[j] = v[j] - mean; s2 += (v[j][0] * v[j][0] + v[j][1] * v[j][1]) + (v[j][2] * v[j][2] + v[j][3] * v[j][3]); }
            const float rstd = 1.0f / sqrtf(wave_sum(s2) * (1.0f / D) + LN_EPS);
            f32x4 o[4];
#pragma unroll
            for (int j = 0; j < 4; ++j) o[j] = v[j] * rstd * gv[j] + bv[j];
            float* orow = out + (size_t)(row0 + i) * D + 8 * F.lane; bf16* brow = xb + (size_t)(row0 + i) * D + 8 * F.lane;
#pragma unroll
            for (int jh = 0; jh < 2; ++jh) { if (final) { *(f32x4*)(orow + 512 * jh) = o[2 * jh]; *(f32x4*)(orow + 512 * jh + 4) = o[2 * jh + 1]; }
                v4u w; w.x = cvt_pk_bf16(o[2 * jh][0], o[2 * jh][1]); w.y = cvt_pk_bf16(o[2 * jh][2], o[2 * jh][3]); w.z = cvt_pk_bf16(o[2 * jh + 1][0], o[2 * jh + 1][1]); w.w = cvt_pk_bf16(o[2 * jh + 1][2], o[2 * jh + 1][3]);
                *(v4u*)(brow + 512 * jh) = w; }
        }
#undef LN2_ISSUE
    }
}

__device__ __forceinline__ void moe_tables(Frame& F, int layer) {
    LAS int* cnt = (LAS int*)(F.lds + TAB_OFF); LAS int* mtp = cnt + 65; LAS int* hoff = mtp + 66;
    __syncthreads();
    if (F.tid < NE) cnt[F.tid] = (int)__hip_atomic_load(F.ctl + CW_CNT + (layer * 64 + F.tid) * 64, RLX_AGENT);
    if (F.tid == NE) cnt[NE] = T;
    __syncthreads();
    if (F.tid == 0) { int m = 0;
_Pragma("nounroll")
        for (int e = 0; e < NEX; ++e) { mtp[e] = m; hoff[e] = m * 256; m += (cnt[e] + 255) >> 8; } mtp[NEX] = m; hoff[NEX] = m * 256; }
    __syncthreads();
}

__device__ __forceinline__ void route_phase(Frame& F, int layer, const float* rbias) {
    const float* lg = (const float*)(F.ws + WS_LOGITS); int* toklist = (int*)(F.ws + WS_TOKLIST); int2* tsel = (int2*)(F.ws + WS_TSEL);
    LAS float* sw = (LAS float*)(F.lds + F.wave * 256);
    const float rb = rbias[F.lane];
    for (int row = F.gw; row < T; row += F.NGW) {
        const float sc = sigmoidf_(lg[(size_t)row * NE + F.lane]); const float bz = sc + rb;
        sw[F.lane] = bz; LDS_WAIT();
        float v[64];
#pragma unroll
        for (int q = 0; q < 16; ++q) { const f32x4 t = *(const LAS f32x4*)(sw + 4 * q); v[4 * q] = t[0]; v[4 * q + 1] = t[1]; v[4 * q + 2] = t[2]; v[4 * q + 3] = t[3]; }
        LDS_WAIT();
        float gs[8];
#pragma unroll
        for (int gi = 0; gi < 8; ++gi) { float m1 = -INFINITY, m2 = -INFINITY;
#pragma unroll
            for (int k = 0; k < 8; ++k) { const float x = v[8 * gi + k]; const bool a = x > m1; const float nm2 = a ? m1 : fmaxf(m2, x); m1 = a ? x : m1; m2 = nm2; }
            gs[gi] = m1 + m2; }
        unsigned keep = 0u;
#pragma unroll
        for (int gi = 0; gi < 8; ++gi) { int rank = 0;
#pragma unroll
            for (int g2 = 0; g2 < 8; ++g2) rank += (gs[g2] > gs[gi] || (gs[g2] == gs[gi] && g2 < gi)) ? 1 : 0;
            keep |= (rank < 4) ? (1u << gi) : 0u; }
        const bool kown = (keep >> (F.lane >> 3)) & 1u; int rank = 0;
#pragma unroll
        for (int e2 = 0; e2 < 64; ++e2) { const bool k2 = (keep >> (e2 >> 3)) & 1u; rank += (k2 && (v[e2] > bz || (v[e2] == bz && e2 < F.lane))) ? 1 : 0; }
        const bool sel = kown && rank < TOPK;
        const unsigned long long bal = __ballot(sel);
        const float ssum = wave_sum(sel ? sc : 0.0f);
        if (sel) { const int j = __popcll(bal & ((1ull << F.lane) - 1ull)); const float gate = sc / ssum * 2.5f;
            const unsigned slot = __hip_atomic_fetch_add(F.ctl + CW_CNT + (layer * 64 + F.lane) * 64, 1u, RLX_AGENT);
            toklist[(size_t)F.lane * T + slot] = row;
            if (j < TOPK) tsel[(size_t)row * TOPK + j] = make_int2((F.lane << 20) | (int)slot, __float_as_int(gate)); }
    }
}

__device__ __forceinline__ void ln1_route_phase(Frame& F, const float* g, const float* bsh, int layer, const float* rbias) {
    float* out = F.out; bf16* xb = (bf16*)(F.ws + WS_XB);
    const unsigned char* WrT = F.ws + WS_WR + (size_t)layer * 256 * D * 2;
    int* toklist = (int*)(F.ws + WS_TOKLIST); int2* tsel = (int2*)(F.ws + WS_TSEL);
    f32x4 gv[4], bv[4];
#pragma unroll
    for (int j = 0; j < 4; ++j) { const int c = 512 * (j >> 1) + 8 * F.lane + 4 * (j & 1); gv[j] = *(const f32x4*)(g + c); bv[j] = *(const f32x4*)(bsh + c); }
    const float rb = rbias[F.lane];
    const int qi = F.lane & 15, gq = F.lane >> 4;
    constexpr int NBAT = T / 16;
    for (int b0 = 0; b0 < NBAT; b0 += F.NGW) {
        const int batch = b0 + F.gw; const bool act = batch < NBAT;
        __syncthreads();
#pragma unroll
        for (int q = 0; q < 16; ++q) { const int hr = F.wave * 16 + q, e = hr >> 1, half = hr & 1; const int c = (64 * half + F.lane) ^ (e & 15);
            __builtin_amdgcn_global_load_lds((const unsigned*)(WrT + (size_t)e * 2048 + 16 * c), (LAS unsigned*)(F.lds + e * 2048 + 1024 * half), 16, 0, 0); }
        if (act) {
_Pragma("nounroll")
            for (int i = 0; i < 16; i += 4) {
                v4u vv[4][2];
#pragma unroll
                for (int r = 0; r < 4; ++r) { const bf16* xr = (const bf16*)out + (size_t)(16 * batch + i + r) * D + 8 * F.lane; vv[r][0] = *(const v4u*)xr; vv[r][1] = *(const v4u*)(xr + 512); }
                __builtin_amdgcn_sched_barrier(0);
#pragma unroll
                for (int r = 0; r < 4; ++r) { const int row = 16 * batch + i + r; f32x4 v[4];
#pragma unroll
                    for (int jh = 0; jh < 2; ++jh) { const v4u w = vv[r][jh]; v[2 * jh] = (f32x4){bflo(w.x), bfhi(w.x), bflo(w.y), bfhi(w.y)}; v[2 * jh + 1] = (f32x4){bflo(w.z), bfhi(w.z), bflo(w.w), bfhi(w.w)}; }
                    float s = 0.f;
#pragma unroll
                    for (int j = 0; j < 4; ++j) s += (v[j][0] + v[j][1]) + (v[j][2] + v[j][3]);
                    const float mean = wave_sum(s) * (1.0f / D); float s2 = 0.f;
#pragma unroll
                    for (int j = 0; j < 4; ++j) { v[j] = v[j] - mean; s2 += (v[j][0] * v[j][0] + v[j][1] * v[j][1]) + (v[j][2] * v[j][2] + v[j][3] * v[j][3]); }
                    const float rstd = 1.0f / sqrtf(wave_sum(s2) * (1.0f / D) + LN_EPS);
                    f32x4 o[4];
#pragma unroll
                    for (int j = 0; j < 4; ++j) o[j] = v[j] * rstd * gv[j] + bv[j];
                    bf16* brow = xb + (size_t)row * D + 8 * F.lane;
#pragma unroll
                    for (int jh = 0; jh < 2; ++jh) {
                        v4u w; w.x = cvt_pk_bf16(o[2 * jh][0], o[2 * jh][1]); w.y = cvt_pk_bf16(o[2 * jh][2], o[2 * jh][3]); w.z = cvt_pk_bf16(o[2 * jh + 1][0], o[2 * jh + 1][1]); w.w = cvt_pk_bf16(o[2 * jh + 1][2], o[2 * jh + 1][3]);
                        *(v4u*)(brow + 512 * jh) = w; } }
                __builtin_amdgcn_sched_barrier(0);
            }
        }
        VM_WAIT(); __syncthreads();
        f32x4 acc[4];
#pragma unroll
        for (int t = 0; t < 4; ++t) acc[t] = (f32x4){0.f, 0.f, 0.f, 0.f};
        if (act) { const bf16* xrow = xb + (size_t)(16 * batch + qi) * D + 8 * gq;
#pragma unroll
            for (int k0 = 0; k0 < 32; k0 += 16) { bf16x8 bfr[16];
#pragma unroll
                for (int ks = 0; ks < 16; ++ks) bfr[ks] = *(const bf16x8*)(xrow + 32 * (k0 + ks));
                __builtin_amdgcn_sched_barrier(0);
#pragma unroll
                for (int ks = 0; ks < 16; ++ks)
#pragma unroll
                    for (int t = 0; t < 4; ++t) { const bf16x8 a = *(const LAS bf16x8*)(F.lds + (16 * t + qi) * 2048 + 16 * ((4 * (k0 + ks) + gq) ^ qi)); acc[t] = __builtin_amdgcn_mfma_f32_16x16x32_bf16(a, bfr[ks], acc[t], 0, 0, 0); }
                __builtin_amdgcn_sched_barrier(0); } }
        __syncthreads();
        if (act) { LAS float* lg = (LAS float*)(F.lds + F.wave * 16384);
#pragma unroll
            for (int t = 0; t < 4; ++t) *(LAS f32x4*)(lg + qi * 64 + 16 * t + 4 * gq) = acc[t];
            LDS_WAIT();
            int cnt = 0;
_Pragma("nounroll")
            for (int i = 0; i < 16; ++i) { LAS float* sw = lg + 64 * i;
                const float sc = sigmoidf_(sw[F.lane]); const float bz = sc + rb;
                const float m1 = max8(bz);
                const unsigned long long bm = __ballot(bz == m1);
                const unsigned gb = (unsigned)(bm >> (F.lane & 56)) & 0xffu;
                const bool isf = (unsigned)(F.lane & 7) == (unsigned)__builtin_ctz(gb);
                const float m2 = max8(isf ? -INFINITY : bz);
                const float gsum = m1 + m2; const int grp = F.lane >> 3; int grank = 0;
#pragma unroll
                for (int g2 = 0; g2 < 8; ++g2) { const float s = __int_as_float(__builtin_amdgcn_readlane(__float_as_int(gsum), 8 * g2)); grank += (s > gsum || (s == gsum && g2 < grp)) ? 1 : 0; }
                float x = (grank < 4) ? bz : -INFINITY; bool sel = false;
#pragma unroll
                for (int r8 = 0; r8 < TOPK; ++r8) { const float m = wave_max(x); const unsigned long long bx = __ballot(x == m); const int first = (int)__builtin_ctzll(bx);
                    if (F.lane == first) { sel = true; x = -INFINITY; } }
                const float ssum = wave_sum(sel ? sc : 0.0f);
                sw[F.lane] = sel ? sc / ssum * 2.5f : -1.0f; cnt += sel ? 1 : 0; }
            unsigned slot = 0; if (cnt > 0) slot = __hip_atomic_fetch_add(F.ctl + CW_CNT + (layer * 64 + F.lane) * 64, (unsigned)cnt, RLX_AGENT);
            LDS_WAIT();
_Pragma("nounroll")
            for (int i = 0; i < 16; ++i) { const float gate = lg[64 * i + F.lane]; const bool sel = gate >= 0.0f; const int row = 16 * batch + i;
                const unsigned long long bal = __ballot(sel);
                if (sel) { const int j = __popcll(bal & ((1ull << F.lane) - 1ull));
                    toklist[(size_t)F.lane * T + slot] = row;
                    if (j < TOPK) tsel[(size_t)row * TOPK + j] = make_int2((F.lane << 20) | (int)slot, __float_as_int(gate));
                    ++slot; } }
            LDS_WAIT();
        }
    }
}

__device__ __forceinline__ void mix_phase(Frame& F, const float* mix) {
    bf16* xm = (bf16*)(F.ws + WS_XMIX);
    f32x4 mc[6][2][2];
#pragma unroll
    for (int i = 0; i < 6; ++i)
#pragma unroll
        for (int jh = 0; jh < 2; ++jh)
#pragma unroll
            for (int q = 0; q < 2; ++q) mc[i][jh][q] = *(const f32x4*)(mix + i * D + 512 * jh + 8 * F.lane + 4 * q);
    constexpr int NBAT = T / 16; const bf16* xbuf = (const bf16*)(F.ws + WS_XB);
    for (int batch = F.gw; batch < NBAT; batch += F.NGW) {
        const int row0 = 16 * batch; const bf16* xr = xbuf + (size_t)row0 * D + 8 * F.lane; const bool first = (row0 & (SEQ - 1)) == 0;
        f32x4 xp[2][2]; v4u xc[2];
#pragma unroll
        for (int jh = 0; jh < 2; ++jh) { xc[jh] = *(const v4u*)(xr + 512 * jh); const v4u w = *(const v4u*)(xr + (first ? 0 : -D) + 512 * jh); const float m_ = first ? 0.0f : 1.0f;
            xp[jh][0] = (f32x4){bflo(w.x), bfhi(w.x), bflo(w.y), bfhi(w.y)} * m_; xp[jh][1] = (f32x4){bflo(w.z), bfhi(w.z), bflo(w.w), bfhi(w.w)} * m_; }
_Pragma("nounroll")
        for (int i = 0; i < 16; ++i) { const bf16* xnp = xr + (size_t)(i + 1 < 16 ? i + 1 : 15) * D; v4u xn[2];
#pragma unroll
            for (int jh = 0; jh < 2; ++jh) xn[jh] = *(const v4u*)(xnp + 512 * jh);
            bf16* orow = xm + (size_t)(row0 + i) * D + 8 * F.lane;
#pragma unroll
            for (int jh = 0; jh < 2; ++jh) { const v4u w = xc[jh]; const f32x4 x0 = {bflo(w.x), bfhi(w.x), bflo(w.y), bfhi(w.y)}, x1 = {bflo(w.z), bfhi(w.z), bflo(w.w), bfhi(w.w)}; const f32x4 d0 = xp[jh][0] - x0, d1 = xp[jh][1] - x1;
#pragma unroll
                for (int k = 0; k < 6; ++k) { const f32x4 o0 = x0 + d0 * mc[k][jh][0], o1 = x1 + d1 * mc[k][jh][1];
                    v4u wo; wo.x = cvt_pk_bf16(o0[0], o0[1]); wo.y = cvt_pk_bf16(o0[2], o0[3]); wo.z = cvt_pk_bf16(o1[0], o1[1]); wo.w = cvt_pk_bf16(o1[2], o1[3]);
                    *(v4u*)(orow + (size_t)k * T * D + 512 * jh) = wo; }
                xp[jh][0] = x0; xp[jh][1] = x1; xc[jh] = xn[jh]; }
        }
    }
}
__device__ __forceinline__ void kmean_phase(Frame& F) {
    const bf16* Kb = (const bf16*)(F.ws + WS_K); float* km = (float*)(F.ws + WS_KMEAN);
    for (int u = F.gw; u < NBATCH * NH * NMB; u += F.NGW) { const int bh = u >> 4, blk = u & 15, b = bh >> 4, h = bh & 15;
        const bf16* p = Kb + ((size_t)b * SEQ + blk * MBLK + (F.lane >> 3)) * D + h * HD + 8 * (F.lane & 7); float s[8];
#pragma unroll
        for (int i = 0; i < 8; ++i) s[i] = 0.f;
#pragma unroll
        for (int r0 = 0; r0 < MBLK / 8; r0 += 16) { v4u w[16];
#pragma unroll
            for (int r = 0; r < 16; ++r) w[r] = *(const v4u*)(p + (size_t)(8 * (r0 + r)) * D);
            __builtin_amdgcn_sched_barrier(0);
#pragma unroll
            for (int r = 0; r < 16; ++r) { s[0] += bflo(w[r].x); s[1] += bfhi(w[r].x); s[2] += bflo(w[r].y); s[3] += bfhi(w[r].y); s[4] += bflo(w[r].z); s[5] += bfhi(w[r].z); s[6] += bflo(w[r].w); s[7] += bfhi(w[r].w); }
            __builtin_amdgcn_sched_barrier(0); }
#pragma unroll
        for (int i = 0; i < 8; ++i) s[i] = q4_sum(dpp_add<0x128>(s[i])) * (1.0f / MBLK);
        if (F.lane < 8) { float* o = km + (size_t)u * HD + 8 * F.lane; *(f32x4*)o = (f32x4){s[0], s[1], s[2], s[3]}; *(f32x4*)(o + 4) = (f32x4){s[4], s[5], s[6], s[7]}; } }
}
__device__ __forceinline__ void sel_phase(Frame& F) {
    const bf16* Q = (const bf16*)(F.ws + WS_Q); const float* km = (const float*)(F.ws + WS_KMEAN); unsigned short* maskb = (unsigned short*)(F.ws + WS_MASK);
    LAS float* kl = (LAS float*)F.lds;
    for (int u = F.vcu; u < NBATCH * NH * (SEQ / NTHREADS); u += F.G) { const int bh = u >> 3, ch = u & 7, b = bh >> 4, h = bh & 15;
        __syncthreads();
        for (int i = F.tid; i < NMB * HD; i += NTHREADS) kl[i] = km[(size_t)bh * NMB * HD + i];
        __syncthreads();
        const int qpos = ch * NTHREADS + F.tid, qblk = qpos >> 8;
        const v4u* qp = (const v4u*)(Q + ((size_t)b * SEQ + qpos) * D + h * HD); float q[64];
#pragma unroll
        for (int i = 0; i < 8; ++i) { const v4u w = qp[i];
#pragma unroll
            for (int k = 0; k < 4; ++k) { q[8 * i + 2 * k] = bflo(w[k]); q[8 * i + 2 * k + 1] = bfhi(w[k]); } }
        float v1 = -INFINITY, v2 = -INFINITY, v3 = -INFINITY; int i1 = -1, i2 = -1, i3 = -1;
        for (int j = 0; j < qblk; ++j) { float gsum = 0.f; const LAS f32x4* kr = (const LAS f32x4*)(kl + j * HD);
#pragma unroll
            for (int i = 0; i < 16; ++i) { const f32x4 kv = kr[i]; gsum += q[4 * i] * kv[0] + q[4 * i + 1] * kv[1] + q[4 * i + 2] * kv[2] + q[4 * i + 3] * kv[3]; }
            if (gsum > v1) { v3 = v2; i3 = i2; v2 = v1; i2 = i1; v1 = gsum; i1 = j; }
            else if (gsum > v2) { v3 = v2; i3 = i2; v2 = gsum; i2 = j; }
            else if (gsum > v3) { v3 = gsum; i3 = j; } }
        unsigned mk = 0u; if (i1 >= 0) mk |= 1u << i1; if (i2 >= 0) mk |= 1u << i2; if (i3 >= 0) mk |= 1u << i3;
        maskb[(size_t)bh * SEQ + qpos] = (unsigned short)mk; }
}
template <int probe> __device__ __forceinline__ void attn_phase(Frame& F, const float* rel_bias) {
    const bf16* Q = (const bf16*)(F.ws + WS_Q); const bf16* Kb = (const bf16*)(F.ws + WS_K); const bf16* Vt = (const bf16*)(F.ws + WS_VT); bf16* O = (bf16*)(F.ws + WS_O);
    const unsigned short* maskb = (const unsigned short*)(F.ws + WS_MASK);
    constexpr int KRS = 144, VRS = 272, KB_ = 128 * KRS, TB = KB_ + 64 * VRS;
    LAS float* tbl = (LAS float*)(F.lds + 2 * TB);
    __syncthreads();
    for (int i = F.tid; i < NH * 129; i += NTHREADS) { const int h = i / 129, d = i % 129; tbl[h * 132 + d] = rel_bias[(int)T5_BUCKET[d] * NH + h] * 1.4426950408889634f; }
    __syncthreads();
    const int qi = F.lane & 15, g = F.lane >> 4; unsigned tcount = 0;
    for (int it = 0;; ++it) {
        int bh, blk;
        if (F.G == 256) { if (it >= 8) break; bh = F.vcu >> 1; blk = (F.vcu & 1) ? ((it & 1) ? 15 - it : it + 1) : ((it & 1) ? 16 - it : it); }
        else { const int L = it * F.G + F.vcu; if (L >= NBATCH * NH * NMB) break; bh = L >> 4; blk = L & 15; }
        const int b = bh >> 4, h = bh & 15;
        const int q0 = blk * MBLK + 32 * F.wave;
        bf16x8 qf[2][2]; unsigned qmask[2];
#pragma unroll
        for (int gp = 0; gp < 2; ++gp) { const int qpos = q0 + 16 * gp + qi; const size_t qrow = (size_t)b * SEQ + qpos; qmask[gp] = maskb[(size_t)bh * SEQ + qpos];
#pragma unroll
            for (int ks = 0; ks < 2; ++ks) qf[gp][ks] = *(const bf16x8*)(Q + qrow * D + h * HD + 32 * ks + 8 * g); }
        const LAS float* tblh = tbl + h * 132; const float bfar = tblh[128];
        float mref[2] = {0.f, 0.f}; f32x4 o[2][5];
#pragma unroll
        for (int gp = 0; gp < 2; ++gp)
#pragma unroll
            for (int dt = 0; dt < 5; ++dt) o[gp][dt] = (f32x4){0.f, 0.f, 0.f, 0.f};
        constexpr float THR = 8.0f;
        const bf16x8 ones = {0x3F80, 0x3F80, 0x3F80, 0x3F80, 0x3F80, 0x3F80, 0x3F80, 0x3F80};
        const int nst = 2 + 2 * blk;
        const int kkey = F.tid >> 3, kch = F.tid & 7;
        const int vd = F.tid >> 3, vch = F.tid & 7;
        const bf16* kbase = Kb + ((size_t)b * SEQ + kkey) * D + h * HD + 8 * kch;
        const bf16* vbase = Vt + (((size_t)bh * HD + vd) << 12) + 8 * vch;
        v4u kreg[2], vreg[2];
        { const int key0 = blk * MBLK; kreg[0] = *(const v4u*)(kbase + (size_t)key0 * D); kreg[1] = *(const v4u*)(kbase + (size_t)(key0 + 64) * D); vreg[0] = *(const v4u*)(vbase + key0); vreg[1] = *(const v4u*)(vbase + key0 + 64); }
        for (int n = 0; n < nst; ++n) {
            int jb, key0; if (n < 2) { jb = blk; key0 = blk * MBLK + 128 * n; } else { const int mm = n - 2; jb = blk - 1 - (mm >> 1); key0 = jb * MBLK + 128 * (mm & 1); }
            LAS unsigned char* buf = F.lds + (tcount & 1u) * TB; ++tcount;
            *(LAS v4u*)(buf + kkey * KRS + kch * 16) = kreg[0]; *(LAS v4u*)(buf + (kkey + 64) * KRS + kch * 16) = kreg[1];
            *(LAS v4u*)(buf + KB_ + vd * VRS + vch * 16) = vreg[0]; *(LAS v4u*)(buf + KB_ + vd * VRS + (vch + 8) * 16) = vreg[1];
            asm volatile("s_waitcnt lgkmcnt(0)" ::: "memory");
            if (n + 1 < nst) { const int n1 = n + 1; int k1; if (n1 < 2) k1 = blk * MBLK + 128 * n1; else { const int mm = n1 - 2; k1 = (blk - 1 - (mm >> 1)) * MBLK + 128 * (mm & 1); }
                kreg[0] = *(const v4u*)(kbase + (size_t)k1 * D); kreg[1] = *(const v4u*)(kbase + (size_t)(k1 + 64) * D); vreg[0] = *(const v4u*)(vbase + k1); vreg[1] = *(const v4u*)(vbase + k1 + 64); }
            asm volatile("s_barrier" ::: "memory");
            const bool own = (jb == blk), nearb = (jb >= blk - 1);
            if (probe == 2) continue;
            if (own && 128 * n > 32 * F.wave + 31) continue;
            f32x4 s[2][8]; bool selb[2];
#pragma unroll
            for (int gp = 0; gp < 2; ++gp) { selb[gp] = (qmask[gp] >> jb) & 1u; const float c0 = (n == 0) ? 0.0f : (nearb ? -mref[gp] : (selb[gp] ? bfar - mref[gp] : -INFINITY));
#pragma unroll
                for (int kt = 0; kt < 8; ++kt) s[gp][kt] = (f32x4){c0, c0, c0, c0}; }
#pragma unroll
            for (int kt = 0; kt < 8; ++kt)
#pragma unroll
                for (int ks = 0; ks < 2; ++ks) { if (probe == 4) break; const bf16x8 a = *(const LAS bf16x8*)(buf + (16 * kt + qi) * KRS + 64 * ks + 16 * g);
                    s[0][kt] = __builtin_amdgcn_mfma_f32_16x16x32_bf16(a, qf[0][ks], s[0][kt], 0, 0, 0); s[1][kt] = __builtin_amdgcn_mfma_f32_16x16x32_bf16(a, qf[1][ks], s[1][kt], 0, 0, 0);
                    }
#pragma unroll
            for (int gp = 0; gp < 2; ++gp) { if (probe == 3) break;
                float mx = -INFINITY;
                if (nearb) {
                    const int qpos = q0 + 16 * gp + qi; const int dist0 = qpos - (key0 + 4 * g);
#pragma unroll
                    for (int kh = 0; kh < 4; ++kh) { float bz[2][4];
#pragma unroll
                        for (int k4 = 0; k4 < 2; ++k4)
#pragma unroll
                            for (int r = 0; r < 4; ++r) { const int dist = dist0 - (16 * (2 * kh + k4) + r); const int dd = dist < 0 ? 0 : (dist > 128 ? 128 : dist); bz[k4][r] = tblh[dd]; }
#pragma unroll
                        for (int k4 = 0; k4 < 2; ++k4) asm volatile("" : "+v"(bz[k4][0]), "+v"(bz[k4][1]), "+v"(bz[k4][2]), "+v"(bz[k4][3]));
#pragma unroll
                        for (int k4 = 0; k4 < 2; ++k4)
#pragma unroll
                            for (int r = 0; r < 4; ++r) { const int kt = 2 * kh + k4; const int dist = dist0 - (16 * kt + r);
                                const bool valid = own ? (dist >= 0) : selb[gp]; const float x = valid ? s[gp][kt][r] + bz[k4][r] : -INFINITY; s[gp][kt][r] = x; mx = __builtin_fmaxf(mx, x); } }
                } else {
#pragma unroll
                    for (int kt = 0; kt < 8; ++kt)
#pragma unroll
                        for (int r = 0; r < 4; ++r) mx = __builtin_fmaxf(mx, s[gp][kt][r]); }
                mx = q4_max(mx);
                if (n == 0) {
                    mref[gp] = mx;
#pragma unroll
                    for (int kt = 0; kt < 8; ++kt)
#pragma unroll
                        for (int r = 0; r < 4; ++r) s[gp][kt][r] -= mx;
                } else if (__any(mx > THR)) {
                    const float dl = __builtin_fmaxf(mx, 0.0f), f = __builtin_amdgcn_exp2f(-dl); mref[gp] += dl;
#pragma unroll
                    for (int kt = 0; kt < 8; ++kt)
#pragma unroll
                        for (int r = 0; r < 4; ++r) s[gp][kt][r] -= dl;
#pragma unroll
                    for (int dt = 0; dt < 5; ++dt) o[gp][dt] = o[gp][dt] * f; }
#pragma unroll
                for (int kt = 0; kt < 8; ++kt)
#pragma unroll
                    for (int r = 0; r < 4; ++r) s[gp][kt][r] = __builtin_amdgcn_exp2f(s[gp][kt][r]);
            }
#pragma unroll
            for (int k2 = 0; k2 < 4; ++k2) { if (probe == 5) break; bf16x8 pb[2][4];
#pragma unroll
                for (int gp = 0; gp < 2; ++gp) { v4u pw; pw.x = cvt_pk_bf16(s[gp][2 * k2][0], s[gp][2 * k2][1]); pw.y = cvt_pk_bf16(s[gp][2 * k2][2], s[gp][2 * k2][3]);
                    pw.z = cvt_pk_bf16(s[gp][2 * k2 + 1][0], s[gp][2 * k2 + 1][1]); pw.w = cvt_pk_bf16(s[gp][2 * k2 + 1][2], s[gp][2 * k2 + 1][3]); pb[gp][k2] = __builtin_bit_cast(bf16x8, pw); }
#pragma unroll
                for (int dt = 0; dt < 4; ++dt) { const LAS unsigned char* vp = buf + KB_ + (16 * dt + qi) * VRS + 64 * k2 + 8 * g; const v2u lo = *(const LAS v2u*)vp, hi = *(const LAS v2u*)(vp + 32);
                    v4u aw; aw.x = lo.x; aw.y = lo.y; aw.z = hi.x; aw.w = hi.y; const bf16x8 av = __builtin_bit_cast(bf16x8, aw);
                    o[0][dt] = __builtin_amdgcn_mfma_f32_16x16x32_bf16(av, pb[0][k2], o[0][dt], 0, 0, 0); o[1][dt] = __builtin_amdgcn_mfma_f32_16x16x32_bf16(av, pb[1][k2], o[1][dt], 0, 0, 0); }
                o[0][4] = __builtin_amdgcn_mfma_f32_16x16x32_bf16(ones, pb[0][k2], o[0][4], 0, 0, 0); o[1][4] = __builtin_amdgcn_mfma_f32_16x16x32_bf16(ones, pb[1][k2], o[1][4], 0, 0, 0); }
        }
#pragma unroll
        for (int gp = 0; gp < 2; ++gp) { const float inv = 1.0f / o[gp][4][0]; const size_t qrow = (size_t)b * SEQ + q0 + 16 * gp + qi;
#pragma unroll
            for (int dt = 0; dt < 4; ++dt) { v2u w; w.x = cvt_pk_bf16(o[gp][dt][0] * inv, o[gp][dt][1] * inv); w.y = cvt_pk_bf16(o[gp][dt][2] * inv, o[gp][dt][3] * inv); *(v2u*)(O + qrow * D + h * HD + 16 * dt + 4 * g) = w; } }
    }
    __syncthreads();
}

constexpr int SC = 32, NCHK = SEQ / SC;
constexpr size_t WS_PT = WS_S + 256 * MiB;
constexpr size_t WS_LT = 48 * MiB;
constexpr size_t WS_QT = WS_S + 576 * MiB;
constexpr size_t WS_YS2 = WS_S;
constexpr int LT_SPLIT = 98; constexpr size_t WS_LT2 = WS_YG + 64 * MiB;
static_assert(WS_LT + (size_t)LT_SPLIT * MiB <= WS_XB && WS_LT2 + (size_t)(NCHK - LT_SPLIT) * MiB <= WS_END && WS_QT + 64 * MiB <= WS_YG, "chunk operator buffers");
__device__ __forceinline__ size_t lt_off(int ck, int bh) { return (ck < LT_SPLIT ? WS_LT + (size_t)ck * MiB : WS_LT2 + (size_t)(ck - LT_SPLIT) * MiB) + (size_t)bh * 8192; }
__device__ __forceinline__ float reduce8(float v) { v = dpp_add<0xB1>(v); v = dpp_add<0x4E>(v); v = dpp_add<0x141>(v); return v; }
template <int KS> __device__ __forceinline__ f32x4 mm_tile(const LAS unsigned char* X, int xs, int m0, const LAS unsigned char* Y, int ys, int n0, f32x4 acc, int qi, int g) {
#pragma unroll
    for (int ks = 0; ks < KS; ++ks) { const bf16x8 a = *(const LAS bf16x8*)(X + (m0 + qi) * xs + 64 * ks + 16 * g), b = *(const LAS bf16x8*)(Y + (n0 + qi) * ys + 64 * ks + 16 * g);
        acc = __builtin_amdgcn_mfma_f32_16x16x32_bf16(a, b, acc, 0, 0, 0); }
    return acc;
}
typedef short v4i16_t_ __attribute__((ext_vector_type(4)));
__device__ __forceinline__ bf16x8 frag_tr(const LAS unsigned char* Z, int zs, int kk0, int c0, int qi, int g) {
    const LAS unsigned char* p = Z + (kk0 + 8 * g + (qi >> 2)) * zs + (c0 + 4 * (qi & 3)) * 2;
    const v4i16_t_ lo = __builtin_amdgcn_ds_read_tr16_b64_v4i16((LAS v4i16_t_*)p), hi = __builtin_amdgcn_ds_read_tr16_b64_v4i16((LAS v4i16_t_*)(p + 4 * zs));
    return (bf16x8){lo[0], lo[1], lo[2], lo[3], hi[0], hi[1], hi[2], hi[3]};
}
template <int KS> __device__ __forceinline__ f32x4 mm_tile_xt(const LAS unsigned char* Z, int zs, int m0, const LAS unsigned char* Y, int ys, int n0, f32x4 acc, int qi, int g) {
#pragma unroll
    for (int ks = 0; ks < KS; ++ks) { const bf16x8 a = frag_tr(Z, zs, 32 * ks, m0, qi, g), b = *(const LAS bf16x8*)(Y + (n0 + qi) * ys + 64 * ks + 16 * g);
        acc = __builtin_amdgcn_mfma_f32_16x16x32_bf16(a, b, acc, 0, 0, 0); }
    return acc;
}
template <int KS> __device__ __forceinline__ f32x4 mm_tile_yt(const LAS unsigned char* X, int xs, int m0, const LAS unsigned char* Z, int zs, int n0, f32x4 acc, int qi, int g) {
#pragma unroll
    for (int ks = 0; ks < KS; ++ks) { const bf16x8 a = *(const LAS bf16x8*)(X + (m0 + qi) * xs + 64 * ks + 16 * g), b = frag_tr(Z, zs, 32 * ks, n0, qi, g);
        acc = __builtin_amdgcn_mfma_f32_16x16x32_bf16(a, b, acc, 0, 0, 0); }
    return acc;
}
__device__ __forceinline__ v2u pack4(const f32x4 v) { v2u w; w.x = cvt_pk_bf16(v[0], v[1]); w.y = cvt_pk_bf16(v[2], v[3]); return w; }
__device__ __forceinline__ void chunk_prep(Frame& F, const bf16* vbuf, const float* k_k, const float* k_a, const bool dry = false) {
    const bf16* rb = (const bf16*)(F.ws + WS_R); const bf16* kb = (const bf16*)(F.ws + WS_KK); const bf16* ab = (const bf16*)(F.ws + WS_A); const bf16* lw = (const bf16*)(F.ws + WS_LW);
    bf16* PTg = (bf16*)(F.ws + WS_PT); bf16* QTg = (bf16*)(F.ws + WS_QT); bf16* LTg = (bf16*)(F.ws + WS_LT); float* ys = (float*)(F.ws + WS_YS2);
    constexpr int RS = 144, TS_ = 80;
    constexpr int O_AT = 0, O_BT = 4608, O_KT = 9216, O_RT = 13824, O_VT = 18432, O_X2T = 23040, O_GT = 28160,
                  O_TM = 33280, O_NRBT = 35840, O_NAK = 38400, O_X1T = 40960, O_HT = 43520, O_NAB = 46080, O_WC = 50688, O_PK = 50944, O_CL = O_X2T;
    const int grp = F.wave >> 2, wg = F.wave & 3;
    LAS unsigned char* L = F.lds + grp * 65536;
    const int gt0 = F.tid & 255, st0 = gt0 >> 3, c80 = gt0 & 7;
    __syncthreads();
    for (int i = gt0; i < D; i += 256) { *(LAS float*)(L + O_PK + i * 4) = k_k[i]; *(LAS float*)(L + O_PK + 4096 + i * 4) = k_a[i]; }
    constexpr int NIT = (NBATCH * NH * NCHK) / (2 * 256);
    v4u pre_r, pre_k, pre_a, pre_v, pre_l;
#define CP_BAR() asm volatile("s_waitcnt lgkmcnt(0)\n\ts_barrier" ::: "memory")
#define CP_LOAD(it_) do { const int item_ = ((it_) * F.G + F.vcu) * 2 + grp, bh_ = item_ >> 7, ck_ = item_ & (NCHK - 1); \
        const size_t o_ = ((size_t)(bh_ >> 4) * SEQ + ck_ * SC + st0) * D + (bh_ & 15) * HD + 8 * c80; \
        pre_r = *(const v4u*)(rb + o_); pre_k = *(const v4u*)(kb + o_); pre_a = *(const v4u*)(ab + o_); pre_v = *(const v4u*)(vbuf + o_); pre_l = *(const v4u*)(lw + o_); } while (0)
    CP_LOAD(0);
    asm volatile("" : "+v"(pre_r), "+v"(pre_k), "+v"(pre_a), "+v"(pre_v), "+v"(pre_l));
    for (int it = 0; it < NIT; ++it) {
        const int item = (it * F.G + F.vcu) * 2 + grp, bh = item >> 7, ck = item & (NCHK - 1), b = bh >> 4, h = bh & 15, t0 = ck * SC;
        const size_t base = ((size_t)b * SEQ + t0) * D + h * HD;
        int lane_i = F.lane; asm volatile("" : "+v"(lane_i));
        const int gt = (wg << 6) | lane_i, qi = lane_i & 15, g = lane_i >> 4, st = gt >> 3, c8 = gt & 7;
        CP_BAR();
        float r8[8], al8[8], be8[8], kh8[8], v8[8];
        { const v4u wr_ = pre_r, wk = pre_k, wa = pre_a, wv = pre_v;
          f32x4 l0 = {bflo(pre_l.x), bfhi(pre_l.x), bflo(pre_l.y), bfhi(pre_l.y)}, l1 = {bflo(pre_l.z), bfhi(pre_l.z), bflo(pre_l.w), bfhi(pre_l.w)};
#pragma unroll
          for (int j = 0; j < 4; ++j) { { const float z = l0[j]; l0[j] = -fast_exp(fminf(z, 0.0f) - __logf(1.0f + fast_exp(-fabsf(z))) - 0.5f); } { const float z = l1[j]; l1[j] = -fast_exp(fminf(z, 0.0f) - __logf(1.0f + fast_exp(-fabsf(z))) - 0.5f); } }
          const f32x4 kk0 = *(const LAS f32x4*)(L + O_PK + (h * HD + 8 * c8) * 4), kk1 = *(const LAS f32x4*)(L + O_PK + (h * HD + 8 * c8 + 4) * 4), ka0 = *(const LAS f32x4*)(L + O_PK + 4096 + (h * HD + 8 * c8) * 4), ka1 = *(const LAS f32x4*)(L + O_PK + 4096 + (h * HD + 8 * c8 + 4) * 4);
          float k8[8], a8[8], kk8[8]; float ss = 0.f;
#pragma unroll
          for (int j = 0; j < 8; ++j) { const unsigned xr = wr_[j >> 1], xk = wk[j >> 1], xa = wa[j >> 1], xv = wv[j >> 1];
              r8[j] = (j & 1) ? bfhi(xr) : bflo(xr); k8[j] = (j & 1) ? bfhi(xk) : bflo(xk); a8[j] = (j & 1) ? bfhi(xa) : bflo(xa); v8[j] = (j & 1) ? bfhi(xv) : bflo(xv);
              kk8[j] = k8[j] * (j < 4 ? kk0[j & 3] : kk1[j & 3]); ss += kk8[j] * kk8[j]; }
          ss = reduce8(ss); const float inv = 1.0f / fmaxf(sqrtf(ss), 1e-12f);
#pragma unroll
          for (int j = 0; j < 8; ++j) { const float kk = kk8[j] * inv; al8[j] = -kk; be8[j] = kk * a8[j]; kh8[j] = k8[j] * (1.0f + (a8[j] - 1.0f) * (j < 4 ? ka0[j & 3] : ka1[j & 3])); }
          *(LAS f32x4*)(L + O_CL + (st * 64 + 8 * c8) * 4) = l0; *(LAS f32x4*)(L + O_CL + (st * 64 + 8 * c8 + 4) * 4) = l1; }
        { const int itn = it + 1 < NIT ? it + 1 : it; CP_LOAD(itn); }
        CP_BAR();
#if DRYCUT == 5
        if (dry) continue;
#endif
        if (gt < 64) { float cv[SC];
#pragma unroll
            for (int t = 0; t < SC; ++t) cv[t] = *(const LAS float*)(L + O_CL + (t * 64 + gt) * 4);
#pragma unroll
            for (int t = 1; t < SC; ++t) cv[t] += cv[t - 1];
#pragma unroll
            for (int t = 0; t < SC; ++t) *(LAS float*)(L + O_CL + (t * 64 + gt) * 4) = cv[t];
            *(LAS float*)(L + O_WC + gt * 4) = fast_exp(cv[SC - 1]); }
        CP_BAR();
#if DRYCUT == 6
        if (dry) continue;
#endif
        { float cl[8], cm[8];
          { const f32x4 c0 = *(const LAS f32x4*)(L + O_CL + (st * 64 + 8 * c8) * 4), c1 = *(const LAS f32x4*)(L + O_CL + (st * 64 + 8 * c8 + 4) * 4);
            f32x4 m0 = {0.f, 0.f, 0.f, 0.f}, m1 = {0.f, 0.f, 0.f, 0.f};
            if (st > 0) { m0 = *(const LAS f32x4*)(L + O_CL + ((st - 1) * 64 + 8 * c8) * 4); m1 = *(const LAS f32x4*)(L + O_CL + ((st - 1) * 64 + 8 * c8 + 4) * 4); }
#pragma unroll
            for (int j = 0; j < 4; ++j) { cl[j] = c0[j]; cl[4 + j] = c1[j]; cm[j] = m0[j]; cm[4 + j] = m1[j]; } }
          float at8[8], bt8[8], kt8[8], rt8[8];
#pragma unroll
          for (int j = 0; j < 8; ++j) { const float e1 = fast_exp(cl[j]), em = fast_exp(cm[j]), en = fast_exp(-cl[j]); at8[j] = al8[j] * em; bt8[j] = be8[j] * en; kt8[j] = kh8[j] * en; rt8[j] = r8[j] * e1; }
          v4u w; w.x = cvt_pk_bf16(at8[0], at8[1]); w.y = cvt_pk_bf16(at8[2], at8[3]); w.z = cvt_pk_bf16(at8[4], at8[5]); w.w = cvt_pk_bf16(at8[6], at8[7]); *(LAS v4u*)(L + O_AT + st * RS + 16 * c8) = w;
          w.x = cvt_pk_bf16(bt8[0], bt8[1]); w.y = cvt_pk_bf16(bt8[2], bt8[3]); w.z = cvt_pk_bf16(bt8[4], bt8[5]); w.w = cvt_pk_bf16(bt8[6], bt8[7]); *(LAS v4u*)(L + O_BT + st * RS + 16 * c8) = w;
          w.x = cvt_pk_bf16(kt8[0], kt8[1]); w.y = cvt_pk_bf16(kt8[2], kt8[3]); w.z = cvt_pk_bf16(kt8[4], kt8[5]); w.w = cvt_pk_bf16(kt8[6], kt8[7]); *(LAS v4u*)(L + O_KT + st * RS + 16 * c8) = w;
          w.x = cvt_pk_bf16(rt8[0], rt8[1]); w.y = cvt_pk_bf16(rt8[2], rt8[3]); w.z = cvt_pk_bf16(rt8[4], rt8[5]); w.w = cvt_pk_bf16(rt8[6], rt8[7]); *(LAS v4u*)(L + O_RT + st * RS + 16 * c8) = w;
          w.x = cvt_pk_bf16(v8[0], v8[1]); w.y = cvt_pk_bf16(v8[2], v8[3]); w.z = cvt_pk_bf16(v8[4], v8[5]); w.w = cvt_pk_bf16(v8[6], v8[7]); *(LAS v4u*)(L + O_VT + st * RS + 16 * c8) = w; }
        CP_BAR();
#if DRYCUT == 1
        if (dry) continue;
#endif
        { const int mt = wg >> 1, nt = wg & 1, n = 16 * nt + qi, m0 = 16 * mt + 4 * g; const f32x4 z = {0.f, 0.f, 0.f, 0.f};
          f32x4 c1 = mm_tile<2>(L + O_AT, RS, 16 * mt, L + O_BT, RS, 16 * nt, z, qi, g);
#pragma unroll
          for (int r = 0; r < 4; ++r) c1[r] = (n < m0 + r) ? c1[r] : 0.f;
          *(LAS f32x4*)(L + O_NAB + n * 144 + m0 * 4) = c1;
          f32x4 c2 = mm_tile<2>(L + O_BT, RS, 16 * mt, L + O_RT, RS, 16 * nt, z, qi, g);
#pragma unroll
          for (int r = 0; r < 4; ++r) c2[r] = (m0 + r <= n) ? c2[r] : 0.f;
          *(LAS v2u*)(L + O_NRBT + n * TS_ + m0 * 2) = pack4(c2);
          f32x4 c3 = mm_tile<2>(L + O_AT, RS, 16 * mt, L + O_KT, RS, 16 * nt, z, qi, g);
#pragma unroll
          for (int r = 0; r < 4; ++r) c3[r] = (n < m0 + r) ? c3[r] : 0.f;
          *(LAS v2u*)(L + O_NAK + n * TS_ + m0 * 2) = pack4(c3); }
        CP_BAR();
#if DRYCUT == 2
        if (dry) continue;
#endif
        if (wg == 0) { const int col = lane_i & 31; float x[SC];
#pragma unroll
            for (int s = SC - 1; s >= 0; --s) { float ac[4] = {(col == s) ? 1.0f : 0.0f, 0.f, 0.f, 0.f};
#pragma unroll
                for (int q4 = SC / 4 - 1; q4 >= (s + 1) >> 2; --q4) { const f32x4 nv = *(const LAS f32x4*)(L + O_NAB + s * 144 + q4 * 16);
#pragma unroll
                    for (int r = 3; r >= 0; --r) { const int t = 4 * q4 + r; if (t > s) ac[r] += nv[r] * x[t]; } }
                x[s] = (ac[0] + ac[1]) + (ac[2] + ac[3]); }
            if (lane_i < 32) {
#pragma unroll
                for (int s = 0; s < SC; ++s) *(LAS bf16*)(L + O_TM + s * TS_ + col * 2) = (bf16)(cvt_pk_bf16(x[s], 0.f) & 0xffffu); } }
        CP_BAR();
#if DRYCUT == 3
        if (dry) continue;
#endif
        { const f32x4 z = {0.f, 0.f, 0.f, 0.f};
          { const int mt = wg >> 1, nt = wg & 1; const f32x4 c = mm_tile<1>(L + O_TM, TS_, 16 * mt, L + O_NRBT, TS_, 16 * nt, z, qi, g); *(LAS v2u*)(L + O_X1T + (16 * nt + qi) * TS_ + (16 * mt + 4 * g) * 2) = pack4(c); }
#pragma unroll
          for (int q = 0; q < 2; ++q) { const int tix = wg * 2 + q, mt = tix >> 2, nt = tix & 3; const f32x4 c = mm_tile_yt<1>(L + O_TM, TS_, 16 * mt, L + O_BT, RS, 16 * nt, z, qi, g);
              *(LAS v2u*)(L + O_X2T + (16 * nt + qi) * TS_ + (16 * mt + 4 * g) * 2) = pack4(c); } }
        CP_BAR();
        asm volatile("" : "+v"(pre_r), "+v"(pre_k), "+v"(pre_a), "+v"(pre_v), "+v"(pre_l));
        { const size_t cid = (size_t)ck * (NBATCH * NH) + bh;
          { const int nt = wg & 1, t = 16 * nt + qi; v2u pk[2];
#pragma unroll
            for (int q = 0; q < 2; ++q) { const int mt = 2 * (wg >> 1) + q; const v2u rw = *(const LAS v2u*)(L + O_RT + t * RS + (16 * mt + 4 * g) * 2);
              f32x4 c = {bflo(rw.x), bfhi(rw.x), bflo(rw.y), bfhi(rw.y)}; c = mm_tile_xt<1>(L + O_AT, RS, 16 * mt, L + O_X1T, TS_, 16 * nt, c, qi, g); pk[q] = pack4(c); }
            v4u w4; w4.x = pk[0].x; w4.y = pk[0].y; w4.z = pk[1].x; w4.w = pk[1].y; *(v4u*)(QTg + (cid * SC + t) * 64 + 32 * (wg >> 1) + 8 * g) = w4; }
          { const int mt = wg >> 1, nt = wg & 1, n = 16 * nt + qi, m0 = 16 * mt + 4 * g; f32x4 c = mm_tile<2>(L + O_KT, RS, 16 * mt, L + O_RT, RS, 16 * nt, (f32x4){0.f, 0.f, 0.f, 0.f}, qi, g);
#pragma unroll
            for (int r = 0; r < 4; ++r) c[r] = (m0 + r <= n) ? c[r] : 0.f;
            c = mm_tile<1>(L + O_NAK, TS_, 16 * mt, L + O_X1T, TS_, 16 * nt, c, qi, g); *(LAS v2u*)(L + O_HT + n * TS_ + m0 * 2) = pack4(c); }
#pragma unroll
          for (int q2 = 0; q2 < 2; ++q2) { const int nt = 2 * (wg >> 1) + q2, k = 16 * nt + qi; const float wc = *(const LAS float*)(L + O_WC + k * 4); v2u pk[2];
#pragma unroll
              for (int q = 0; q < 2; ++q) { const int mt = 2 * (wg & 1) + q, m0 = 16 * mt + 4 * g; f32x4 c = mm_tile_xt<1>(L + O_AT, RS, 16 * mt, L + O_X2T, TS_, 16 * nt, (f32x4){0.f, 0.f, 0.f, 0.f}, qi, g);
#pragma unroll
                  for (int r = 0; r < 4; ++r) c[r] = (c[r] + ((m0 + r == k) ? 1.0f : 0.0f)) * wc;
                  pk[q] = pack4(c); }
              v4u w4; w4.x = pk[0].x; w4.y = pk[0].y; w4.z = pk[1].x; w4.w = pk[1].y; *(v4u*)(PTg + (cid * 64 + k) * 64 + 32 * (wg & 1) + 8 * g) = w4; }
#pragma unroll
          for (int q = 0; q < 2; ++q) { const int tix = wg * 2 + q, mt = tix >> 2, nt = tix & 3, k = 16 * nt + qi, m0 = 16 * mt + 4 * g; f32x4 c;
#pragma unroll
              for (int r = 0; r < 4; ++r) c[r] = bf1(*(const LAS bf16*)(L + O_KT + (m0 + r) * RS + k * 2));
              c = mm_tile<1>(L + O_NAK, TS_, 16 * mt, L + O_X2T, TS_, 16 * nt, c, qi, g); const float wc = *(const LAS float*)(L + O_WC + k * 4);
              *(LAS v2u*)(L + O_GT + k * TS_ + m0 * 2) = pack4(c * wc); } }
        CP_BAR();
#if DRYCUT == 4
        if (dry) continue;
#endif
        { const size_t cid = (size_t)ck * (NBATCH * NH) + bh; const f32x4 z = {0.f, 0.f, 0.f, 0.f};
#pragma unroll
          for (int q = 0; q < 4; ++q) { const int mt = q, nt = wg; const f32x4 c = mm_tile_yt<1>(L + O_GT, TS_, 16 * mt, L + O_VT, RS, 16 * nt, z, qi, g);
              *(v2u*)((bf16*)(F.ws + lt_off(ck, bh)) + (((size_t)nt * 4 + mt) * 64 + lane_i) * 4) = pack4(c); }
#pragma unroll
          for (int q = 0; q < 2; ++q) { const int mt = q, nt = wg; const f32x4 c = mm_tile_yt<1>(L + O_HT, TS_, 16 * mt, L + O_VT, RS, 16 * nt, z, qi, g);
              if (!dry) *(v2u*)((bf16*)(F.ws + WS_YG) + ((cid * 8 + 4 * mt + nt) * 64 + lane_i) * 4) = pack4(c); } }
    }
#undef CP_LOAD
#undef CP_BAR
    __syncthreads();
}
__device__ __forceinline__ void chunk_scan(Frame& F, const bool dry = false) {
    const bf16* PTg = (const bf16*)(F.ws + WS_PT); const bf16* QTg = (const bf16*)(F.ws + WS_QT); const bf16* YLg = (const bf16*)(F.ws + WS_YG); bf16* ys = (bf16*)(F.ws + WS_YS2);
    const int qi = F.lane & 15, g = F.lane >> 4, w = F.wave & 3, ty = w & 1, vy0 = 2 * (w >> 1);
    constexpr int SRS = 144, SBUF = 64 * SRS;
    constexpr int YRS = 68, YBUF = SC * YRS * 4;
    LAS unsigned char* SL = F.lds;
    const int hs = (F.G >= 2 * NBATCH * NH) ? 2 : 1;
    for (int bh = (F.vcu % hs) ? NBATCH * NH : F.vcu / hs; bh < NBATCH * NH; bh += F.G / hs) {
        const int b = bh >> 4, h = bh & 15;
        __syncthreads();
        if (F.wave >= 4) { __syncthreads();
            const int u_ = F.wave - 4, tr_ = 8 * u_ + (F.lane >> 3), vc_ = 8 * (F.lane & 7);
            for (int ck = 0; ck < NCHK; ++ck) { asm volatile("s_barrier" ::: "memory");
                const LAS float* yb_ = (const LAS float*)(SL + 2 * SBUF + (ck & 1) * YBUF) + tr_ * YRS + vc_; const f32x4 a0 = *(const LAS f32x4*)yb_, a1 = *(const LAS f32x4*)(yb_ + 4);
                v4u wv_; wv_.x = cvt_pk_bf16(a0[0], a0[1]); wv_.y = cvt_pk_bf16(a0[2], a0[3]); wv_.z = cvt_pk_bf16(a1[0], a1[1]); wv_.w = cvt_pk_bf16(a1[2], a1[3]);
                bf16* yo_ = ys + ((size_t)b * SEQ + ck * SC + tr_) * D + h * HD + vc_; if (!dry) *(v4u*)yo_ = wv_; }
            continue; }
        unsigned z_ = 0u; asm volatile("" : "+v"(z_));
        for (int i = F.lane; i < 16 * 64 / 8; i += 64) *(LAS v4u*)(SL + (16 * w + (i >> 3)) * SRS + (i & 7) * 16) = (v4u){z_, z_, z_, z_};
        __syncthreads();
        v4u pa0[2], qa0[2], pa1[2], qa1[2], pa2[2], qa2[2], pa3[2], qa3[2]; v2u lt0[4], lt1[4], lt2[4], lt3[4]; v2u yl0[2], yl1[2], yl2[2], yl3[2];
#define CS_LOAD(pa, qa, lt, yl, ck_) do { const size_t cid = (size_t)(ck_) * (NBATCH * NH) + bh; \
        _Pragma("unroll") for (int ks = 0; ks < 2; ++ks) { pa[ks] = *(const v4u*)(PTg + (cid * 64 + 16 * w + qi) * 64 + 32 * ks + 8 * g); qa[ks] = *(const v4u*)(QTg + (cid * SC + 16 * ty + qi) * 64 + 32 * ks + 8 * g); } \
        { const bf16* ltb_ = (const bf16*)(F.ws + lt_off((ck_), bh)); _Pragma("unroll") for (int nt = 0; nt < 4; ++nt) lt[nt] = *(const v2u*)(ltb_ + (((size_t)nt * 4 + w) * 64 + F.lane) * 4); } \
        _Pragma("unroll") for (int i_ = 0; i_ < 2; ++i_) yl[i_] = *(const v2u*)(YLg + ((cid * 8 + 4 * ty + vy0 + i_) * 64 + F.lane) * 4); } while (0)
#define CS_STEP(pa, qa, lt, yl, ck_) do { const LAS unsigned char* Sc = SL + ((ck_) & 1) * SBUF; LAS unsigned char* Sn = SL + (((ck_) + 1) & 1) * SBUF; \
        bf16x8 bfr[4][2]; \
        _Pragma("unroll") for (int nt = 0; nt < 4; ++nt) { _Pragma("unroll") for (int ks = 0; ks < 2; ++ks) bfr[nt][ks] = *(const LAS bf16x8*)(Sc + (16 * nt + qi) * SRS + 64 * ks + 16 * g); } \
        f32x4 y_[2]; \
        _Pragma("unroll") for (int i_ = 0; i_ < 2; ++i_) { y_[i_] = (f32x4){bflo(yl[i_].x), bfhi(yl[i_].x), bflo(yl[i_].y), bfhi(yl[i_].y)}; \
            _Pragma("unroll") for (int ks = 0; ks < 2; ++ks) { const bf16x8 by_ = *(const LAS bf16x8*)(Sc + (16 * (vy0 + i_) + qi) * SRS + 64 * ks + 16 * g);     \
                y_[i_] = __builtin_amdgcn_mfma_f32_16x16x32_bf16(__builtin_bit_cast(bf16x8, qa[ks]), by_, y_[i_], 0, 0, 0); } } \
        _Pragma("unroll") for (int nt = 0; nt < 4; ++nt) { f32x4 sn = {bflo(lt[nt].x), bfhi(lt[nt].x), bflo(lt[nt].y), bfhi(lt[nt].y)}; \
            _Pragma("unroll") for (int ks = 0; ks < 2; ++ks) sn = __builtin_amdgcn_mfma_f32_16x16x32_bf16(__builtin_bit_cast(bf16x8, pa[ks]), bfr[nt][ks], sn, 0, 0, 0); \
            *(LAS v2u*)(Sn + (16 * nt + qi) * SRS + (32 * (w >> 1) + 8 * g + 4 * (w & 1)) * 2) = pack4(sn); }       \
        __builtin_amdgcn_sched_barrier(0); \
        { const int ckn_ = (DRYCUT == 7 && dry) ? ((ck_) & 3) : ((ck_) + 4 < NCHK ? (ck_) + 4 : NCHK - 1); CS_LOAD(pa, qa, lt, yl, ckn_); }        \
        __builtin_amdgcn_sched_barrier(0);              \
        { LAS float* yb_ = (LAS float*)(SL + 2 * SBUF + ((ck_) & 1) * YBUF); \
          _Pragma("unroll") for (int i_ = 0; i_ < 2; ++i_) { _Pragma("unroll") for (int r = 0; r < 4; ++r) yb_[(16 * ty + 4 * g + r) * YRS + 16 * (vy0 + i_) + qi] = y_[i_][r]; } } \
        asm volatile("s_waitcnt lgkmcnt(0)\n\ts_barrier" ::: "memory");        \
        __builtin_amdgcn_sched_barrier(0); } while (0)
        CS_LOAD(pa0, qa0, lt0, yl0, 0); CS_LOAD(pa1, qa1, lt1, yl1, 1); CS_LOAD(pa2, qa2, lt2, yl2, 2); CS_LOAD(pa3, qa3, lt3, yl3, 3);
#pragma unroll 4
        for (int ck = 0; ck < NCHK; ck += 4) { CS_STEP(pa0, qa0, lt0, yl0, ck); CS_STEP(pa1, qa1, lt1, yl1, ck + 1); CS_STEP(pa2, qa2, lt2, yl2, ck + 2); CS_STEP(pa3, qa3, lt3, yl3, ck + 3); }
#undef CS_STEP
#undef CS_LOAD
    }
    __syncthreads();
}
__device__ __forceinline__ void post_phase(Frame& F, const bf16* vbuf, const float* k_a, const float* r_k, const float* gn_g, const float* gn_b) {
    const bf16* rb = (const bf16*)(F.ws + WS_R); const bf16* kb = (const bf16*)(F.ws + WS_KK); const bf16* ab = (const bf16*)(F.ws + WS_A); const bf16* gb = (const bf16*)(F.ws + WS_G);
    const bf16* ys = (const bf16*)(F.ws + WS_YS2); bf16* yg = (bf16*)(F.ws + WS_YG);
    f32x4 kav[2][2], rkv[2][2], gg[2][2], gbv[2][2];
#pragma unroll
    for (int jh = 0; jh < 2; ++jh)
#pragma unroll
        for (int q = 0; q < 2; ++q) { const int cc = 512 * jh + 8 * F.lane + 4 * q; kav[jh][q] = *(const f32x4*)(k_a + cc); rkv[jh][q] = *(const f32x4*)(r_k + cc); gg[jh][q] = *(const f32x4*)(gn_g + cc); gbv[jh][q] = *(const f32x4*)(gn_b + cc); }
    for (int row = F.gw; row < T; row += F.NGW) {
        v4u yw_[2]; v4u wr_[2], wk[2], wa[2], wv[2], wg[2];
#pragma unroll
        for (int jh = 0; jh < 2; ++jh) { const size_t o = (size_t)row * D + 512 * jh + 8 * F.lane;
            yw_[jh] = *(const v4u*)(ys + o); wr_[jh] = *(const v4u*)(rb + o); wk[jh] = *(const v4u*)(kb + o); wa[jh] = *(const v4u*)(ab + o); wv[jh] = *(const v4u*)(vbuf + o); wg[jh] = *(const v4u*)(gb + o); }
#pragma unroll
        for (int jh = 0; jh < 2; ++jh) { const size_t o = (size_t)row * D + 512 * jh + 8 * F.lane; v4u w;
            const f32x4 y0 = {bflo(yw_[jh].x), bfhi(yw_[jh].x), bflo(yw_[jh].y), bfhi(yw_[jh].y)}, y1 = {bflo(yw_[jh].z), bfhi(yw_[jh].z), bflo(yw_[jh].w), bfhi(yw_[jh].w)};
            const float mean = reduce8(((y0[0] + y0[1]) + (y0[2] + y0[3])) + ((y1[0] + y1[1]) + (y1[2] + y1[3]))) * (1.0f / HD); const f32x4 dy0 = y0 - mean, dy1 = y1 - mean;
            const float var = reduce8(((dy0[0] * dy0[0] + dy0[1] * dy0[1]) + (dy0[2] * dy0[2] + dy0[3] * dy0[3])) + ((dy1[0] * dy1[0] + dy1[1] * dy1[1]) + (dy1[2] * dy1[2] + dy1[3] * dy1[3]))) * (1.0f / HD);
            const float rstd = 1.0f / sqrtf(var + GN_EPS);
            f32x4 pr[2], v4[2], g4[2];
#pragma unroll
            for (int q = 0; q < 2; ++q) { const unsigned r0 = q ? wr_[jh].z : wr_[jh].x, r1 = q ? wr_[jh].w : wr_[jh].y, k0 = q ? wk[jh].z : wk[jh].x, k1 = q ? wk[jh].w : wk[jh].y, a0 = q ? wa[jh].z : wa[jh].x, a1 = q ? wa[jh].w : wa[jh].y;
                const unsigned v0 = q ? wv[jh].z : wv[jh].x, v1 = q ? wv[jh].w : wv[jh].y, g0 = q ? wg[jh].z : wg[jh].x, g1 = q ? wg[jh].w : wg[jh].y;
                const f32x4 r4 = {bflo(r0), bfhi(r0), bflo(r1), bfhi(r1)}, k4 = {bflo(k0), bfhi(k0), bflo(k1), bfhi(k1)}, a4 = {bflo(a0), bfhi(a0), bflo(a1), bfhi(a1)};
                v4[q] = (f32x4){bflo(v0), bfhi(v0), bflo(v1), bfhi(v1)}; g4[q] = (f32x4){bflo(g0), bfhi(g0), bflo(g1), bfhi(g1)};
                const f32x4 kh = k4 * (1.0f + (a4 - 1.0f) * kav[jh][q]); pr[q] = r4 * kh * rkv[jh][q]; }
            const float rk = reduce8(((pr[0][0] + pr[0][1]) + (pr[0][2] + pr[0][3])) + ((pr[1][0] + pr[1][1]) + (pr[1][2] + pr[1][3])));
            const f32x4 res0 = (dy0 * rstd * gg[jh][0] + gbv[jh][0] + v4[0] * rk) * g4[0], res1 = (dy1 * rstd * gg[jh][1] + gbv[jh][1] + v4[1] * rk) * g4[1];
            w.x = cvt_pk_bf16(res0[0], res0[1]); w.y = cvt_pk_bf16(res0[2], res0[3]); w.z = cvt_pk_bf16(res1[0], res1[1]); w.w = cvt_pk_bf16(res1[2], res1[3]); *(v4u*)(yg + o) = w; }
    }
}

__global__ void __launch_bounds__(NTHREADS, 2) fwd_kernel(Args args) {
    extern __shared__ __attribute__((aligned(16))) unsigned char lds_raw[];
    Frame F;
    F.lds = (LAS unsigned char*)lds_raw; F.ws = args.ws; F.out = args.out; F.ctl = (gu32*)(args.ws + WS_CTL);
    F.tid = 0; F.lane = 0; F.wave = __builtin_amdgcn_readfirstlane((int)threadIdx.x >> 6);
    F.G = gridDim.x; { const int bx = blockIdx.x; F.vcu = (F.G % 8 == 0) ? (bx % 8) * (F.G / 8) + bx / 8 : bx; }
    F.gw = F.vcu * NWAVES + F.wave; F.NGW = F.G * NWAVES;
    for (int i = threadIdx.x; i < (LDS_BYTES - MISC_OFF) / 4; i += NTHREADS) ((LAS unsigned*)(F.lds + MISC_OFF))[i] = 0u;
    __syncthreads();
    XcdBarrier bar = xcd_barrier_post((unsigned*)(F.ctl + CW_BAR), (volatile LAS unsigned*)(F.lds + MISC_OFF) + 8);
#if TIMING
    unsigned long long t_last = __builtin_amdgcn_s_memrealtime(), t_acc = 0; int t_class = 3, t_idx = 0;
#define GRID_BAR() do { xcd_barrier(bar); const unsigned long long now_ = __builtin_amdgcn_s_memrealtime(); if (t_class == TIMED_CLASS && ((TIMED_MASK >> t_idx) & 1)) t_acc += now_ - t_last; t_last = now_; ++t_idx; } while (0)
#define T_CLASS(c) do { t_class = (c); t_idx = 0; } while (0)
#else
#define GRID_BAR() xcd_barrier(bar)
#define T_CLASS(c) do { } while (0)
#endif
    if (threadIdx.x < 35) ((LAS unsigned long long*)(F.lds + PTAB_OFF))[threadIdx.x] = (unsigned long long)args.in[threadIdx.x];
    __syncthreads();
#define IN(k) in_ptr(F, (k))
    unsigned char* ws = args.ws;
    MoeTab MT; MT.cnt = (const LAS int*)(F.lds + TAB_OFF); MT.mtpref = MT.cnt + 65; MT.hoff = MT.mtpref + 66;

#if EN_P0
    { Frame P = phase_frame(F);
    cast_phase(P, IN(0));
    for (int j = 0; j < 2; ++j) {
        convert_plain(P, IN(1) + (size_t)j * D * 3 * D, D, 3 * D, (bf16*)(ws + WS_WQKV) + (size_t)j * 3 * D * D, 0);
        convert_plain(P, IN(2) + (size_t)j * D * D, D, D, (bf16*)(ws + WS_WOA) + (size_t)j * D * D, 0);
        for (int s = 0; s < 3; ++s) convert_plain(P, IN(5) + ((size_t)j * 3 + s) * D * D, D, D, (bf16*)(ws + WS_WRKV) + (size_t)j * 3 * D * D, s * D);
        convert_plain(P, IN(22) + (size_t)j * D * D, D, D, (bf16*)(ws + WS_WOB) + (size_t)j * D * D, 0);
        bf16* L1 = (bf16*)(ws + WS_L1) + (size_t)j * 4 * 256 * D; bf16* L2 = (bf16*)(ws + WS_L2) + (size_t)j * 4 * D * 256;
        { const SmallJob w1{IN(7) + (size_t)j * D * 64, D, 64, L1, 256, D}, a1{IN(10) + (size_t)j * D * 64, D, 64, L1 + 256 * D, 256, D}, g1{IN(15) + (size_t)j * D * 160, D, 160, L1 + 2 * 256 * D, 256, D};
          const SmallJob w2{IN(8) + (size_t)j * 64 * D, 64, D, L2, D, 256}, a2{IN(11) + (size_t)j * 64 * D, 64, D, L2 + D * 256, D, 256}, g2{IN(16) + (size_t)j * 160 * D, 160, D, L2 + 2 * D * 256, D, 256};
          const SmallJob v1{IN(13), D, 32, L1 + 3 * 256 * D, 256, D}, v2{IN(14), 32, D, L2 + 3 * D * 256, D, 256};
          convert_small4(P, w1, a1, g1, w2);
          if (j == 1) convert_small4(P, a2, g2, v1, v2); else { convert_small(P, a2.W, a2.K, a2.N, a2.WT, a2.Np, a2.Kp); convert_small(P, g2.W, g2.K, g2.N, g2.WT, g2.Np, g2.Kp); } }
    }
    { const SmallJob r0{IN(23), D, NE, (bf16*)(ws + WS_WR), 256, D}, r1{IN(23) + (size_t)1 * D * NE, D, NE, (bf16*)(ws + WS_WR) + (size_t)1 * 256 * D, 256, D};
      const SmallJob r2{IN(23) + (size_t)2 * D * NE, D, NE, (bf16*)(ws + WS_WR) + (size_t)2 * 256 * D, 256, D}, r3{IN(23) + (size_t)3 * D * NE, D, NE, (bf16*)(ws + WS_WR) + (size_t)3 * 256 * D, 256, D};
      convert_small4(P, r0, r1, r2, r3); }
    }
#endif
    GRID_BAR();

#define PH_BEGIN { Frame P = phase_frame(F);
#define PH_END } GRID_BAR();
    for (int i = 0; i < DEPTH; ++i) {
        const int j = i >> 1;
        if ((i & 1) == 0) { T_CLASS(0);
            PH_BEGIN
#if EN_QKV
              SchedDense S{T / 256, 12, P.G, (int)blockIdx.x, D, (const char*)(ws + WS_XB), (const char*)(ws + WS_WQKV) + (size_t)j * 3 * D * D * 2};
              EpiQKV E{(bf16*)(ws + WS_Q), (bf16*)(ws + WS_K), (bf16*)(ws + WS_VT)};
              _Pragma("nounroll") for (int rep = 0; rep < REP_QKV; ++rep) pg8::gemm_phase<D>(P.lds, P.tid, S, E);
#endif
            PH_END
            PH_BEGIN
#if EN_KMEAN
            kmean_phase(P);
#endif
            PH_END
            PH_BEGIN
#if EN_SEL
            sel_phase(P);
#endif
            PH_END
#if REP_ATTN > 1
            PH_BEGIN
            attn_phase<ATTN_PROBE>(P, IN(3));
            PH_END
#endif
            PH_BEGIN
#if EN_ATTN
            attn_phase<0>(P, IN(3));
#endif
            PH_END
            PH_BEGIN
#if EN_OPA
              SchedDense S{T / 256, 4, P.G, (int)blockIdx.x, D, (const char*)(ws + WS_O), (const char*)(ws + WS_WOA) + (size_t)j * D * D * 2};
              EpiAdd E{(bf16*)P.out, (const bf16*)(ws + WS_XB)};
              pg8::gemm_phase<D>(P.lds, P.tid, S, E);
#endif
            PH_END
        } else {
            T_CLASS(1);
            const size_t voff = (j == 0 ? WS_VF : WS_V);
            PH_BEGIN
#if EN_MIX
            for (int rep = 0; rep < REP_MIX; ++rep) mix_phase(P, IN(4) + (size_t)j * 6 * D);
#endif
            PH_END
            PH_BEGIN
#if EN_RKV
              SchedRkv S{T / 256, j == 0 ? 15 : 16, P.G, (int)blockIdx.x, (const char*)(ws + WS_XMIX), (const char*)(ws + WS_WRKV) + (size_t)j * 3 * D * D * 2, (const char*)(ws + WS_L1) + (size_t)j * 4 * 256 * D * 2};
              EpiRkv E{ws, voff};
              pg8::gemm_phase<D>(P.lds, P.tid, S, E);
#endif
            PH_END
            PH_BEGIN
#if EN_L2
              SchedL2 S{T / 256, j == 0 ? 12 : 16, P.G, (int)blockIdx.x, (const char*)(ws + WS_HL), (const char*)(ws + WS_L2) + (size_t)j * 4 * D * 256 * 2};
              EpiL2 E{(bf16*)(ws + WS_LW), (bf16*)(ws + WS_A), (bf16*)(ws + WS_G), (bf16*)(ws + voff), (const bf16*)(ws + WS_VF), IN(6) + j * D, IN(9) + j * D, IN(12)};
              pg8::gemm_phase<256>(P.lds, P.tid, S, E);
#endif
            PH_END
            PH_BEGIN
#if EN_SCAN
            for (int rep = 0; rep < REP_SCAN; ++rep) chunk_prep(P, (const bf16*)(ws + voff), IN(17) + j * D, IN(18) + j * D, rep + 1 < REP_SCAN);
#endif
            PH_END
            PH_BEGIN
#if EN_SCANB
            _Pragma("nounroll") for (int rep = 0; rep < REP_SCANB; ++rep) chunk_scan(P, rep + 1 < REP_SCANB);
#endif
            PH_END
            PH_BEGIN
#if EN_POST
#ifdef DBG_POST_COPY
            { const v4u* s_ = (const v4u*)(ws + WS_A); v4u* d_ = (v4u*)(ws + WS_YG); for (size_t q = (size_t)P.gw * 64 + P.lane; q < (size_t)T * D / 8; q += (size_t)P.NGW * 64) d_[q] = s_[q]; }
#else
            post_phase(P, (const bf16*)(ws + voff), IN(18) + j * D, IN(19) + j * D, IN(20) + j * D, IN(21) + j * D);
#endif
#endif
            PH_END
            PH_BEGIN
#if EN_OPB
              SchedDense S{T / 256, 4, P.G, (int)blockIdx.x, D, (const char*)(ws + WS_YG), (const char*)(ws + WS_WOB) + (size_t)j * D * D * 2};
              EpiAdd E{(bf16*)P.out, (const bf16*)(ws + WS_XB)};
              pg8::gemm_phase<D>(P.lds, P.tid, S, E);
#endif
            PH_END
        }
        T_CLASS(2);
        PH_BEGIN
#if EN_LN1
        ln1_route_phase(P, IN(31) + i * D, IN(32) + i * D, i, IN(24) + i * NE);
#endif
#if EN_CVT
        for (int rep = 0; rep < REP_CVT; ++rep) convert_moe(P, IN(25) + (size_t)i * NE * D * DE, IN(26) + (size_t)i * NE * D * DE, IN(27) + (size_t)i * NE * DE * D, IN(28) + (size_t)i * D * DE, IN(29) + (size_t)i * D * DE, IN(30) + (size_t)i * DE * D);
#endif
        PH_END
        PH_BEGIN
        moe_tables(P, i);
#if EN_G1
          SchedMoe1 S{P.G, P.vcu, MT, (const char*)(ws + WS_XB), (const char*)(ws + WS_WGU), (const int*)(ws + WS_TOKLIST), 0};
          _Pragma("nounroll") for (int rep = 0; rep < REP_G1; ++rep) { S.eh = 0; EpiSwiglu E{(bf16*)(ws + WS_H), rep + 1 < REP_G1}; pg8::gemm_phase<D>(P.lds, P.tid, S, E); }
#endif
        PH_END
        PH_BEGIN
#if EN_G2
          SchedMoe2 S{P.G, P.vcu, MT, (const char*)(ws + WS_H), (const char*)(ws + WS_WD), 0};
          if (G2_STAGGER > 0 && (P.vcu & 1)) { const unsigned long long t0_ = __builtin_amdgcn_s_memrealtime(); while (__builtin_amdgcn_s_memrealtime() - t0_ < (unsigned long long)G2_STAGGER) __builtin_amdgcn_s_sleep(8); }
          _Pragma("nounroll") for (int rep = 0; rep < REP_G2; ++rep) { S.eh = 0; EpiMoeDown E{ws, rep + 1 < REP_G2, (LAS float*)(P.lds + MISC_OFF + 4096)}; pg8::gemm_phase<DE>(P.lds, P.tid, S, E); }
#endif
        PH_END
        { Frame P = phase_frame(F);
#if EN_LN2
        ln2_phase(P, IN(33) + i * D, IN(34) + i * D, i == DEPTH - 1, MT);
#endif
        }
        if (i + 1 < DEPTH) GRID_BAR();
#if TIMING
        else { const unsigned long long now_ = __builtin_amdgcn_s_memrealtime(); if (t_class == TIMED_CLASS && ((TIMED_MASK >> t_idx) & 1)) t_acc += now_ - t_last; t_last = now_; }
#endif
    }
#if TIMING
    if (blockIdx.x == 0) { const unsigned long long t0_ = __builtin_amdgcn_s_memrealtime(); while (__builtin_amdgcn_s_memrealtime() - t0_ < (unsigned long long)TIMED_MULT * t_acc) __builtin_amdgcn_s_sleep(16); }
#endif
#undef IN
#undef GRID_BAR
}

extern "C" void kernel_launch(void* const* d_in, const int* in_sizes, int n_in, void* d_out, int out_size, void* d_ws, size_t ws_size, hipStream_t stream) {
    static int grid = 0;
    if (grid == 0) {
        if (n_in != 35 || out_size != T * D || ws_size < WS_END) { fprintf(stderr, "kernel_launch: unexpected shapes (n_in %d, out %d, ws %zu)\n", n_in, out_size, ws_size); grid = -1; return; }
        int dev = 0, cus = 0, per_cu = 0;
        if (hipGetDevice(&dev) != hipSuccess || hipDeviceGetAttribute(&cus, hipDeviceAttributeMultiprocessorCount, dev) != hipSuccess) { grid = -1; return; }
        if (hipFuncSetAttribute((const void*)fwd_kernel, hipFuncAttributeMaxDynamicSharedMemorySize, LDS_BYTES) != hipSuccess) { fprintf(stderr, "kernel_launch: hipFuncSetAttribute failed\n"); grid = -1; return; }
        if (hipOccupancyMaxActiveBlocksPerMultiprocessor(&per_cu, (const void*)fwd_kernel, NTHREADS, LDS_BYTES) != hipSuccess || per_cu < 1) { fprintf(stderr, "kernel_launch: occupancy query says %d\n", per_cu); }
        (void)hipGetLastError();
        grid = cus;
    }
    if (grid < 0) return;
    if (hipMemsetAsync((char*)d_ws + WS_CTL, 0, CTL_ZERO_BYTES, stream) != hipSuccess) return;
    Args a{};
    for (int i = 0; i < 35; ++i) a.in[i] = (const float*)d_in[i];
    a.out = (float*)d_out; a.ws = (unsigned char*)d_ws;
    hipLaunchKernelGGL(fwd_kernel, dim3(grid), dim3(NTHREADS), LDS_BYTES, stream, a);
}
```

```cpp
#include <hip/hip_runtime.h>
#include <cstdio>
#include <cstdint>

#define GAS __attribute__((address_space(1)))
#define LAS __attribute__((address_space(3)))
typedef unsigned short bf16;
typedef unsigned v4u __attribute__((ext_vector_type(4)));
typedef unsigned v2u __attribute__((ext_vector_type(2)));
typedef float f32x4 __attribute__((ext_vector_type(4)));
typedef float f32x2 __attribute__((ext_vector_type(2)));
typedef short bf16x8 __attribute__((ext_vector_type(8)));
typedef short bf16x4 __attribute__((ext_vector_type(4)));

#ifndef EN_DEFAULT
#define EN_DEFAULT 1
#endif
#ifndef REP_SCAN
#define REP_SCAN 1
#endif
#ifndef EN_SCANB
#define EN_SCANB EN_DEFAULT
#endif
#ifndef DRYCUT
#define DRYCUT 0
#endif
#ifndef REP_SCANB
#define REP_SCANB 1
#endif
#ifndef REP_ATTN
#define REP_ATTN 1
#endif
#ifndef G2_STAGGER
#define G2_STAGGER 0
#endif
#ifndef TIMING
#define TIMING 0
#endif
#ifndef TIMED_CLASS
#define TIMED_CLASS 2
#endif
#ifndef TIMED_MASK
#define TIMED_MASK 1
#endif
#ifndef TIMED_MULT
#define TIMED_MULT 16
#endif
#ifndef ATTN_PROBE
#define ATTN_PROBE 1
#endif
#ifndef REP_G1
#define REP_G1 1
#endif
#ifndef REP_G2
#define REP_G2 1
#endif
#ifndef REP_CVT
#define REP_CVT 1
#endif
#ifndef REP_MIX
#define REP_MIX 1
#endif
#ifndef REP_QKV
#define REP_QKV 1
#endif
#ifndef EN_P0
#define EN_P0 EN_DEFAULT
#endif
#ifndef EN_QKV
#define EN_QKV EN_DEFAULT
#endif
#ifndef EN_KMEAN
#define EN_KMEAN EN_DEFAULT
#endif
#ifndef EN_SEL
#define EN_SEL EN_DEFAULT
#endif
#ifndef EN_ATTN
#define EN_ATTN EN_DEFAULT
#endif
#ifndef EN_OPA
#define EN_OPA EN_DEFAULT
#endif
#ifndef EN_MIX
#define EN_MIX EN_DEFAULT
#endif
#ifndef EN_RKV
#define EN_RKV EN_DEFAULT
#endif
#ifndef EN_L2
#define EN_L2 EN_DEFAULT
#endif
#ifndef EN_SCAN
#define EN_SCAN EN_DEFAULT
#endif
#ifndef EN_POST
#define EN_POST EN_DEFAULT
#endif
#ifndef EN_OPB
#define EN_OPB EN_DEFAULT
#endif
#ifndef EN_LN1
#define EN_LN1 EN_DEFAULT
#endif
#ifndef EN_CVT
#define EN_CVT EN_DEFAULT
#endif
#ifndef EN_ROUTER
#define EN_ROUTER EN_DEFAULT
#endif
#ifndef EN_ROUTE
#define EN_ROUTE EN_DEFAULT
#endif
#ifndef EN_G1
#define EN_G1 EN_DEFAULT
#endif
#ifndef EN_G2
#define EN_G2 EN_DEFAULT
#endif
#ifndef EN_LN2
#define EN_LN2 EN_DEFAULT
#endif
constexpr int D = 1024, NBATCH = 8, SEQ = 4096, T = NBATCH * SEQ, NH = 16, HD = 64, DEPTH = 4;
constexpr int NE = 64, TOPK = 8, DE = 256, NEX = NE + 1;
constexpr int MBLK = 256, NMB = SEQ / MBLK;
constexpr float ALPHA = 1.6817928305074290f;
constexpr float LN_EPS = 1e-5f, GN_EPS = 64e-5f;
constexpr int NWAVES = 8, NTHREADS = 512;

constexpr size_t MiB = 1u << 20;
constexpr size_t WS_CTL = 0, CTL_ZERO_BYTES = 1 * MiB;
constexpr size_t WS_WR = 1 * MiB;
constexpr size_t WS_KMEAN = 3 * MiB;
constexpr size_t WS_MASK = 4 * MiB;
constexpr size_t WS_TSEL = 5 * MiB;
constexpr size_t WS_WQKV = 8 * MiB;
constexpr size_t WS_WOA = 20 * MiB;
constexpr size_t WS_WRKV = 24 * MiB;
constexpr size_t WS_WOB = 36 * MiB;
constexpr size_t WS_L1 = 40 * MiB;
constexpr size_t WS_L2 = 44 * MiB;
constexpr size_t WS_WGU = 48 * MiB;
constexpr size_t WS_WD = 113 * MiB;
constexpr size_t WS_XB = 146 * MiB;
constexpr size_t WS_VF = 210 * MiB;
constexpr size_t WS_S = 274 * MiB;
constexpr size_t WS_LOGITS = WS_S;
constexpr size_t WS_TOKLIST = WS_S + 8 * MiB;
constexpr size_t WS_H = WS_S + 16 * MiB;
constexpr size_t WS_Y = WS_S + 168 * MiB;
constexpr size_t WS_Q = WS_S, WS_K = WS_S + 64 * MiB, WS_VT = WS_S + 128 * MiB, WS_O = WS_S + 192 * MiB;
constexpr size_t WS_XMIX = WS_S;
constexpr size_t WS_R = WS_S + 384 * MiB, WS_KK = WS_S + 448 * MiB, WS_V = WS_S + 512 * MiB;
constexpr size_t WS_HL = WS_S + 576 * MiB;
constexpr size_t WS_LW = WS_S + 64 * MiB;
constexpr size_t WS_A = WS_S + 128 * MiB, WS_G = WS_S + 192 * MiB;
constexpr size_t WS_YS = WS_S + 256 * MiB;
constexpr size_t WS_YG = WS_S + 640 * MiB;
constexpr size_t WS_END = 1024 * MiB;
static_assert(WS_Y + (size_t)278528 * 2048 <= WS_END && WS_YG + 64 * MiB <= WS_END, "d_ws map");

constexpr int CW_TMO = 0;
constexpr int CW_BAR = 4096;
constexpr int CW_CNT = 8192;

constexpr int RING_BYTES = 131072;
constexpr int MISC_OFF = RING_BYTES;
constexpr int TAB_OFF = MISC_OFF + 256;
constexpr int PTAB_OFF = MISC_OFF + 2048;
constexpr int LDS_BYTES = 147456;

#define RLX_AGENT __ATOMIC_RELAXED, __HIP_MEMORY_SCOPE_AGENT
#define LDS_WAIT() asm volatile("s_waitcnt lgkmcnt(0)" ::: "memory")
#define VM_WAIT() asm volatile("s_waitcnt vmcnt(0)" ::: "memory")
typedef float f32x2_t_ __attribute__((ext_vector_type(2))); typedef __bf16 bf16x2_t_ __attribute__((ext_vector_type(2)));
__device__ __forceinline__ unsigned cvt_pk_bf16(float lo, float hi) { const f32x2_t_ v = {lo, hi}; const bf16x2_t_ b = __builtin_convertvector(v, bf16x2_t_); return __builtin_bit_cast(unsigned, b); }
__device__ __forceinline__ float bflo(unsigned w) { return __uint_as_float(w << 16); }
__device__ __forceinline__ float bfhi(unsigned w) { return __uint_as_float(w & 0xffff0000u); }
__device__ __forceinline__ float bf1(bf16 b) { return __uint_as_float(((unsigned)b) << 16); }
__device__ __forceinline__ float fast_exp(float x) { return __builtin_amdgcn_exp2f(x * 1.4426950408889634f); }
__device__ __forceinline__ float fast_rcp(float x) { return __builtin_amdgcn_rcpf(x); }
__device__ __forceinline__ float sigmoidf_(float x) { return fast_rcp(1.0f + fast_exp(-x)); }
template <int CTRL> __device__ __forceinline__ float dpp_add(float v) {
    const int t = __builtin_amdgcn_update_dpp(0, __float_as_int(v), CTRL, 0xf, 0xf, true);
    return v + __int_as_float(t);
}
template <int CTRL> __device__ __forceinline__ float dpp_max(float v) {
    const int t = __builtin_amdgcn_update_dpp(__float_as_int(v), __float_as_int(v), CTRL, 0xf, 0xf, false);
    return __builtin_fmaxf(v, __int_as_float(t));
}
__device__ __forceinline__ float reduce16(float v) {
    v = dpp_add<0xB1>(v); v = dpp_add<0x4E>(v); v = dpp_add<0x141>(v); v = dpp_add<0x140>(v);
    return v;
}
__device__ __forceinline__ float max8(float v) { v = dpp_max<0xB1>(v); v = dpp_max<0x4E>(v); v = dpp_max<0x141>(v); return v; }
__device__ __forceinline__ float q4_max(float v) {
    auto a = __builtin_amdgcn_permlane16_swap(__float_as_uint(v), __float_as_uint(v), false, false); v = __builtin_fmaxf(__uint_as_float(a[0]), __uint_as_float(a[1]));
    auto b = __builtin_amdgcn_permlane32_swap(__float_as_uint(v), __float_as_uint(v), false, false); return __builtin_fmaxf(__uint_as_float(b[0]), __uint_as_float(b[1])); }
__device__ __forceinline__ float q4_sum(float v) {
    auto a = __builtin_amdgcn_permlane16_swap(__float_as_uint(v), __float_as_uint(v), false, false); v = __uint_as_float(a[0]) + __uint_as_float(a[1]);
    auto b = __builtin_amdgcn_permlane32_swap(__float_as_uint(v), __float_as_uint(v), false, false); return __uint_as_float(b[0]) + __uint_as_float(b[1]); }
__device__ __forceinline__ float wave_sum(float v) { return q4_sum(reduce16(v)); }
__device__ __forceinline__ float wave_max(float v) { return q4_max(dpp_max<0x140>(max8(v))); }
__device__ const unsigned char T5_BUCKET[129] = {
    0, 1, 2, 3, 4, 5, 6, 7, 8, 9, 10, 11, 12, 13, 14, 15, 16, 16, 16, 17, 17, 18, 18, 18, 19, 19, 19, 20, 20, 20, 20, 21, 21, 21, 21, 22, 22, 22, 22, 22, 23, 23, 23, 23, 23, 23, 24, 24, 24,
    24, 24, 24, 25, 25, 25, 25, 25, 25, 25, 26, 26, 26, 26, 26, 26, 26, 26, 27, 27, 27, 27, 27, 27, 27, 27, 27, 27, 28, 28, 28, 28, 28, 28, 28, 28, 28, 28, 29, 29, 29, 29, 29, 29, 29, 29, 29, 29,
    29, 29, 30, 30, 30, 30, 30, 30, 30, 30, 30, 30, 30, 30, 30, 30, 31, 31, 31, 31, 31, 31, 31, 31, 31, 31, 31, 31, 31, 31, 31, 31};

namespace pg8 {
constexpr int BM = 256, BK = 64, HALF = 128, HTB = HALF * BK * 2, STAGE_BYTES = 8 * HTB, NXCD = 8, WGM = 8;
__host__ __device__ __forceinline__ int lds_byte(int r, int c) { const int st = (r >> 4) * 2 + (c >> 5), rr = r & 15, cc = c & 31, ob = rr * 64 + cc * 2; return st * 1024 + (ob ^ (((ob >> 9) & 1) << 5)); }
__host__ __device__ __forceinline__ void stage_rc(int b, int& R, int& C) { const int st = b / 1024, sb = b % 1024, swz = sb ^ (((sb >> 9) & 1) << 5); R = (st >> 1) * 16 + swz / 64; C = (st & 1) * 32 + (swz % 64) / 2; }
__host__ __device__ __forceinline__ int perm32(int rho) { const int n = rho >> 4, i = rho & 15; return 8 * (i >> 2) + 4 * n + (i & 3); }

struct Unit { int pm, pn, e, nvalid, arow0, orow0; const int* gidx; };

__device__ __forceinline__ bool static_tile(int i, int G, int c, int nM, int nN, int& pm, int& pn) {
    const int nwg = nM * nN; const long L = (long)i * G + c; if (L >= nwg) return false;
    int wgid = (int)L;
    if (((nwg | nM) & 7) == 0) {
        wgid = (wgid & 7) * (nwg >> 3) + (wgid >> 3); const int nig = WGM * nN, gid = wgid / nig, r = wgid - gid * nig; pm = gid * WGM + (r & 7); pn = r >> 3; return true; }
    { const int q = nwg / NXCD, r = nwg % NXCD, xcd = wgid % NXCD, off = wgid / NXCD; wgid = (xcd < r ? xcd * (q + 1) : r * (q + 1) + (xcd - r) * q) + off; }
    const int nig = WGM * nN, gid = wgid / nig, fm = gid * WGM, gsz = (nM - fm) < WGM ? (nM - fm) : WGM;
    pm = fm + ((wgid % nig) % gsz); pn = (wgid % nig) / gsz; return true;
}

template <int K, class Epi, class Sched>
__device__ __forceinline__ void gemm_phase(LAS unsigned char* lds, const int tid, const Sched& S, const Epi& E) {
    constexpr bool GA = Sched::GATHER;
    const int wid = __builtin_amdgcn_readfirstlane(tid >> 6), lane = tid & 63, wr = wid >> 2, wc = wid & 3, fr = lane & 15, fq = lane >> 4;
    constexpr int nt = K / BK;
    unsigned voffA[2], voffB[2];
#pragma unroll
    for (int i = 0; i < 2; ++i) { int R, C; stage_rc(tid * 16 + i * 8192, R, C); const int Rb = ((int)Epi::PERM == 2) ? (64 * (R >> 5) + 16 * ((R & 15) >> 2) + 4 * ((R >> 4) & 1) + (R & 3)) : (Epi::PERM ? ((R & ~31) + perm32(R & 31)) : R);
        voffA[i] = (unsigned)(R * K + C) * 2u; voffB[i] = (unsigned)(Rb * K + C) * 2u; }
    const size_t kstep = (size_t)(BK * 2);
    const size_t hstep = (size_t)HALF * K * 2;
    const size_t bhstep = ((int)Epi::PERM == 2) ? (size_t)8 * K * 2 : hstep;
    const unsigned rowb = (unsigned)K * 2u;
    const unsigned ldsw = (unsigned)wid * 1024u;
    const int aoff = lds_byte(wr * 64 + fr, fq * 8), boff = lds_byte(wc * 32 + fr, fq * 8);
#define PG8_SA(b, h) (((b) * 2 + (h)) * HTB)
#define PG8_SB(b, h) ((4 + (b) * 2 + (h)) * HTB)
#define PG8_STAGE(bufoff, gbase, voff) do { _Pragma("unroll") for (int _i = 0; _i < 2; ++_i) \
        __builtin_amdgcn_global_load_lds((const unsigned*)((const char*)(gbase) + (voff)[_i]), (LAS unsigned*)(lds + (bufoff) + ldsw + _i * 8192), 16, 0, 0); } while (0)
#define PG8_STAGE_A(bufoff, p, h, O) do { if constexpr (GA) { PG8_STAGE(bufoff, p, O[h]); } else { PG8_STAGE(bufoff, (p) + (h) * hstep, voffA); } } while (0)
#define PG8_LDA(dst, b, h) do { _Pragma("unroll") for (int m = 0; m < 4; ++m) _Pragma("unroll") for (int k = 0; k < 2; ++k) dst[m][k] = *(const LAS bf16x8*)(lds + PG8_SA(b, h) + aoff + m * 2048 + k * 1024); } while (0)
#define PG8_LDB(dst, b, h) do { _Pragma("unroll") for (int n = 0; n < 2; ++n) _Pragma("unroll") for (int k = 0; k < 2; ++k) dst[n][k] = *(const LAS bf16x8*)(lds + PG8_SB(b, h) + boff + n * 2048 + k * 1024); } while (0)
#define PG8_MMA(ai, bj, At, Bt) do { __builtin_amdgcn_s_setprio(1); _Pragma("unroll") for (int m = 0; m < 4; ++m) _Pragma("unroll") for (int n = 0; n < 2; ++n) _Pragma("unroll") for (int k = 0; k < 2; ++k) \
        acc[ai][bj][m][n] = __builtin_amdgcn_mfma_f32_16x16x32_bf16(Bt[n][k], At[m][k], acc[ai][bj][m][n], 0, 0, 0); __builtin_amdgcn_s_setprio(0); } while (0)
#define PG8_WAIT_V(n) asm volatile("s_waitcnt vmcnt(" #n ")" ::: "memory")
#define PG8_WAIT_L(n) asm volatile("s_waitcnt lgkmcnt(" #n ")" ::: "memory")
#define PG8_BAR __builtin_amdgcn_s_barrier()
#define PG8_SCHED __builtin_amdgcn_sched_barrier(0)
#define PG8_OFFS(u, o) do { if constexpr (GA) { _Pragma("unroll") for (int _h = 0; _h < 2; ++_h) _Pragma("unroll") for (int _i = 0; _i < 2; ++_i) { int R_, C_; stage_rc(tid * 16 + _i * 8192, R_, C_); \
        o[_h][_i] = (unsigned)S.a_row(u, _h * HALF + R_) * rowb + (unsigned)C_ * 2u; } } } while (0)
#define PG8_TRIP(a1, a2, b2, O1, O2) do { const char* a3 = (a2) + kstep; const char* b3 = (b2) + kstep; \
            PG8_LDB(B0, 0, 0); PG8_LDB(B1, 0, 1); PG8_SCHED; PG8_LDA(At, 0, 0); PG8_STAGE_A(PG8_SA(1, 1), a1, 1, O1); \
            PG8_WAIT_V(8); PG8_WAIT_L(0); PG8_BAR; PG8_MMA(0, 0, At, B0); PG8_MMA(0, 1, At, B1); PG8_BAR; PG8_SCHED; \
            PG8_LDA(At, 0, 1); PG8_STAGE(PG8_SB(0, 0), b2, voffB); PG8_STAGE(PG8_SB(0, 1), (b2) + bhstep, voffB); PG8_STAGE_A(PG8_SA(0, 0), a2, 0, O2); \
            PG8_WAIT_V(8); PG8_WAIT_L(0); PG8_BAR; PG8_MMA(1, 0, At, B0); PG8_MMA(1, 1, At, B1); PG8_BAR; PG8_SCHED; \
            PG8_LDB(B0, 1, 0); PG8_LDB(B1, 1, 1); PG8_SCHED; PG8_LDA(At, 1, 0); PG8_STAGE_A(PG8_SA(0, 1), a2, 1, O2); \
            PG8_WAIT_V(8); PG8_WAIT_L(0); PG8_BAR; PG8_MMA(0, 0, At, B0); PG8_MMA(0, 1, At, B1); PG8_BAR; PG8_SCHED; \
            PG8_LDA(At, 1, 1); PG8_STAGE(PG8_SB(1, 0), b3, voffB); PG8_STAGE(PG8_SB(1, 1), b3 + bhstep, voffB); PG8_STAGE_A(PG8_SA(1, 0), a3, 0, O2); \
            PG8_WAIT_V(8); PG8_WAIT_L(0); PG8_BAR; PG8_MMA(1, 0, At, B0); PG8_MMA(1, 1, At, B1); PG8_BAR; PG8_SCHED; } while (0)
    Unit cur, nxt; int ui = 0;
    if (!S.next(0, cur)) return;
    f32x4 acc[2][2][4][2];
#pragma unroll
    for (int a = 0; a < 2; ++a)
#pragma unroll
        for (int b = 0; b < 2; ++b)
#pragma unroll
            for (int m = 0; m < 4; ++m)
#pragma unroll
                for (int n = 0; n < 2; ++n) acc[a][b][m][n] = (f32x4){0.f, 0.f, 0.f, 0.f};
    bf16x8 At[4][2], B0[2][2], B1[2][2];
    unsigned cOff[2][2], nOff[2][2];
    PG8_OFFS(cur, cOff);
    const char* cA = S.a_tile(cur); const char* cB = S.b_tile(cur);
    PG8_STAGE(PG8_SB(0, 0), cB, voffB); PG8_STAGE(PG8_SB(0, 1), cB + bhstep, voffB); PG8_STAGE_A(PG8_SA(0, 0), cA, 0, cOff); PG8_STAGE_A(PG8_SA(0, 1), cA, 1, cOff);
    if (wr == 1) PG8_BAR;
    PG8_WAIT_V(2); PG8_BAR;
    PG8_STAGE(PG8_SB(1, 0), cB + kstep, voffB); PG8_STAGE_A(PG8_SA(1, 0), cA + kstep, 0, cOff); PG8_STAGE(PG8_SB(1, 1), cB + bhstep + kstep, voffB);
    PG8_WAIT_V(6); PG8_BAR;
    for (;;) {
        const bool has_next = S.next(ui + 1, nxt);
        const char* nA = cA; const char* nB = cB;
        if constexpr (GA) {
#pragma unroll
            for (int h = 0; h < 2; ++h)
#pragma unroll
                for (int i = 0; i < 2; ++i) nOff[h][i] = cOff[h][i]; }
        if (has_next) { PG8_OFFS(nxt, nOff); nA = S.a_tile(nxt); nB = S.b_tile(nxt); }
_Pragma("nounroll")
        for (int t = 0; t < nt; t += 2) { const bool last = (t == nt - 2);
            const char* a2 = last ? nA : cA + (size_t)(t + 2) * kstep; const char* b2 = last ? nB : cB + (size_t)(t + 2) * kstep;
            if constexpr (GA) { unsigned o2[2][2];
#pragma unroll
                for (int h = 0; h < 2; ++h)
#pragma unroll
                    for (int i = 0; i < 2; ++i) o2[h][i] = last ? nOff[h][i] : cOff[h][i];
                PG8_TRIP(cA + (size_t)(t + 1) * kstep, a2, b2, cOff, o2);
            } else { PG8_TRIP(cA + (size_t)(t + 1) * kstep, a2, b2, cOff, cOff); } }
        if (wr == 0) PG8_BAR;
        PG8_SCHED; E(acc, cur, wr, wc, fr, fq); PG8_SCHED;
        if (!has_next) break;
#pragma unroll
        for (int a = 0; a < 2; ++a)
#pragma unroll
            for (int b = 0; b < 2; ++b)
#pragma unroll
                for (int m = 0; m < 4; ++m)
#pragma unroll
                    for (int n = 0; n < 2; ++n) acc[a][b][m][n] = (f32x4){0.f, 0.f, 0.f, 0.f};
        cur = nxt; cA = nA; cB = nB; ++ui;
        if constexpr (GA) {
#pragma unroll
            for (int h = 0; h < 2; ++h)
#pragma unroll
                for (int i = 0; i < 2; ++i) cOff[h][i] = nOff[h][i]; }
        if (wr == 1) PG8_BAR;
    }
    PG8_WAIT_V(0);
    PG8_BAR;
#undef PG8_SA
#undef PG8_SB
#undef PG8_STAGE
#undef PG8_STAGE_A
#undef PG8_LDA
#undef PG8_LDB
#undef PG8_MMA
#undef PG8_WAIT_V
#undef PG8_WAIT_L
#undef PG8_BAR
#undef PG8_SCHED
#undef PG8_OFFS
#undef PG8_TRIP
}
}
using pg8::Unit;
typedef f32x4 AccT[2][2][4][2];

struct SchedDense {
    int nM, nN, G, c, K; const char* A; const char* Bt;
    __device__ __forceinline__ bool next(int i, Unit& u) const { int pm, pn; if (!pg8::static_tile(i, G, c, nM, nN, pm, pn)) return false;
        u.pm = pm; u.pn = pn; u.e = 0; u.nvalid = 256; u.arow0 = pm * 256; u.orow0 = pm * 256; u.gidx = nullptr; return true; }
    static constexpr bool GATHER = false;
    __device__ __forceinline__ const char* a_tile(const Unit& u) const { return A + (size_t)u.arow0 * K * 2; }
    __device__ __forceinline__ const char* b_tile(const Unit& u) const { return Bt + (size_t)u.pn * 256 * K * 2; }
    __device__ __forceinline__ int a_row(const Unit& u, int r) const { return u.arow0 + r; }
};
struct SchedRkv {
    int nM, nN, G, c; const char* xmix; const char* Wrkv; const char* L1;
    __device__ __forceinline__ bool next(int i, Unit& u) const { int pm, pn; if (!pg8::static_tile(i, G, c, nM, nN, pm, pn)) return false;
        u.pm = pm; u.pn = pn; u.e = 0; u.nvalid = 256; u.arow0 = pm * 256; u.orow0 = pm * 256; u.gidx = nullptr; return true; }
    static constexpr bool GATHER = false;
    __device__ __forceinline__ const char* a_tile(const Unit& u) const { const int grp = u.pn < 12 ? (u.pn >> 2) : (u.pn == 15 ? 2 : u.pn - 9); return xmix + ((size_t)grp * T + u.arow0) * D * 2; }
    __device__ __forceinline__ const char* b_tile(const Unit& u) const { return u.pn < 12 ? Wrkv + (size_t)u.pn * 256 * D * 2 : L1 + (size_t)(u.pn - 12) * 256 * D * 2; }
    __device__ __forceinline__ int a_row(const Unit& u, int r) const { return u.arow0 + r; }
};
struct SchedL2 {
    int nM, nN, G, c; const char* hl; const char* L2;
    __device__ __forceinline__ bool next(int i, Unit& u) const { int pm, pn; if (!pg8::static_tile(i, G, c, nM, nN, pm, pn)) return false;
        u.pm = pm; u.pn = pn & 3; u.e = pn >> 2; u.nvalid = 256; u.arow0 = pm * 256; u.orow0 = pm * 256; u.gidx = nullptr; return true; }
    static constexpr bool GATHER = false;
    __device__ __forceinline__ const char* a_tile(const Unit& u) const { return hl + ((size_t)u.e * T + u.arow0) * 256 * 2; }
    __device__ __forceinline__ const char* b_tile(const Unit& u) const { return L2 + ((size_t)u.e * 1024 + (size_t)u.pn * 256) * 256 * 2; }
    __device__ __forceinline__ int a_row(const Unit& u, int r) const { return u.arow0 + r; }
};
struct MoeTab { const LAS int* cnt; const LAS int* mtpref; const LAS int* hoff; };
__device__ __forceinline__ int moe_find_expert(const MoeTab& M, int m, int& hint) { int e = hint;
_Pragma("nounroll")
    while (e + 1 < NEX && M.mtpref[e + 1] <= m) ++e;
    e = __builtin_amdgcn_readfirstlane(e); hint = e; return e; }
struct SchedMoe1 {
    int G, c; MoeTab M; const char* xb; const char* Wgu; const int* toklist; mutable int eh;
    __device__ __forceinline__ bool next(int i, Unit& u) const { const long L = (long)i * G + c; const int nun = M.mtpref[NEX] * 2; if (L >= nun) return false;
        const int m = (int)(L >> 1), e = moe_find_expert(M, m, eh), mt = m - M.mtpref[e];
        u.pm = mt; u.pn = (int)(L & 1); u.e = e; u.arow0 = mt * 256; u.orow0 = M.hoff[e] + mt * 256;
        if (e < NE) { const int left = M.cnt[e] - mt * 256; u.nvalid = left < 256 ? left : 256; u.gidx = toklist + (size_t)e * T + mt * 256; } else { u.nvalid = 256; u.gidx = nullptr; }
        return true; }
    static constexpr bool GATHER = true;
    __device__ __forceinline__ const char* a_tile(const Unit&) const { return xb; }
    __device__ __forceinline__ const char* b_tile(const Unit& u) const { return Wgu + ((size_t)u.e * 512 + (size_t)u.pn * 256) * D * 2; }
    __device__ __forceinline__ int a_row(const Unit& u, int r) const { if (u.gidx) return r < u.nvalid ? u.gidx[r] : 0; return u.arow0 + r; }
};
struct SchedMoe2 {
    int G, c; MoeTab M; const char* hb; const char* Wd; mutable int eh;
    __device__ __forceinline__ bool next(int i, Unit& u) const { const long L = (long)i * G + c; const int nun = M.mtpref[NEX] * 4; if (L >= nun) return false;
        const int m = (int)(L >> 2), e = moe_find_expert(M, m, eh), mt = m - M.mtpref[e];
        u.pm = mt; u.pn = (int)(L & 3); u.e = e; u.nvalid = 256; u.arow0 = M.hoff[e] + mt * 256; u.orow0 = (e < NE) ? (M.hoff[e] + mt * 256) : mt * 256; u.gidx = nullptr; return true; }
    static constexpr bool GATHER = false;
    __device__ __forceinline__ const char* a_tile(const Unit& u) const { return hb + (size_t)u.arow0 * 256 * 2; }
    __device__ __forceinline__ const char* b_tile(const Unit& u) const { return Wd + ((size_t)u.e * 1024 + (size_t)u.pn * 256) * 256 * 2; }
    __device__ __forceinline__ int a_row(const Unit& u, int r) const { return u.arow0 + r; }
};

#define EPI_ARGS const AccT& acc, const Unit& u, int wr, int wc, int fr, int fq
struct EpiQKV { static constexpr bool PERM = true; bf16* Q; bf16* Kb; bf16* Vt;
    __device__ __forceinline__ void operator()(EPI_ARGS) const {
        const int row0 = u.orow0 + wr * 64 + fr, sec = u.pn >> 2, col0 = (u.pn & 3) * 256 + wc * 32 + 8 * fq;
        if (sec < 2) { bf16* base = sec == 0 ? Q : Kb; const float sc = sec == 0 ? 0.18033688011112042f : 1.0f;
#pragma unroll
            for (int ai = 0; ai < 2; ++ai)
#pragma unroll
                for (int m = 0; m < 4; ++m) { bf16* rowp = base + (size_t)(row0 + ai * 128 + m * 16) * D + col0;
#pragma unroll
                    for (int bj = 0; bj < 2; ++bj) { const f32x4 v0 = acc[ai][bj][m][0] * sc, v1 = acc[ai][bj][m][1] * sc; v4u w;
                        w.x = cvt_pk_bf16(v0[0], v0[1]); w.y = cvt_pk_bf16(v0[2], v0[3]); w.z = cvt_pk_bf16(v1[0], v1[1]); w.w = cvt_pk_bf16(v1[2], v1[3]); *(v4u*)(rowp + bj * 128) = w; } }
        } else {
#pragma unroll
            for (int ai = 0; ai < 2; ++ai)
#pragma unroll
                for (int m = 0; m < 4; ++m) { const int r = row0 + ai * 128 + m * 16, b = r >> 12, s = r & 4095;
#pragma unroll
                    for (int bj = 0; bj < 2; ++bj)
#pragma unroll
                        for (int n = 0; n < 2; ++n) { const f32x4 v = acc[ai][bj][m][n];
#pragma unroll
                            for (int j = 0; j < 4; j += 2) { const int c = col0 + bj * 128 + 4 * n + j, h = c >> 6, d = c & 63; const unsigned w = cvt_pk_bf16(v[j], v[j + 1]);
                                bf16* p = Vt + ((((size_t)(b * NH + h) * HD + d)) << 12) + s; p[0] = (bf16)(w & 0xffffu); p[SEQ] = (bf16)(w >> 16); } } }
        }
    }
};
struct EpiAdd { static constexpr bool PERM = true; bf16* ob; const bf16* xb;
    __device__ __forceinline__ void operator()(EPI_ARGS) const {
        const int row0 = u.orow0 + wr * 64 + fr, col0 = u.pn * 256 + wc * 32 + 8 * fq;
#pragma unroll
        for (int ai = 0; ai < 2; ++ai) { v4u t[4][2];
#pragma unroll
            for (int m = 0; m < 4; ++m) { const bf16* rowp = xb + (size_t)(row0 + ai * 128 + m * 16) * D + col0;
#pragma unroll
                for (int bj = 0; bj < 2; ++bj) t[m][bj] = *(const v4u*)(rowp + bj * 128); }
            __builtin_amdgcn_sched_barrier(0);
#pragma unroll
            for (int m = 0; m < 4; ++m) { bf16* rowp = ob + (size_t)(row0 + ai * 128 + m * 16) * D + col0;
#pragma unroll
                for (int bj = 0; bj < 2; ++bj) { const v4u w = t[m][bj]; const f32x4 x0 = {bflo(w.x), bfhi(w.x), bflo(w.y), bfhi(w.y)}, x1 = {bflo(w.z), bfhi(w.z), bflo(w.w), bfhi(w.w)};
                    const f32x4 s0 = x0 * ALPHA + acc[ai][bj][m][0], s1 = x1 * ALPHA + acc[ai][bj][m][1];
                    v4u o; o.x = cvt_pk_bf16(s0[0], s0[1]); o.y = cvt_pk_bf16(s0[2], s0[3]); o.z = cvt_pk_bf16(s1[0], s1[1]); o.w = cvt_pk_bf16(s1[2], s1[3]); *(v4u*)(rowp + bj * 128) = o; } }
            __builtin_amdgcn_sched_barrier(0); }
    }
};
struct EpiLogits { static constexpr bool PERM = false; float* lg;
    __device__ __forceinline__ void operator()(EPI_ARGS) const {
        if (wc >= 2) return;
        const int row0 = u.orow0 + wr * 64 + fr, col0 = wc * 32 + 4 * fq;
#pragma unroll
        for (int ai = 0; ai < 2; ++ai)
#pragma unroll
            for (int m = 0; m < 4; ++m) { float* rowp = lg + (size_t)(row0 + ai * 128 + m * 16) * NE + col0;
#pragma unroll
                for (int n = 0; n < 2; ++n) *(f32x4*)(rowp + n * 16) = acc[ai][0][m][n]; }
    }
};
struct EpiSwiglu { static constexpr bool PERM = true; bf16* hb; bool dry;
    __device__ __forceinline__ void operator()(EPI_ARGS) const {
        const int row0 = u.orow0 + wr * 64 + fr, col0 = u.pn * 128 + wc * 32 + 8 * fq;
#pragma unroll
        for (int ai = 0; ai < 2; ++ai)
#pragma unroll
            for (int m = 0; m < 4; ++m) { bf16* rowp = hb + (size_t)(row0 + ai * 128 + m * 16) * DE + col0; float o[8];
#pragma unroll
                for (int n = 0; n < 2; ++n)
#pragma unroll
                    for (int j = 0; j < 4; ++j) { const float g = acc[ai][0][m][n][j], up = acc[ai][1][m][n][j]; o[4 * n + j] = g * sigmoidf_(g) * up; }
                v4u w; w.x = cvt_pk_bf16(o[0], o[1]); w.y = cvt_pk_bf16(o[2], o[3]); w.z = cvt_pk_bf16(o[4], o[5]); w.w = cvt_pk_bf16(o[6], o[7]); if (!dry) *(v4u*)rowp = w; }
    }
};
constexpr int Y_SHARED0 = 278528, Y_ROWS = Y_SHARED0 + T;
constexpr size_t WS_YSC = WS_Y + (size_t)Y_ROWS * D;
static_assert(WS_YSC + (size_t)Y_ROWS * 4 * 4 <= WS_END, "fp8 y buffer");
struct EpiMoeDown { static constexpr int PERM = 2; unsigned char* ws; bool dry; LAS float* amx;
    __device__ __forceinline__ void operator()(EPI_ARGS) const {
        if (dry) return;
        const int rl0 = wr * 64 + fr, row0 = (u.e < NE ? u.orow0 : Y_SHARED0 + u.orow0) + rl0, col0 = u.pn * 256 + wc * 64 + 16 * fq;
        unsigned char* y8 = ws + WS_Y; float* ysc = (float*)(ws + WS_YSC);
        float am8[2][4];
#pragma unroll
        for (int ai = 0; ai < 2; ++ai)
#pragma unroll
            for (int m = 0; m < 4; ++m) { float am = 0.f;
#pragma unroll
                for (int bj = 0; bj < 2; ++bj)
#pragma unroll
                    for (int n = 0; n < 2; ++n) { const f32x4 v = acc[ai][bj][m][n]; am = __builtin_fmaxf(am, __builtin_fmaxf(__builtin_fmaxf(__builtin_fabsf(v[0]), __builtin_fabsf(v[1])), __builtin_fmaxf(__builtin_fabsf(v[2]), __builtin_fabsf(v[3])))); }
                am = q4_max(am);
                if (fq == 0) amx[(rl0 + ai * 128 + m * 16) * 4 + wc] = am; }
        asm volatile("s_waitcnt lgkmcnt(0)\n\ts_barrier" ::: "memory");
#pragma unroll
        for (int ai = 0; ai < 2; ++ai)
#pragma unroll
            for (int m = 0; m < 4; ++m) { const f32x4 t = *(const LAS f32x4*)(amx + (rl0 + ai * 128 + m * 16) * 4); am8[ai][m] = __builtin_fmaxf(__builtin_fmaxf(__builtin_fmaxf(t[0], t[1]), __builtin_fmaxf(t[2], t[3])), 1e-30f); }
#pragma unroll
        for (int ai = 0; ai < 2; ++ai)
#pragma unroll
            for (int m = 0; m < 4; ++m) { const size_t row = (size_t)(row0 + ai * 128 + m * 16); const float am = am8[ai][m];
                const float inv = 448.0f * fast_rcp(am) * 0.999f; unsigned wq[4];
#pragma unroll
                for (int bj = 0; bj < 2; ++bj)
#pragma unroll
                    for (int n = 0; n < 2; ++n) { const f32x4 v = acc[ai][bj][m][n]; int t = __builtin_amdgcn_cvt_pk_fp8_f32(v[0] * inv, v[1] * inv, 0, false); t = __builtin_amdgcn_cvt_pk_fp8_f32(v[2] * inv, v[3] * inv, t, true); wq[2 * bj + n] = (unsigned)t; }
                v4u w; w.x = wq[0]; w.y = wq[1]; w.z = wq[2]; w.w = wq[3]; *(v4u*)(y8 + row * D + col0) = w;
                if (wc == 0 && fq == 0) ysc[row * 4 + u.pn] = am * (1.0f / (448.0f * 0.999f)); }
    }
};
struct EpiRkv { static constexpr bool PERM = true; unsigned char* ws; size_t voff;
    __device__ __forceinline__ void operator()(EPI_ARGS) const {
        const int row0 = u.orow0 + wr * 64 + fr;
        size_t boff; int ldc, colt, act = 0;
        if (u.pn < 12) { const int sec = u.pn >> 2; boff = WS_R; if (sec == 1) boff = WS_KK; if (sec == 2) boff = voff; ldc = D; colt = (u.pn & 3) * 256; }
        else { const int kind = u.pn - 12; boff = WS_HL + (size_t)kind * T * 256 * 2; ldc = 256; colt = 0; act = kind == 0 ? 1 : (kind == 2 ? 2 : 0); }
        bf16* base = (bf16*)(ws + boff);
        const int col0 = colt + wc * 32 + 8 * fq;
#pragma unroll
        for (int ai = 0; ai < 2; ++ai)
#pragma unroll
            for (int m = 0; m < 4; ++m) { bf16* rowp = base + (size_t)(row0 + ai * 128 + m * 16) * ldc + col0;
#pragma unroll
                for (int bj = 0; bj < 2; ++bj) { f32x4 v0 = acc[ai][bj][m][0], v1 = acc[ai][bj][m][1];
                    if (act == 1) {
#pragma unroll
                        for (int j = 0; j < 4; ++j) { v0[j] = 1.0f - 2.0f * fast_rcp(fast_exp(2.0f * v0[j]) + 1.0f); v1[j] = 1.0f - 2.0f * fast_rcp(fast_exp(2.0f * v1[j]) + 1.0f); } }
                    if (act == 2) {
#pragma unroll
                        for (int j = 0; j < 4; ++j) { v0[j] = sigmoidf_(v0[j]); v1[j] = sigmoidf_(v1[j]); } }
                    v4u w; w.x = cvt_pk_bf16(v0[0], v0[1]); w.y = cvt_pk_bf16(v0[2], v0[3]); w.z = cvt_pk_bf16(v1[0], v1[1]); w.w = cvt_pk_bf16(v1[2], v1[3]); *(v4u*)(rowp + bj * 128) = w; } }
    }
};
struct EpiL2 { static constexpr bool PERM = true; bf16* lw; bf16* ab; bf16* gb; bf16* vb; const bf16* vf; const float* w0; const float* a0; const float* v0;
    __device__ __forceinline__ void operator()(EPI_ARGS) const {
        const int row0 = u.orow0 + wr * 64 + fr, col0 = u.pn * 256 + wc * 32 + 8 * fq, kind = u.e;
        if (kind == 3) {
#pragma unroll
            for (int ai = 0; ai < 2; ++ai) { v4u vv[4][2], ff[4][2];
#pragma unroll
                for (int m = 0; m < 4; ++m)
#pragma unroll
                    for (int bj = 0; bj < 2; ++bj) { const size_t o = (size_t)(row0 + ai * 128 + m * 16) * D + col0 + bj * 128; vv[m][bj] = *(const v4u*)(vb + o); ff[m][bj] = *(const v4u*)(vf + o); }
                __builtin_amdgcn_sched_barrier(0);
#pragma unroll
                for (int m = 0; m < 4; ++m)
#pragma unroll
                    for (int bj = 0; bj < 2; ++bj) { const size_t o = (size_t)(row0 + ai * 128 + m * 16) * D + col0 + bj * 128; const int c = col0 + bj * 128;
                        const f32x4 b0 = *(const f32x4*)(v0 + c), b1 = *(const f32x4*)(v0 + c + 4); float y[8];
#pragma unroll
                        for (int j = 0; j < 8; ++j) { const unsigned wv = vv[m][bj][j >> 1], wf = ff[m][bj][j >> 1]; const float v = (j & 1) ? bfhi(wv) : bflo(wv), f = (j & 1) ? bfhi(wf) : bflo(wf);
                            const float gt = sigmoidf_(acc[ai][bj][m][j >> 2][j & 3] + (j < 4 ? b0[j & 3] : b1[j & 3])); y[j] = v + (f - v) * gt; }
                        v4u w; w.x = cvt_pk_bf16(y[0], y[1]); w.y = cvt_pk_bf16(y[2], y[3]); w.z = cvt_pk_bf16(y[4], y[5]); w.w = cvt_pk_bf16(y[6], y[7]); *(v4u*)(vb + o) = w; }
                __builtin_amdgcn_sched_barrier(0); }
            return; }
#pragma unroll
        for (int ai = 0; ai < 2; ++ai)
#pragma unroll
            for (int m = 0; m < 4; ++m) { const size_t ro = (size_t)(row0 + ai * 128 + m * 16) * D + col0;
#pragma unroll
                for (int bj = 0; bj < 2; ++bj) { const size_t o = ro + bj * 128; const int c = col0 + bj * 128; float x[8];
#pragma unroll
                    for (int n = 0; n < 2; ++n)
#pragma unroll
                        for (int j = 0; j < 4; ++j) x[4 * n + j] = acc[ai][bj][m][n][j];
                    if (kind == 0) { const f32x4 b0 = *(const f32x4*)(w0 + c), b1 = *(const f32x4*)(w0 + c + 4); f32x4 r0, r1;
#pragma unroll
                        for (int j = 0; j < 8; ++j) { const float z = x[j] + (j < 4 ? b0[j & 3] : b1[j & 3]); if (j < 4) r0[j & 3] = z; else r1[j & 3] = z; }
                        { v4u w; w.x = cvt_pk_bf16(r0[0], r0[1]); w.y = cvt_pk_bf16(r0[2], r0[3]); w.z = cvt_pk_bf16(r1[0], r1[1]); w.w = cvt_pk_bf16(r1[2], r1[3]); *(v4u*)(lw + o) = w; }
                    } else if (kind == 1) { const f32x4 b0 = *(const f32x4*)(a0 + c), b1 = *(const f32x4*)(a0 + c + 4);
#pragma unroll
                        for (int j = 0; j < 8; ++j) x[j] = sigmoidf_(x[j] + (j < 4 ? b0[j & 3] : b1[j & 3]));
                        v4u w; w.x = cvt_pk_bf16(x[0], x[1]); w.y = cvt_pk_bf16(x[2], x[3]); w.z = cvt_pk_bf16(x[4], x[5]); w.w = cvt_pk_bf16(x[6], x[7]); *(v4u*)(ab + o) = w;
                    } else {
                        v4u w; w.x = cvt_pk_bf16(x[0], x[1]); w.y = cvt_pk_bf16(x[2], x[3]); w.z = cvt_pk_bf16(x[4], x[5]); w.w = cvt_pk_bf16(x[6], x[7]); *(v4u*)(gb + o) = w; }
                } }
    }
};

typedef GAS unsigned gu32;
#define XB_TMO      128
#define XB_XCNT(j)  (256  + 64 * (j))
#define XB_XSUB(j)  (1280 + 64 * (j))
#define XB_XGEN(j)  (2304 + 64 * (j))
#define XB_TOP      3328
#define XB_TOPGEN   3392
#define XCD_BAR_WORDS 3456
#define XB_SPIN_CAP (1u << 23)
__device__ __forceinline__ unsigned xb_ld(unsigned* p)              { return __hip_atomic_load(p, __ATOMIC_RELAXED, __HIP_MEMORY_SCOPE_AGENT); }
__device__ __forceinline__ unsigned xb_add(unsigned* p, unsigned v) { return __hip_atomic_fetch_add(p, v, __ATOMIC_RELAXED, __HIP_MEMORY_SCOPE_AGENT); }
__device__ __forceinline__ unsigned xb_xcc_id() { return (unsigned)__builtin_amdgcn_s_getreg((3 << 11) | 20) & 0xFu; }
#define XB_SPIN(cond, bar) do { unsigned _sp = 0; while (cond) { __builtin_amdgcn_s_sleep(1); \
    if ((++_sp & 255u) == 0u) { if (xb_ld(&(bar)[XB_TMO])) break; if (_sp > XB_SPIN_CAP) { atomicAdd(&(bar)[XB_TMO], 1u); break; } } } } while (0)
struct XcdBarrier { unsigned* bar; unsigned x; volatile LAS unsigned* st; };
__device__ __forceinline__ XcdBarrier xcd_barrier_post(unsigned* bar, volatile LAS unsigned* st) {
    XcdBarrier b; b.bar = bar; b.x = xb_xcc_id(); b.st = st;
    if (threadIdx.x == 0) (void)xb_add(&bar[XB_XCNT(b.x)], 1u);
    return b;
}
__device__ __forceinline__ void xcd_barrier_complete(unsigned* bar, unsigned x, unsigned& nloc, unsigned& nx) {
    const unsigned G = gridDim.x * gridDim.y * gridDim.z;
    unsigned sum, cnt, mine, sp = 0u;
    for (;;) {
        sum = 0u; cnt = 0u; mine = 0u;
#pragma unroll
        for (unsigned j = 0; j < 16; ++j) { const unsigned c = xb_ld(&bar[XB_XCNT(j)]); sum += c; cnt += (c > 0u) ? 1u : 0u; mine = (j == x) ? c : mine; }
        if (sum == G) break;
        __builtin_amdgcn_s_sleep(1);
        if ((++sp & 255u) == 0u) { if (xb_ld(&bar[XB_TMO])) break; if (sp > XB_SPIN_CAP) { atomicAdd(&bar[XB_TMO], 1u); break; } }
    }
    nloc = mine > 0u ? mine : 1u; nx = cnt > 0u ? cnt : 1u;
}
__device__ __forceinline__ void xcd_barrier(const XcdBarrier& b) {
    asm volatile("s_waitcnt vmcnt(0)" ::: "memory");
    __syncthreads();
    if (threadIdx.x == 0) {
        unsigned long long bp = (unsigned long long)b.bar; unsigned bx = b.x;
        asm volatile("" : "+s"(bp), "+s"(bx));
        unsigned* bar = (unsigned*)(GAS unsigned*)bp;
        __builtin_amdgcn_s_waitcnt(0);
        unsigned nloc = b.st[0], nx = b.st[1];
        if (nloc == 0u) { xcd_barrier_complete(bar, bx, nloc, nx); b.st[0] = nloc; b.st[1] = nx; }
        const unsigned old = xb_add(&bar[XB_XSUB(bx)], 1u);
        const unsigned gen = old / nloc;
        if (old + 1u == (gen + 1u) * nloc) {
            __builtin_amdgcn_fence(__ATOMIC_RELEASE, "agent");
            asm volatile("s_waitcnt vmcnt(0)" ::: "memory");
            const unsigned og = xb_add(&bar[XB_TOP], 1u);
            const unsigned tg = og / nx;
            if (og + 1u == (tg + 1u) * nx) xb_add(&bar[XB_TOPGEN], 1u);
            else XB_SPIN(xb_ld(&bar[XB_TOPGEN]) == tg, bar);
            __builtin_amdgcn_fence(__ATOMIC_ACQUIRE, "agent");
            xb_add(&bar[XB_XGEN(bx)], 1u);
            asm volatile("s_waitcnt vmcnt(0)" ::: "memory");
        } else {
            XB_SPIN(xb_ld(&bar[XB_XGEN(bx)]) == gen, bar);
            __builtin_amdgcn_fence(__ATOMIC_ACQUIRE, "agent");
            asm volatile("s_waitcnt vmcnt(0)" ::: "memory");
        }
    }
    __syncthreads();
}

struct Args { const float* in[35]; float* out; unsigned char* ws; };
struct Frame {
    LAS unsigned char* lds; gu32* ctl; unsigned char* ws; float* out;
    int tid, lane, wave, vcu, G, gw, NGW;
};

__device__ __forceinline__ Frame phase_frame(const Frame& F) {
    Frame P = F; int lane; asm volatile("v_mbcnt_lo_u32_b32 %0, -1, 0\n\tv_mbcnt_hi_u32_b32 %0, -1, %0" : "=v"(lane)); int wave = F.wave;
    asm volatile("" : "+v"(lane), "+s"(wave)); P.lane = lane; P.wave = wave; P.tid = wave * 64 + lane; P.gw = P.vcu * NWAVES + wave; return P;
}
__device__ __forceinline__ const float* in_ptr(const Frame& F, int k) {
    const unsigned long long v = ((const LAS unsigned long long*)(F.lds + PTAB_OFF))[k];
    const unsigned lo = (unsigned)__builtin_amdgcn_readfirstlane((int)(unsigned)v), hi = (unsigned)__builtin_amdgcn_readfirstlane((int)(unsigned)(v >> 32));
    return (const float*)(GAS const float*)(((unsigned long long)hi << 32) | lo);
}
__device__ __forceinline__ void transpose_item(const float* W, int N, int k0, int n0, bf16* WT, size_t orow, int ldk, LAS float* scr, int lane) {
    f32x4 w[8];
#pragma unroll
    for (int i = 0; i < 8; ++i) w[i] = *(const f32x4*)(W + (size_t)(k0 + 8 * i + (lane >> 3)) * N + n0 + 4 * (lane & 7));
    __builtin_amdgcn_sched_barrier(0);
#pragma unroll
    for (int i = 0; i < 8; ++i) { LAS float* d = scr + (8 * i + (lane >> 3)) * 33 + 4 * (lane & 7); d[0] = w[i][0]; d[1] = w[i][1]; d[2] = w[i][2]; d[3] = w[i][3]; }
    LDS_WAIT(); asm volatile("" ::: "memory");
    const int c = lane & 7;
#pragma unroll
    for (int j = 0; j < 4; ++j) { const int n = (lane >> 3) + 8 * j; const LAS float* s = scr + (8 * c) * 33 + n;
        v4u o; o.x = cvt_pk_bf16(s[0 * 33], s[1 * 33]); o.y = cvt_pk_bf16(s[2 * 33], s[3 * 33]); o.z = cvt_pk_bf16(s[4 * 33], s[5 * 33]); o.w = cvt_pk_bf16(s[6 * 33], s[7 * 33]);
        *(v4u*)(WT + (orow + n) * ldk + k0 + 8 * c) = o; }
    LDS_WAIT(); asm volatile("" ::: "memory");
}
__device__ __forceinline__ void convert_plain(Frame& F, const float* W, int K, int N, bf16* WT, int row_off) {
    LAS float* scr = (LAS float*)(F.lds + F.wave * 16384);
    const int nblk = N / 32, nitems = (K / 64) * nblk;
    for (int it = F.gw; it < nitems; it += F.NGW) { const int kb = it / nblk, nb = it % nblk; transpose_item(W, N, 64 * kb, 32 * nb, WT, (size_t)row_off + 32 * nb, K, scr, F.lane); }
}
struct SmallJob { const float* W; int K, N; bf16* WT; int Np, Kp; };
__device__ __forceinline__ void small_load(const Frame& F, const SmallJob& J, float (&v)[2]) {
    const size_t tot = (size_t)J.Np * J.Kp, step = (size_t)F.NGW * 64;
#pragma unroll
    for (int q = 0; q < 2; ++q) { const size_t i = (size_t)F.gw * 64 + F.lane + q * step; const int n = (int)(i / J.Kp), k = (int)(i % J.Kp); v[q] = (i < tot && k < J.K && n < J.N) ? J.W[(size_t)k * J.N + n] : 0.0f; }
}
__device__ __forceinline__ void small_store(const Frame& F, const SmallJob& J, const float (&v)[2]) {
    const size_t tot = (size_t)J.Np * J.Kp, step = (size_t)F.NGW * 64;
#pragma unroll
    for (int q = 0; q < 2; ++q) { const size_t i = (size_t)F.gw * 64 + F.lane + q * step; if (i < tot) J.WT[i] = (bf16)(cvt_pk_bf16(v[q], 0.0f) & 0xffffu); }
}
__device__ __forceinline__ void convert_small(Frame& F, const float* W, int K, int N, bf16* WT, int Np, int Kp);
__device__ __forceinline__ void convert_small4(Frame& F, const SmallJob& A, const SmallJob& B, const SmallJob& C, const SmallJob& E) {
    if ((size_t)F.NGW * 128 < (size_t)A.Np * A.Kp) { convert_small(F, A.W, A.K, A.N, A.WT, A.Np, A.Kp); convert_small(F, B.W, B.K, B.N, B.WT, B.Np, B.Kp); convert_small(F, C.W, C.K, C.N, C.WT, C.Np, C.Kp); convert_small(F, E.W, E.K, E.N, E.WT, E.Np, E.Kp); return; }
    float va[2], vb[2], vc[2], ve[2];
    small_load(F, A, va); small_load(F, B, vb); small_load(F, C, vc); small_load(F, E, ve);
    __builtin_amdgcn_sched_barrier(0);
    small_store(F, A, va); small_store(F, B, vb); small_store(F, C, vc); small_store(F, E, ve);
}
__device__ __forceinline__ void convert_small(Frame& F, const float* W, int K, int N, bf16* WT, int Np, int Kp) {
    const size_t tot = (size_t)Np * Kp, step = (size_t)F.NGW * 64;
    for (size_t i0 = (size_t)F.gw * 64 + F.lane; i0 < tot; i0 += 4 * step) { float v[4];
#pragma unroll
        for (int q = 0; q < 4; ++q) { const size_t i = i0 + q * step; const int n = (int)(i / Kp), k = (int)(i % Kp); v[q] = (i < tot && k < K && n < N) ? W[(size_t)k * N + n] : 0.0f; }
#pragma unroll
        for (int q = 0; q < 4; ++q) { const size_t i = i0 + q * step; if (i < tot) WT[i] = (bf16)(cvt_pk_bf16(v[q], 0.0f) & 0xffffu); } }
}
__device__ __forceinline__ void convert_moe(Frame& F, const float* wg, const float* wu, const float* wd, const float* sg, const float* su, const float* sd) {
    LAS float* scr = (LAS float*)(F.lds + F.wave * 16384);
    bf16* Wgu = (bf16*)(F.ws + WS_WGU); bf16* Wd = (bf16*)(F.ws + WS_WD);
    constexpr int PER = 128;
    const int total = NEX * 3 * PER;
    for (int it = F.gw; it < total; it += F.NGW) {
        const int e = it / (3 * PER), r = it % (3 * PER), which = r / PER, q = r % PER;
        if (which < 2) { const float* W = (e < NE) ? (which == 0 ? wg : wu) + (size_t)e * D * DE : (which == 0 ? sg : su);
            const int kb = q >> 3, nb = q & 7, n0 = 32 * nb; const size_t orow = (size_t)e * 512 + (n0 >> 7) * 256 + which * 128 + (n0 & 127);
            transpose_item(W, DE, 64 * kb, n0, Wgu, orow, D, scr, F.lane);
        } else { const float* W = (e < NE) ? wd + (size_t)e * DE * D : sd;
            const int kb = q >> 5, nb = q & 31, n0 = 32 * nb;
            transpose_item(W, D, 64 * kb, n0, Wd, (size_t)e * 1024 + n0, DE, scr, F.lane); }
    }
}

template <int MODE>
__device__ __forceinline__ void ln_phase(Frame& F, const float* src, const float* g, const float* bsh, bool final, const MoeTab& M) {
    float* out = F.out; bf16* xb = (bf16*)(F.ws + WS_XB);
    const bf16* yb = (const bf16*)(F.ws + WS_Y); const int2* tsel = (const int2*)(F.ws + WS_TSEL);
    f32x4 gv[4], bv[4];
    if (MODE != 2) {
#pragma unroll
        for (int j = 0; j < 4; ++j) { const int c = 512 * (j >> 1) + 8 * F.lane + 4 * (j & 1); gv[j] = *(const f32x4*)(g + c); bv[j] = *(const f32x4*)(bsh + c); } }
    for (int row = F.gw; row < T; row += F.NGW) {
        const float* xr = src + (size_t)row * D + 8 * F.lane;
        f32x4 v[4];
#pragma unroll
        for (int j = 0; j < 4; ++j) v[j] = *(const f32x4*)(xr + 512 * (j >> 1) + 4 * (j & 1));
        if (MODE == 1) {
#pragma unroll
            for (int jj = 0; jj < TOPK; ++jj) { const int2 ts = tsel[(size_t)row * TOPK + jj]; const int e = ts.x >> 20, slot = ts.x & 0xfffff; const float gt = __int_as_float(ts.y);
                const bf16* yp = yb + (size_t)(M.hoff[e] + slot) * D + 8 * F.lane;
#pragma unroll
                for (int jh = 0; jh < 2; ++jh) { const v4u w = *(const v4u*)(yp + 512 * jh);
                    v[2 * jh][0] += gt * bflo(w.x); v[2 * jh][1] += gt * bfhi(w.x); v[2 * jh][2] += gt * bflo(w.y); v[2 * jh][3] += gt * bfhi(w.y);
                    v[2 * jh + 1][0] += gt * bflo(w.z); v[2 * jh + 1][1] += gt * bfhi(w.z); v[2 * jh + 1][2] += gt * bflo(w.w); v[2 * jh + 1][3] += gt * bfhi(w.w); } }
        }
        f32x4 o[4];
        if (MODE == 2) {
#pragma unroll
            for (int j = 0; j < 4; ++j) o[j] = v[j];
        } else {
            float s = 0.f;
#pragma unroll
            for (int j = 0; j < 4; ++j) s += (v[j][0] + v[j][1]) + (v[j][2] + v[j][3]);
            const float mean = wave_sum(s) * (1.0f / D); float s2 = 0.f;
#pragma unroll
            for (int j = 0; j < 4; ++j) { v[j] = v[j] - mean; s2 += (v[j][0] * v[j][0] + v[j][1] * v[j][1]) + (v[j][2] * v[j][2] + v[j][3] * v[j][3]); }
            const float rstd = 1.0f / sqrtf(wave_sum(s2) * (1.0f / D) + LN_EPS);
#pragma unroll
            for (int j = 0; j < 4; ++j) o[j] = v[j] * rstd * gv[j] + bv[j];
        }
        float* orow = out + (size_t)row * D + 8 * F.lane; bf16* brow = xb + (size_t)row * D + 8 * F.lane;
        const float sc = final ? 1.0f : ALPHA;
#pragma unroll
        for (int jh = 0; jh < 2; ++jh) { if (MODE != 2) { *(f32x4*)(orow + 512 * jh) = o[2 * jh] * sc; *(f32x4*)(orow + 512 * jh + 4) = o[2 * jh + 1] * sc; }
            v4u w; w.x = cvt_pk_bf16(o[2 * jh][0], o[2 * jh][1]); w.y = cvt_pk_bf16(o[2 * jh][2], o[2 * jh][3]); w.z = cvt_pk_bf16(o[2 * jh + 1][0], o[2 * jh + 1][1]); w.w = cvt_pk_bf16(o[2 * jh + 1][2], o[2 * jh + 1][3]);
            *(v4u*)(brow + 512 * jh) = w; }
    }
}

__device__ __forceinline__ void cast_phase(Frame& F, const float* x) {
    bf16* xb = (bf16*)(F.ws + WS_XB);
    for (int r0 = 4 * F.gw; r0 < T; r0 += 4 * F.NGW) { f32x4 v[4][4];
#pragma unroll
        for (int r = 0; r < 4; ++r) { const float* xr = x + (size_t)(r0 + r) * D + 8 * F.lane;
#pragma unroll
            for (int j = 0; j < 4; ++j) v[r][j] = *(const f32x4*)(xr + 512 * (j >> 1) + 4 * (j & 1)); }
        __builtin_amdgcn_sched_barrier(0);
#pragma unroll
        for (int r = 0; r < 4; ++r) { bf16* brow = xb + (size_t)(r0 + r) * D + 8 * F.lane;
#pragma unroll
            for (int jh = 0; jh < 2; ++jh) { v4u w; w.x = cvt_pk_bf16(v[r][2 * jh][0], v[r][2 * jh][1]); w.y = cvt_pk_bf16(v[r][2 * jh][2], v[r][2 * jh][3]); w.z = cvt_pk_bf16(v[r][2 * jh + 1][0], v[r][2 * jh + 1][1]);
                w.w = cvt_pk_bf16(v[r][2 * jh + 1][2], v[r][2 * jh + 1][3]); *(v4u*)(brow + 512 * jh) = w; } }
        __builtin_amdgcn_sched_barrier(0); }
}
__device__ __forceinline__ void ln2_phase(Frame& F, const float* g, const float* bsh, bool final, const MoeTab& M) {
    float* out = F.out; bf16* xb = (bf16*)(F.ws + WS_XB);
    const unsigned char* y8 = F.ws + WS_Y; const float* ysc = (const float*)(F.ws + WS_YSC); const int4* tsel4 = (const int4*)(F.ws + WS_TSEL);
    f32x4 gv[4], bv[4];
#pragma unroll
    for (int j = 0; j < 4; ++j) { const int c = 512 * (j >> 1) + 8 * F.lane + 4 * (j & 1); gv[j] = *(const f32x4*)(g + c); bv[j] = *(const f32x4*)(bsh + c); }
    const float sc = final ? 1.0f : ALPHA;
    constexpr int NBAT = T / 16;
    for (int batch = F.gw; batch < NBAT; batch += F.NGW) {
        const int row0 = 16 * batch;
        const int4 tsv = tsel4[(size_t)row0 * 4 + F.lane];
        v4u xv[2]; v2u yw[TOPK + 1][2]; float ysv[TOPK + 1][2];
#define LN2_ISSUE(I_) do { const int i_ = (I_); const bf16* xr = xb + (size_t)(row0 + i_) * D + 8 * F.lane; \
            xv[0] = *(const v4u*)xr; xv[1] = *(const v4u*)(xr + 512); \
            { const size_t yr = (size_t)(Y_SHARED0 + row0 + i_); const unsigned char* yp = y8 + yr * D + 8 * F.lane; yw[TOPK][0] = *(const v2u*)yp; yw[TOPK][1] = *(const v2u*)(yp + 512); \
              ysv[TOPK][0] = ysc[yr * 4 + (F.lane >> 5)]; ysv[TOPK][1] = ysc[yr * 4 + 2 + (F.lane >> 5)]; } \
            _Pragma("unroll") for (int jj = 0; jj < TOPK; ++jj) { const int tx = __builtin_amdgcn_readlane((jj & 1) ? tsv.z : tsv.x, 4 * i_ + (jj >> 1)); const int e = tx >> 20, slot = tx & 0xfffff; \
                const size_t yr = (size_t)(M.hoff[e] + slot); const unsigned char* yp = y8 + yr * D + 8 * F.lane; yw[jj][0] = *(const v2u*)yp; yw[jj][1] = *(const v2u*)(yp + 512); \
                ysv[jj][0] = ysc[yr * 4 + (F.lane >> 5)]; ysv[jj][1] = ysc[yr * 4 + 2 + (F.lane >> 5)]; } } while (0)
        LN2_ISSUE(0);
_Pragma("nounroll")
        for (int i = 0; i < 16; ++i) {
            f32x4 v[4];
#pragma unroll
            for (int jh = 0; jh < 2; ++jh) { const v4u w = xv[jh]; v[2 * jh] = (f32x4){bflo(w.x), bfhi(w.x), bflo(w.y), bfhi(w.y)} * ALPHA; v[2 * jh + 1] = (f32x4){bflo(w.z), bfhi(w.z), bflo(w.w), bfhi(w.w)} * ALPHA; }
#pragma unroll
            for (int jj = 0; jj <= TOPK; ++jj) { const float gt = jj == TOPK ? 1.0f : __int_as_float(__builtin_amdgcn_readlane((jj & 1) ? tsv.w : tsv.y, 4 * i + (jj >> 1)));
#pragma unroll
                for (int jh = 0; jh < 2; ++jh) { const v2u w = yw[jj][jh]; const float gs_ = gt * ysv[jj][jh];
                    const auto p0 = __builtin_amdgcn_cvt_pk_f32_fp8((int)w.x, false), p1 = __builtin_amdgcn_cvt_pk_f32_fp8((int)w.x, true), p2 = __builtin_amdgcn_cvt_pk_f32_fp8((int)w.y, false), p3 = __builtin_amdgcn_cvt_pk_f32_fp8((int)w.y, true);
                    v[2 * jh][0] += gs_ * p0[0]; v[2 * jh][1] += gs_ * p0[1]; v[2 * jh][2] += gs_ * p1[0]; v[2 * jh][3] += gs_ * p1[1];
                    v[2 * jh + 1][0] += gs_ * p2[0]; v[2 * jh + 1][1] += gs_ * p2[1]; v[2 * jh + 1][2] += gs_ * p3[0]; v[2 * jh + 1][3] += gs_ * p3[1]; } }
            __builtin_amdgcn_sched_barrier(0);
            LN2_ISSUE(i + 1 < 16 ? i + 1 : 15);
            __builtin_amdgcn_sched_barrier(0);
            float s = 0.f;
#pragma unroll
            for (int j = 0; j < 4; ++j) s += (v[j][0] + v[j][1]) + (v[j][2] + v[j][3]);
            const float mean = wave_sum(s) * (1.0f / D); float s2 = 0.f;
#pragma unroll
            for (int j = 0; j < 4; ++j) { v[j] = v[j] - mean; s2 += (v[j][0] * v[j][0] + v[j][1] * v[j][1]) + (v[j][2] * v[j][2] + v[j][3] * v[j][3]); }
            const float rstd = 1.0f / sqrtf(wave_sum(s2) * (1.0f / D) + LN_EPS);
            f32x4 o[4];
#pragma unroll
            for (int j = 0; j < 4; ++j) o[j] = v[j] * rstd * gv[j] + bv[j];
            float* orow = out + (size_t)(row0 + i) * D + 8 * F.lane; bf16* brow = xb + (size_t)(row0 + i) * D + 8 * F.lane;
#pragma unroll
            for (int jh = 0; jh < 2; ++jh) { if (final) { *(f32x4*)(orow + 512 * jh) = o[2 * jh]; *(f32x4*)(orow + 512 * jh + 4) = o[2 * jh + 1]; }
                v4u w; w.x = cvt_pk_bf16(o[2 * jh][0], o[2 * jh][1]); w.y = cvt_pk_bf16(o[2 * jh][2], o[2 * jh][3]); w.z = cvt_pk_bf16(o[2 * jh + 1][0], o[2 * jh + 1][1]); w.w = cvt_pk_bf16(o[2 * jh + 1][2], o[2 * jh + 1][3]);
                *(v4u*)(brow + 512 * jh) = w; }
        }
#undef LN2_ISSUE
    }
}

__device__ __forceinline__ void moe_tables(Frame& F, int layer) {
    LAS int* cnt = (LAS int*)(F.lds + TAB_OFF); LAS int* mtp = cnt + 65; LAS int* hoff = mtp + 66;
    __syncthreads();
    if (F.tid < NE) cnt[F.tid] = (int)__hip_atomic_load(F.ctl + CW_CNT + (layer * 64 + F.tid) * 64, RLX_AGENT);
    if (F.tid == NE) cnt[NE] = T;
    __syncthreads();
    if (F.tid == 0) { int m = 0;
_Pragma("nounroll")
        for (int e = 0; e < NEX; ++e) { mtp[e] = m; hoff[e] = m * 256; m += (cnt[e] + 255) >> 8; } mtp[NEX] = m; hoff[NEX] = m * 256; }
    __syncthreads();
}

__device__ __forceinline__ void route_phase(Frame& F, int layer, const float* rbias) {
    const float* lg = (const float*)(F.ws + WS_LOGITS); int* toklist = (int*)(F.ws + WS_TOKLIST); int2* tsel = (int2*)(F.ws + WS_TSEL);
    LAS float* sw = (LAS float*)(F.lds + F.wave * 256);
    const float rb = rbias[F.lane];
    for (int row = F.gw; row < T; row += F.NGW) {
        const float sc = sigmoidf_(lg[(size_t)row * NE + F.lane]); const float bz = sc + rb;
        sw[F.lane] = bz; LDS_WAIT();
        float v[64];
#pragma unroll
        for (int q = 0; q < 16; ++q) { const f32x4 t = *(const LAS f32x4*)(sw + 4 * q); v[4 * q] = t[0]; v[4 * q + 1] = t[1]; v[4 * q + 2] = t[2]; v[4 * q + 3] = t[3]; }
        LDS_WAIT();
        float gs[8];
#pragma unroll
        for (int gi = 0; gi < 8; ++gi) { float m1 = -INFINITY, m2 = -INFINITY;
#pragma unroll
            for (int k = 0; k < 8; ++k) { const float x = v[8 * gi + k]; const bool a = x > m1; const float nm2 = a ? m1 : fmaxf(m2, x); m1 = a ? x : m1; m2 = nm2; }
            gs[gi] = m1 + m2; }
        unsigned keep = 0u;
#pragma unroll
        for (int gi = 0; gi < 8; ++gi) { int rank = 0;
#pragma unroll
            for (int g2 = 0; g2 < 8; ++g2) rank += (gs[g2] > gs[gi] || (gs[g2] == gs[gi] && g2 < gi)) ? 1 : 0;
            keep |= (rank < 4) ? (1u << gi) : 0u; }
        const bool kown = (keep >> (F.lane >> 3)) & 1u; int rank = 0;
#pragma unroll
        for (int e2 = 0; e2 < 64; ++e2) { const bool k2 = (keep >> (e2 >> 3)) & 1u; rank += (k2 && (v[e2] > bz || (v[e2] == bz && e2 < F.lane))) ? 1 : 0; }
        const bool sel = kown && rank < TOPK;
        const unsigned long long bal = __ballot(sel);
        const float ssum = wave_sum(sel ? sc : 0.0f);
        if (sel) { const int j = __popcll(bal & ((1ull << F.lane) - 1ull)); const float gate = sc / ssum * 2.5f;
            const unsigned slot = __hip_atomic_fetch_add(F.ctl + CW_CNT + (layer * 64 + F.lane) * 64, 1u, RLX_AGENT);
            toklist[(size_t)F.lane * T + slot] = row;
            if (j < TOPK) tsel[(size_t)row * TOPK + j] = make_int2((F.lane << 20) | (int)slot, __float_as_int(gate)); }
    }
}

__device__ __forceinline__ void ln1_route_phase(Frame& F, const float* g, const float* bsh, int layer, const float* rbias) {
    float* out = F.out; bf16* xb = (bf16*)(F.ws + WS_XB);
    const unsigned char* WrT = F.ws + WS_WR + (size_t)layer * 256 * D * 2;
    int* toklist = (int*)(F.ws + WS_TOKLIST); int2* tsel = (int2*)(F.ws + WS_TSEL);
    f32x4 gv[4], bv[4];
#pragma unroll
    for (int j = 0; j < 4; ++j) { const int c = 512 * (j >> 1) + 8 * F.lane + 4 * (j & 1); gv[j] = *(const f32x4*)(g + c); bv[j] = *(const f32x4*)(bsh + c); }
    const float rb = rbias[F.lane];
    const int qi = F.lane & 15, gq = F.lane >> 4;
    constexpr int NBAT = T / 16;
    for (int b0 = 0; b0 < NBAT; b0 += F.NGW) {
        const int batch = b0 + F.gw; const bool act = batch < NBAT;
        __syncthreads();
#pragma unroll
        for (int q = 0; q < 16; ++q) { const int hr = F.wave * 16 + q, e = hr >> 1, half = hr & 1; const int c = (64 * half + F.lane) ^ (e & 15);
            __builtin_amdgcn_global_load_lds((const unsigned*)(WrT + (size_t)e * 2048 + 16 * c), (LAS unsigned*)(F.lds + e * 2048 + 1024 * half), 16, 0, 0); }
        if (act) {
_Pragma("nounroll")
            for (int i = 0; i < 16; i += 4) {
                v4u vv[4][2];
#pragma unroll
                for (int r = 0; r < 4; ++r) { const bf16* xr = (const bf16*)out + (size_t)(16 * batch + i + r) * D + 8 * F.lane; vv[r][0] = *(const v4u*)xr; vv[r][1] = *(const v4u*)(xr + 512); }
                __builtin_amdgcn_sched_barrier(0);
#pragma unroll
                for (int r = 0; r < 4; ++r) { const int row = 16 * batch + i + r; f32x4 v[4];
#pragma unroll
                    for (int jh = 0; jh < 2; ++jh) { const v4u w = vv[r][jh]; v[2 * jh] = (f32x4){bflo(w.x), bfhi(w.x), bflo(w.y), bfhi(w.y)}; v[2 * jh + 1] = (f32x4){bflo(w.z), bfhi(w.z), bflo(w.w), bfhi(w.w)}; }
                    float s = 0.f;
#pragma unroll
                    for (int j = 0; j < 4; ++j) s += (v[j][0] + v[j][1]) + (v[j][2] + v[j][3]);
                    const float mean = wave_sum(s) * (1.0f / D); float s2 = 0.f;
#pragma unroll
                    for (int j = 0; j < 4; ++j) { v[j] = v[j] - mean; s2 += (v[j][0] * v[j][0] + v[j][1] * v[j][1]) + (v[j][2] * v[j][2] + v[j][3] * v[j][3]); }
                    const float rstd = 1.0f / sqrtf(wave_sum(s2) * (1.0f / D) + LN_EPS);
                    f32x4 o[4];
#pragma unroll
                    for (int j = 0; j < 4; ++j) o[j] = v[j] * rstd * gv[j] + bv[j];
                    bf16* brow = xb + (size_t)row * D + 8 * F.lane;
#pragma unroll
                    for (int jh = 0; jh < 2; ++jh) {
                        v4u w; w.x = cvt_pk_bf16(o[2 * jh][0], o[2 * jh][1]); w.y = cvt_pk_bf16(o[2 * jh][2], o[2 * jh][3]); w.z = cvt_pk_bf16(o[2 * jh + 1][0], o[2 * jh + 1][1]); w.w = cvt_pk_bf16(o[2 * jh + 1][2], o[2 * jh + 1][3]);
                        *(v4u*)(brow + 512 * jh) = w; } }
                __builtin_amdgcn_sched_barrier(0);
            }
        }
        VM_WAIT(); __syncthreads();
        f32x4 acc[4];
#pragma unroll
        for (int t = 0; t < 4; ++t) acc[t] = (f32x4){0.f, 0.f, 0.f, 0.f};
        if (act) { const bf16* xrow = xb + (size_t)(16 * batch + qi) * D + 8 * gq;
#pragma unroll
            for (int k0 = 0; k0 < 32; k0 += 16) { bf16x8 bfr[16];
#pragma unroll
                for (int ks = 0; ks < 16; ++ks) bfr[ks] = *(const bf16x8*)(xrow + 32 * (k0 + ks));
                __builtin_amdgcn_sched_barrier(0);
#pragma unroll
                for (int ks = 0; ks < 16; ++ks)
#pragma unroll
                    for (int t = 0; t < 4; ++t) { const bf16x8 a = *(const LAS bf16x8*)(F.lds + (16 * t + qi) * 2048 + 16 * ((4 * (k0 + ks) + gq) ^ qi)); acc[t] = __builtin_amdgcn_mfma_f32_16x16x32_bf16(a, bfr[ks], acc[t], 0, 0, 0); }
                __builtin_amdgcn_sched_barrier(0); } }
        __syncthreads();
        if (act) { LAS float* lg = (LAS float*)(F.lds + F.wave * 16384);
#pragma unroll
            for (int t = 0; t < 4; ++t) *(LAS f32x4*)(lg + qi * 64 + 16 * t + 4 * gq) = acc[t];
            LDS_WAIT();
            int cnt = 0;
_Pragma("nounroll")
            for (int i = 0; i < 16; ++i) { LAS float* sw = lg + 64 * i;
                const float sc = sigmoidf_(sw[F.lane]); const float bz = sc + rb;
                const float m1 = max8(bz);
                const unsigned long long bm = __ballot(bz == m1);
                const unsigned gb = (unsigned)(bm >> (F.lane & 56)) & 0xffu;
                const bool isf = (unsigned)(F.lane & 7) == (unsigned)__builtin_ctz(gb);
                const float m2 = max8(isf ? -INFINITY : bz);
                const float gsum = m1 + m2; const int grp = F.lane >> 3; int grank = 0;
#pragma unroll
                for (int g2 = 0; g2 < 8; ++g2) { const float s = __int_as_float(__builtin_amdgcn_readlane(__float_as_int(gsum), 8 * g2)); grank += (s > gsum || (s == gsum && g2 < grp)) ? 1 : 0; }
                float x = (grank < 4) ? bz : -INFINITY; bool sel = false;
#pragma unroll
                for (int r8 = 0; r8 < TOPK; ++r8) { const float m = wave_max(x); const unsigned long long bx = __ballot(x == m); const int first = (int)__builtin_ctzll(bx);
                    if (F.lane == first) { sel = true; x = -INFINITY; } }
                const float ssum = wave_sum(sel ? sc : 0.0f);
                sw[F.lane] = sel ? sc / ssum * 2.5f : -1.0f; cnt += sel ? 1 : 0; }
            unsigned slot = 0; if (cnt > 0) slot = __hip_atomic_fetch_add(F.ctl + CW_CNT + (layer * 64 + F.lane) * 64, (unsigned)cnt, RLX_AGENT);
            LDS_WAIT();
_Pragma("nounroll")
            for (int i = 0; i < 16; ++i) { const float gate = lg[64 * i + F.lane]; const bool sel = gate >= 0.0f; const int row = 16 * batch + i;
                const unsigned long long bal = __ballot(sel);
                if (sel) { const int j = __popcll(bal & ((1ull << F.lane) - 1ull));
                    toklist[(size_t)F.lane * T + slot] = row;
                    if (j < TOPK) tsel[(size_t)row * TOPK + j] = make_int2((F.lane << 20) | (int)slot, __float_as_int(gate));
                    ++slot; } }
            LDS_WAIT();
        }
    }
}

__device__ __forceinline__ void mix_phase(Frame& F, const float* mix) {
    bf16* xm = (bf16*)(F.ws + WS_XMIX);
    f32x4 mc[6][2][2];
#pragma unroll
    for (int i = 0; i < 6; ++i)
#pragma unroll
        for (int jh = 0; jh < 2; ++jh)
#pragma unroll
            for (int q = 0; q < 2; ++q) mc[i][jh][q] = *(const f32x4*)(mix + i * D + 512 * jh + 8 * F.lane + 4 * q);
    constexpr int NBAT = T / 16; const bf16* xbuf = (const bf16*)(F.ws + WS_XB);
    for (int batch = F.gw; batch < NBAT; batch += F.NGW) {
        const int row0 = 16 * batch; const bf16* xr = xbuf + (size_t)row0 * D + 8 * F.lane; const bool first = (row0 & (SEQ - 1)) == 0;
        f32x4 xp[2][2]; v4u xc[2];
#pragma unroll
        for (int jh = 0; jh < 2; ++jh) { xc[jh] = *(const v4u*)(xr + 512 * jh); const v4u w = *(const v4u*)(xr + (first ? 0 : -D) + 512 * jh); const float m_ = first ? 0.0f : 1.0f;
            xp[jh][0] = (f32x4){bflo(w.x), bfhi(w.x), bflo(w.y), bfhi(w.y)} * m_; xp[jh][1] = (f32x4){bflo(w.z), bfhi(w.z), bflo(w.w), bfhi(w.w)} * m_; }
_Pragma("nounroll")
        for (int i = 0; i < 16; ++i) { const bf16* xnp = xr + (size_t)(i + 1 < 16 ? i + 1 : 15) * D; v4u xn[2];
#pragma unroll
            for (int jh = 0; jh < 2; ++jh) xn[jh] = *(const v4u*)(xnp + 512 * jh);
            bf16* orow = xm + (size_t)(row0 + i) * D + 8 * F.lane;
#pragma unroll
            for (int jh = 0; jh < 2; ++jh) { const v4u w = xc[jh]; const f32x4 x0 = {bflo(w.x), bfhi(w.x), bflo(w.y), bfhi(w.y)}, x1 = {bflo(w.z), bfhi(w.z), bflo(w.w), bfhi(w.w)}; const f32x4 d0 = xp[jh][0] - x0, d1 = xp[jh][1] - x1;
#pragma unroll
                for (int k = 0; k < 6; ++k) { const f32x4 o0 = x0 + d0 * mc[k][jh][0], o1 = x1 + d1 * mc[k][jh][1];
                    v4u wo; wo.x = cvt_pk_bf16(o0[0], o0[1]); wo.y = cvt_pk_bf16(o0[2], o0[3]); wo.z = cvt_pk_bf16(o1[0], o1[1]); wo.w = cvt_pk_bf16(o1[2], o1[3]);
                    *(v4u*)(orow + (size_t)k * T * D + 512 * jh) = wo; }
                xp[jh][0] = x0; xp[jh][1] = x1; xc[jh] = xn[jh]; }
        }
    }
}
__device__ __forceinline__ void kmean_phase(Frame& F) {
    const bf16* Kb = (const bf16*)(F.ws + WS_K); float* km = (float*)(F.ws + WS_KMEAN);
    for (int u = F.gw; u < NBATCH * NH * NMB; u += F.NGW) { const int bh = u >> 4, blk = u & 15, b = bh >> 4, h = bh & 15;
        const bf16* p = Kb + ((size_t)b * SEQ + blk * MBLK + (F.lane >> 3)) * D + h * HD + 8 * (F.lane & 7); float s[8];
#pragma unroll
        for (int i = 0; i < 8; ++i) s[i] = 0.f;
#pragma unroll
        for (int r0 = 0; r0 < MBLK / 8; r0 += 16) { v4u w[16];
#pragma unroll
            for (int r = 0; r < 16; ++r) w[r] = *(const v4u*)(p + (size_t)(8 * (r0 + r)) * D);
            __builtin_amdgcn_sched_barrier(0);
#pragma unroll
            for (int r = 0; r < 16; ++r) { s[0] += bflo(w[r].x); s[1] += bfhi(w[r].x); s[2] += bflo(w[r].y); s[3] += bfhi(w[r].y); s[4] += bflo(w[r].z); s[5] += bfhi(w[r].z); s[6] += bflo(w[r].w); s[7] += bfhi(w[r].w); }
            __builtin_amdgcn_sched_barrier(0); }
#pragma unroll
        for (int i = 0; i < 8; ++i) s[i] = q4_sum(dpp_add<0x128>(s[i])) * (1.0f / MBLK);
        if (F.lane < 8) { float* o = km + (size_t)u * HD + 8 * F.lane; *(f32x4*)o = (f32x4){s[0], s[1], s[2], s[3]}; *(f32x4*)(o + 4) = (f32x4){s[4], s[5], s[6], s[7]}; } }
}
template <int CTRL> __device__ __forceinline__ float dpp_max_f(float v) { return dpp_max<CTRL>(v); }
__device__ __forceinline__ void sel_phase(Frame& F) {
    const bf16* Q = (const bf16*)(F.ws + WS_Q); const float* km = (const float*)(F.ws + WS_KMEAN); unsigned short* maskb = (unsigned short*)(F.ws + WS_MASK);
    const int j = F.lane & 15, g = F.lane >> 4;
    for (int u = F.vcu; u < NBATCH * NH * (SEQ / NTHREADS); u += F.G) { const int bh = u >> 3, ch = u & 7, b = bh >> 4, h = bh & 15;
        const int q0 = ch * NTHREADS + 64 * F.wave, qblk = q0 >> 8;
        bf16x8 khi[2], klo[2];
#pragma unroll
        for (int ks = 0; ks < 2; ++ks) { const float* kp = km + ((size_t)bh * NMB + j) * HD + 32 * ks + 8 * g; const f32x4 k0 = *(const f32x4*)kp, k1 = *(const f32x4*)(kp + 4); v4u hw, lw_;
            float hf[8], lf[8];
#pragma unroll
            for (int i = 0; i < 8; ++i) { const float x = i < 4 ? k0[i & 3] : k1[i & 3]; const unsigned hb = cvt_pk_bf16(x, 0.0f) & 0xffffu; hf[i] = __uint_as_float(hb << 16); lf[i] = x - hf[i]; }
            hw.x = cvt_pk_bf16(hf[0], hf[1]); hw.y = cvt_pk_bf16(hf[2], hf[3]); hw.z = cvt_pk_bf16(hf[4], hf[5]); hw.w = cvt_pk_bf16(hf[6], hf[7]);
            lw_.x = cvt_pk_bf16(lf[0], lf[1]); lw_.y = cvt_pk_bf16(lf[2], lf[3]); lw_.z = cvt_pk_bf16(lf[4], lf[5]); lw_.w = cvt_pk_bf16(lf[6], lf[7]);
            khi[ks] = __builtin_bit_cast(bf16x8, hw); klo[ks] = __builtin_bit_cast(bf16x8, lw_); }
        bf16x8 qf[4][2];
#pragma unroll
        for (int t = 0; t < 4; ++t)
#pragma unroll
            for (int ks = 0; ks < 2; ++ks) qf[t][ks] = *(const bf16x8*)(Q + ((size_t)b * SEQ + q0 + 16 * t + j) * D + h * HD + 32 * ks + 8 * g);
#pragma unroll
        for (int t = 0; t < 4; ++t) { f32x4 acc = {0.f, 0.f, 0.f, 0.f};
#pragma unroll
            for (int ks = 0; ks < 2; ++ks) { acc = __builtin_amdgcn_mfma_f32_16x16x32_bf16(qf[t][ks], klo[ks], acc, 0, 0, 0); acc = __builtin_amdgcn_mfma_f32_16x16x32_bf16(qf[t][ks], khi[ks], acc, 0, 0, 0); }
            unsigned mk[4];
#pragma unroll
            for (int r = 0; r < 4; ++r) { float x = (j < qblk) ? acc[r] : -INFINITY; unsigned m_ = 0u;
#pragma unroll
                for (int rd = 0; rd < 3; ++rd) { float mx = dpp_max<0xB1>(x); mx = dpp_max<0x4E>(mx); mx = dpp_max<0x141>(mx); mx = dpp_max<0x140>(mx);
                    const unsigned long long bal = __ballot(x == mx && mx > -INFINITY); const unsigned rb_ = (unsigned)(bal >> (16 * g)) & 0xffffu;
                    if (rb_) { const int js = __builtin_ctz(rb_); m_ |= 1u << js; if (j == js) x = -INFINITY; } }
                mk[r] = m_; }
            if (j == 0) { v2u w; w.x = mk[0] | (mk[1] << 16); w.y = mk[2] | (mk[3] << 16); *(v2u*)(maskb + (size_t)bh * SEQ + q0 + 16 * t + 4 * g) = w; } }
    }
}
template <int probe> __device__ __forceinline__ void attn_phase(Frame& F, const float* rel_bias) {
    const bf16* Q = (const bf16*)(F.ws + WS_Q); const bf16* Kb = (const bf16*)(F.ws + WS_K); const bf16* Vt = (const bf16*)(F.ws + WS_VT); bf16* O = (bf16*)(F.ws + WS_O);
    const unsigned short* maskb = (const unsigned short*)(F.ws + WS_MASK);
    constexpr int KRS = 144, VRS = 272, KB_ = 128 * KRS, TB = KB_ + 64 * VRS;
    LAS float* tbl = (LAS float*)(F.lds + 2 * TB);
    __syncthreads();
    for (int i = F.tid; i < NH * 129; i += NTHREADS) { const int h = i / 129, d = i % 129; tbl[h * 132 + d] = rel_bias[(int)T5_BUCKET[d] * NH + h] * 1.4426950408889634f; }
    __syncthreads();
    const int qi = F.lane & 15, g = F.lane >> 4; unsigned tcount = 0;
    for (int it = 0;; ++it) {
        int bh, blk;
        if (F.G == 256) { if (it >= 8) break; bh = F.vcu >> 1; blk = (F.vcu & 1) ? ((it & 1) ? 15 - it : it + 1) : ((it & 1) ? 16 - it : it); }
        else { const int L = it * F.G + F.vcu; if (L >= NBATCH * NH * NMB) break; bh = L >> 4; blk = L & 15; }
        const int b = bh >> 4, h = bh & 15;
        const int q0 = blk * MBLK + 32 * F.wave;
        bf16x8 qf[2][2]; unsigned qmask[2];
#pragma unroll
        for (int gp = 0; gp < 2; ++gp) { const int qpos = q0 + 16 * gp + qi; const size_t qrow = (size_t)b * SEQ + qpos; qmask[gp] = maskb[(size_t)bh * SEQ + qpos];
#pragma unroll
            for (int ks = 0; ks < 2; ++ks) qf[gp][ks] = *(const bf16x8*)(Q + qrow * D + h * HD + 32 * ks + 8 * g); }
        const LAS float* tblh = tbl + h * 132; const float bfar = tblh[128];
        float mref[2] = {0.f, 0.f}; f32x4 o[2][5];
#pragma unroll
        for (int gp = 0; gp < 2; ++gp)
#pragma unroll
            for (int dt = 0; dt < 5; ++dt) o[gp][dt] = (f32x4){0.f, 0.f, 0.f, 0.f};
        constexpr float THR = 8.0f;
        const bf16x8 ones = {0x3F80, 0x3F80, 0x3F80, 0x3F80, 0x3F80, 0x3F80, 0x3F80, 0x3F80};
        const int nst = 2 + 2 * blk;
        const int kkey = F.tid >> 3, kch = F.tid & 7;
        const int vd = F.tid >> 3, vch = F.tid & 7;
        const bf16* kbase = Kb + ((size_t)b * SEQ + kkey) * D + h * HD + 8 * kch;
        const bf16* vbase = Vt + (((size_t)bh * HD + vd) << 12) + 8 * vch;
        v4u kreg[2], vreg[2];
        { const int key0 = blk * MBLK; kreg[0] = *(const v4u*)(kbase + (size_t)key0 * D); kreg[1] = *(const v4u*)(kbase + (size_t)(key0 + 64) * D); vreg[0] = *(const v4u*)(vbase + key0); vreg[1] = *(const v4u*)(vbase + key0 + 64); }
        for (int n = 0; n < nst; ++n) {
            int jb, key0; if (n < 2) { jb = blk; key0 = blk * MBLK + 128 * n; } else { const int mm = n - 2; jb = blk - 1 - (mm >> 1); key0 = jb * MBLK + 128 * (mm & 1); }
            LAS unsigned char* buf = F.lds + (tcount & 1u) * TB; ++tcount;
            *(LAS v4u*)(buf + kkey * KRS + kch * 16) = kreg[0]; *(LAS v4u*)(buf + (kkey + 64) * KRS + kch * 16) = kreg[1];
            *(LAS v4u*)(buf + KB_ + vd * VRS + vch * 16) = vreg[0]; *(LAS v4u*)(buf + KB_ + vd * VRS + (vch + 8) * 16) = vreg[1];
            asm volatile("s_waitcnt lgkmcnt(0)" ::: "memory");
            if (n + 1 < nst) { const int n1 = n + 1; int k1; if (n1 < 2) k1 = blk * MBLK + 128 * n1; else { const int mm = n1 - 2; k1 = (blk - 1 - (mm >> 1)) * MBLK + 128 * (mm & 1); }
                kreg[0] = *(const v4u*)(kbase + (size_t)k1 * D); kreg[1] = *(const v4u*)(kbase + (size_t)(k1 + 64) * D); vreg[0] = *(const v4u*)(vbase + k1); vreg[1] = *(const v4u*)(vbase + k1 + 64); }
            asm volatile("s_barrier" ::: "memory");
            const bool own = (jb == blk), nearb = (jb >= blk - 1);
            if (probe == 2) continue;
            if (own && 128 * n > 32 * F.wave + 31) continue;
            f32x4 s[2][8]; bool selb[2];
#pragma unroll
            for (int gp = 0; gp < 2; ++gp) { selb[gp] = (qmask[gp] >> jb) & 1u; const float c0 = (n == 0) ? 0.0f : (nearb ? -mref[gp] : (selb[gp] ? bfar - mref[gp] : -INFINITY));
#pragma unroll
                for (int kt = 0; kt < 8; ++kt) s[gp][kt] = (f32x4){c0, c0, c0, c0}; }
#pragma unroll
            for (int kt = 0; kt < 8; ++kt)
#pragma unroll
                for (int ks = 0; ks < 2; ++ks) { if (probe == 4) break; const bf16x8 a = *(const LAS bf16x8*)(buf + (16 * kt + qi) * KRS + 64 * ks + 16 * g);
                    s[0][kt] = __builtin_amdgcn_mfma_f32_16x16x32_bf16(a, qf[0][ks], s[0][kt], 0, 0, 0); s[1][kt] = __builtin_amdgcn_mfma_f32_16x16x32_bf16(a, qf[1][ks], s[1][kt], 0, 0, 0);
                    }
#pragma unroll
            for (int gp = 0; gp < 2; ++gp) { if (probe == 3) break;
                float mx = -INFINITY;
                if (nearb) {
                    const int qpos = q0 + 16 * gp + qi; const int dist0 = qpos - (key0 + 4 * g);
#pragma unroll
                    for (int kh = 0; kh < 4; ++kh) { float bz[2][4];
#pragma unroll
                        for (int k4 = 0; k4 < 2; ++k4)
#pragma unroll
                            for (int r = 0; r < 4; ++r) { const int dist = dist0 - (16 * (2 * kh + k4) + r); const int dd = dist < 0 ? 0 : (dist > 128 ? 128 : dist); bz[k4][r] = tblh[dd]; }
#pragma unroll
                        for (int k4 = 0; k4 < 2; ++k4) asm volatile("" : "+v"(bz[k4][0]), "+v"(bz[k4][1]), "+v"(bz[k4][2]), "+v"(bz[k4][3]));
#pragma unroll
                        for (int k4 = 0; k4 < 2; ++k4)
#pragma unroll
                            for (int r = 0; r < 4; ++r) { const int kt = 2 * kh + k4; const int dist = dist0 - (16 * kt + r);
                                const bool valid = own ? (dist >= 0) : selb[gp]; const float x = valid ? s[gp][kt][r] + bz[k4][r] : -INFINITY; s[gp][kt][r] = x; mx = __builtin_fmaxf(mx, x); } }
                } else {
#pragma unroll
                    for (int kt = 0; kt < 8; ++kt)
#pragma unroll
                        for (int r = 0; r < 4; ++r) mx = __builtin_fmaxf(mx, s[gp][kt][r]); }
                mx = q4_max(mx);
                if (n == 0) {
                    mref[gp] = mx;
#pragma unroll
                    for (int kt = 0; kt < 8; ++kt)
#pragma unroll
                        for (int r = 0; r < 4; ++r) s[gp][kt][r] -= mx;
                } else if (__any(mx > THR)) {
                    const float dl = __builtin_fmaxf(mx, 0.0f), f = __builtin_amdgcn_exp2f(-dl); mref[gp] += dl;
#pragma unroll
                    for (int kt = 0; kt < 8; ++kt)
#pragma unroll
                        for (int r = 0; r < 4; ++r) s[gp][kt][r] -= dl;
#pragma unroll
                    for (int dt = 0; dt < 5; ++dt) o[gp][dt] = o[gp][dt] * f; }
#pragma unroll
                for (int kt = 0; kt < 8; ++kt)
#pragma unroll
                    for (int r = 0; r < 4; ++r) s[gp][kt][r] = __builtin_amdgcn_exp2f(s[gp][kt][r]);
            }
#pragma unroll
            for (int k2 = 0; k2 < 4; ++k2) { if (probe == 5) break; bf16x8 pb[2][4];
#pragma unroll
                for (int gp = 0; gp < 2; ++gp) { v4u pw; pw.x = cvt_pk_bf16(s[gp][2 * k2][0], s[gp][2 * k2][1]); pw.y = cvt_pk_bf16(s[gp][2 * k2][2], s[gp][2 * k2][3]);
                    pw.z = cvt_pk_bf16(s[gp][2 * k2 + 1][0], s[gp][2 * k2 + 1][1]); pw.w = cvt_pk_bf16(s[gp][2 * k2 + 1][2], s[gp][2 * k2 + 1][3]); pb[gp][k2] = __builtin_bit_cast(bf16x8, pw); }
#pragma unroll
                for (int dt = 0; dt < 4; ++dt) { const LAS unsigned char* vp = buf + KB_ + (16 * dt + qi) * VRS + 64 * k2 + 8 * g; const v2u lo = *(const LAS v2u*)vp, hi = *(const LAS v2u*)(vp + 32);
                    v4u aw; aw.x = lo.x; aw.y = lo.y; aw.z = hi.x; aw.w = hi.y; const bf16x8 av = __builtin_bit_cast(bf16x8, aw);
                    o[0][dt] = __builtin_amdgcn_mfma_f32_16x16x32_bf16(av, pb[0][k2], o[0][dt], 0, 0, 0); o[1][dt] = __builtin_amdgcn_mfma_f32_16x16x32_bf16(av, pb[1][k2], o[1][dt], 0, 0, 0); }
                o[0][4] = __builtin_amdgcn_mfma_f32_16x16x32_bf16(ones, pb[0][k2], o[0][4], 0, 0, 0); o[1][4] = __builtin_amdgcn_mfma_f32_16x16x32_bf16(ones, pb[1][k2], o[1][4], 0, 0, 0); }
        }
#pragma unroll
        for (int gp = 0; gp < 2; ++gp) { const float inv = 1.0f / o[gp][4][0]; const size_t qrow = (size_t)b * SEQ + q0 + 16 * gp + qi;
#pragma unroll
            for (int dt = 0; dt < 4; ++dt) { v2u w; w.x = cvt_pk_bf16(o[gp][dt][0] * inv, o[gp][dt][1] * inv); w.y = cvt_pk_bf16(o[gp][dt][2] * inv, o[gp][dt][3] * inv); *(v2u*)(O + qrow * D + h * HD + 16 * dt + 4 * g) = w; } }
    }
    __syncthreads();
}

constexpr int SC = 32, NCHK = SEQ / SC;
constexpr size_t WS_PT = WS_S + 256 * MiB;
constexpr size_t WS_LT = 48 * MiB;
constexpr size_t WS_QT = WS_S + 576 * MiB;
constexpr size_t WS_YS2 = WS_S;
constexpr int LT_SPLIT = 98; constexpr size_t WS_LT2 = WS_YG + 64 * MiB;
static_assert(WS_LT + (size_t)LT_SPLIT * MiB <= WS_XB && WS_LT2 + (size_t)(NCHK - LT_SPLIT) * MiB <= WS_END && WS_QT + 64 * MiB <= WS_YG, "chunk operator buffers");
__device__ __forceinline__ size_t lt_off(int ck, int bh) { return (ck < LT_SPLIT ? WS_LT + (size_t)ck * MiB : WS_LT2 + (size_t)(ck - LT_SPLIT) * MiB) + (size_t)bh * 8192; }
__device__ __forceinline__ float reduce8(float v) { v = dpp_add<0xB1>(v); v = dpp_add<0x4E>(v); v = dpp_add<0x141>(v); return v; }
template <int KS> __device__ __forceinline__ f32x4 mm_tile(const LAS unsigned char* X, int xs, int m0, const LAS unsigned char* Y, int ys, int n0, f32x4 acc, int qi, int g) {
#pragma unroll
    for (int ks = 0; ks < KS; ++ks) { const bf16x8 a = *(const LAS bf16x8*)(X + (m0 + qi) * xs + 64 * ks + 16 * g), b = *(const LAS bf16x8*)(Y + (n0 + qi) * ys + 64 * ks + 16 * g);
        acc = __builtin_amdgcn_mfma_f32_16x16x32_bf16(a, b, acc, 0, 0, 0); }
    return acc;
}
typedef short v4i16_t_ __attribute__((ext_vector_type(4)));
__device__ __forceinline__ bf16x8 frag_tr(const LAS unsigned char* Z, int zs, int kk0, int c0, int qi, int g) {
    const LAS unsigned char* p = Z + (kk0 + 8 * g + (qi >> 2)) * zs + (c0 + 4 * (qi & 3)) * 2;
    const v4i16_t_ lo = __builtin_amdgcn_ds_read_tr16_b64_v4i16((LAS v4i16_t_*)p), hi = __builtin_amdgcn_ds_read_tr16_b64_v4i16((LAS v4i16_t_*)(p + 4 * zs));
    return (bf16x8){lo[0], lo[1], lo[2], lo[3], hi[0], hi[1], hi[2], hi[3]};
}
template <int KS> __device__ __forceinline__ f32x4 mm_tile_xt(const LAS unsigned char* Z, int zs, int m0, const LAS unsigned char* Y, int ys, int n0, f32x4 acc, int qi, int g) {
#pragma unroll
    for (int ks = 0; ks < KS; ++ks) { const bf16x8 a = frag_tr(Z, zs, 32 * ks, m0, qi, g), b = *(const LAS bf16x8*)(Y + (n0 + qi) * ys + 64 * ks + 16 * g);
        acc = __builtin_amdgcn_mfma_f32_16x16x32_bf16(a, b, acc, 0, 0, 0); }
    return acc;
}
template <int KS> __device__ __forceinline__ f32x4 mm_tile_yt(const LAS unsigned char* X, int xs, int m0, const LAS unsigned char* Z, int zs, int n0, f32x4 acc, int qi, int g) {
#pragma unroll
    for (int ks = 0; ks < KS; ++ks) { const bf16x8 a = *(const LAS bf16x8*)(X + (m0 + qi) * xs + 64 * ks + 16 * g), b = frag_tr(Z, zs, 32 * ks, n0, qi, g);
        acc = __builtin_amdgcn_mfma_f32_16x16x32_bf16(a, b, acc, 0, 0, 0); }
    return acc;
}
__device__ __forceinline__ v2u pack4(const f32x4 v) { v2u w; w.x = cvt_pk_bf16(v[0], v[1]); w.y = cvt_pk_bf16(v[2], v[3]); return w; }
__device__ __forceinline__ void chunk_prep(Frame& F, const bf16* vbuf, const float* k_k, const float* k_a, const bool dry = false) {
    const bf16* rb = (const bf16*)(F.ws + WS_R); const bf16* kb = (const bf16*)(F.ws + WS_KK); const bf16* ab = (const bf16*)(F.ws + WS_A); const bf16* lw = (const bf16*)(F.ws + WS_LW);
    bf16* PTg = (bf16*)(F.ws + WS_PT); bf16* QTg = (bf16*)(F.ws + WS_QT); bf16* LTg = (bf16*)(F.ws + WS_LT); float* ys = (float*)(F.ws + WS_YS2);
    constexpr int RS = 144, TS_ = 80;
    constexpr int O_AT = 0, O_BT = 4608, O_KT = 9216, O_RT = 13824, O_VT = 18432, O_X2T = 23040, O_GT = 28160,
                  O_TM = 33280, O_NRBT = 35840, O_NAK = 38400, O_X1T = 40960, O_HT = 43520, O_NAB = 46080, O_WC = 50688, O_PK = 50944, O_CL = O_X2T;
    const int grp = F.wave >> 2, wg = F.wave & 3;
    LAS unsigned char* L = F.lds + grp * 65536;
    const int gt0 = F.tid & 255, st0 = gt0 >> 3, c80 = gt0 & 7;
    __syncthreads();
    for (int i = gt0; i < D; i += 256) { *(LAS float*)(L + O_PK + i * 4) = k_k[i]; *(LAS float*)(L + O_PK + 4096 + i * 4) = k_a[i]; }
    constexpr int NIT = (NBATCH * NH * NCHK) / (2 * 256);
    v4u pre_r, pre_k, pre_a, pre_v, pre_l;
#define CP_BAR() asm volatile("s_waitcnt lgkmcnt(0)\n\ts_barrier" ::: "memory")
#define CP_LOAD(it_) do { const int item_ = ((it_) * F.G + F.vcu) * 2 + grp, bh_ = item_ >> 7, ck_ = item_ & (NCHK - 1); \
        const size_t o_ = ((size_t)(bh_ >> 4) * SEQ + ck_ * SC + st0) * D + (bh_ & 15) * HD + 8 * c80; \
        pre_r = *(const v4u*)(rb + o_); pre_k = *(const v4u*)(kb + o_); pre_a = *(const v4u*)(ab + o_); pre_v = *(const v4u*)(vbuf + o_); pre_l = *(const v4u*)(lw + o_); } while (0)
    CP_LOAD(0);
    asm volatile("" : "+v"(pre_r), "+v"(pre_k), "+v"(pre_a), "+v"(pre_v), "+v"(pre_l));
    for (int it = 0; it < NIT; ++it) {
        const int item = (it * F.G + F.vcu) * 2 + grp, bh = item >> 7, ck = item & (NCHK - 1), b = bh >> 4, h = bh & 15, t0 = ck * SC;
        const size_t base = ((size_t)b * SEQ + t0) * D + h * HD;
        int lane_i = F.lane; asm volatile("" : "+v"(lane_i));
        const int gt = (wg << 6) | lane_i, qi = lane_i & 15, g = lane_i >> 4, st = gt >> 3, c8 = gt & 7;
        CP_BAR();
        float r8[8], al8[8], be8[8], kh8[8], v8[8];
        { const v4u wr_ = pre_r, wk = pre_k, wa = pre_a, wv = pre_v;
          f32x4 l0 = {bflo(pre_l.x), bfhi(pre_l.x), bflo(pre_l.y), bfhi(pre_l.y)}, l1 = {bflo(pre_l.z), bfhi(pre_l.z), bflo(pre_l.w), bfhi(pre_l.w)};
#pragma unroll
          for (int j = 0; j < 4; ++j) { { const float z = l0[j]; l0[j] = -fast_exp(fminf(z, 0.0f) - __logf(1.0f + fast_exp(-fabsf(z))) - 0.5f); } { const float z = l1[j]; l1[j] = -fast_exp(fminf(z, 0.0f) - __logf(1.0f + fast_exp(-fabsf(z))) - 0.5f); } }
          const f32x4 kk0 = *(const LAS f32x4*)(L + O_PK + (h * HD + 8 * c8) * 4), kk1 = *(const LAS f32x4*)(L + O_PK + (h * HD + 8 * c8 + 4) * 4), ka0 = *(const LAS f32x4*)(L + O_PK + 4096 + (h * HD + 8 * c8) * 4), ka1 = *(const LAS f32x4*)(L + O_PK + 4096 + (h * HD + 8 * c8 + 4) * 4);
          float k8[8], a8[8], kk8[8]; float ss = 0.f;
#pragma unroll
          for (int j = 0; j < 8; ++j) { const unsigned xr = wr_[j >> 1], xk = wk[j >> 1], xa = wa[j >> 1], xv = wv[j >> 1];
              r8[j] = (j & 1) ? bfhi(xr) : bflo(xr); k8[j] = (j & 1) ? bfhi(xk) : bflo(xk); a8[j] = (j & 1) ? bfhi(xa) : bflo(xa); v8[j] = (j & 1) ? bfhi(xv) : bflo(xv);
              kk8[j] = k8[j] * (j < 4 ? kk0[j & 3] : kk1[j & 3]); ss += kk8[j] * kk8[j]; }
          ss = reduce8(ss); const float inv = 1.0f / fmaxf(sqrtf(ss), 1e-12f);
#pragma unroll
          for (int j = 0; j < 8; ++j) { const float kk = kk8[j] * inv; al8[j] = -kk; be8[j] = kk * a8[j]; kh8[j] = k8[j] * (1.0f + (a8[j] - 1.0f) * (j < 4 ? ka0[j & 3] : ka1[j & 3])); }
          *(LAS f32x4*)(L + O_CL + (st * 64 + 8 * c8) * 4) = l0; *(LAS f32x4*)(L + O_CL + (st * 64 + 8 * c8 + 4) * 4) = l1; }
        { const int itn = it + 1 < NIT ? it + 1 : it; CP_LOAD(itn); }
        CP_BAR();
#if DRYCUT == 5
        if (dry) continue;
#endif
        if (gt < 64) { float cv[SC];
#pragma unroll
            for (int t = 0; t < SC; ++t) cv[t] = *(const LAS float*)(L + O_CL + (t * 64 + gt) * 4);
#pragma unroll
            for (int t = 1; t < SC; ++t) cv[t] += cv[t - 1];
#pragma unroll
            for (int t = 0; t < SC; ++t) *(LAS float*)(L + O_CL + (t * 64 + gt) * 4) = cv[t];
            *(LAS float*)(L + O_WC + gt * 4) = fast_exp(cv[SC - 1]); }
        CP_BAR();
#if DRYCUT == 6
        if (dry) continue;
#endif
        { float cl[8], cm[8];
          { const f32x4 c0 = *(const LAS f32x4*)(L + O_CL + (st * 64 + 8 * c8) * 4), c1 = *(const LAS f32x4*)(L + O_CL + (st * 64 + 8 * c8 + 4) * 4);
            f32x4 m0 = {0.f, 0.f, 0.f, 0.f}, m1 = {0.f, 0.f, 0.f, 0.f};
            if (st > 0) { m0 = *(const LAS f32x4*)(L + O_CL + ((st - 1) * 64 + 8 * c8) * 4); m1 = *(const LAS f32x4*)(L + O_CL + ((st - 1) * 64 + 8 * c8 + 4) * 4); }
#pragma unroll
            for (int j = 0; j < 4; ++j) { cl[j] = c0[j]; cl[4 + j] = c1[j]; cm[j] = m0[j]; cm[4 + j] = m1[j]; } }
          float at8[8], bt8[8], kt8[8], rt8[8];
#pragma unroll
          for (int j = 0; j < 8; ++j) { const float e1 = fast_exp(cl[j]), em = fast_exp(cm[j]), en = fast_exp(-cl[j]); at8[j] = al8[j] * em; bt8[j] = be8[j] * en; kt8[j] = kh8[j] * en; rt8[j] = r8[j] * e1; }
          v4u w; w.x = cvt_pk_bf16(at8[0], at8[1]); w.y = cvt_pk_bf16(at8[2], at8[3]); w.z = cvt_pk_bf16(at8[4], at8[5]); w.w = cvt_pk_bf16(at8[6], at8[7]); *(LAS v4u*)(L + O_AT + st * RS + 16 * c8) = w;
          w.x = cvt_pk_bf16(bt8[0], bt8[1]); w.y = cvt_pk_bf16(bt8[2], bt8[3]); w.z = cvt_pk_bf16(bt8[4], bt8[5]); w.w = cvt_pk_bf16(bt8[6], bt8[7]); *(LAS v4u*)(L + O_BT + st * RS + 16 * c8) = w;
          w.x = cvt_pk_bf16(kt8[0], kt8[1]); w.y = cvt_pk_bf16(kt8[2], kt8[3]); w.z = cvt_pk_bf16(kt8[4], kt8[5]); w.w = cvt_pk_bf16(kt8[6], kt8[7]); *(LAS v4u*)(L + O_KT + st * RS + 16 * c8) = w;
          w.x = cvt_pk_bf16(rt8[0], rt8[1]); w.y = cvt_pk_bf16(rt8[2], rt8[3]); w.z = cvt_pk_bf16(rt8[4], rt8[5]); w.w = cvt_pk_bf16(rt8[6], rt8[7]); *(LAS v4u*)(L + O_RT + st * RS + 16 * c8) = w;
          w.x = cvt_pk_bf16(v8[0], v8[1]); w.y = cvt_pk_bf16(v8[2], v8[3]); w.z = cvt_pk_bf16(v8[4], v8[5]); w.w = cvt_pk_bf16(v8[6], v8[7]); *(LAS v4u*)(L + O_VT + st * RS + 16 * c8) = w; }
        CP_BAR();
#if DRYCUT == 1
        if (dry) continue;
#endif
        { const int mt = wg >> 1, nt = wg & 1, n = 16 * nt + qi, m0 = 16 * mt + 4 * g; const f32x4 z = {0.f, 0.f, 0.f, 0.f};
          f32x4 c1 = mm_tile<2>(L + O_AT, RS, 16 * mt, L + O_BT, RS, 16 * nt, z, qi, g);
#pragma unroll
          for (int r = 0; r < 4; ++r) c1[r] = (n < m0 + r) ? c1[r] : 0.f;
          *(LAS f32x4*)(L + O_NAB + n * 144 + m0 * 4) = c1;
          f32x4 c2 = mm_tile<2>(L + O_BT, RS, 16 * mt, L + O_RT, RS, 16 * nt, z, qi, g);
#pragma unroll
          for (int r = 0; r < 4; ++r) c2[r] = (m0 + r <= n) ? c2[r] : 0.f;
          *(LAS v2u*)(L + O_NRBT + n * TS_ + m0 * 2) = pack4(c2);
          f32x4 c3 = mm_tile<2>(L + O_AT, RS, 16 * mt, L + O_KT, RS, 16 * nt, z, qi, g);
#pragma unroll
          for (int r = 0; r < 4; ++r) c3[r] = (n < m0 + r) ? c3[r] : 0.f;
          *(LAS v2u*)(L + O_NAK + n * TS_ + m0 * 2) = pack4(c3); }
        CP_BAR();
#if DRYCUT == 2
        if (dry) continue;
#endif
        if (wg == 0) { const int col = lane_i & 31; float x[SC];
#pragma unroll
            for (int s = SC - 1; s >= 0; --s) { float ac[4] = {(col == s) ? 1.0f : 0.0f, 0.f, 0.f, 0.f};
#pragma unroll
                for (int q4 = SC / 4 - 1; q4 >= (s + 1) >> 2; --q4) { const f32x4 nv = *(const LAS f32x4*)(L + O_NAB + s * 144 + q4 * 16);
#pragma unroll
                    for (int r = 3; r >= 0; --r) { const int t = 4 * q4 + r; if (t > s) ac[r] += nv[r] * x[t]; } }
                x[s] = (ac[0] + ac[1]) + (ac[2] + ac[3]); }
            if (lane_i < 32) {
#pragma unroll
                for (int s = 0; s < SC; ++s) *(LAS bf16*)(L + O_TM + s * TS_ + col * 2) = (bf16)(cvt_pk_bf16(x[s], 0.f) & 0xffffu); } }
        CP_BAR();
#if DRYCUT == 3
        if (dry) continue;
#endif
        { const f32x4 z = {0.f, 0.f, 0.f, 0.f};
          { const int mt = wg >> 1, nt = wg & 1; const f32x4 c = mm_tile<1>(L + O_TM, TS_, 16 * mt, L + O_NRBT, TS_, 16 * nt, z, qi, g); *(LAS v2u*)(L + O_X1T + (16 * nt + qi) * TS_ + (16 * mt + 4 * g) * 2) = pack4(c); }
#pragma unroll
          for (int q = 0; q < 2; ++q) { const int tix = wg * 2 + q, mt = tix >> 2, nt = tix & 3; const f32x4 c = mm_tile_yt<1>(L + O_TM, TS_, 16 * mt, L + O_BT, RS, 16 * nt, z, qi, g);
              *(LAS v2u*)(L + O_X2T + (16 * nt + qi) * TS_ + (16 * mt + 4 * g) * 2) = pack4(c); } }
        CP_BAR();
        asm volatile("" : "+v"(pre_r), "+v"(pre_k), "+v"(pre_a), "+v"(pre_v), "+v"(pre_l));
        { const size_t cid = (size_t)ck * (NBATCH * NH) + bh;
          { const int nt = wg & 1, t = 16 * nt + qi; v2u pk[2];
#pragma unroll
            for (int q = 0; q < 2; ++q) { const int mt = 2 * (wg >> 1) + q; const v2u rw = *(const LAS v2u*)(L + O_RT + t * RS + (16 * mt + 4 * g) * 2);
              f32x4 c = {bflo(rw.x), bfhi(rw.x), bflo(rw.y), bfhi(rw.y)}; c = mm_tile_xt<1>(L + O_AT, RS, 16 * mt, L + O_X1T, TS_, 16 * nt, c, qi, g); pk[q] = pack4(c); }
            v4u w4; w4.x = pk[0].x; w4.y = pk[0].y; w4.z = pk[1].x; w4.w = pk[1].y; *(v4u*)(QTg + (cid * SC + t) * 64 + 32 * (wg >> 1) + 8 * g) = w4; }
          { const int mt = wg >> 1, nt = wg & 1, n = 16 * nt + qi, m0 = 16 * mt + 4 * g; f32x4 c = mm_tile<2>(L + O_KT, RS, 16 * mt, L + O_RT, RS, 16 * nt, (f32x4){0.f, 0.f, 0.f, 0.f}, qi, g);
#pragma unroll
            for (int r = 0; r < 4; ++r) c[r] = (m0 + r <= n) ? c[r] : 0.f;
            c = mm_tile<1>(L + O_NAK, TS_, 16 * mt, L + O_X1T, TS_, 16 * nt, c, qi, g); *(LAS v2u*)(L + O_HT + n * TS_ + m0 * 2) = pack4(c); }
#pragma unroll
          for (int q2 = 0; q2 < 2; ++q2) { const int nt = 2 * (wg >> 1) + q2, k = 16 * nt + qi; const float wc = *(const LAS float*)(L + O_WC + k * 4); v2u pk[2];
#pragma unroll
              for (int q = 0; q < 2; ++q) { const int mt = 2 * (wg & 1) + q, m0 = 16 * mt + 4 * g; f32x4 c = mm_tile_xt<1>(L + O_AT, RS, 16 * mt, L + O_X2T, TS_, 16 * nt, (f32x4){0.f, 0.f, 0.f, 0.f}, qi, g);
#pragma unroll
                  for (int r = 0; r < 4; ++r) c[r] = (c[r] + ((m0 + r == k) ? 1.0f : 0.0f)) * wc;
                  pk[q] = pack4(c); }
              v4u w4; w4.x = pk[0].x; w4.y = pk[0].y; w4.z = pk[1].x; w4.w = pk[1].y; *(v4u*)(PTg + (cid * 64 + k) * 64 + 32 * (wg & 1) + 8 * g) = w4; }
#pragma unroll
          for (int q = 0; q < 2; ++q) { const int tix = wg * 2 + q, mt = tix >> 2, nt = tix & 3, k = 16 * nt + qi, m0 = 16 * mt + 4 * g; f32x4 c;
#pragma unroll
              for (int r = 0; r < 4; ++r) c[r] = bf1(*(const LAS bf16*)(L + O_KT + (m0 + r) * RS + k * 2));
              c = mm_tile<1>(L + O_NAK, TS_, 16 * mt, L + O_X2T, TS_, 16 * nt, c, qi, g); const float wc = *(const LAS float*)(L + O_WC + k * 4);
              *(LAS v2u*)(L + O_GT + k * TS_ + m0 * 2) = pack4(c * wc); } }
        CP_BAR();
#if DRYCUT == 4
        if (dry) continue;
#endif
        { const size_t cid = (size_t)ck * (NBATCH * NH) + bh; const f32x4 z = {0.f, 0.f, 0.f, 0.f};
#pragma unroll
          for (int q = 0; q < 4; ++q) { const int mt = q, nt = wg; const f32x4 c = mm_tile_yt<1>(L + O_GT, TS_, 16 * mt, L + O_VT, RS, 16 * nt, z, qi, g);
              *(v2u*)((bf16*)(F.ws + lt_off(ck, bh)) + (((size_t)nt * 4 + mt) * 64 + lane_i) * 4) = pack4(c); }
#pragma unroll
          for (int q = 0; q < 2; ++q) { const int mt = q, nt = wg; const f32x4 c = mm_tile_yt<1>(L + O_HT, TS_, 16 * mt, L + O_VT, RS, 16 * nt, z, qi, g);
              if (!dry) *(v2u*)((bf16*)(F.ws + WS_YG) + ((cid * 8 + 4 * mt + nt) * 64 + lane_i) * 4) = pack4(c); } }
    }
#undef CP_LOAD
#undef CP_BAR
    __syncthreads();
}
__device__ __forceinline__ void chunk_scan(Frame& F, const bool dry = false) {
    const bf16* PTg = (const bf16*)(F.ws + WS_PT); const bf16* QTg = (const bf16*)(F.ws + WS_QT); const bf16* YLg = (const bf16*)(F.ws + WS_YG); bf16* ys = (bf16*)(F.ws + WS_YS2);
    const int qi = F.lane & 15, g = F.lane >> 4, w = F.wave & 3, ty = w & 1, vy0 = 2 * (w >> 1);
    constexpr int SRS = 144, SBUF = 64 * SRS;
    constexpr int YRS = 68, YBUF = SC * YRS * 4;
    LAS unsigned char* SL = F.lds;
    const int hs = (F.G >= 2 * NBATCH * NH) ? 2 : 1;
    for (int bh = (F.vcu % hs) ? NBATCH * NH : F.vcu / hs; bh < NBATCH * NH; bh += F.G / hs) {
        const int b = bh >> 4, h = bh & 15;
        __syncthreads();
        if (F.wave >= 4) { __syncthreads();
            const int u_ = F.wave - 4, tr_ = 8 * u_ + (F.lane >> 3), vc_ = 8 * (F.lane & 7);
            for (int ck = 0; ck < NCHK; ++ck) { asm volatile("s_barrier" ::: "memory");
                const LAS float* yb_ = (const LAS float*)(SL + 2 * SBUF + (ck & 1) * YBUF) + tr_ * YRS + vc_; const f32x4 a0 = *(const LAS f32x4*)yb_, a1 = *(const LAS f32x4*)(yb_ + 4);
                v4u wv_; wv_.x = cvt_pk_bf16(a0[0], a0[1]); wv_.y = cvt_pk_bf16(a0[2], a0[3]); wv_.z = cvt_pk_bf16(a1[0], a1[1]); wv_.w = cvt_pk_bf16(a1[2], a1[3]);
                bf16* yo_ = ys + ((size_t)b * SEQ + ck * SC + tr_) * D + h * HD + vc_; if (!dry) *(v4u*)yo_ = wv_; }
            continue; }
        unsigned z_ = 0u; asm volatile("" : "+v"(z_));
        for (int i = F.lane; i < 16 * 64 / 8; i += 64) *(LAS v4u*)(SL + (16 * w + (i >> 3)) * SRS + (i & 7) * 16) = (v4u){z_, z_, z_, z_};
        __syncthreads();
        v4u pa0[2], qa0[2], pa1[2], qa1[2], pa2[2], qa2[2], pa3[2], qa3[2]; v2u lt0[4], lt1[4], lt2[4], lt3[4]; v2u yl0[2], yl1[2], yl2[2], yl3[2];
#define CS_LOAD(pa, qa, lt, yl, ck_) do { const size_t cid = (size_t)(ck_) * (NBATCH * NH) + bh; \
        _Pragma("unroll") for (int ks = 0; ks < 2; ++ks) { pa[ks] = *(const v4u*)(PTg + (cid * 64 + 16 * w + qi) * 64 + 32 * ks + 8 * g); qa[ks] = *(const v4u*)(QTg + (cid * SC + 16 * ty + qi) * 64 + 32 * ks + 8 * g); } \
        { const bf16* ltb_ = (const bf16*)(F.ws + lt_off((ck_), bh)); _Pragma("unroll") for (int nt = 0; nt < 4; ++nt) lt[nt] = *(const v2u*)(ltb_ + (((size_t)nt * 4 + w) * 64 + F.lane) * 4); } \
        _Pragma("unroll") for (int i_ = 0; i_ < 2; ++i_) yl[i_] = *(const v2u*)(YLg + ((cid * 8 + 4 * ty + vy0 + i_) * 64 + F.lane) * 4); } while (0)
#define CS_STEP(pa, qa, lt, yl, ck_) do { const LAS unsigned char* Sc = SL + ((ck_) & 1) * SBUF; LAS unsigned char* Sn = SL + (((ck_) + 1) & 1) * SBUF; \
        bf16x8 bfr[4][2]; \
        _Pragma("unroll") for (int nt = 0; nt < 4; ++nt) { _Pragma("unroll") for (int ks = 0; ks < 2; ++ks) bfr[nt][ks] = *(const LAS bf16x8*)(Sc + (16 * nt + qi) * SRS + 64 * ks + 16 * g); } \
        f32x4 y_[2]; \
        _Pragma("unroll") for (int i_ = 0; i_ < 2; ++i_) { y_[i_] = (f32x4){bflo(yl[i_].x), bfhi(yl[i_].x), bflo(yl[i_].y), bfhi(yl[i_].y)}; \
            _Pragma("unroll") for (int ks = 0; ks < 2; ++ks) { const bf16x8 by_ = *(const LAS bf16x8*)(Sc + (16 * (vy0 + i_) + qi) * SRS + 64 * ks + 16 * g);     \
                y_[i_] = __builtin_amdgcn_mfma_f32_16x16x32_bf16(__builtin_bit_cast(bf16x8, qa[ks]), by_, y_[i_], 0, 0, 0); } } \
        _Pragma("unroll") for (int nt = 0; nt < 4; ++nt) { f32x4 sn = {bflo(lt[nt].x), bfhi(lt[nt].x), bflo(lt[nt].y), bfhi(lt[nt].y)}; \
            _Pragma("unroll") for (int ks = 0; ks < 2; ++ks) sn = __builtin_amdgcn_mfma_f32_16x16x32_bf16(__builtin_bit_cast(bf16x8, pa[ks]), bfr[nt][ks], sn, 0, 0, 0); \
            *(LAS v2u*)(Sn + (16 * nt + qi) * SRS + (32 * (w >> 1) + 8 * g + 4 * (w & 1)) * 2) = pack4(sn); }       \
        __builtin_amdgcn_sched_barrier(0); \
        { const int ckn_ = (DRYCUT == 7 && dry) ? ((ck_) & 3) : ((ck_) + 4 < NCHK ? (ck_) + 4 : NCHK - 1); CS_LOAD(pa, qa, lt, yl, ckn_); }        \
        __builtin_amdgcn_sched_barrier(0);              \
        { LAS float* yb_ = (LAS float*)(SL + 2 * SBUF + ((ck_) & 1) * YBUF); \
          _Pragma("unroll") for (int i_ = 0; i_ < 2; ++i_) { _Pragma("unroll") for (int r = 0; r < 4; ++r) yb_[(16 * ty + 4 * g + r) * YRS + 16 * (vy0 + i_) + qi] = y_[i_][r]; } } \
        asm volatile("s_waitcnt lgkmcnt(0)\n\ts_barrier" ::: "memory");        \
        __builtin_amdgcn_sched_barrier(0); } while (0)
        CS_LOAD(pa0, qa0, lt0, yl0, 0); CS_LOAD(pa1, qa1, lt1, yl1, 1); CS_LOAD(pa2, qa2, lt2, yl2, 2); CS_LOAD(pa3, qa3, lt3, yl3, 3);
#pragma unroll 4
        for (int ck = 0; ck < NCHK; ck += 4) { CS_STEP(pa0, qa0, lt0, yl0, ck); CS_STEP(pa1, qa1, lt1, yl1, ck + 1); CS_STEP(pa2, qa2, lt2, yl2, ck + 2); CS_STEP(pa3, qa3, lt3, yl3, ck + 3); }
#undef CS_STEP
#undef CS_LOAD
    }
    __syncthreads();
}
__device__ __forceinline__ void post_phase(Frame& F, const bf16* vbuf, const float* k_a, const float* r_k, const float* gn_g, const float* gn_b) {
    const bf16* rb = (const bf16*)(F.ws + WS_R); const bf16* kb = (const bf16*)(F.ws + WS_KK); const bf16* ab = (const bf16*)(F.ws + WS_A); const bf16* gb = (const bf16*)(F.ws + WS_G);
    const bf16* ys = (const bf16*)(F.ws + WS_YS2); bf16* yg = (bf16*)(F.ws + WS_YG);
    f32x4 kav[2][2], rkv[2][2], gg[2][2], gbv[2][2];
#pragma unroll
    for (int jh = 0; jh < 2; ++jh)
#pragma unroll
        for (int q = 0; q < 2; ++q) { const int cc = 512 * jh + 8 * F.lane + 4 * q; kav[jh][q] = *(const f32x4*)(k_a + cc); rkv[jh][q] = *(const f32x4*)(r_k + cc); gg[jh][q] = *(const f32x4*)(gn_g + cc); gbv[jh][q] = *(const f32x4*)(gn_b + cc); }
    for (int row = F.gw; row < T; row += F.NGW) {
        v4u yw_[2]; v4u wr_[2], wk[2], wa[2], wv[2], wg[2];
#pragma unroll
        for (int jh = 0; jh < 2; ++jh) { const size_t o = (size_t)row * D + 512 * jh + 8 * F.lane;
            yw_[jh] = *(const v4u*)(ys + o); wr_[jh] = *(const v4u*)(rb + o); wk[jh] = *(const v4u*)(kb + o); wa[jh] = *(const v4u*)(ab + o); wv[jh] = *(const v4u*)(vbuf + o); wg[jh] = *(const v4u*)(gb + o); }
#pragma unroll
        for (int jh = 0; jh < 2; ++jh) { const size_t o = (size_t)row * D + 512 * jh + 8 * F.lane; v4u w;
            const f32x4 y0 = {bflo(yw_[jh].x), bfhi(yw_[jh].x), bflo(yw_[jh].y), bfhi(yw_[jh].y)}, y1 = {bflo(yw_[jh].z), bfhi(yw_[jh].z), bflo(yw_[jh].w), bfhi(yw_[jh].w)};
            const float mean = reduce8(((y0[0] + y0[1]) + (y0[2] + y0[3])) + ((y1[0] + y1[1]) + (y1[2] + y1[3]))) * (1.0f / HD); const f32x4 dy0 = y0 - mean, dy1 = y1 - mean;
            const float var = reduce8(((dy0[0] * dy0[0] + dy0[1] * dy0[1]) + (dy0[2] * dy0[2] + dy0[3] * dy0[3])) + ((dy1[0] * dy1[0] + dy1[1] * dy1[1]) + (dy1[2] * dy1[2] + dy1[3] * dy1[3]))) * (1.0f / HD);
            const float rstd = 1.0f / sqrtf(var + GN_EPS);
            f32x4 pr[2], v4[2], g4[2];
#pragma unroll
            for (int q = 0; q < 2; ++q) { const unsigned r0 = q ? wr_[jh].z : wr_[jh].x, r1 = q ? wr_[jh].w : wr_[jh].y, k0 = q ? wk[jh].z : wk[jh].x, k1 = q ? wk[jh].w : wk[jh].y, a0 = q ? wa[jh].z : wa[jh].x, a1 = q ? wa[jh].w : wa[jh].y;
                const unsigned v0 = q ? wv[jh].z : wv[jh].x, v1 = q ? wv[jh].w : wv[jh].y, g0 = q ? wg[jh].z : wg[jh].x, g1 = q ? wg[jh].w : wg[jh].y;
                const f32x4 r4 = {bflo(r0), bfhi(r0), bflo(r1), bfhi(r1)}, k4 = {bflo(k0), bfhi(k0), bflo(k1), bfhi(k1)}, a4 = {bflo(a0), bfhi(a0), bflo(a1), bfhi(a1)};
                v4[q] = (f32x4){bflo(v0), bfhi(v0), bflo(v1), bfhi(v1)}; g4[q] = (f32x4){bflo(g0), bfhi(g0), bflo(g1), bfhi(g1)};
                const f32x4 kh = k4 * (1.0f + (a4 - 1.0f) * kav[jh][q]); pr[q] = r4 * kh * rkv[jh][q]; }
            const float rk = reduce8(((pr[0][0] + pr[0][1]) + (pr[0][2] + pr[0][3])) + ((pr[1][0] + pr[1][1]) + (pr[1][2] + pr[1][3])));
            const f32x4 res0 = (dy0 * rstd * gg[jh][0] + gbv[jh][0] + v4[0] * rk) * g4[0], res1 = (dy1 * rstd * gg[jh][1] + gbv[jh][1] + v4[1] * rk) * g4[1];
            w.x = cvt_pk_bf16(res0[0], res0[1]); w.y = cvt_pk_bf16(res0[2], res0[3]); w.z = cvt_pk_bf16(res1[0], res1[1]); w.w = cvt_pk_bf16(res1[2], res1[3]); *(v4u*)(yg + o) = w; }
    }
}

__global__ void __launch_bounds__(NTHREADS, 2) fwd_kernel(Args args) {
    extern __shared__ __attribute__((aligned(16))) unsigned char lds_raw[];
    Frame F;
    F.lds = (LAS unsigned char*)lds_raw; F.ws = args.ws; F.out = args.out; F.ctl = (gu32*)(args.ws + WS_CTL);
    F.tid = 0; F.lane = 0; F.wave = __builtin_amdgcn_readfirstlane((int)threadIdx.x >> 6);
    F.G = gridDim.x; { const int bx = blockIdx.x; F.vcu = (F.G % 8 == 0) ? (bx % 8) * (F.G / 8) + bx / 8 : bx; }
    F.gw = F.vcu * NWAVES + F.wave; F.NGW = F.G * NWAVES;
    for (int i = threadIdx.x; i < (LDS_BYTES - MISC_OFF) / 4; i += NTHREADS) ((LAS unsigned*)(F.lds + MISC_OFF))[i] = 0u;
    __syncthreads();
    XcdBarrier bar = xcd_barrier_post((unsigned*)(F.ctl + CW_BAR), (volatile LAS unsigned*)(F.lds + MISC_OFF) + 8);
#if TIMING
    unsigned long long t_last = __builtin_amdgcn_s_memrealtime(), t_acc = 0; int t_class = 3, t_idx = 0;
#define GRID_BAR() do { xcd_barrier(bar); const unsigned long long now_ = __builtin_amdgcn_s_memrealtime(); if (t_class == TIMED_CLASS && ((TIMED_MASK >> t_idx) & 1)) t_acc += now_ - t_last; t_last = now_; ++t_idx; } while (0)
#define T_CLASS(c) do { t_class = (c); t_idx = 0; } while (0)
#else
#define GRID_BAR() xcd_barrier(bar)
#define T_CLASS(c) do { } while (0)
#endif
    if (threadIdx.x < 35) ((LAS unsigned long long*)(F.lds + PTAB_OFF))[threadIdx.x] = (unsigned long long)args.in[threadIdx.x];
    __syncthreads();
#define IN(k) in_ptr(F, (k))
    unsigned char* ws = args.ws;
    MoeTab MT; MT.cnt = (const LAS int*)(F.lds + TAB_OFF); MT.mtpref = MT.cnt + 65; MT.hoff = MT.mtpref + 66;

#if EN_P0
    { Frame P = phase_frame(F);
    cast_phase(P, IN(0));
    for (int j = 0; j < 2; ++j) {
        convert_plain(P, IN(1) + (size_t)j * D * 3 * D, D, 3 * D, (bf16*)(ws + WS_WQKV) + (size_t)j * 3 * D * D, 0);
        convert_plain(P, IN(2) + (size_t)j * D * D, D, D, (bf16*)(ws + WS_WOA) + (size_t)j * D * D, 0);
        for (int s = 0; s < 3; ++s) convert_plain(P, IN(5) + ((size_t)j * 3 + s) * D * D, D, D, (bf16*)(ws + WS_WRKV) + (size_t)j * 3 * D * D, s * D);
        convert_plain(P, IN(22) + (size_t)j * D * D, D, D, (bf16*)(ws + WS_WOB) + (size_t)j * D * D, 0);
        bf16* L1 = (bf16*)(ws + WS_L1) + (size_t)j * 4 * 256 * D; bf16* L2 = (bf16*)(ws + WS_L2) + (size_t)j * 4 * D * 256;
        { const SmallJob w1{IN(7) + (size_t)j * D * 64, D, 64, L1, 256, D}, a1{IN(10) + (size_t)j * D * 64, D, 64, L1 + 256 * D, 256, D}, g1{IN(15) + (size_t)j * D * 160, D, 160, L1 + 2 * 256 * D, 256, D};
          const SmallJob w2{IN(8) + (size_t)j * 64 * D, 64, D, L2, D, 256}, a2{IN(11) + (size_t)j * 64 * D, 64, D, L2 + D * 256, D, 256}, g2{IN(16) + (size_t)j * 160 * D, 160, D, L2 + 2 * D * 256, D, 256};
          const SmallJob v1{IN(13), D, 32, L1 + 3 * 256 * D, 256, D}, v2{IN(14), 32, D, L2 + 3 * D * 256, D, 256};
          convert_small4(P, w1, a1, g1, w2);
          if (j == 1) convert_small4(P, a2, g2, v1, v2); else { convert_small(P, a2.W, a2.K, a2.N, a2.WT, a2.Np, a2.Kp); convert_small(P, g2.W, g2.K, g2.N, g2.WT, g2.Np, g2.Kp); } }
    }
    { const SmallJob r0{IN(23), D, NE, (bf16*)(ws + WS_WR), 256, D}, r1{IN(23) + (size_t)1 * D * NE, D, NE, (bf16*)(ws + WS_WR) + (size_t)1 * 256 * D, 256, D};
      const SmallJob r2{IN(23) + (size_t)2 * D * NE, D, NE, (bf16*)(ws + WS_WR) + (size_t)2 * 256 * D, 256, D}, r3{IN(23) + (size_t)3 * D * NE, D, NE, (bf16*)(ws + WS_WR) + (size_t)3 * 256 * D, 256, D};
      convert_small4(P, r0, r1, r2, r3); }
    }
#endif
    GRID_BAR();

#define PH_BEGIN { Frame P = phase_frame(F);
#define PH_END } GRID_BAR();
    for (int i = 0; i < DEPTH; ++i) {
        const int j = i >> 1;
        if ((i & 1) == 0) { T_CLASS(0);
            PH_BEGIN
#if EN_QKV
              SchedDense S{T / 256, 12, P.G, (int)blockIdx.x, D, (const char*)(ws + WS_XB), (const char*)(ws + WS_WQKV) + (size_t)j * 3 * D * D * 2};
              EpiQKV E{(bf16*)(ws + WS_Q), (bf16*)(ws + WS_K), (bf16*)(ws + WS_VT)};
              _Pragma("nounroll") for (int rep = 0; rep < REP_QKV; ++rep) pg8::gemm_phase<D>(P.lds, P.tid, S, E);
#endif
            PH_END
            PH_BEGIN
#if EN_KMEAN
            kmean_phase(P);
#endif
            PH_END
            PH_BEGIN
#if EN_SEL
            sel_phase(P);
#endif
            PH_END
#if REP_ATTN > 1
            PH_BEGIN
            attn_phase<ATTN_PROBE>(P, IN(3));
            PH_END
#endif
            PH_BEGIN
#if EN_ATTN
            attn_phase<0>(P, IN(3));
#endif
            PH_END
            PH_BEGIN
#if EN_OPA
              SchedDense S{T / 256, 4, P.G, (int)blockIdx.x, D, (const char*)(ws + WS_O), (const char*)(ws + WS_WOA) + (size_t)j * D * D * 2};
              EpiAdd E{(bf16*)P.out, (const bf16*)(ws + WS_XB)};
              pg8::gemm_phase<D>(P.lds, P.tid, S, E);
#endif
            PH_END
        } else {
            T_CLASS(1);
            const size_t voff = (j == 0 ? WS_VF : WS_V);
            PH_BEGIN
#if EN_MIX
            for (int rep = 0; rep < REP_MIX; ++rep) mix_phase(P, IN(4) + (size_t)j * 6 * D);
#endif
            PH_END
            PH_BEGIN
#if EN_RKV
              SchedRkv S{T / 256, j == 0 ? 15 : 16, P.G, (int)blockIdx.x, (const char*)(ws + WS_XMIX), (const char*)(ws + WS_WRKV) + (size_t)j * 3 * D * D * 2, (const char*)(ws + WS_L1) + (size_t)j * 4 * 256 * D * 2};
              EpiRkv E{ws, voff};
              pg8::gemm_phase<D>(P.lds, P.tid, S, E);
#endif
            PH_END
            PH_BEGIN
#if EN_L2
              SchedL2 S{T / 256, j == 0 ? 12 : 16, P.G, (int)blockIdx.x, (const char*)(ws + WS_HL), (const char*)(ws + WS_L2) + (size_t)j * 4 * D * 256 * 2};
              EpiL2 E{(bf16*)(ws + WS_LW), (bf16*)(ws + WS_A), (bf16*)(ws + WS_G), (bf16*)(ws + voff), (const bf16*)(ws + WS_VF), IN(6) + j * D, IN(9) + j * D, IN(12)};
              pg8::gemm_phase<256>(P.lds, P.tid, S, E);
#endif
            PH_END
            PH_BEGIN
#if EN_SCAN
            for (int rep = 0; rep < REP_SCAN; ++rep) chunk_prep(P, (const bf16*)(ws + voff), IN(17) + j * D, IN(18) + j * D, rep + 1 < REP_SCAN);
#endif
            PH_END
            PH_BEGIN
#if EN_SCANB
            _Pragma("nounroll") for (int rep = 0; rep < REP_SCANB; ++rep) chunk_scan(P, rep + 1 < REP_SCANB);
#endif
            PH_END
            PH_BEGIN
#if EN_POST
#ifdef DBG_POST_COPY
            { const v4u* s_ = (const v4u*)(ws + WS_A); v4u* d_ = (v4u*)(ws + WS_YG); for (size_t q = (size_t)P.gw * 64 + P.lane; q < (size_t)T * D / 8; q += (size_t)P.NGW * 64) d_[q] = s_[q]; }
#else
            post_phase(P, (const bf16*)(ws + voff), IN(18) + j * D, IN(19) + j * D, IN(20) + j * D, IN(21) + j * D);
#endif
#endif
            PH_END
            PH_BEGIN
#if EN_OPB
              SchedDense S{T / 256, 4, P.G, (int)blockIdx.x, D, (const char*)(ws + WS_YG), (const char*)(ws + WS_WOB) + (size_t)j * D * D * 2};
              EpiAdd E{(bf16*)P.out, (const bf16*)(ws + WS_XB)};
              pg8::gemm_phase<D>(P.lds, P.tid, S, E);
#endif
            PH_END
        }
        T_CLASS(2);
        PH_BEGIN
#if EN_LN1
        ln1_route_phase(P, IN(31) + i * D, IN(32) + i * D, i, IN(24) + i * NE);
#endif
#if EN_CVT
        for (int rep = 0; rep < REP_CVT; ++rep) convert_moe(P, IN(25) + (size_t)i * NE * D * DE, IN(26) + (size_t)i * NE * D * DE, IN(27) + (size_t)i * NE * DE * D, IN(28) + (size_t)i * D * DE, IN(29) + (size_t)i * D * DE, IN(30) + (size_t)i * DE * D);
#endif
        PH_END
        PH_BEGIN
        moe_tables(P, i);
#if EN_G1
          SchedMoe1 S{P.G, P.vcu, MT, (const char*)(ws + WS_XB), (const char*)(ws + WS_WGU), (const int*)(ws + WS_TOKLIST), 0};
          _Pragma("nounroll") for (int rep = 0; rep < REP_G1; ++rep) { S.eh = 0; EpiSwiglu E{(bf16*)(ws + WS_H), rep + 1 < REP_G1}; pg8::gemm_phase<D>(P.lds, P.tid, S, E); }
#endif
        PH_END
        PH_BEGIN
#if EN_G2
          SchedMoe2 S{P.G, P.vcu, MT, (const char*)(ws + WS_H), (const char*)(ws + WS_WD), 0};
          if (G2_STAGGER > 0 && (P.vcu & 1)) { const unsigned long long t0_ = __builtin_amdgcn_s_memrealtime(); while (__builtin_amdgcn_s_memrealtime() - t0_ < (unsigned long long)G2_STAGGER) __builtin_amdgcn_s_sleep(8); }
          _Pragma("nounroll") for (int rep = 0; rep < REP_G2; ++rep) { S.eh = 0; EpiMoeDown E{ws, rep + 1 < REP_G2, (LAS float*)(P.lds + MISC_OFF + 4096)}; pg8::gemm_phase<DE>(P.lds, P.tid, S, E); }
#endif
        PH_END
        { Frame P = phase_frame(F);
#if EN_LN2
        ln2_phase(P, IN(33) + i * D, IN(34) + i * D, i == DEPTH - 1, MT);
#endif
        }
        if (i + 1 < DEPTH) GRID_BAR();
#if TIMING
        else { const unsigned long long now_ = __builtin_amdgcn_s_memrealtime(); if (t_class == TIMED_CLASS && ((TIMED_MASK >> t_idx) & 1)) t_acc += now_ - t_last; t_last = now_; }
#endif
    }
#if TIMING
    if (blockIdx.x == 0) { const unsigned long long t0_ = __builtin_amdgcn_s_memrealtime(); while (__builtin_amdgcn_s_memrealtime() - t0_ < (unsigned long long)TIMED_MULT * t_acc) __builtin_amdgcn_s_sleep(16); }
#endif
#undef IN
#undef GRID_BAR
}

extern "C" void kernel_launch(void* const* d_in, const int* in_sizes, int n_in, void* d_out, int out_size, void* d_ws, size_t ws_size, hipStream_t stream) {
    static int grid = 0;
    if (grid == 0) {
        if (n_in != 35 || out_size != T * D || ws_size < WS_END) { fprintf(stderr, "kernel_launch: unexpected shapes (n_in %d, out %d, ws %zu)\n", n_in, out_size, ws_size); grid = -1; return; }
        int dev = 0, cus = 0, per_cu = 0;
        if (hipGetDevice(&dev) != hipSuccess || hipDeviceGetAttribute(&cus, hipDeviceAttributeMultiprocessorCount, dev) != hipSuccess) { grid = -1; return; }
        if (hipFuncSetAttribute((const void*)fwd_kernel, hipFuncAttributeMaxDynamicSharedMemorySize, LDS_BYTES) != hipSuccess) { fprintf(stderr, "kernel_launch: hipFuncSetAttribute failed\n"); grid = -1; return; }
        if (hipOccupancyMaxActiveBlocksPerMultiprocessor(&per_cu, (const void*)fwd_kernel, NTHREADS, LDS_BYTES) != hipSuccess || per_cu < 1) { fprintf(stderr, "kernel_launch: occupancy query says %d\n", per_cu); }
        (void)hipGetLastError();
        grid = cus;
    }
    if (grid < 0) return;
    if (hipMemsetAsync((char*)d_ws + WS_CTL, 0, CTL_ZERO_BYTES, stream) != hipSuccess) return;
    Args a{};
    for (int i = 0; i < 35; ++i) a.in[i] = (const float*)d_in[i];
    a.out = (float*)d_out; a.ws = (unsigned char*)d_ws;
    hipLaunchKernelGGL(fwd_kernel, dim3(grid), dim3(NTHREADS), LDS_BYTES, stream, a);
}
```

```cpp
#include <hip/hip_runtime.h>
#include <cstdio>
#include <cstdint>

#define GAS __attribute__((address_space(1)))
#define LAS __attribute__((address_space(3)))
typedef unsigned short bf16;
typedef unsigned v4u __attribute__((ext_vector_type(4)));
typedef unsigned v2u __attribute__((ext_vector_type(2)));
typedef float f32x4 __attribute__((ext_vector_type(4)));
typedef float f32x2 __attribute__((ext_vector_type(2)));
typedef short bf16x8 __attribute__((ext_vector_type(8)));
typedef short bf16x4 __attribute__((ext_vector_type(4)));

#ifndef EN_DEFAULT
#define EN_DEFAULT 1
#endif
#ifndef REP_SCAN
#define REP_SCAN 1
#endif
#ifndef EN_SCANB
#define EN_SCANB EN_DEFAULT
#endif
#ifndef DRYCUT
#define DRYCUT 0
#endif
#ifndef REP_SCANB
#define REP_SCANB 1
#endif
#ifndef REP_ATTN
#define REP_ATTN 1
#endif
#ifndef G2_STAGGER
#define G2_STAGGER 0
#endif
#ifndef TIMING
#define TIMING 0
#endif
#ifndef TIMED_CLASS
#define TIMED_CLASS 2
#endif
#ifndef TIMED_MASK
#define TIMED_MASK 1
#endif
#ifndef TIMED_MULT
#define TIMED_MULT 16
#endif
#ifndef ATTN_PROBE
#define ATTN_PROBE 1
#endif
#ifndef REP_G1
#define REP_G1 1
#endif
#ifndef REP_G2
#define REP_G2 1
#endif
#ifndef REP_CVT
#define REP_CVT 1
#endif
#ifndef REP_MIX
#define REP_MIX 1
#endif
#ifndef REP_QKV
#define REP_QKV 1
#endif
#ifndef EN_P0
#define EN_P0 EN_DEFAULT
#endif
#ifndef EN_QKV
#define EN_QKV EN_DEFAULT
#endif
#ifndef EN_KMEAN
#define EN_KMEAN EN_DEFAULT
#endif
#ifndef EN_SEL
#define EN_SEL EN_DEFAULT
#endif
#ifndef EN_ATTN
#define EN_ATTN EN_DEFAULT
#endif
#ifndef EN_OPA
#define EN_OPA EN_DEFAULT
#endif
#ifndef EN_MIX
#define EN_MIX EN_DEFAULT
#endif
#ifndef EN_RKV
#define EN_RKV EN_DEFAULT
#endif
#ifndef EN_L2
#define EN_L2 EN_DEFAULT
#endif
#ifndef EN_SCAN
#define EN_SCAN EN_DEFAULT
#endif
#ifndef EN_POST
#define EN_POST EN_DEFAULT
#endif
#ifndef EN_OPB
#define EN_OPB EN_DEFAULT
#endif
#ifndef EN_LN1
#define EN_LN1 EN_DEFAULT
#endif
#ifndef EN_CVT
#define EN_CVT EN_DEFAULT
#endif
#ifndef EN_ROUTER
#define EN_ROUTER EN_DEFAULT
#endif
#ifndef EN_ROUTE
#define EN_ROUTE EN_DEFAULT
#endif
#ifndef EN_G1
#define EN_G1 EN_DEFAULT
#endif
#ifndef EN_G2
#define EN_G2 EN_DEFAULT
#endif
#ifndef EN_LN2
#define EN_LN2 EN_DEFAULT
#endif
constexpr int D = 1024, NBATCH = 8, SEQ = 4096, T = NBATCH * SEQ, NH = 16, HD = 64, DEPTH = 4;
constexpr int NE = 64, TOPK = 8, DE = 256, NEX = NE + 1;
constexpr int MBLK = 256, NMB = SEQ / MBLK;
constexpr float ALPHA = 1.6817928305074290f;
constexpr float LN_EPS = 1e-5f, GN_EPS = 64e-5f;
constexpr int NWAVES = 8, NTHREADS = 512;

constexpr size_t MiB = 1u << 20;
constexpr size_t WS_CTL = 0, CTL_ZERO_BYTES = 1 * MiB;
constexpr size_t WS_WR = 1 * MiB;
constexpr size_t WS_KMEAN = 3 * MiB;
constexpr size_t WS_MASK = 4 * MiB;
constexpr size_t WS_TSEL = 5 * MiB;
constexpr size_t WS_WQKV = 8 * MiB;
constexpr size_t WS_WOA = 20 * MiB;
constexpr size_t WS_WRKV = 24 * MiB;
constexpr size_t WS_WOB = 36 * MiB;
constexpr size_t WS_L1 = 40 * MiB;
constexpr size_t WS_L2 = 44 * MiB;
constexpr size_t WS_WGU = 48 * MiB;
constexpr size_t WS_WD = 113 * MiB;
constexpr size_t WS_XB = 146 * MiB;
constexpr size_t WS_VF = 210 * MiB;
constexpr size_t WS_S = 274 * MiB;
constexpr size_t WS_LOGITS = WS_S;
constexpr size_t WS_TOKLIST = WS_S + 8 * MiB;
constexpr size_t WS_H = WS_S + 16 * MiB;
constexpr size_t WS_Y = WS_S + 168 * MiB;
constexpr size_t WS_Q = WS_S, WS_K = WS_S + 64 * MiB, WS_VT = WS_S + 128 * MiB, WS_O = WS_S + 192 * MiB;
constexpr size_t WS_XMIX = WS_S;
constexpr size_t WS_R = WS_S + 384 * MiB, WS_KK = WS_S + 448 * MiB, WS_V = WS_S + 512 * MiB;
constexpr size_t WS_HL = WS_S + 576 * MiB;
constexpr size_t WS_LW = WS_S + 64 * MiB;
constexpr size_t WS_A = WS_S + 128 * MiB, WS_G = WS_S + 192 * MiB;
constexpr size_t WS_YS = WS_S + 256 * MiB;
constexpr size_t WS_YG = WS_S + 640 * MiB;
constexpr size_t WS_END = 1024 * MiB;
static_assert(WS_Y + (size_t)278528 * 2048 <= WS_END && WS_YG + 64 * MiB <= WS_END, "d_ws map");

constexpr int CW_TMO = 0;
constexpr int CW_BAR = 4096;
constexpr int CW_CNT = 8192;

constexpr int RING_BYTES = 131072;
constexpr int MISC_OFF = RING_BYTES;
constexpr int TAB_OFF = MISC_OFF + 256;
constexpr int PTAB_OFF = MISC_OFF + 2048;
constexpr int LDS_BYTES = 147456;

#define RLX_AGENT __ATOMIC_RELAXED, __HIP_MEMORY_SCOPE_AGENT
#define LDS_WAIT() asm volatile("s_waitcnt lgkmcnt(0)" ::: "memory")
#define VM_WAIT() asm volatile("s_waitcnt vmcnt(0)" ::: "memory")
typedef float f32x2_t_ __attribute__((ext_vector_type(2))); typedef __bf16 bf16x2_t_ __attribute__((ext_vector_type(2)));
__device__ __forceinline__ unsigned cvt_pk_bf16(float lo, float hi) { const f32x2_t_ v = {lo, hi}; const bf16x2_t_ b = __builtin_convertvector(v, bf16x2_t_); return __builtin_bit_cast(unsigned, b); }
__device__ __forceinline__ void st_wt(void* p, v4u v) { asm volatile("s_nop 4\n\tglobal_store_dwordx4 %0, %1, off sc1\n\ts_nop 1" :: "v"(p), "v"(v) : "memory"); }
__device__ __forceinline__ void st_wt(void* p, f32x4 v) { asm volatile("s_nop 4\n\tglobal_store_dwordx4 %0, %1, off sc1\n\ts_nop 1" :: "v"(p), "v"(v) : "memory"); }
__device__ __forceinline__ void st_wt(void* p, v2u v) { asm volatile("s_nop 4\n\tglobal_store_dwordx2 %0, %1, off sc1\n\ts_nop 0" :: "v"(p), "v"(v) : "memory"); }
__device__ __forceinline__ float bflo(unsigned w) { return __uint_as_float(w << 16); }
__device__ __forceinline__ float bfhi(unsigned w) { return __uint_as_float(w & 0xffff0000u); }
__device__ __forceinline__ float bf1(bf16 b) { return __uint_as_float(((unsigned)b) << 16); }
__device__ __forceinline__ float fast_exp(float x) { return __builtin_amdgcn_exp2f(x * 1.4426950408889634f); }
__device__ __forceinline__ float fast_rcp(float x) { return __builtin_amdgcn_rcpf(x); }
__device__ __forceinline__ float sigmoidf_(float x) { return fast_rcp(1.0f + fast_exp(-x)); }
template <int CTRL> __device__ __forceinline__ float dpp_add(float v) {
    const int t = __builtin_amdgcn_update_dpp(0, __float_as_int(v), CTRL, 0xf, 0xf, true);
    return v + __int_as_float(t);
}
template <int CTRL> __device__ __forceinline__ float dpp_max(float v) {
    const int t = __builtin_amdgcn_update_dpp(__float_as_int(v), __float_as_int(v), CTRL, 0xf, 0xf, false);
    return __builtin_fmaxf(v, __int_as_float(t));
}
__device__ __forceinline__ float reduce16(float v) {
    v = dpp_add<0xB1>(v); v = dpp_add<0x4E>(v); v = dpp_add<0x141>(v); v = dpp_add<0x140>(v);
    return v;
}
__device__ __forceinline__ float max8(float v) { v = dpp_max<0xB1>(v); v = dpp_max<0x4E>(v); v = dpp_max<0x141>(v); return v; }
__device__ __forceinline__ float q4_max(float v) {
    auto a = __builtin_amdgcn_permlane16_swap(__float_as_uint(v), __float_as_uint(v), false, false); v = __builtin_fmaxf(__uint_as_float(a[0]), __uint_as_float(a[1]));
    auto b = __builtin_amdgcn_permlane32_swap(__float_as_uint(v), __float_as_uint(v), false, false); return __builtin_fmaxf(__uint_as_float(b[0]), __uint_as_float(b[1])); }
__device__ __forceinline__ float q4_sum(float v) {
    auto a = __builtin_amdgcn_permlane16_swap(__float_as_uint(v), __float_as_uint(v), false, false); v = __uint_as_float(a[0]) + __uint_as_float(a[1]);
    auto b = __builtin_amdgcn_permlane32_swap(__float_as_uint(v), __float_as_uint(v), false, false); return __uint_as_float(b[0]) + __uint_as_float(b[1]); }
__device__ __forceinline__ float wave_sum(float v) { return q4_sum(reduce16(v)); }
__device__ __forceinline__ float wave_max(float v) { return q4_max(dpp_max<0x140>(max8(v))); }
__device__ const unsigned char T5_BUCKET[129] = {
    0, 1, 2, 3, 4, 5, 6, 7, 8, 9, 10, 11, 12, 13, 14, 15, 16, 16, 16, 17, 17, 18, 18, 18, 19, 19, 19, 20, 20, 20, 20, 21, 21, 21, 21, 22, 22, 22, 22, 22, 23, 23, 23, 23, 23, 23, 24, 24, 24,
    24, 24, 24, 25, 25, 25, 25, 25, 25, 25, 26, 26, 26, 26, 26, 26, 26, 26, 27, 27, 27, 27, 27, 27, 27, 27, 27, 27, 28, 28, 28, 28, 28, 28, 28, 28, 28, 28, 29, 29, 29, 29, 29, 29, 29, 29, 29, 29,
    29, 29, 30, 30, 30, 30, 30, 30, 30, 30, 30, 30, 30, 30, 30, 30, 31, 31, 31, 31, 31, 31, 31, 31, 31, 31, 31, 31, 31, 31, 31, 31};

namespace pg8 {
constexpr int BM = 256, BK = 64, HALF = 128, HTB = HALF * BK * 2, STAGE_BYTES = 8 * HTB, NXCD = 8, WGM = 8;
__host__ __device__ __forceinline__ int lds_byte(int r, int c) { const int st = (r >> 4) * 2 + (c >> 5), rr = r & 15, cc = c & 31, ob = rr * 64 + cc * 2; return st * 1024 + (ob ^ (((ob >> 9) & 1) << 5)); }
__host__ __device__ __forceinline__ void stage_rc(int b, int& R, int& C) { const int st = b / 1024, sb = b % 1024, swz = sb ^ (((sb >> 9) & 1) << 5); R = (st >> 1) * 16 + swz / 64; C = (st & 1) * 32 + (swz % 64) / 2; }
__host__ __device__ __forceinline__ int perm32(int rho) { const int n = rho >> 4, i = rho & 15; return 8 * (i >> 2) + 4 * n + (i & 3); }

struct Unit { int pm, pn, e, nvalid, arow0, orow0; const int* gidx; };

__device__ __forceinline__ bool static_tile(int i, int G, int c, int nM, int nN, int& pm, int& pn) {
    const int nwg = nM * nN; const long L = (long)i * G + c; if (L >= nwg) return false;
    int wgid = (int)L;
    if (((nwg | nM) & 7) == 0) {
        wgid = (wgid & 7) * (nwg >> 3) + (wgid >> 3); const int nig = WGM * nN, gid = wgid / nig, r = wgid - gid * nig; pm = gid * WGM + (r & 7); pn = r >> 3; return true; }
    { const int q = nwg / NXCD, r = nwg % NXCD, xcd = wgid % NXCD, off = wgid / NXCD; wgid = (xcd < r ? xcd * (q + 1) : r * (q + 1) + (xcd - r) * q) + off; }
    const int nig = WGM * nN, gid = wgid / nig, fm = gid * WGM, gsz = (nM - fm) < WGM ? (nM - fm) : WGM;
    pm = fm + ((wgid % nig) % gsz); pn = (wgid % nig) / gsz; return true;
}

template <int K, class Epi, class Sched>
__device__ __forceinline__ void gemm_phase(LAS unsigned char* lds, const int tid, const Sched& S, const Epi& E) {
    constexpr bool GA = Sched::GATHER;
    const int wid = __builtin_amdgcn_readfirstlane(tid >> 6), lane = tid & 63, wr = wid >> 2, wc = wid & 3, fr = lane & 15, fq = lane >> 4;
    constexpr int nt = K / BK;
    unsigned voffA[2], voffB[2];
#pragma unroll
    for (int i = 0; i < 2; ++i) { int R, C; stage_rc(tid * 16 + i * 8192, R, C); const int Rb = ((int)Epi::PERM == 2) ? (64 * (R >> 5) + 16 * ((R & 15) >> 2) + 4 * ((R >> 4) & 1) + (R & 3)) : (Epi::PERM ? ((R & ~31) + perm32(R & 31)) : R);
        voffA[i] = (unsigned)(R * K + C) * 2u; voffB[i] = (unsigned)(Rb * K + C) * 2u; }
    const size_t kstep = (size_t)(BK * 2);
    const size_t hstep = (size_t)HALF * K * 2;
    const size_t bhstep = ((int)Epi::PERM == 2) ? (size_t)8 * K * 2 : hstep;
    const unsigned rowb = (unsigned)K * 2u;
    const unsigned ldsw = (unsigned)wid * 1024u;
    const int aoff = lds_byte(wr * 64 + fr, fq * 8), boff = lds_byte(wc * 32 + fr, fq * 8);
#define PG8_SA(b, h) (((b) * 2 + (h)) * HTB)
#define PG8_SB(b, h) ((4 + (b) * 2 + (h)) * HTB)
#define PG8_STAGE(bufoff, gbase, voff) do { _Pragma("unroll") for (int _i = 0; _i < 2; ++_i) \
        __builtin_amdgcn_global_load_lds((const unsigned*)((const char*)(gbase) + (voff)[_i]), (LAS unsigned*)(lds + (bufoff) + ldsw + _i * 8192), 16, 0, 0); } while (0)
#define PG8_STAGE_A(bufoff, p, h, O) do { if constexpr (GA) { PG8_STAGE(bufoff, p, O[h]); } else { PG8_STAGE(bufoff, (p) + (h) * hstep, voffA); } } while (0)
#define PG8_LDA(dst, b, h) do { _Pragma("unroll") for (int m = 0; m < 4; ++m) _Pragma("unroll") for (int k = 0; k < 2; ++k) dst[m][k] = *(const LAS bf16x8*)(lds + PG8_SA(b, h) + aoff + m * 2048 + k * 1024); } while (0)
#define PG8_LDB(dst, b, h) do { _Pragma("unroll") for (int n = 0; n < 2; ++n) _Pragma("unroll") for (int k = 0; k < 2; ++k) dst[n][k] = *(const LAS bf16x8*)(lds + PG8_SB(b, h) + boff + n * 2048 + k * 1024); } while (0)
#define PG8_MMA(ai, bj, At, Bt) do { __builtin_amdgcn_s_setprio(1); _Pragma("unroll") for (int m = 0; m < 4; ++m) _Pragma("unroll") for (int n = 0; n < 2; ++n) _Pragma("unroll") for (int k = 0; k < 2; ++k) \
        acc[ai][bj][m][n] = __builtin_amdgcn_mfma_f32_16x16x32_bf16(Bt[n][k], At[m][k], acc[ai][bj][m][n], 0, 0, 0); __builtin_amdgcn_s_setprio(0); } while (0)
#define PG8_WAIT_V(n) asm volatile("s_waitcnt vmcnt(" #n ")" ::: "memory")
#define PG8_WAIT_L(n) asm volatile("s_waitcnt lgkmcnt(" #n ")" ::: "memory")
#define PG8_BAR __builtin_amdgcn_s_barrier()
#define PG8_SCHED __builtin_amdgcn_sched_barrier(0)
#define PG8_OFFS(u, o) do { if constexpr (GA) { _Pragma("unroll") for (int _h = 0; _h < 2; ++_h) _Pragma("unroll") for (int _i = 0; _i < 2; ++_i) { int R_, C_; stage_rc(tid * 16 + _i * 8192, R_, C_); \
        o[_h][_i] = (unsigned)S.a_row(u, _h * HALF + R_) * rowb + (unsigned)C_ * 2u; } } } while (0)
#define PG8_TRIP(a1, a2, b2, O1, O2) do { const char* a3 = (a2) + kstep; const char* b3 = (b2) + kstep; \
            PG8_LDB(B0, 0, 0); PG8_LDB(B1, 0, 1); PG8_SCHED; PG8_LDA(At, 0, 0); PG8_STAGE_A(PG8_SA(1, 1), a1, 1, O1); \
            PG8_WAIT_V(8); PG8_WAIT_L(0); PG8_BAR; PG8_MMA(0, 0, At, B0); PG8_MMA(0, 1, At, B1); PG8_BAR; PG8_SCHED; \
            PG8_LDA(At, 0, 1); PG8_STAGE(PG8_SB(0, 0), b2, voffB); PG8_STAGE(PG8_SB(0, 1), (b2) + bhstep, voffB); PG8_STAGE_A(PG8_SA(0, 0), a2, 0, O2); \
            PG8_WAIT_V(8); PG8_WAIT_L(0); PG8_BAR; PG8_MMA(1, 0, At, B0); PG8_MMA(1, 1, At, B1); PG8_BAR; PG8_SCHED; \
            PG8_LDB(B0, 1, 0); PG8_LDB(B1, 1, 1); PG8_SCHED; PG8_LDA(At, 1, 0); PG8_STAGE_A(PG8_SA(0, 1), a2, 1, O2); \
            PG8_WAIT_V(8); PG8_WAIT_L(0); PG8_BAR; PG8_MMA(0, 0, At, B0); PG8_MMA(0, 1, At, B1); PG8_BAR; PG8_SCHED; \
            PG8_LDA(At, 1, 1); PG8_STAGE(PG8_SB(1, 0), b3, voffB); PG8_STAGE(PG8_SB(1, 1), b3 + bhstep, voffB); PG8_STAGE_A(PG8_SA(1, 0), a3, 0, O2); \
            PG8_WAIT_V(8); PG8_WAIT_L(0); PG8_BAR; PG8_MMA(1, 0, At, B0); PG8_MMA(1, 1, At, B1); PG8_BAR; PG8_SCHED; } while (0)
    Unit cur, nxt; int ui = 0;
    if (!S.next(0, cur)) return;
    f32x4 acc[2][2][4][2];
#pragma unroll
    for (int a = 0; a < 2; ++a)
#pragma unroll
        for (int b = 0; b < 2; ++b)
#pragma unroll
            for (int m = 0; m < 4; ++m)
#pragma unroll
                for (int n = 0; n < 2; ++n) acc[a][b][m][n] = (f32x4){0.f, 0.f, 0.f, 0.f};
    bf16x8 At[4][2], B0[2][2], B1[2][2];
    unsigned cOff[2][2], nOff[2][2];
    PG8_OFFS(cur, cOff);
    const char* cA = S.a_tile(cur); const char* cB = S.b_tile(cur);
    PG8_STAGE(PG8_SB(0, 0), cB, voffB); PG8_STAGE(PG8_SB(0, 1), cB + bhstep, voffB); PG8_STAGE_A(PG8_SA(0, 0), cA, 0, cOff); PG8_STAGE_A(PG8_SA(0, 1), cA, 1, cOff);
    if (wr == 1) PG8_BAR;
    PG8_WAIT_V(2); PG8_BAR;
    PG8_STAGE(PG8_SB(1, 0), cB + kstep, voffB); PG8_STAGE_A(PG8_SA(1, 0), cA + kstep, 0, cOff); PG8_STAGE(PG8_SB(1, 1), cB + bhstep + kstep, voffB);
    PG8_WAIT_V(6); PG8_BAR;
    for (;;) {
        const bool has_next = S.next(ui + 1, nxt);
        const char* nA = cA; const char* nB = cB;
        if constexpr (GA) {
#pragma unroll
            for (int h = 0; h < 2; ++h)
#pragma unroll
                for (int i = 0; i < 2; ++i) nOff[h][i] = cOff[h][i]; }
        if (has_next) { PG8_OFFS(nxt, nOff); nA = S.a_tile(nxt); nB = S.b_tile(nxt); }
_Pragma("nounroll")
        for (int t = 0; t < nt; t += 2) { const bool last = (t == nt - 2);
            const char* a2 = last ? nA : cA + (size_t)(t + 2) * kstep; const char* b2 = last ? nB : cB + (size_t)(t + 2) * kstep;
            if constexpr (GA) { unsigned o2[2][2];
#pragma unroll
                for (int h = 0; h < 2; ++h)
#pragma unroll
                    for (int i = 0; i < 2; ++i) o2[h][i] = last ? nOff[h][i] : cOff[h][i];
                PG8_TRIP(cA + (size_t)(t + 1) * kstep, a2, b2, cOff, o2);
            } else { PG8_TRIP(cA + (size_t)(t + 1) * kstep, a2, b2, cOff, cOff); } }
        if (wr == 0) PG8_BAR;
        PG8_SCHED; E(acc, cur, wr, wc, fr, fq); PG8_SCHED;
        if (!has_next) break;
#pragma unroll
        for (int a = 0; a < 2; ++a)
#pragma unroll
            for (int b = 0; b < 2; ++b)
#pragma unroll
                for (int m = 0; m < 4; ++m)
#pragma unroll
                    for (int n = 0; n < 2; ++n) acc[a][b][m][n] = (f32x4){0.f, 0.f, 0.f, 0.f};
        cur = nxt; cA = nA; cB = nB; ++ui;
        if constexpr (GA) {
#pragma unroll
            for (int h = 0; h < 2; ++h)
#pragma unroll
                for (int i = 0; i < 2; ++i) cOff[h][i] = nOff[h][i]; }
        if (wr == 1) PG8_BAR;
    }
    PG8_WAIT_V(0);
    PG8_BAR;
#undef PG8_SA
#undef PG8_SB
#undef PG8_STAGE
#undef PG8_STAGE_A
#undef PG8_LDA
#undef PG8_LDB
#undef PG8_MMA
#undef PG8_WAIT_V
#undef PG8_WAIT_L
#undef PG8_BAR
#undef PG8_SCHED
#undef PG8_OFFS
#undef PG8_TRIP
}
}
using pg8::Unit;
typedef f32x4 AccT[2][2][4][2];

struct SchedDense {
    int nM, nN, G, c, K; const char* A; const char* Bt;
    __device__ __forceinline__ bool next(int i, Unit& u) const { int pm, pn; if (!pg8::static_tile(i, G, c, nM, nN, pm, pn)) return false;
        u.pm = pm; u.pn = pn; u.e = 0; u.nvalid = 256; u.arow0 = pm * 256; u.orow0 = pm * 256; u.gidx = nullptr; return true; }
    static constexpr bool GATHER = false;
    __device__ __forceinline__ const char* a_tile(const Unit& u) const { return A + (size_t)u.arow0 * K * 2; }
    __device__ __forceinline__ const char* b_tile(const Unit& u) const { return Bt + (size_t)u.pn * 256 * K * 2; }
    __device__ __forceinline__ int a_row(const Unit& u, int r) const { return u.arow0 + r; }
};
struct SchedRkv {
    int nM, nN, G, c; const char* xmix; const char* Wrkv; const char* L1;
    __device__ __forceinline__ bool next(int i, Unit& u) const { int pm, pn; if (!pg8::static_tile(i, G, c, nM, nN, pm, pn)) return false;
        u.pm = pm; u.pn = pn; u.e = 0; u.nvalid = 256; u.arow0 = pm * 256; u.orow0 = pm * 256; u.gidx = nullptr; return true; }
    static constexpr bool GATHER = false;
    __device__ __forceinline__ const char* a_tile(const Unit& u) const { const int grp = u.pn < 12 ? (u.pn >> 2) : (u.pn == 15 ? 2 : u.pn - 9); return xmix + ((size_t)grp * T + u.arow0) * D * 2; }
    __device__ __forceinline__ const char* b_tile(const Unit& u) const { return u.pn < 12 ? Wrkv + (size_t)u.pn * 256 * D * 2 : L1 + (size_t)(u.pn - 12) * 256 * D * 2; }
    __device__ __forceinline__ int a_row(const Unit& u, int r) const { return u.arow0 + r; }
};
struct SchedL2 {
    int nM, nN, G, c; const char* hl; const char* L2;
    __device__ __forceinline__ bool next(int i, Unit& u) const { int pm, pn; if (!pg8::static_tile(i, G, c, nM, nN, pm, pn)) return false;
        u.pm = pm; u.pn = pn & 3; u.e = pn >> 2; u.nvalid = 256; u.arow0 = pm * 256; u.orow0 = pm * 256; u.gidx = nullptr; return true; }
    static constexpr bool GATHER = false;
    __device__ __forceinline__ const char* a_tile(const Unit& u) const { return hl + ((size_t)u.e * T + u.arow0) * 256 * 2; }
    __device__ __forceinline__ const char* b_tile(const Unit& u) const { return L2 + ((size_t)u.e * 1024 + (size_t)u.pn * 256) * 256 * 2; }
    __device__ __forceinline__ int a_row(const Unit& u, int r) const { return u.arow0 + r; }
};
struct MoeTab { const LAS int* cnt; const LAS int* mtpref; const LAS int* hoff; };
__device__ __forceinline__ int moe_find_expert(const MoeTab& M, int m, int& hint) { int e = hint;
_Pragma("nounroll")
    while (e + 1 < NEX && M.mtpref[e + 1] <= m) ++e;
    e = __builtin_amdgcn_readfirstlane(e); hint = e; return e; }
struct SchedMoe1 {
    int G, c; MoeTab M; const char* xb; const char* Wgu; const int* toklist; mutable int eh;
    __device__ __forceinline__ bool next(int i, Unit& u) const { const long L = (long)i * G + c; const int nun = M.mtpref[NEX] * 2; if (L >= nun) return false;
        const int m = (int)(L >> 1), e = moe_find_expert(M, m, eh), mt = m - M.mtpref[e];
        u.pm = mt; u.pn = (int)(L & 1); u.e = e; u.arow0 = mt * 256; u.orow0 = M.hoff[e] + mt * 256;
        if (e < NE) { const int left = M.cnt[e] - mt * 256; u.nvalid = left < 256 ? left : 256; u.gidx = toklist + (size_t)e * T + mt * 256; } else { u.nvalid = 256; u.gidx = nullptr; }
        return true; }
    static constexpr bool GATHER = true;
    __device__ __forceinline__ const char* a_tile(const Unit&) const { return xb; }
    __device__ __forceinline__ const char* b_tile(const Unit& u) const { return Wgu + ((size_t)u.e * 512 + (size_t)u.pn * 256) * D * 2; }
    __device__ __forceinline__ int a_row(const Unit& u, int r) const { if (u.gidx) return r < u.nvalid ? u.gidx[r] : 0; return u.arow0 + r; }
};
struct SchedMoe2 {
    int G, c; MoeTab M; const char* hb; const char* Wd; mutable int eh;
    __device__ __forceinline__ bool next(int i, Unit& u) const { const long L = (long)i * G + c; const int nun = M.mtpref[NEX] * 4; if (L >= nun) return false;
        const int m = (int)(L >> 2), e = moe_find_expert(M, m, eh), mt = m - M.mtpref[e];
        u.pm = mt; u.pn = (int)(L & 3); u.e = e; u.nvalid = 256; u.arow0 = M.hoff[e] + mt * 256; u.orow0 = (e < NE) ? (M.hoff[e] + mt * 256) : mt * 256; u.gidx = nullptr; return true; }
    static constexpr bool GATHER = false;
    __device__ __forceinline__ const char* a_tile(const Unit& u) const { return hb + (size_t)u.arow0 * 256 * 2; }
    __device__ __forceinline__ const char* b_tile(const Unit& u) const { return Wd + ((size_t)u.e * 1024 + (size_t)u.pn * 256) * 256 * 2; }
    __device__ __forceinline__ int a_row(const Unit& u, int r) const { return u.arow0 + r; }
};

#define EPI_ARGS const AccT& acc, const Unit& u, int wr, int wc, int fr, int fq
struct EpiQKV { static constexpr bool PERM = true; bf16* Q; bf16* Kb; bf16* Vt;
    __device__ __forceinline__ void operator()(EPI_ARGS) const {
        const int row0 = u.orow0 + wr * 64 + fr, sec = u.pn >> 2, col0 = (u.pn & 3) * 256 + wc * 32 + 8 * fq;
        if (sec < 2) { bf16* base = sec == 0 ? Q : Kb; const float sc = sec == 0 ? 0.18033688011112042f : 1.0f;
#pragma unroll
            for (int ai = 0; ai < 2; ++ai)
#pragma unroll
                for (int m = 0; m < 4; ++m) { bf16* rowp = base + (size_t)(row0 + ai * 128 + m * 16) * D + col0;
#pragma unroll
                    for (int bj = 0; bj < 2; ++bj) { const f32x4 v0 = acc[ai][bj][m][0] * sc, v1 = acc[ai][bj][m][1] * sc; v4u w;
                        w.x = cvt_pk_bf16(v0[0], v0[1]); w.y = cvt_pk_bf16(v0[2], v0[3]); w.z = cvt_pk_bf16(v1[0], v1[1]); w.w = cvt_pk_bf16(v1[2], v1[3]); *(v4u*)(rowp + bj * 128) = w; } }
        } else {
#pragma unroll
            for (int ai = 0; ai < 2; ++ai)
#pragma unroll
                for (int m = 0; m < 4; ++m) { const int r = row0 + ai * 128 + m * 16, b = r >> 12, s = r & 4095;
#pragma unroll
                    for (int bj = 0; bj < 2; ++bj)
#pragma unroll
                        for (int n = 0; n < 2; ++n) { const f32x4 v = acc[ai][bj][m][n];
#pragma unroll
                            for (int j = 0; j < 4; j += 2) { const int c = col0 + bj * 128 + 4 * n + j, h = c >> 6, d = c & 63; const unsigned w = cvt_pk_bf16(v[j], v[j + 1]);
                                bf16* p = Vt + ((((size_t)(b * NH + h) * HD + d)) << 12) + s; p[0] = (bf16)(w & 0xffffu); p[SEQ] = (bf16)(w >> 16); } } }
        }
    }
};
struct EpiAdd { static constexpr bool PERM = true; bf16* ob; const bf16* xb;
    __device__ __forceinline__ void operator()(EPI_ARGS) const {
        const int row0 = u.orow0 + wr * 64 + fr, col0 = u.pn * 256 + wc * 32 + 8 * fq;
#pragma unroll
        for (int ai = 0; ai < 2; ++ai) { v4u t[4][2];
#pragma unroll
            for (int m = 0; m < 4; ++m) { const bf16* rowp = xb + (size_t)(row0 + ai * 128 + m * 16) * D + col0;
#pragma unroll
                for (int bj = 0; bj < 2; ++bj) t[m][bj] = __builtin_nontemporal_load((const v4u*)(rowp + bj * 128)); }
            __builtin_amdgcn_sched_barrier(0);
#pragma unroll
            for (int m = 0; m < 4; ++m) { bf16* rowp = ob + (size_t)(row0 + ai * 128 + m * 16) * D + col0;
#pragma unroll
                for (int bj = 0; bj < 2; ++bj) { const v4u w = t[m][bj]; const f32x4 x0 = {bflo(w.x), bfhi(w.x), bflo(w.y), bfhi(w.y)}, x1 = {bflo(w.z), bfhi(w.z), bflo(w.w), bfhi(w.w)};
                    const f32x4 s0 = x0 * ALPHA + acc[ai][bj][m][0], s1 = x1 * ALPHA + acc[ai][bj][m][1];
                    v4u o; o.x = cvt_pk_bf16(s0[0], s0[1]); o.y = cvt_pk_bf16(s0[2], s0[3]); o.z = cvt_pk_bf16(s1[0], s1[1]); o.w = cvt_pk_bf16(s1[2], s1[3]); *(v4u*)(rowp + bj * 128) = o; } }
            __builtin_amdgcn_sched_barrier(0); }
    }
};
struct EpiLogits { static constexpr bool PERM = false; float* lg;
    __device__ __forceinline__ void operator()(EPI_ARGS) const {
        if (wc >= 2) return;
        const int row0 = u.orow0 + wr * 64 + fr, col0 = wc * 32 + 4 * fq;
#pragma unroll
        for (int ai = 0; ai < 2; ++ai)
#pragma unroll
            for (int m = 0; m < 4; ++m) { float* rowp = lg + (size_t)(row0 + ai * 128 + m * 16) * NE + col0;
#pragma unroll
                for (int n = 0; n < 2; ++n) *(f32x4*)(rowp + n * 16) = acc[ai][0][m][n]; }
    }
};
struct EpiSwiglu { static constexpr bool PERM = true; bf16* hb; bool dry;
    __device__ __forceinline__ void operator()(EPI_ARGS) const {
        const int row0 = u.orow0 + wr * 64 + fr, col0 = u.pn * 128 + wc * 32 + 8 * fq;
#pragma unroll
        for (int ai = 0; ai < 2; ++ai)
#pragma unroll
            for (int m = 0; m < 4; ++m) { bf16* rowp = hb + (size_t)(row0 + ai * 128 + m * 16) * DE + col0; float o[8];
#pragma unroll
                for (int n = 0; n < 2; ++n)
#pragma unroll
                    for (int j = 0; j < 4; ++j) { const float g = acc[ai][0][m][n][j], up = acc[ai][1][m][n][j]; o[4 * n + j] = g * sigmoidf_(g) * up; }
                v4u w; w.x = cvt_pk_bf16(o[0], o[1]); w.y = cvt_pk_bf16(o[2], o[3]); w.z = cvt_pk_bf16(o[4], o[5]); w.w = cvt_pk_bf16(o[6], o[7]); if (!dry) *(v4u*)rowp = w; }
    }
};
constexpr int Y_SHARED0 = 278528, Y_ROWS = Y_SHARED0 + T;
constexpr size_t WS_YSC = WS_Y + (size_t)Y_ROWS * D;
static_assert(WS_YSC + (size_t)Y_ROWS * 4 * 4 <= WS_END, "fp8 y buffer");
struct EpiMoeDown { static constexpr int PERM = 2; unsigned char* ws; bool dry; LAS float* amx;
    __device__ __forceinline__ void operator()(EPI_ARGS) const {
        if (dry) return;
        const int rl0 = wr * 64 + fr, row0 = (u.e < NE ? u.orow0 : Y_SHARED0 + u.orow0) + rl0, col0 = u.pn * 256 + wc * 64 + 16 * fq;
        unsigned char* y8 = ws + WS_Y; float* ysc = (float*)(ws + WS_YSC);
        float am8[2][4];
#pragma unroll
        for (int ai = 0; ai < 2; ++ai)
#pragma unroll
            for (int m = 0; m < 4; ++m) { float am = 0.f;
#pragma unroll
                for (int bj = 0; bj < 2; ++bj)
#pragma unroll
                    for (int n = 0; n < 2; ++n) { const f32x4 v = acc[ai][bj][m][n]; am = __builtin_fmaxf(am, __builtin_fmaxf(__builtin_fmaxf(__builtin_fabsf(v[0]), __builtin_fabsf(v[1])), __builtin_fmaxf(__builtin_fabsf(v[2]), __builtin_fabsf(v[3])))); }
                am = q4_max(am);
                if (fq == 0) amx[(rl0 + ai * 128 + m * 16) * 4 + wc] = am; }
        asm volatile("s_waitcnt lgkmcnt(0)\n\ts_barrier" ::: "memory");
#pragma unroll
        for (int ai = 0; ai < 2; ++ai)
#pragma unroll
            for (int m = 0; m < 4; ++m) { const f32x4 t = *(const LAS f32x4*)(amx + (rl0 + ai * 128 + m * 16) * 4); am8[ai][m] = __builtin_fmaxf(__builtin_fmaxf(__builtin_fmaxf(t[0], t[1]), __builtin_fmaxf(t[2], t[3])), 1e-30f); }
#pragma unroll
        for (int ai = 0; ai < 2; ++ai)
#pragma unroll
            for (int m = 0; m < 4; ++m) { const size_t row = (size_t)(row0 + ai * 128 + m * 16); const float am = am8[ai][m];
                const float inv = 448.0f * fast_rcp(am) * 0.999f; unsigned wq[4];
#pragma unroll
                for (int bj = 0; bj < 2; ++bj)
#pragma unroll
                    for (int n = 0; n < 2; ++n) { const f32x4 v = acc[ai][bj][m][n]; int t = __builtin_amdgcn_cvt_pk_fp8_f32(v[0] * inv, v[1] * inv, 0, false); t = __builtin_amdgcn_cvt_pk_fp8_f32(v[2] * inv, v[3] * inv, t, true); wq[2 * bj + n] = (unsigned)t; }
                v4u w; w.x = wq[0]; w.y = wq[1]; w.z = wq[2]; w.w = wq[3]; st_wt(y8 + row * D + col0, w);
                if (wc == 0 && fq == 0) ysc[row * 4 + u.pn] = am * (1.0f / (448.0f * 0.999f)); }
    }
};
struct EpiRkv { static constexpr bool PERM = true; unsigned char* ws; size_t voff;
    __device__ __forceinline__ void operator()(EPI_ARGS) const {
        const int row0 = u.orow0 + wr * 64 + fr;
        size_t boff; int ldc, colt, act = 0;
        if (u.pn < 12) { const int sec = u.pn >> 2; boff = WS_R; if (sec == 1) boff = WS_KK; if (sec == 2) boff = voff; ldc = D; colt = (u.pn & 3) * 256; }
        else { const int kind = u.pn - 12; boff = WS_HL + (size_t)kind * T * 256 * 2; ldc = 256; colt = 0; act = kind == 0 ? 1 : (kind == 2 ? 2 : 0); }
        bf16* base = (bf16*)(ws + boff);
        const int col0 = colt + wc * 32 + 8 * fq;
#pragma unroll
        for (int ai = 0; ai < 2; ++ai)
#pragma unroll
            for (int m = 0; m < 4; ++m) { bf16* rowp = base + (size_t)(row0 + ai * 128 + m * 16) * ldc + col0;
#pragma unroll
                for (int bj = 0; bj < 2; ++bj) { f32x4 v0 = acc[ai][bj][m][0], v1 = acc[ai][bj][m][1];
                    if (act == 1) {
#pragma unroll
                        for (int j = 0; j < 4; ++j) { v0[j] = 1.0f - 2.0f * fast_rcp(fast_exp(2.0f * v0[j]) + 1.0f); v1[j] = 1.0f - 2.0f * fast_rcp(fast_exp(2.0f * v1[j]) + 1.0f); } }
                    if (act == 2) {
#pragma unroll
                        for (int j = 0; j < 4; ++j) { v0[j] = sigmoidf_(v0[j]); v1[j] = sigmoidf_(v1[j]); } }
                    v4u w; w.x = cvt_pk_bf16(v0[0], v0[1]); w.y = cvt_pk_bf16(v0[2], v0[3]); w.z = cvt_pk_bf16(v1[0], v1[1]); w.w = cvt_pk_bf16(v1[2], v1[3]); *(v4u*)(rowp + bj * 128) = w; } }
    }
};
struct EpiL2 { static constexpr bool PERM = true; bf16* lw; bf16* ab; bf16* gb; bf16* vb; const bf16* vf; const float* w0; const float* a0; const float* v0;
    __device__ __forceinline__ void operator()(EPI_ARGS) const {
        const int row0 = u.orow0 + wr * 64 + fr, col0 = u.pn * 256 + wc * 32 + 8 * fq, kind = u.e;
        if (kind == 3) {
#pragma unroll
            for (int ai = 0; ai < 2; ++ai) { v4u vv[4][2], ff[4][2];
#pragma unroll
                for (int m = 0; m < 4; ++m)
#pragma unroll
                    for (int bj = 0; bj < 2; ++bj) { const size_t o = (size_t)(row0 + ai * 128 + m * 16) * D + col0 + bj * 128; vv[m][bj] = __builtin_nontemporal_load((const v4u*)(vb + o)); ff[m][bj] = __builtin_nontemporal_load((const v4u*)(vf + o)); }
                __builtin_amdgcn_sched_barrier(0);
#pragma unroll
                for (int m = 0; m < 4; ++m)
#pragma unroll
                    for (int bj = 0; bj < 2; ++bj) { const size_t o = (size_t)(row0 + ai * 128 + m * 16) * D + col0 + bj * 128; const int c = col0 + bj * 128;
                        const f32x4 b0 = *(const f32x4*)(v0 + c), b1 = *(const f32x4*)(v0 + c + 4); float y[8];
#pragma unroll
                        for (int j = 0; j < 8; ++j) { const unsigned wv = vv[m][bj][j >> 1], wf = ff[m][bj][j >> 1]; const float v = (j & 1) ? bfhi(wv) : bflo(wv), f = (j & 1) ? bfhi(wf) : bflo(wf);
                            const float gt = sigmoidf_(acc[ai][bj][m][j >> 2][j & 3] + (j < 4 ? b0[j & 3] : b1[j & 3])); y[j] = v + (f - v) * gt; }
                        v4u w; w.x = cvt_pk_bf16(y[0], y[1]); w.y = cvt_pk_bf16(y[2], y[3]); w.z = cvt_pk_bf16(y[4], y[5]); w.w = cvt_pk_bf16(y[6], y[7]); *(v4u*)(vb + o) = w; }
                __builtin_amdgcn_sched_barrier(0); }
            return; }
#pragma unroll
        for (int ai = 0; ai < 2; ++ai)
#pragma unroll
            for (int m = 0; m < 4; ++m) { const size_t ro = (size_t)(row0 + ai * 128 + m * 16) * D + col0;
#pragma unroll
                for (int bj = 0; bj < 2; ++bj) { const size_t o = ro + bj * 128; const int c = col0 + bj * 128; float x[8];
#pragma unroll
                    for (int n = 0; n < 2; ++n)
#pragma unroll
                        for (int j = 0; j < 4; ++j) x[4 * n + j] = acc[ai][bj][m][n][j];
                    if (kind == 0) { const f32x4 b0 = *(const f32x4*)(w0 + c), b1 = *(const f32x4*)(w0 + c + 4); f32x4 r0, r1;
#pragma unroll
                        for (int j = 0; j < 8; ++j) { const float z = x[j] + (j < 4 ? b0[j & 3] : b1[j & 3]); if (j < 4) r0[j & 3] = z; else r1[j & 3] = z; }
                        { v4u w; w.x = cvt_pk_bf16(r0[0], r0[1]); w.y = cvt_pk_bf16(r0[2], r0[3]); w.z = cvt_pk_bf16(r1[0], r1[1]); w.w = cvt_pk_bf16(r1[2], r1[3]); *(v4u*)(lw + o) = w; }
                    } else if (kind == 1) { const f32x4 b0 = *(const f32x4*)(a0 + c), b1 = *(const f32x4*)(a0 + c + 4);
#pragma unroll
                        for (int j = 0; j < 8; ++j) x[j] = sigmoidf_(x[j] + (j < 4 ? b0[j & 3] : b1[j & 3]));
                        v4u w; w.x = cvt_pk_bf16(x[0], x[1]); w.y = cvt_pk_bf16(x[2], x[3]); w.z = cvt_pk_bf16(x[4], x[5]); w.w = cvt_pk_bf16(x[6], x[7]); *(v4u*)(ab + o) = w;
                    } else {
                        v4u w; w.x = cvt_pk_bf16(x[0], x[1]); w.y = cvt_pk_bf16(x[2], x[3]); w.z = cvt_pk_bf16(x[4], x[5]); w.w = cvt_pk_bf16(x[6], x[7]); *(v4u*)(gb + o) = w; }
                } }
    }
};

typedef GAS unsigned gu32;
#define XB_TMO      128
#define XB_XCNT(j)  (256  + 64 * (j))
#define XB_XSUB(j)  (1280 + 64 * (j))
#define XB_XGEN(j)  (2304 + 64 * (j))
#define XB_TOP      3328
#define XB_TOPGEN   3392
#define XCD_BAR_WORDS 3456
#define XB_SPIN_CAP (1u << 23)
__device__ __forceinline__ unsigned xb_ld(unsigned* p)              { return __hip_atomic_load(p, __ATOMIC_RELAXED, __HIP_MEMORY_SCOPE_AGENT); }
__device__ __forceinline__ unsigned xb_add(unsigned* p, unsigned v) { return __hip_atomic_fetch_add(p, v, __ATOMIC_RELAXED, __HIP_MEMORY_SCOPE_AGENT); }
__device__ __forceinline__ unsigned xb_xcc_id() { return (unsigned)__builtin_amdgcn_s_getreg((3 << 11) | 20) & 0xFu; }
#define XB_SPIN(cond, bar) do { unsigned _sp = 0; while (cond) { __builtin_amdgcn_s_sleep(1); \
    if ((++_sp & 255u) == 0u) { if (xb_ld(&(bar)[XB_TMO])) break; if (_sp > XB_SPIN_CAP) { atomicAdd(&(bar)[XB_TMO], 1u); break; } } } } while (0)
struct XcdBarrier { unsigned* bar; unsigned x; volatile LAS unsigned* st; };
__device__ __forceinline__ XcdBarrier xcd_barrier_post(unsigned* bar, volatile LAS unsigned* st) {
    XcdBarrier b; b.bar = bar; b.x = xb_xcc_id(); b.st = st;
    if (threadIdx.x == 0) (void)xb_add(&bar[XB_XCNT(b.x)], 1u);
    return b;
}
__device__ __forceinline__ void xcd_barrier_complete(unsigned* bar, unsigned x, unsigned& nloc, unsigned& nx) {
    const unsigned G = gridDim.x * gridDim.y * gridDim.z;
    unsigned sum, cnt, mine, sp = 0u;
    for (;;) {
        sum = 0u; cnt = 0u; mine = 0u;
#pragma unroll
        for (unsigned j = 0; j < 16; ++j) { const unsigned c = xb_ld(&bar[XB_XCNT(j)]); sum += c; cnt += (c > 0u) ? 1u : 0u; mine = (j == x) ? c : mine; }
        if (sum == G) break;
        __builtin_amdgcn_s_sleep(1);
        if ((++sp & 255u) == 0u) { if (xb_ld(&bar[XB_TMO])) break; if (sp > XB_SPIN_CAP) { atomicAdd(&bar[XB_TMO], 1u); break; } }
    }
    nloc = mine > 0u ? mine : 1u; nx = cnt > 0u ? cnt : 1u;
}
__device__ __forceinline__ void xcd_barrier(const XcdBarrier& b) {
    asm volatile("s_waitcnt vmcnt(0)" ::: "memory");
    __syncthreads();
    if (threadIdx.x == 0) {
        unsigned long long bp = (unsigned long long)b.bar; unsigned bx = b.x;
        asm volatile("" : "+s"(bp), "+s"(bx));
        unsigned* bar = (unsigned*)(GAS unsigned*)bp;
        __builtin_amdgcn_s_waitcnt(0);
        unsigned nloc = b.st[0], nx = b.st[1];
        if (nloc == 0u) { xcd_barrier_complete(bar, bx, nloc, nx); b.st[0] = nloc; b.st[1] = nx; }
        const unsigned old = xb_add(&bar[XB_XSUB(bx)], 1u);
        const unsigned gen = old / nloc;
        if (old + 1u == (gen + 1u) * nloc) {
            __builtin_amdgcn_fence(__ATOMIC_RELEASE, "agent");
            asm volatile("s_waitcnt vmcnt(0)" ::: "memory");
            const unsigned og = xb_add(&bar[XB_TOP], 1u);
            const unsigned tg = og / nx;
            if (og + 1u == (tg + 1u) * nx) xb_add(&bar[XB_TOPGEN], 1u);
            else XB_SPIN(xb_ld(&bar[XB_TOPGEN]) == tg, bar);
            __builtin_amdgcn_fence(__ATOMIC_ACQUIRE, "agent");
            xb_add(&bar[XB_XGEN(bx)], 1u);
            asm volatile("s_waitcnt vmcnt(0)" ::: "memory");
        } else {
            XB_SPIN(xb_ld(&bar[XB_XGEN(bx)]) == gen, bar);
            __builtin_amdgcn_fence(__ATOMIC_ACQUIRE, "agent");
            asm volatile("s_waitcnt vmcnt(0)" ::: "memory");
        }
    }
    __syncthreads();
}

struct Args { const float* in[35]; float* out; unsigned char* ws; };
struct Frame {
    LAS unsigned char* lds; gu32* ctl; unsigned char* ws; float* out;
    int tid, lane, wave, vcu, G, gw, NGW;
};

__device__ __forceinline__ Frame phase_frame(const Frame& F) {
    Frame P = F; int lane; asm volatile("v_mbcnt_lo_u32_b32 %0, -1, 0\n\tv_mbcnt_hi_u32_b32 %0, -1, %0" : "=v"(lane)); int wave = F.wave;
    asm volatile("" : "+v"(lane), "+s"(wave)); P.lane = lane; P.wave = wave; P.tid = wave * 64 + lane; P.gw = P.vcu * NWAVES + wave; return P;
}
__device__ __forceinline__ const float* in_ptr(const Frame& F, int k) {
    const unsigned long long v = ((const LAS unsigned long long*)(F.lds + PTAB_OFF))[k];
    const unsigned lo = (unsigned)__builtin_amdgcn_readfirstlane((int)(unsigned)v), hi = (unsigned)__builtin_amdgcn_readfirstlane((int)(unsigned)(v >> 32));
    return (const float*)(GAS const float*)(((unsigned long long)hi << 32) | lo);
}
__device__ __forceinline__ void transpose_item(const float* W, int N, int k0, int n0, bf16* WT, size_t orow, int ldk, LAS float* scr, int lane) {
    f32x4 w[8];
#pragma unroll
    for (int i = 0; i < 8; ++i) w[i] = __builtin_nontemporal_load((const f32x4*)(W + (size_t)(k0 + 8 * i + (lane >> 3)) * N + n0 + 4 * (lane & 7)));
    __builtin_amdgcn_sched_barrier(0);
#pragma unroll
    for (int i = 0; i < 8; ++i) { LAS float* d = scr + (8 * i + (lane >> 3)) * 33 + 4 * (lane & 7); d[0] = w[i][0]; d[1] = w[i][1]; d[2] = w[i][2]; d[3] = w[i][3]; }
    LDS_WAIT(); asm volatile("" ::: "memory");
    const int c = lane & 7;
#pragma unroll
    for (int j = 0; j < 4; ++j) { const int n = (lane >> 3) + 8 * j; const LAS float* s = scr + (8 * c) * 33 + n;
        v4u o; o.x = cvt_pk_bf16(s[0 * 33], s[1 * 33]); o.y = cvt_pk_bf16(s[2 * 33], s[3 * 33]); o.z = cvt_pk_bf16(s[4 * 33], s[5 * 33]); o.w = cvt_pk_bf16(s[6 * 33], s[7 * 33]);
        st_wt(WT + (orow + n) * ldk + k0 + 8 * c, o); }
    LDS_WAIT(); asm volatile("" ::: "memory");
}
__device__ __forceinline__ void convert_plain(Frame& F, const float* W, int K, int N, bf16* WT, int row_off) {
    LAS float* scr = (LAS float*)(F.lds + F.wave * 16384);
    const int nblk = N / 32, nitems = (K / 64) * nblk;
    for (int it = F.gw; it < nitems; it += F.NGW) { const int kb = it / nblk, nb = it % nblk; transpose_item(W, N, 64 * kb, 32 * nb, WT, (size_t)row_off + 32 * nb, K, scr, F.lane); }
}
struct SmallJob { const float* W; int K, N; bf16* WT; int Np, Kp; };
__device__ __forceinline__ void small_load(const Frame& F, const SmallJob& J, float (&v)[2]) {
    const size_t tot = (size_t)J.Np * J.Kp, step = (size_t)F.NGW * 64;
#pragma unroll
    for (int q = 0; q < 2; ++q) { const size_t i = (size_t)F.gw * 64 + F.lane + q * step; const int n = (int)(i / J.Kp), k = (int)(i % J.Kp); v[q] = (i < tot && k < J.K && n < J.N) ? J.W[(size_t)k * J.N + n] : 0.0f; }
}
__device__ __forceinline__ void small_store(const Frame& F, const SmallJob& J, const float (&v)[2]) {
    const size_t tot = (size_t)J.Np * J.Kp, step = (size_t)F.NGW * 64;
#pragma unroll
    for (int q = 0; q < 2; ++q) { const size_t i = (size_t)F.gw * 64 + F.lane + q * step; if (i < tot) J.WT[i] = (bf16)(cvt_pk_bf16(v[q], 0.0f) & 0xffffu); }
}
__device__ __forceinline__ void convert_small(Frame& F, const float* W, int K, int N, bf16* WT, int Np, int Kp);
__device__ __forceinline__ void convert_small4(Frame& F, const SmallJob& A, const SmallJob& B, const SmallJob& C, const SmallJob& E) {
    if ((size_t)F.NGW * 128 < (size_t)A.Np * A.Kp) { convert_small(F, A.W, A.K, A.N, A.WT, A.Np, A.Kp); convert_small(F, B.W, B.K, B.N, B.WT, B.Np, B.Kp); convert_small(F, C.W, C.K, C.N, C.WT, C.Np, C.Kp); convert_small(F, E.W, E.K, E.N, E.WT, E.Np, E.Kp); return; }
    float va[2], vb[2], vc[2], ve[2];
    small_load(F, A, va); small_load(F, B, vb); small_load(F, C, vc); small_load(F, E, ve);
    __builtin_amdgcn_sched_barrier(0);
    small_store(F, A, va); small_store(F, B, vb); small_store(F, C, vc); small_store(F, E, ve);
}
__device__ __forceinline__ void convert_small(Frame& F, const float* W, int K, int N, bf16* WT, int Np, int Kp) {
    const size_t tot = (size_t)Np * Kp, step = (size_t)F.NGW * 64;
    for (size_t i0 = (size_t)F.gw * 64 + F.lane; i0 < tot; i0 += 4 * step) { float v[4];
#pragma unroll
        for (int q = 0; q < 4; ++q) { const size_t i = i0 + q * step; const int n = (int)(i / Kp), k = (int)(i % Kp); v[q] = (i < tot && k < K && n < N) ? W[(size_t)k * N + n] : 0.0f; }
#pragma unroll
        for (int q = 0; q < 4; ++q) { const size_t i = i0 + q * step; if (i < tot) WT[i] = (bf16)(cvt_pk_bf16(v[q], 0.0f) & 0xffffu); } }
}
__device__ __forceinline__ void convert_moe(Frame& F, const float* wg, const float* wu, const float* wd, const float* sg, const float* su, const float* sd) {
    LAS float* scr = (LAS float*)(F.lds + F.wave * 16384);
    bf16* Wgu = (bf16*)(F.ws + WS_WGU); bf16* Wd = (bf16*)(F.ws + WS_WD);
    constexpr int PER = 128;
    const int total = NEX * 3 * PER;
    for (int it = F.gw; it < total; it += F.NGW) {
        const int e = it / (3 * PER), r = it % (3 * PER), which = r / PER, q = r % PER;
        if (which < 2) { const float* W = (e < NE) ? (which == 0 ? wg : wu) + (size_t)e * D * DE : (which == 0 ? sg : su);
            const int kb = q >> 3, nb = q & 7, n0 = 32 * nb; const size_t orow = (size_t)e * 512 + (n0 >> 7) * 256 + which * 128 + (n0 & 127);
            transpose_item(W, DE, 64 * kb, n0, Wgu, orow, D, scr, F.lane);
        } else { const float* W = (e < NE) ? wd + (size_t)e * DE * D : sd;
            const int kb = q >> 5, nb = q & 31, n0 = 32 * nb;
            transpose_item(W, D, 64 * kb, n0, Wd, (size_t)e * 1024 + n0, DE, scr, F.lane); }
    }
}

template <int MODE>
__device__ __forceinline__ void ln_phase(Frame& F, const float* src, const float* g, const float* bsh, bool final, const MoeTab& M) {
    float* out = F.out; bf16* xb = (bf16*)(F.ws + WS_XB);
    const bf16* yb = (const bf16*)(F.ws + WS_Y); const int2* tsel = (const int2*)(F.ws + WS_TSEL);
    f32x4 gv[4], bv[4];
    if (MODE != 2) {
#pragma unroll
        for (int j = 0; j < 4; ++j) { const int c = 512 * (j >> 1) + 8 * F.lane + 4 * (j & 1); gv[j] = *(const f32x4*)(g + c); bv[j] = *(const f32x4*)(bsh + c); } }
    for (int row = F.gw; row < T; row += F.NGW) {
        const float* xr = src + (size_t)row * D + 8 * F.lane;
        f32x4 v[4];
#pragma unroll
        for (int j = 0; j < 4; ++j) v[j] = *(const f32x4*)(xr + 512 * (j >> 1) + 4 * (j & 1));
        if (MODE == 1) {
#pragma unroll
            for (int jj = 0; jj < TOPK; ++jj) { const int2 ts = tsel[(size_t)row * TOPK + jj]; const int e = ts.x >> 20, slot = ts.x & 0xfffff; const float gt = __int_as_float(ts.y);
                const bf16* yp = yb + (size_t)(M.hoff[e] + slot) * D + 8 * F.lane;
#pragma unroll
                for (int jh = 0; jh < 2; ++jh) { const v4u w = *(const v4u*)(yp + 512 * jh);
                    v[2 * jh][0] += gt * bflo(w.x); v[2 * jh][1] += gt * bfhi(w.x); v[2 * jh][2] += gt * bflo(w.y); v[2 * jh][3] += gt * bfhi(w.y);
                    v[2 * jh + 1][0] += gt * bflo(w.z); v[2 * jh + 1][1] += gt * bfhi(w.z); v[2 * jh + 1][2] += gt * bflo(w.w); v[2 * jh + 1][3] += gt * bfhi(w.w); } }
        }
        f32x4 o[4];
        if (MODE == 2) {
#pragma unroll
            for (int j = 0; j < 4; ++j) o[j] = v[j];
        } else {
            float s = 0.f;
#pragma unroll
            for (int j = 0; j < 4; ++j) s += (v[j][0] + v[j][1]) + (v[j][2] + v[j][3]);
            const float mean = wave_sum(s) * (1.0f / D); float s2 = 0.f;
#pragma unroll
            for (int j = 0; j < 4; ++j) { v[j] = v[j] - mean; s2 += (v[j][0] * v[j][0] + v[j][1] * v[j][1]) + (v[j][2] * v[j][2] + v[j][3] * v[j][3]); }
            const float rstd = 1.0f / sqrtf(wave_sum(s2) * (1.0f / D) + LN_EPS);
#pragma unroll
            for (int j = 0; j < 4; ++j) o[j] = v[j] * rstd * gv[j] + bv[j];
        }
        float* orow = out + (size_t)row * D + 8 * F.lane; bf16* brow = xb + (size_t)row * D + 8 * F.lane;
        const float sc = final ? 1.0f : ALPHA;
#pragma unroll
        for (int jh = 0; jh < 2; ++jh) { if (MODE != 2) { *(f32x4*)(orow + 512 * jh) = o[2 * jh] * sc; *(f32x4*)(orow + 512 * jh + 4) = o[2 * jh + 1] * sc; }
            v4u w; w.x = cvt_pk_bf16(o[2 * jh][0], o[2 * jh][1]); w.y = cvt_pk_bf16(o[2 * jh][2], o[2 * jh][3]); w.z = cvt_pk_bf16(o[2 * jh + 1][0], o[2 * jh + 1][1]); w.w = cvt_pk_bf16(o[2 * jh + 1][2], o[2 * jh + 1][3]);
            *(v4u*)(brow + 512 * jh) = w; }
    }
}

__device__ __forceinline__ void cast_phase(Frame& F, const float* x) {
    bf16* xb = (bf16*)(F.ws + WS_XB);
    for (int r0 = 4 * F.gw; r0 < T; r0 += 4 * F.NGW) { f32x4 v[4][4];
#pragma unroll
        for (int r = 0; r < 4; ++r) { const float* xr = x + (size_t)(r0 + r) * D + 8 * F.lane;
#pragma unroll
            for (int j = 0; j < 4; ++j) v[r][j] = __builtin_nontemporal_load((const f32x4*)(xr + 512 * (j >> 1) + 4 * (j & 1))); }
        __builtin_amdgcn_sched_barrier(0);
#pragma unroll
        for (int r = 0; r < 4; ++r) { bf16* brow = xb + (size_t)(r0 + r) * D + 8 * F.lane;
#pragma unroll
            for (int jh = 0; jh < 2; ++jh) { v4u w; w.x = cvt_pk_bf16(v[r][2 * jh][0], v[r][2 * jh][1]); w.y = cvt_pk_bf16(v[r][2 * jh][2], v[r][2 * jh][3]); w.z = cvt_pk_bf16(v[r][2 * jh + 1][0], v[r][2 * jh + 1][1]);
                w.w = cvt_pk_bf16(v[r][2 * jh + 1][2], v[r][2 * jh + 1][3]); st_wt(brow + 512 * jh, w); } }
        __builtin_amdgcn_sched_barrier(0); }
}
__device__ __forceinline__ void ln2_phase(Frame& F, const float* g, const float* bsh, bool final, const MoeTab& M) {
    float* out = F.out; bf16* xb = (bf16*)(F.ws + WS_XB);
    const unsigned char* y8 = F.ws + WS_Y; const float* ysc = (const float*)(F.ws + WS_YSC); const int4* tsel4 = (const int4*)(F.ws + WS_TSEL);
    f32x4 gv[4], bv[4];
#pragma unroll
    for (int j = 0; j < 4; ++j) { const int c = 512 * (j >> 1) + 8 * F.lane + 4 * (j & 1); gv[j] = *(const f32x4*)(g + c); bv[j] = *(const f32x4*)(bsh + c); }
    const float sc = final ? 1.0f : ALPHA;
    constexpr int NBAT = T / 16;
    for (int batch = F.gw; batch < NBAT; batch += F.NGW) {
        const int row0 = 16 * batch;
        int4 tsv; { const v4u t_ = __builtin_nontemporal_load((const v4u*)(tsel4 + (size_t)row0 * 4 + F.lane)); tsv.x = (int)t_.x; tsv.y = (int)t_.y; tsv.z = (int)t_.z; tsv.w = (int)t_.w; }
        v4u xv[2]; v2u yw[TOPK + 1][2]; float ysv[TOPK + 1][2];
#define LN2_ISSUE(I_) do { const int i_ = (I_); const bf16* xr = xb + (size_t)(row0 + i_) * D + 8 * F.lane; \
            xv[0] = __builtin_nontemporal_load((const v4u*)xr); xv[1] = __builtin_nontemporal_load((const v4u*)(xr + 512)); \
            { const size_t yr = (size_t)(Y_SHARED0 + row0 + i_); const unsigned char* yp = y8 + yr * D + 8 * F.lane; yw[TOPK][0] = __builtin_nontemporal_load((const v2u*)yp); yw[TOPK][1] = __builtin_nontemporal_load((const v2u*)(yp + 512)); \
              ysv[TOPK][0] = ysc[yr * 4 + (F.lane >> 5)]; ysv[TOPK][1] = ysc[yr * 4 + 2 + (F.lane >> 5)]; } \
            _Pragma("unroll") for (int jj = 0; jj < TOPK; ++jj) { const int tx = __builtin_amdgcn_readlane((jj & 1) ? tsv.z : tsv.x, 4 * i_ + (jj >> 1)); const int e = tx >> 20, slot = tx & 0xfffff; \
                const size_t yr = (size_t)(M.hoff[e] + slot); const unsigned char* yp = y8 + yr * D + 8 * F.lane; yw[jj][0] = __builtin_nontemporal_load((const v2u*)yp); yw[jj][1] = __builtin_nontemporal_load((const v2u*)(yp + 512)); \
                ysv[jj][0] = ysc[yr * 4 + (F.lane >> 5)]; ysv[jj][1] = ysc[yr * 4 + 2 + (F.lane >> 5)]; } } while (0)
        LN2_ISSUE(0);
_Pragma("nounroll")
        for (int i = 0; i < 16; ++i) {
            f32x4 v[4];
#pragma unroll
            for (int jh = 0; jh < 2; ++jh) { const v4u w = xv[jh]; v[2 * jh] = (f32x4){bflo(w.x), bfhi(w.x), bflo(w.y), bfhi(w.y)} * ALPHA; v[2 * jh + 1] = (f32x4){bflo(w.z), bfhi(w.z), bflo(w.w), bfhi(w.w)} * ALPHA; }
#pragma unroll
            for (int jj = 0; jj <= TOPK; ++jj) { const float gt = jj == TOPK ? 1.0f : __int_as_float(__builtin_amdgcn_readlane((jj & 1) ? tsv.w : tsv.y, 4 * i + (jj >> 1)));
#pragma unroll
                for (int jh = 0; jh < 2; ++jh) { const v2u w = yw[jj][jh]; const float gs_ = gt * ysv[jj][jh];
                    const auto p0 = __builtin_amdgcn_cvt_pk_f32_fp8((int)w.x, false), p1 = __builtin_amdgcn_cvt_pk_f32_fp8((int)w.x, true), p2 = __builtin_amdgcn_cvt_pk_f32_fp8((int)w.y, false), p3 = __builtin_amdgcn_cvt_pk_f32_fp8((int)w.y, true);
                    v[2 * jh][0] += gs_ * p0[0]; v[2 * jh][1] += gs_ * p0[1]; v[2 * jh][2] += gs_ * p1[0]; v[2 * jh][3] += gs_ * p1[1];
                    v[2 * jh + 1][0] += gs_ * p2[0]; v[2 * jh + 1][1] += gs_ * p2[1]; v[2 * jh + 1][2] += gs_ * p3[0]; v[2 * jh + 1][3] += gs_ * p3[1]; } }
            __builtin_amdgcn_sched_barrier(0);
            LN2_ISSUE(i + 1 < 16 ? i + 1 : 15);
            __builtin_amdgcn_sched_barrier(0);
            float s = 0.f;
#pragma unroll
            for (int j = 0; j < 4; ++j) s += (v[j][0] + v[j][1]) + (v[j][2] + v[j][3]);
            const float mean = wave_sum(s) * (1.0f / D); float s2 = 0.f;
#pragma unroll
            for (int j = 0; j < 4; ++j) { v[j] = v[j] - mean; s2 += (v[j][0] * v[j][0] + v[j][1] * v[j][1]) + (v[j][2] * v[j][2] + v[j][3] * v[j][3]); }
            const float rstd = 1.0f / sqrtf(wave_sum(s2) * (1.0f / D) + LN_EPS);
            f32x4 o[4];
#pragma unroll
            for (int j = 0; j < 4; ++j) o[j] = v[j] * rstd * gv[j] + bv[j];
            float* orow = out + (size_t)(row0 + i) * D + 8 * F.lane; bf16* brow = xb + (size_t)(row0 + i) * D + 8 * F.lane;
#pragma unroll
            for (int jh = 0; jh < 2; ++jh) { if (final) { *(f32x4*)(orow + 512 * jh) = o[2 * jh]; *(f32x4*)(orow + 512 * jh + 4) = o[2 * jh + 1]; }
                v4u w; w.x = cvt_pk_bf16(o[2 * jh][0], o[2 * jh][1]); w.y = cvt_pk_bf16(o[2 * jh][2], o[2 * jh][3]); w.z = cvt_pk_bf16(o[2 * jh + 1][0], o[2 * jh + 1][1]); w.w = cvt_pk_bf16(o[2 * jh + 1][2], o[2 * jh + 1][3]);
                *(v4u*)(brow + 512 * jh) = w; }
        }
#undef LN2_ISSUE
    }
}

__device__ __forceinline__ void moe_tables(Frame& F, int layer) {
    LAS int* cnt = (LAS int*)(F.lds + TAB_OFF); LAS int* mtp = cnt + 65; LAS int* hoff = mtp + 66;
    __syncthreads();
    if (F.tid < NE) cnt[F.tid] = (int)__hip_atomic_load(F.ctl + CW_CNT + (layer * 64 + F.tid) * 64, RLX_AGENT);
    if (F.tid == NE) cnt[NE] = T;
    __syncthreads();
    if (F.tid == 0) { int m = 0;
_Pragma("nounroll")
        for (int e = 0; e < NEX; ++e) { mtp[e] = m; hoff[e] = m * 256; m += (cnt[e] + 255) >> 8; } mtp[NEX] = m; hoff[NEX] = m * 256; }
    __syncthreads();
}

__device__ __forceinline__ void route_phase(Frame& F, int layer, const float* rbias) {
    const float* lg = (const float*)(F.ws + WS_LOGITS); int* toklist = (int*)(F.ws + WS_TOKLIST); int2* tsel = (int2*)(F.ws + WS_TSEL);
    LAS float* sw = (LAS float*)(F.lds + F.wave * 256);
    const float rb = rbias[F.lane];
    for (int row = F.gw; row < T; row += F.NGW) {
        const float sc = sigmoidf_(lg[(size_t)row * NE + F.lane]); const float bz = sc + rb;
        sw[F.lane] = bz; LDS_WAIT();
        float v[64];
#pragma unroll
        for (int q = 0; q < 16; ++q) { const f32x4 t = *(const LAS f32x4*)(sw + 4 * q); v[4 * q] = t[0]; v[4 * q + 1] = t[1]; v[4 * q + 2] = t[2]; v[4 * q + 3] = t[3]; }
        LDS_WAIT();
        float gs[8];
#pragma unroll
        for (int gi = 0; gi < 8; ++gi) { float m1 = -INFINITY, m2 = -INFINITY;
#pragma unroll
            for (int k = 0; k < 8; ++k) { const float x = v[8 * gi + k]; const bool a = x > m1; const float nm2 = a ? m1 : fmaxf(m2, x); m1 = a ? x : m1; m2 = nm2; }
            gs[gi] = m1 + m2; }
        unsigned keep = 0u;
#pragma unroll
        for (int gi = 0; gi < 8; ++gi) { int rank = 0;
#pragma unroll
            for (int g2 = 0; g2 < 8; ++g2) rank += (gs[g2] > gs[gi] || (gs[g2] == gs[gi] && g2 < gi)) ? 1 : 0;
            keep |= (rank < 4) ? (1u << gi) : 0u; }
        const bool kown = (keep >> (F.lane >> 3)) & 1u; int rank = 0;
#pragma unroll
        for (int e2 = 0; e2 < 64; ++e2) { const bool k2 = (keep >> (e2 >> 3)) & 1u; rank += (k2 && (v[e2] > bz || (v[e2] == bz && e2 < F.lane))) ? 1 : 0; }
        const bool sel = kown && rank < TOPK;
        const unsigned long long bal = __ballot(sel);
        const float ssum = wave_sum(sel ? sc : 0.0f);
        if (sel) { const int j = __popcll(bal & ((1ull << F.lane) - 1ull)); const float gate = sc / ssum * 2.5f;
            const unsigned slot = __hip_atomic_fetch_add(F.ctl + CW_CNT + (layer * 64 + F.lane) * 64, 1u, RLX_AGENT);
            toklist[(size_t)F.lane * T + slot] = row;
            if (j < TOPK) tsel[(size_t)row * TOPK + j] = make_int2((F.lane << 20) | (int)slot, __float_as_int(gate)); }
    }
}

__device__ __forceinline__ void ln1_route_phase(Frame& F, const float* g, const float* bsh, int layer, const float* rbias) {
    float* out = F.out; bf16* xb = (bf16*)(F.ws + WS_XB);
    const unsigned char* WrT = F.ws + WS_WR + (size_t)layer * 256 * D * 2;
    int* toklist = (int*)(F.ws + WS_TOKLIST); int2* tsel = (int2*)(F.ws + WS_TSEL);
    f32x4 gv[4], bv[4];
#pragma unroll
    for (int j = 0; j < 4; ++j) { const int c = 512 * (j >> 1) + 8 * F.lane + 4 * (j & 1); gv[j] = *(const f32x4*)(g + c); bv[j] = *(const f32x4*)(bsh + c); }
    const float rb = rbias[F.lane];
    const int qi = F.lane & 15, gq = F.lane >> 4;
    constexpr int NBAT = T / 16;
    for (int b0 = 0; b0 < NBAT; b0 += F.NGW) {
        const int batch = b0 + F.gw; const bool act = batch < NBAT;
        __syncthreads();
#pragma unroll
        for (int q = 0; q < 16; ++q) { const int hr = F.wave * 16 + q, e = hr >> 1, half = hr & 1; const int c = (64 * half + F.lane) ^ (e & 15);
            __builtin_amdgcn_global_load_lds((const unsigned*)(WrT + (size_t)e * 2048 + 16 * c), (LAS unsigned*)(F.lds + e * 2048 + 1024 * half), 16, 0, 0); }
        if (act) {
_Pragma("nounroll")
            for (int i = 0; i < 16; i += 4) {
                v4u vv[4][2];
#pragma unroll
                for (int r = 0; r < 4; ++r) { const bf16* xr = (const bf16*)out + (size_t)(16 * batch + i + r) * D + 8 * F.lane; vv[r][0] = __builtin_nontemporal_load((const v4u*)xr); vv[r][1] = __builtin_nontemporal_load((const v4u*)(xr + 512)); }
                __builtin_amdgcn_sched_barrier(0);
#pragma unroll
                for (int r = 0; r < 4; ++r) { const int row = 16 * batch + i + r; f32x4 v[4];
#pragma unroll
                    for (int jh = 0; jh < 2; ++jh) { const v4u w = vv[r][jh]; v[2 * jh] = (f32x4){bflo(w.x), bfhi(w.x), bflo(w.y), bfhi(w.y)}; v[2 * jh + 1] = (f32x4){bflo(w.z), bfhi(w.z), bflo(w.w), bfhi(w.w)}; }
                    float s = 0.f;
#pragma unroll
                    for (int j = 0; j < 4; ++j) s += (v[j][0] + v[j][1]) + (v[j][2] + v[j][3]);
                    const float mean = wave_sum(s) * (1.0f / D); float s2 = 0.f;
#pragma unroll
                    for (int j = 0; j < 4; ++j) { v[j] = v[j] - mean; s2 += (v[j][0] * v[j][0] + v[j][1] * v[j][1]) + (v[j][2] * v[j][2] + v[j][3] * v[j][3]); }
                    const float rstd = 1.0f / sqrtf(wave_sum(s2) * (1.0f / D) + LN_EPS);
                    f32x4 o[4];
#pragma unroll
                    for (int j = 0; j < 4; ++j) o[j] = v[j] * rstd * gv[j] + bv[j];
                    bf16* brow = xb + (size_t)row * D + 8 * F.lane;
#pragma unroll
                    for (int jh = 0; jh < 2; ++jh) {
                        v4u w; w.x = cvt_pk_bf16(o[2 * jh][0], o[2 * jh][1]); w.y = cvt_pk_bf16(o[2 * jh][2], o[2 * jh][3]); w.z = cvt_pk_bf16(o[2 * jh + 1][0], o[2 * jh + 1][1]); w.w = cvt_pk_bf16(o[2 * jh + 1][2], o[2 * jh + 1][3]);
                        *(v4u*)(brow + 512 * jh) = w; } }
                __builtin_amdgcn_sched_barrier(0);
            }
        }
        VM_WAIT(); __syncthreads();
        f32x4 acc[4];
#pragma unroll
        for (int t = 0; t < 4; ++t) acc[t] = (f32x4){0.f, 0.f, 0.f, 0.f};
        if (act) { const bf16* xrow = xb + (size_t)(16 * batch + qi) * D + 8 * gq;
#pragma unroll
            for (int k0 = 0; k0 < 32; k0 += 16) { bf16x8 bfr[16];
#pragma unroll
                for (int ks = 0; ks < 16; ++ks) bfr[ks] = *(const bf16x8*)(xrow + 32 * (k0 + ks));
                __builtin_amdgcn_sched_barrier(0);
#pragma unroll
                for (int ks = 0; ks < 16; ++ks)
#pragma unroll
                    for (int t = 0; t < 4; ++t) { const bf16x8 a = *(const LAS bf16x8*)(F.lds + (16 * t + qi) * 2048 + 16 * ((4 * (k0 + ks) + gq) ^ qi)); acc[t] = __builtin_amdgcn_mfma_f32_16x16x32_bf16(a, bfr[ks], acc[t], 0, 0, 0); }
                __builtin_amdgcn_sched_barrier(0); } }
        __syncthreads();
        if (act) { LAS float* lg = (LAS float*)(F.lds + F.wave * 16384);
#pragma unroll
            for (int t = 0; t < 4; ++t) *(LAS f32x4*)(lg + qi * 64 + 16 * t + 4 * gq) = acc[t];
            LDS_WAIT();
            int cnt = 0;
_Pragma("nounroll")
            for (int i = 0; i < 16; ++i) { LAS float* sw = lg + 64 * i;
                const float sc = sigmoidf_(sw[F.lane]); const float bz = sc + rb;
                const float m1 = max8(bz);
                const unsigned long long bm = __ballot(bz == m1);
                const unsigned gb = (unsigned)(bm >> (F.lane & 56)) & 0xffu;
                const bool isf = (unsigned)(F.lane & 7) == (unsigned)__builtin_ctz(gb);
                const float m2 = max8(isf ? -INFINITY : bz);
                const float gsum = m1 + m2; const int grp = F.lane >> 3; int grank = 0;
#pragma unroll
                for (int g2 = 0; g2 < 8; ++g2) { const float s = __int_as_float(__builtin_amdgcn_readlane(__float_as_int(gsum), 8 * g2)); grank += (s > gsum || (s == gsum && g2 < grp)) ? 1 : 0; }
                float x = (grank < 4) ? bz : -INFINITY; bool sel = false;
#pragma unroll
                for (int r8 = 0; r8 < TOPK; ++r8) { const float m = wave_max(x); const unsigned long long bx = __ballot(x == m); const int first = (int)__builtin_ctzll(bx);
                    if (F.lane == first) { sel = true; x = -INFINITY; } }
                const float ssum = wave_sum(sel ? sc : 0.0f);
                sw[F.lane] = sel ? sc / ssum * 2.5f : -1.0f; cnt += sel ? 1 : 0; }
            unsigned slot = 0; if (cnt > 0) slot = __hip_atomic_fetch_add(F.ctl + CW_CNT + (layer * 64 + F.lane) * 64, (unsigned)cnt, RLX_AGENT);
            LDS_WAIT();
_Pragma("nounroll")
            for (int i = 0; i < 16; ++i) { const float gate = lg[64 * i + F.lane]; const bool sel = gate >= 0.0f; const int row = 16 * batch + i;
                const unsigned long long bal = __ballot(sel);
                if (sel) { const int j = __popcll(bal & ((1ull << F.lane) - 1ull));
                    toklist[(size_t)F.lane * T + slot] = row;
                    if (j < TOPK) tsel[(size_t)row * TOPK + j] = make_int2((F.lane << 20) | (int)slot, __float_as_int(gate));
                    ++slot; } }
            LDS_WAIT();
        }
    }
}

__device__ __forceinline__ void mix_phase(Frame& F, const float* mix) {
    bf16* xm = (bf16*)(F.ws + WS_XMIX);
    f32x4 mc[6][2][2];
#pragma unroll
    for (int i = 0; i < 6; ++i)
#pragma unroll
        for (int jh = 0; jh < 2; ++jh)
#pragma unroll
            for (int q = 0; q < 2; ++q) mc[i][jh][q] = *(const f32x4*)(mix + i * D + 512 * jh + 8 * F.lane + 4 * q);
    constexpr int NBAT = T / 16; const bf16* xbuf = (const bf16*)(F.ws + WS_XB);
    for (int batch = F.gw; batch < NBAT; batch += F.NGW) {
        const int row0 = 16 * batch; const bf16* xr = xbuf + (size_t)row0 * D + 8 * F.lane; const bool first = (row0 & (SEQ - 1)) == 0;
        f32x4 xp[2][2]; v4u xc[2];
#pragma unroll
        for (int jh = 0; jh < 2; ++jh) { xc[jh] = *(const v4u*)(xr + 512 * jh); const v4u w = *(const v4u*)(xr + (first ? 0 : -D) + 512 * jh); const float m_ = first ? 0.0f : 1.0f;
            xp[jh][0] = (f32x4){bflo(w.x), bfhi(w.x), bflo(w.y), bfhi(w.y)} * m_; xp[jh][1] = (f32x4){bflo(w.z), bfhi(w.z), bflo(w.w), bfhi(w.w)} * m_; }
_Pragma("nounroll")
        for (int i = 0; i < 16; ++i) { const bf16* xnp = xr + (size_t)(i + 1 < 16 ? i + 1 : 15) * D; v4u xn[2];
#pragma unroll
            for (int jh = 0; jh < 2; ++jh) xn[jh] = *(const v4u*)(xnp + 512 * jh);
            bf16* orow = xm + (size_t)(row0 + i) * D + 8 * F.lane;
#pragma unroll
            for (int jh = 0; jh < 2; ++jh) { const v4u w = xc[jh]; const f32x4 x0 = {bflo(w.x), bfhi(w.x), bflo(w.y), bfhi(w.y)}, x1 = {bflo(w.z), bfhi(w.z), bflo(w.w), bfhi(w.w)}; const f32x4 d0 = xp[jh][0] - x0, d1 = xp[jh][1] - x1;
#pragma unroll
                for (int k = 0; k < 6; ++k) { const f32x4 o0 = x0 + d0 * mc[k][jh][0], o1 = x1 + d1 * mc[k][jh][1];
                    v4u wo; wo.x = cvt_pk_bf16(o0[0], o0[1]); wo.y = cvt_pk_bf16(o0[2], o0[3]); wo.z = cvt_pk_bf16(o1[0], o1[1]); wo.w = cvt_pk_bf16(o1[2], o1[3]);
                    st_wt(orow + (size_t)k * T * D + 512 * jh, wo); }
                xp[jh][0] = x0; xp[jh][1] = x1; xc[jh] = xn[jh]; }
        }
    }
}
__device__ __forceinline__ void kmean_phase(Frame& F) {
    const bf16* Kb = (const bf16*)(F.ws + WS_K); float* km = (float*)(F.ws + WS_KMEAN);
    for (int u = F.gw; u < NBATCH * NH * NMB; u += F.NGW) { const int bh = u >> 4, blk = u & 15, b = bh >> 4, h = bh & 15;
        const bf16* p = Kb + ((size_t)b * SEQ + blk * MBLK + (F.lane >> 3)) * D + h * HD + 8 * (F.lane & 7); float s[8];
#pragma unroll
        for (int i = 0; i < 8; ++i) s[i] = 0.f;
#pragma unroll
        for (int r0 = 0; r0 < MBLK / 8; r0 += 16) { v4u w[16];
#pragma unroll
            for (int r = 0; r < 16; ++r) w[r] = __builtin_nontemporal_load((const v4u*)(p + (size_t)(8 * (r0 + r)) * D));
            __builtin_amdgcn_sched_barrier(0);
#pragma unroll
            for (int r = 0; r < 16; ++r) { s[0] += bflo(w[r].x); s[1] += bfhi(w[r].x); s[2] += bflo(w[r].y); s[3] += bfhi(w[r].y); s[4] += bflo(w[r].z); s[5] += bfhi(w[r].z); s[6] += bflo(w[r].w); s[7] += bfhi(w[r].w); }
            __builtin_amdgcn_sched_barrier(0); }
#pragma unroll
        for (int i = 0; i < 8; ++i) s[i] = q4_sum(dpp_add<0x128>(s[i])) * (1.0f / MBLK);
        if (F.lane < 8) { float* o = km + (size_t)u * HD + 8 * F.lane; *(f32x4*)o = (f32x4){s[0], s[1], s[2], s[3]}; *(f32x4*)(o + 4) = (f32x4){s[4], s[5], s[6], s[7]}; } }
}
template <int CTRL> __device__ __forceinline__ float dpp_max_f(float v) { return dpp_max<CTRL>(v); }
__device__ __forceinline__ void sel_phase(Frame& F) {
    const bf16* Q = (const bf16*)(F.ws + WS_Q); const float* km = (const float*)(F.ws + WS_KMEAN); unsigned short* maskb = (unsigned short*)(F.ws + WS_MASK);
    const int j = F.lane & 15, g = F.lane >> 4;
    for (int u = F.vcu; u < NBATCH * NH * (SEQ / NTHREADS); u += F.G) { const int bh = u >> 3, ch = u & 7, b = bh >> 4, h = bh & 15;
        const int q0 = ch * NTHREADS + 64 * F.wave, qblk = q0 >> 8;
        bf16x8 khi[2], klo[2];
#pragma unroll
        for (int ks = 0; ks < 2; ++ks) { const float* kp = km + ((size_t)bh * NMB + j) * HD + 32 * ks + 8 * g; const f32x4 k0 = *(const f32x4*)kp, k1 = *(const f32x4*)(kp + 4); v4u hw, lw_;
            float hf[8], lf[8];
#pragma unroll
            for (int i = 0; i < 8; ++i) { const float x = i < 4 ? k0[i & 3] : k1[i & 3]; const unsigned hb = cvt_pk_bf16(x, 0.0f) & 0xffffu; hf[i] = __uint_as_float(hb << 16); lf[i] = x - hf[i]; }
            hw.x = cvt_pk_bf16(hf[0], hf[1]); hw.y = cvt_pk_bf16(hf[2], hf[3]); hw.z = cvt_pk_bf16(hf[4], hf[5]); hw.w = cvt_pk_bf16(hf[6], hf[7]);
            lw_.x = cvt_pk_bf16(lf[0], lf[1]); lw_.y = cvt_pk_bf16(lf[2], lf[3]); lw_.z = cvt_pk_bf16(lf[4], lf[5]); lw_.w = cvt_pk_bf16(lf[6], lf[7]);
            khi[ks] = __builtin_bit_cast(bf16x8, hw); klo[ks] = __builtin_bit_cast(bf16x8, lw_); }
        bf16x8 qf[4][2];
#pragma unroll
        for (int t = 0; t < 4; ++t)
#pragma unroll
            for (int ks = 0; ks < 2; ++ks) qf[t][ks] = *(const bf16x8*)(Q + ((size_t)b * SEQ + q0 + 16 * t + j) * D + h * HD + 32 * ks + 8 * g);
#pragma unroll
        for (int t = 0; t < 4; ++t) { f32x4 acc = {0.f, 0.f, 0.f, 0.f};
#pragma unroll
            for (int ks = 0; ks < 2; ++ks) { acc = __builtin_amdgcn_mfma_f32_16x16x32_bf16(qf[t][ks], klo[ks], acc, 0, 0, 0); acc = __builtin_amdgcn_mfma_f32_16x16x32_bf16(qf[t][ks], khi[ks], acc, 0, 0, 0); }
            unsigned mk[4];
#pragma unroll
            for (int r = 0; r < 4; ++r) { float x = (j < qblk) ? acc[r] : -INFINITY; unsigned m_ = 0u;
#pragma unroll
                for (int rd = 0; rd < 3; ++rd) { float mx = dpp_max<0xB1>(x); mx = dpp_max<0x4E>(mx); mx = dpp_max<0x141>(mx); mx = dpp_max<0x140>(mx);
                    const unsigned long long bal = __ballot(x == mx && mx > -INFINITY); const unsigned rb_ = (unsigned)(bal >> (16 * g)) & 0xffffu;
                    if (rb_) { const int js = __builtin_ctz(rb_); m_ |= 1u << js; if (j == js) x = -INFINITY; } }
                mk[r] = m_; }
            if (j == 0) { v2u w; w.x = mk[0] | (mk[1] << 16); w.y = mk[2] | (mk[3] << 16); *(v2u*)(maskb + (size_t)bh * SEQ + q0 + 16 * t + 4 * g) = w; } }
    }
}
template <int probe> __device__ __forceinline__ void attn_phase(Frame& F, const float* rel_bias) {
    const bf16* Q = (const bf16*)(F.ws + WS_Q); const bf16* Kb = (const bf16*)(F.ws + WS_K); const bf16* Vt = (const bf16*)(F.ws + WS_VT); bf16* O = (bf16*)(F.ws + WS_O);
    const unsigned short* maskb = (const unsigned short*)(F.ws + WS_MASK);
    constexpr int KRS = 144, VRS = 272, KB_ = 128 * KRS, TB = KB_ + 64 * VRS;
    LAS float* tbl = (LAS float*)(F.lds + 2 * TB);
    __syncthreads();
    for (int i = F.tid; i < NH * 129; i += NTHREADS) { const int h = i / 129, d = i % 129; tbl[h * 132 + d] = rel_bias[(int)T5_BUCKET[d] * NH + h] * 1.4426950408889634f; }
    __syncthreads();
    const int qi = F.lane & 15, g = F.lane >> 4; unsigned tcount = 0;
    for (int it = 0;; ++it) {
        int bh, blk;
        if (F.G == 256) { if (it >= 8) break; bh = F.vcu >> 1; blk = (F.vcu & 1) ? ((it & 1) ? 15 - it : it + 1) : ((it & 1) ? 16 - it : it); }
        else { const int L = it * F.G + F.vcu; if (L >= NBATCH * NH * NMB) break; bh = L >> 4; blk = L & 15; }
        const int b = bh >> 4, h = bh & 15;
        const int q0 = blk * MBLK + 32 * F.wave;
        bf16x8 qf[2][2]; unsigned qmask[2];
#pragma unroll
        for (int gp = 0; gp < 2; ++gp) { const int qpos = q0 + 16 * gp + qi; const size_t qrow = (size_t)b * SEQ + qpos; qmask[gp] = maskb[(size_t)bh * SEQ + qpos];
#pragma unroll
            for (int ks = 0; ks < 2; ++ks) qf[gp][ks] = __builtin_nontemporal_load((const bf16x8*)(Q + qrow * D + h * HD + 32 * ks + 8 * g)); }
        const LAS float* tblh = tbl + h * 132; const float bfar = tblh[128];
        float mref[2] = {0.f, 0.f}; f32x4 o[2][5];
#pragma unroll
        for (int gp = 0; gp < 2; ++gp)
#pragma unroll
            for (int dt = 0; dt < 5; ++dt) o[gp][dt] = (f32x4){0.f, 0.f, 0.f, 0.f};
        constexpr float THR = 8.0f;
        const bf16x8 ones = {0x3F80, 0x3F80, 0x3F80, 0x3F80, 0x3F80, 0x3F80, 0x3F80, 0x3F80};
        const int nst = 2 + 2 * blk;
        const int kkey = F.tid >> 3, kch = F.tid & 7;
        const int vd = F.tid >> 3, vch = F.tid & 7;
        const bf16* kbase = Kb + ((size_t)b * SEQ + kkey) * D + h * HD + 8 * kch;
        const bf16* vbase = Vt + (((size_t)bh * HD + vd) << 12) + 8 * vch;
        v4u kreg[2], vreg[2];
        { const int key0 = blk * MBLK; kreg[0] = *(const v4u*)(kbase + (size_t)key0 * D); kreg[1] = *(const v4u*)(kbase + (size_t)(key0 + 64) * D); vreg[0] = *(const v4u*)(vbase + key0); vreg[1] = *(const v4u*)(vbase + key0 + 64); }
        for (int n = 0; n < nst; ++n) {
            int jb, key0; if (n < 2) { jb = blk; key0 = blk * MBLK + 128 * n; } else { const int mm = n - 2; jb = blk - 1 - (mm >> 1); key0 = jb * MBLK + 128 * (mm & 1); }
            LAS unsigned char* buf = F.lds + (tcount & 1u) * TB; ++tcount;
            *(LAS v4u*)(buf + kkey * KRS + kch * 16) = kreg[0]; *(LAS v4u*)(buf + (kkey + 64) * KRS + kch * 16) = kreg[1];
            *(LAS v4u*)(buf + KB_ + vd * VRS + vch * 16) = vreg[0]; *(LAS v4u*)(buf + KB_ + vd * VRS + (vch + 8) * 16) = vreg[1];
            asm volatile("s_waitcnt lgkmcnt(0)" ::: "memory");
            if (n + 1 < nst) { const int n1 = n + 1; int k1; if (n1 < 2) k1 = blk * MBLK + 128 * n1; else { const int mm = n1 - 2; k1 = (blk - 1 - (mm >> 1)) * MBLK + 128 * (mm & 1); }
                kreg[0] = *(const v4u*)(kbase + (size_t)k1 * D); kreg[1] = *(const v4u*)(kbase + (size_t)(k1 + 64) * D); vreg[0] = *(const v4u*)(vbase + k1); vreg[1] = *(const v4u*)(vbase + k1 + 64); }
            asm volatile("s_barrier" ::: "memory");
            const bool own = (jb == blk), nearb = (jb >= blk - 1);
            if (probe == 2) continue;
            if (own && 128 * n > 32 * F.wave + 31) continue;
            f32x4 s[2][8]; bool selb[2];
#pragma unroll
            for (int gp = 0; gp < 2; ++gp) { selb[gp] = (qmask[gp] >> jb) & 1u; const float c0 = (n == 0) ? 0.0f : (nearb ? -mref[gp] : (selb[gp] ? bfar - mref[gp] : -INFINITY));
#pragma unroll
                for (int kt = 0; kt < 8; ++kt) s[gp][kt] = (f32x4){c0, c0, c0, c0}; }
#pragma unroll
            for (int kt = 0; kt < 8; ++kt)
#pragma unroll
                for (int ks = 0; ks < 2; ++ks) { if (probe == 4) break; const bf16x8 a = *(const LAS bf16x8*)(buf + (16 * kt + qi) * KRS + 64 * ks + 16 * g);
                    s[0][kt] = __builtin_amdgcn_mfma_f32_16x16x32_bf16(a, qf[0][ks], s[0][kt], 0, 0, 0); s[1][kt] = __builtin_amdgcn_mfma_f32_16x16x32_bf16(a, qf[1][ks], s[1][kt], 0, 0, 0);
                    }
#pragma unroll
            for (int gp = 0; gp < 2; ++gp) { if (probe == 3) break;
                float mx = -INFINITY;
                if (nearb) {
                    const int qpos = q0 + 16 * gp + qi; const int dist0 = qpos - (key0 + 4 * g);
#pragma unroll
                    for (int kh = 0; kh < 4; ++kh) { float bz[2][4];
#pragma unroll
                        for (int k4 = 0; k4 < 2; ++k4)
#pragma unroll
                            for (int r = 0; r < 4; ++r) { const int dist = dist0 - (16 * (2 * kh + k4) + r); const int dd = dist < 0 ? 0 : (dist > 128 ? 128 : dist); bz[k4][r] = tblh[dd]; }
#pragma unroll
                        for (int k4 = 0; k4 < 2; ++k4) asm volatile("" : "+v"(bz[k4][0]), "+v"(bz[k4][1]), "+v"(bz[k4][2]), "+v"(bz[k4][3]));
#pragma unroll
                        for (int k4 = 0; k4 < 2; ++k4)
#pragma unroll
                            for (int r = 0; r < 4; ++r) { const int kt = 2 * kh + k4; const int dist = dist0 - (16 * kt + r);
                                const bool valid = own ? (dist >= 0) : selb[gp]; const float x = valid ? s[gp][kt][r] + bz[k4][r] : -INFINITY; s[gp][kt][r] = x; mx = __builtin_fmaxf(mx, x); } }
                } else {
#pragma unroll
                    for (int kt = 0; kt < 8; ++kt)
#pragma unroll
                        for (int r = 0; r < 4; ++r) mx = __builtin_fmaxf(mx, s[gp][kt][r]); }
                mx = q4_max(mx);
                if (n == 0) {
                    mref[gp] = mx;
#pragma unroll
                    for (int kt = 0; kt < 8; ++kt)
#pragma unroll
                        for (int r = 0; r < 4; ++r) s[gp][kt][r] -= mx;
                } else if (__any(mx > THR)) {
                    const float dl = __builtin_fmaxf(mx, 0.0f), f = __builtin_amdgcn_exp2f(-dl); mref[gp] += dl;
#pragma unroll
                    for (int kt = 0; kt < 8; ++kt)
#pragma unroll
                        for (int r = 0; r < 4; ++r) s[gp][kt][r] -= dl;
#pragma unroll
                    for (int dt = 0; dt < 5; ++dt) o[gp][dt] = o[gp][dt] * f; }
#pragma unroll
                for (int kt = 0; kt < 8; ++kt)
#pragma unroll
                    for (int r = 0; r < 4; ++r) s[gp][kt][r] = __builtin_amdgcn_exp2f(s[gp][kt][r]);
            }
#pragma unroll
            for (int k2 = 0; k2 < 4; ++k2) { if (probe == 5) break; bf16x8 pb[2][4];
#pragma unroll
                for (int gp = 0; gp < 2; ++gp) { v4u pw; pw.x = cvt_pk_bf16(s[gp][2 * k2][0], s[gp][2 * k2][1]); pw.y = cvt_pk_bf16(s[gp][2 * k2][2], s[gp][2 * k2][3]);
                    pw.z = cvt_pk_bf16(s[gp][2 * k2 + 1][0], s[gp][2 * k2 + 1][1]); pw.w = cvt_pk_bf16(s[gp][2 * k2 + 1][2], s[gp][2 * k2 + 1][3]); pb[gp][k2] = __builtin_bit_cast(bf16x8, pw); }
#pragma unroll
                for (int dt = 0; dt < 4; ++dt) { const LAS unsigned char* vp = buf + KB_ + (16 * dt + qi) * VRS + 64 * k2 + 8 * g; const v2u lo = *(const LAS v2u*)vp, hi = *(const LAS v2u*)(vp + 32);
                    v4u aw; aw.x = lo.x; aw.y = lo.y; aw.z = hi.x; aw.w = hi.y; const bf16x8 av = __builtin_bit_cast(bf16x8, aw);
                    o[0][dt] = __builtin_amdgcn_mfma_f32_16x16x32_bf16(av, pb[0][k2], o[0][dt], 0, 0, 0); o[1][dt] = __builtin_amdgcn_mfma_f32_16x16x32_bf16(av, pb[1][k2], o[1][dt], 0, 0, 0); }
                o[0][4] = __builtin_amdgcn_mfma_f32_16x16x32_bf16(ones, pb[0][k2], o[0][4], 0, 0, 0); o[1][4] = __builtin_amdgcn_mfma_f32_16x16x32_bf16(ones, pb[1][k2], o[1][4], 0, 0, 0); }
        }
#pragma unroll
        for (int gp = 0; gp < 2; ++gp) { const float inv = 1.0f / o[gp][4][0]; const size_t qrow = (size_t)b * SEQ + q0 + 16 * gp + qi;
#pragma unroll
            for (int dt = 0; dt < 4; ++dt) { v2u w; w.x = cvt_pk_bf16(o[gp][dt][0] * inv, o[gp][dt][1] * inv); w.y = cvt_pk_bf16(o[gp][dt][2] * inv, o[gp][dt][3] * inv); *(v2u*)(O + qrow * D + h * HD + 16 * dt + 4 * g) = w; } }
    }
    __syncthreads();
}

constexpr int SC = 32, NCHK = SEQ / SC;
constexpr size_t WS_PT = WS_S + 256 * MiB;
constexpr size_t WS_LT = 48 * MiB;
constexpr size_t WS_QT = WS_S + 576 * MiB;
constexpr size_t WS_YS2 = WS_S;
constexpr int LT_SPLIT = 98; constexpr size_t WS_LT2 = WS_YG + 64 * MiB;
static_assert(WS_LT + (size_t)LT_SPLIT * MiB <= WS_XB && WS_LT2 + (size_t)(NCHK - LT_SPLIT) * MiB <= WS_END && WS_QT + 64 * MiB <= WS_YG, "chunk operator buffers");
__device__ __forceinline__ size_t lt_off(int ck, int bh) { return (ck < LT_SPLIT ? WS_LT + (size_t)ck * MiB : WS_LT2 + (size_t)(ck - LT_SPLIT) * MiB) + (size_t)bh * 8192; }
__device__ __forceinline__ float reduce8(float v) { v = dpp_add<0xB1>(v); v = dpp_add<0x4E>(v); v = dpp_add<0x141>(v); return v; }
template <int KS> __device__ __forceinline__ f32x4 mm_tile(const LAS unsigned char* X, int xs, int m0, const LAS unsigned char* Y, int ys, int n0, f32x4 acc, int qi, int g) {
#pragma unroll
    for (int ks = 0; ks < KS; ++ks) { const bf16x8 a = *(const LAS bf16x8*)(X + (m0 + qi) * xs + 64 * ks + 16 * g), b = *(const LAS bf16x8*)(Y + (n0 + qi) * ys + 64 * ks + 16 * g);
        acc = __builtin_amdgcn_mfma_f32_16x16x32_bf16(a, b, acc, 0, 0, 0); }
    return acc;
}
typedef short v4i16_t_ __attribute__((ext_vector_type(4)));
__device__ __forceinline__ bf16x8 frag_tr(const LAS unsigned char* Z, int zs, int kk0, int c0, int qi, int g) {
    const LAS unsigned char* p = Z + (kk0 + 8 * g + (qi >> 2)) * zs + (c0 + 4 * (qi & 3)) * 2;
    const v4i16_t_ lo = __builtin_amdgcn_ds_read_tr16_b64_v4i16((LAS v4i16_t_*)p), hi = __builtin_amdgcn_ds_read_tr16_b64_v4i16((LAS v4i16_t_*)(p + 4 * zs));
    return (bf16x8){lo[0], lo[1], lo[2], lo[3], hi[0], hi[1], hi[2], hi[3]};
}
template <int KS> __device__ __forceinline__ f32x4 mm_tile_xt(const LAS unsigned char* Z, int zs, int m0, const LAS unsigned char* Y, int ys, int n0, f32x4 acc, int qi, int g) {
#pragma unroll
    for (int ks = 0; ks < KS; ++ks) { const bf16x8 a = frag_tr(Z, zs, 32 * ks, m0, qi, g), b = *(const LAS bf16x8*)(Y + (n0 + qi) * ys + 64 * ks + 16 * g);
        acc = __builtin_amdgcn_mfma_f32_16x16x32_bf16(a, b, acc, 0, 0, 0); }
    return acc;
}
template <int KS> __device__ __forceinline__ f32x4 mm_tile_yt(const LAS unsigned char* X, int xs, int m0, const LAS unsigned char* Z, int zs, int n0, f32x4 acc, int qi, int g) {
#pragma unroll
    for (int ks = 0; ks < KS; ++ks) { const bf16x8 a = *(const LAS bf16x8*)(X + (m0 + qi) * xs + 64 * ks + 16 * g), b = frag_tr(Z, zs, 32 * ks, n0, qi, g);
        acc = __builtin_amdgcn_mfma_f32_16x16x32_bf16(a, b, acc, 0, 0, 0); }
    return acc;
}
__device__ __forceinline__ v2u pack4(const f32x4 v) { v2u w; w.x = cvt_pk_bf16(v[0], v[1]); w.y = cvt_pk_bf16(v[2], v[3]); return w; }
__device__ __forceinline__ void chunk_prep(Frame& F, const bf16* vbuf, const float* k_k, const float* k_a, const bool dry = false) {
    const bf16* rb = (const bf16*)(F.ws + WS_R); const bf16* kb = (const bf16*)(F.ws + WS_KK); const bf16* ab = (const bf16*)(F.ws + WS_A); const bf16* lw = (const bf16*)(F.ws + WS_LW);
    bf16* PTg = (bf16*)(F.ws + WS_PT); bf16* QTg = (bf16*)(F.ws + WS_QT); bf16* LTg = (bf16*)(F.ws + WS_LT); float* ys = (float*)(F.ws + WS_YS2);
    constexpr int RS = 144, TS_ = 80;
    constexpr int O_AT = 0, O_BT = 4608, O_KT = 9216, O_RT = 13824, O_VT = 18432, O_X2T = 23040, O_GT = 28160,
                  O_TM = 33280, O_NRBT = 35840, O_NAK = 38400, O_X1T = 40960, O_HT = 43520, O_NAB = 46080, O_WC = 50688, O_PK = 50944, O_CL = O_X2T;
    const int grp = F.wave >> 2, wg = F.wave & 3;
    LAS unsigned char* L = F.lds + grp * 65536;
    const int gt0 = F.tid & 255, st0 = gt0 >> 3, c80 = gt0 & 7;
    __syncthreads();
    for (int i = gt0; i < D; i += 256) { *(LAS float*)(L + O_PK + i * 4) = k_k[i]; *(LAS float*)(L + O_PK + 4096 + i * 4) = k_a[i]; }
    constexpr int NIT = (NBATCH * NH * NCHK) / (2 * 256);
    v4u pre_r, pre_k, pre_a, pre_v, pre_l;
#define CP_BAR() asm volatile("s_waitcnt lgkmcnt(0)\n\ts_barrier" ::: "memory")
#define CP_LOAD(it_) do { const int item_ = ((it_) * F.G + F.vcu) * 2 + grp, bh_ = item_ >> 7, ck_ = item_ & (NCHK - 1); \
        const size_t o_ = ((size_t)(bh_ >> 4) * SEQ + ck_ * SC + st0) * D + (bh_ & 15) * HD + 8 * c80; \
        pre_r = *(const v4u*)(rb + o_); pre_k = *(const v4u*)(kb + o_); pre_a = *(const v4u*)(ab + o_); pre_v = *(const v4u*)(vbuf + o_); pre_l = __builtin_nontemporal_load((const v4u*)(lw + o_)); } while (0)
    CP_LOAD(0);
    asm volatile("" : "+v"(pre_r), "+v"(pre_k), "+v"(pre_a), "+v"(pre_v), "+v"(pre_l));
    for (int it = 0; it < NIT; ++it) {
        const int item = (it * F.G + F.vcu) * 2 + grp, bh = item >> 7, ck = item & (NCHK - 1), b = bh >> 4, h = bh & 15, t0 = ck * SC;
        const size_t base = ((size_t)b * SEQ + t0) * D + h * HD;
        int lane_i = F.lane; asm volatile("" : "+v"(lane_i));
        const int gt = (wg << 6) | lane_i, qi = lane_i & 15, g = lane_i >> 4, st = gt >> 3, c8 = gt & 7;
        CP_BAR();
        float r8[8], al8[8], be8[8], kh8[8], v8[8];
        { const v4u wr_ = pre_r, wk = pre_k, wa = pre_a, wv = pre_v;
          f32x4 l0 = {bflo(pre_l.x), bfhi(pre_l.x), bflo(pre_l.y), bfhi(pre_l.y)}, l1 = {bflo(pre_l.z), bfhi(pre_l.z), bflo(pre_l.w), bfhi(pre_l.w)};
#pragma unroll
          for (int j = 0; j < 4; ++j) { { const float z = l0[j]; l0[j] = -fast_exp(fminf(z, 0.0f) - __logf(1.0f + fast_exp(-fabsf(z))) - 0.5f); } { const float z = l1[j]; l1[j] = -fast_exp(fminf(z, 0.0f) - __logf(1.0f + fast_exp(-fabsf(z))) - 0.5f); } }
          const f32x4 kk0 = *(const LAS f32x4*)(L + O_PK + (h * HD + 8 * c8) * 4), kk1 = *(const LAS f32x4*)(L + O_PK + (h * HD + 8 * c8 + 4) * 4), ka0 = *(const LAS f32x4*)(L + O_PK + 4096 + (h * HD + 8 * c8) * 4), ka1 = *(const LAS f32x4*)(L + O_PK + 4096 + (h * HD + 8 * c8 + 4) * 4);
          float k8[8], a8[8], kk8[8]; float ss = 0.f;
#pragma unroll
          for (int j = 0; j < 8; ++j) { const unsigned xr = wr_[j >> 1], xk = wk[j >> 1], xa = wa[j >> 1], xv = wv[j >> 1];
              r8[j] = (j & 1) ? bfhi(xr) : bflo(xr); k8[j] = (j & 1) ? bfhi(xk) : bflo(xk); a8[j] = (j & 1) ? bfhi(xa) : bflo(xa); v8[j] = (j & 1) ? bfhi(xv) : bflo(xv);
              kk8[j] = k8[j] * (j < 4 ? kk0[j & 3] : kk1[j & 3]); ss += kk8[j] * kk8[j]; }
          ss = reduce8(ss); const float inv = 1.0f / fmaxf(sqrtf(ss), 1e-12f);
#pragma unroll
          for (int j = 0; j < 8; ++j) { const float kk = kk8[j] * inv; al8[j] = -kk; be8[j] = kk * a8[j]; kh8[j] = k8[j] * (1.0f + (a8[j] - 1.0f) * (j < 4 ? ka0[j & 3] : ka1[j & 3])); }
          *(LAS f32x4*)(L + O_CL + (st * 64 + 8 * c8) * 4) = l0; *(LAS f32x4*)(L + O_CL + (st * 64 + 8 * c8 + 4) * 4) = l1; }
        { const int itn = it + 1 < NIT ? it + 1 : it; CP_LOAD(itn); }
        CP_BAR();
#if DRYCUT == 5
        if (dry) continue;
#endif
        if (gt < 64) { float cv[SC];
#pragma unroll
            for (int t = 0; t < SC; ++t) cv[t] = *(const LAS float*)(L + O_CL + (t * 64 + gt) * 4);
#pragma unroll
            for (int t = 1; t < SC; ++t) cv[t] += cv[t - 1];
#pragma unroll
            for (int t = 0; t < SC; ++t) *(LAS float*)(L + O_CL + (t * 64 + gt) * 4) = cv[t];
            *(LAS float*)(L + O_WC + gt * 4) = fast_exp(cv[SC - 1]); }
        CP_BAR();
#if DRYCUT == 6
        if (dry) continue;
#endif
        { float cl[8], cm[8];
          { const f32x4 c0 = *(const LAS f32x4*)(L + O_CL + (st * 64 + 8 * c8) * 4), c1 = *(const LAS f32x4*)(L + O_CL + (st * 64 + 8 * c8 + 4) * 4);
            f32x4 m0 = {0.f, 0.f, 0.f, 0.f}, m1 = {0.f, 0.f, 0.f, 0.f};
            if (st > 0) { m0 = *(const LAS f32x4*)(L + O_CL + ((st - 1) * 64 + 8 * c8) * 4); m1 = *(const LAS f32x4*)(L + O_CL + ((st - 1) * 64 + 8 * c8 + 4) * 4); }
#pragma unroll
            for (int j = 0; j < 4; ++j) { cl[j] = c0[j]; cl[4 + j] = c1[j]; cm[j] = m0[j]; cm[4 + j] = m1[j]; } }
          float at8[8], bt8[8], kt8[8], rt8[8];
#pragma unroll
          for (int j = 0; j < 8; ++j) { const float e1 = fast_exp(cl[j]), em = fast_exp(cm[j]), en = fast_exp(-cl[j]); at8[j] = al8[j] * em; bt8[j] = be8[j] * en; kt8[j] = kh8[j] * en; rt8[j] = r8[j] * e1; }
          v4u w; w.x = cvt_pk_bf16(at8[0], at8[1]); w.y = cvt_pk_bf16(at8[2], at8[3]); w.z = cvt_pk_bf16(at8[4], at8[5]); w.w = cvt_pk_bf16(at8[6], at8[7]); *(LAS v4u*)(L + O_AT + st * RS + 16 * c8) = w;
          w.x = cvt_pk_bf16(bt8[0], bt8[1]); w.y = cvt_pk_bf16(bt8[2], bt8[3]); w.z = cvt_pk_bf16(bt8[4], bt8[5]); w.w = cvt_pk_bf16(bt8[6], bt8[7]); *(LAS v4u*)(L + O_BT + st * RS + 16 * c8) = w;
          w.x = cvt_pk_bf16(kt8[0], kt8[1]); w.y = cvt_pk_bf16(kt8[2], kt8[3]); w.z = cvt_pk_bf16(kt8[4], kt8[5]); w.w = cvt_pk_bf16(kt8[6], kt8[7]); *(LAS v4u*)(L + O_KT + st * RS + 16 * c8) = w;
          w.x = cvt_pk_bf16(rt8[0], rt8[1]); w.y = cvt_pk_bf16(rt8[2], rt8[3]); w.z = cvt_pk_bf16(rt8[4], rt8[5]); w.w = cvt_pk_bf16(rt8[6], rt8[7]); *(LAS v4u*)(L + O_RT + st * RS + 16 * c8) = w;
          w.x = cvt_pk_bf16(v8[0], v8[1]); w.y = cvt_pk_bf16(v8[2], v8[3]); w.z = cvt_pk_bf16(v8[4], v8[5]); w.w = cvt_pk_bf16(v8[6], v8[7]); *(LAS v4u*)(L + O_VT + st * RS + 16 * c8) = w; }
        CP_BAR();
#if DRYCUT == 1
        if (dry) continue;
#endif
        { const int mt = wg >> 1, nt = wg & 1, n = 16 * nt + qi, m0 = 16 * mt + 4 * g; const f32x4 z = {0.f, 0.f, 0.f, 0.f};
          f32x4 c1 = mm_tile<2>(L + O_AT, RS, 16 * mt, L + O_BT, RS, 16 * nt, z, qi, g);
#pragma unroll
          for (int r = 0; r < 4; ++r) c1[r] = (n < m0 + r) ? c1[r] : 0.f;
          *(LAS f32x4*)(L + O_NAB + n * 144 + m0 * 4) = c1;
          f32x4 c2 = mm_tile<2>(L + O_BT, RS, 16 * mt, L + O_RT, RS, 16 * nt, z, qi, g);
#pragma unroll
          for (int r = 0; r < 4; ++r) c2[r] = (m0 + r <= n) ? c2[r] : 0.f;
          *(LAS v2u*)(L + O_NRBT + n * TS_ + m0 * 2) = pack4(c2);
          f32x4 c3 = mm_tile<2>(L + O_AT, RS, 16 * mt, L + O_KT, RS, 16 * nt, z, qi, g);
#pragma unroll
          for (int r = 0; r < 4; ++r) c3[r] = (n < m0 + r) ? c3[r] : 0.f;
          *(LAS v2u*)(L + O_NAK + n * TS_ + m0 * 2) = pack4(c3); }
        CP_BAR();
#if DRYCUT == 2
        if (dry) continue;
#endif
        if (wg == 0) { const int col = lane_i & 31; float x[SC];
#pragma unroll
            for (int s = SC - 1; s >= 0; --s) { float ac[4] = {(col == s) ? 1.0f : 0.0f, 0.f, 0.f, 0.f};
#pragma unroll
                for (int q4 = SC / 4 - 1; q4 >= (s + 1) >> 2; --q4) { const f32x4 nv = *(const LAS f32x4*)(L + O_NAB + s * 144 + q4 * 16);
#pragma unroll
                    for (int r = 3; r >= 0; --r) { const int t = 4 * q4 + r; if (t > s) ac[r] += nv[r] * x[t]; } }
                x[s] = (ac[0] + ac[1]) + (ac[2] + ac[3]); }
            if (lane_i < 32) {
#pragma unroll
                for (int s = 0; s < SC; ++s) *(LAS bf16*)(L + O_TM + s * TS_ + col * 2) = (bf16)(cvt_pk_bf16(x[s], 0.f) & 0xffffu); } }
        CP_BAR();
#if DRYCUT == 3
        if (dry) continue;
#endif
        { const f32x4 z = {0.f, 0.f, 0.f, 0.f};
          { const int mt = wg >> 1, nt = wg & 1; const f32x4 c = mm_tile<1>(L + O_TM, TS_, 16 * mt, L + O_NRBT, TS_, 16 * nt, z, qi, g); *(LAS v2u*)(L + O_X1T + (16 * nt + qi) * TS_ + (16 * mt + 4 * g) * 2) = pack4(c); }
#pragma unroll
          for (int q = 0; q < 2; ++q) { const int tix = wg * 2 + q, mt = tix >> 2, nt = tix & 3; const f32x4 c = mm_tile_yt<1>(L + O_TM, TS_, 16 * mt, L + O_BT, RS, 16 * nt, z, qi, g);
              *(LAS v2u*)(L + O_X2T + (16 * nt + qi) * TS_ + (16 * mt + 4 * g) * 2) = pack4(c); } }
        CP_BAR();
        asm volatile("" : "+v"(pre_r), "+v"(pre_k), "+v"(pre_a), "+v"(pre_v), "+v"(pre_l));
        { const size_t cid = (size_t)ck * (NBATCH * NH) + bh;
          { const int nt = wg & 1, t = 16 * nt + qi; v2u pk[2];
#pragma unroll
            for (int q = 0; q < 2; ++q) { const int mt = 2 * (wg >> 1) + q; const v2u rw = *(const LAS v2u*)(L + O_RT + t * RS + (16 * mt + 4 * g) * 2);
              f32x4 c = {bflo(rw.x), bfhi(rw.x), bflo(rw.y), bfhi(rw.y)}; c = mm_tile_xt<1>(L + O_AT, RS, 16 * mt, L + O_X1T, TS_, 16 * nt, c, qi, g); pk[q] = pack4(c); }
            v4u w4; w4.x = pk[0].x; w4.y = pk[0].y; w4.z = pk[1].x; w4.w = pk[1].y; *(v4u*)(QTg + (cid * SC + t) * 64 + 32 * (wg >> 1) + 8 * g) = w4; }
          { const int mt = wg >> 1, nt = wg & 1, n = 16 * nt + qi, m0 = 16 * mt + 4 * g; f32x4 c = mm_tile<2>(L + O_KT, RS, 16 * mt, L + O_RT, RS, 16 * nt, (f32x4){0.f, 0.f, 0.f, 0.f}, qi, g);
#pragma unroll
            for (int r = 0; r < 4; ++r) c[r] = (m0 + r <= n) ? c[r] : 0.f;
            c = mm_tile<1>(L + O_NAK, TS_, 16 * mt, L + O_X1T, TS_, 16 * nt, c, qi, g); *(LAS v2u*)(L + O_HT + n * TS_ + m0 * 2) = pack4(c); }
#pragma unroll
          for (int q2 = 0; q2 < 2; ++q2) { const int nt = 2 * (wg >> 1) + q2, k = 16 * nt + qi; const float wc = *(const LAS float*)(L + O_WC + k * 4); v2u pk[2];
#pragma unroll
              for (int q = 0; q < 2; ++q) { const int mt = 2 * (wg & 1) + q, m0 = 16 * mt + 4 * g; f32x4 c = mm_tile_xt<1>(L + O_AT, RS, 16 * mt, L + O_X2T, TS_, 16 * nt, (f32x4){0.f, 0.f, 0.f, 0.f}, qi, g);
#pragma unroll
                  for (int r = 0; r < 4; ++r) c[r] = (c[r] + ((m0 + r == k) ? 1.0f : 0.0f)) * wc;
                  pk[q] = pack4(c); }
              v4u w4; w4.x = pk[0].x; w4.y = pk[0].y; w4.z = pk[1].x; w4.w = pk[1].y; *(v4u*)(PTg + (cid * 64 + k) * 64 + 32 * (wg & 1) + 8 * g) = w4; }
#pragma unroll
          for (int q = 0; q < 2; ++q) { const int tix = wg * 2 + q, mt = tix >> 2, nt = tix & 3, k = 16 * nt + qi, m0 = 16 * mt + 4 * g; f32x4 c;
#pragma unroll
              for (int r = 0; r < 4; ++r) c[r] = bf1(*(const LAS bf16*)(L + O_KT + (m0 + r) * RS + k * 2));
              c = mm_tile<1>(L + O_NAK, TS_, 16 * mt, L + O_X2T, TS_, 16 * nt, c, qi, g); const float wc = *(const LAS float*)(L + O_WC + k * 4);
              *(LAS v2u*)(L + O_GT + k * TS_ + m0 * 2) = pack4(c * wc); } }
        CP_BAR();
#if DRYCUT == 4
        if (dry) continue;
#endif
        { const size_t cid = (size_t)ck * (NBATCH * NH) + bh; const f32x4 z = {0.f, 0.f, 0.f, 0.f};
          { const int mt = wg; v2u pk[4];
#pragma unroll
            for (int nt = 0; nt < 4; ++nt) pk[nt] = pack4(mm_tile_yt<1>(L + O_GT, TS_, 16 * mt, L + O_VT, RS, 16 * nt, z, qi, g));
            bf16* lp = (bf16*)(F.ws + lt_off(ck, bh)) + ((size_t)mt * 64 + lane_i) * 16; v4u w0, w1; w0.x = pk[0].x; w0.y = pk[0].y; w0.z = pk[1].x; w0.w = pk[1].y; w1.x = pk[2].x; w1.y = pk[2].y; w1.z = pk[3].x; w1.w = pk[3].y;
            *(v4u*)lp = w0; *(v4u*)(lp + 8) = w1; }
          { const int mt = wg & 1, vp = wg >> 1; v2u pk[2];
#pragma unroll
            for (int i = 0; i < 2; ++i) pk[i] = pack4(mm_tile_yt<1>(L + O_HT, TS_, 16 * mt, L + O_VT, RS, 16 * (2 * vp + i), z, qi, g));
            v4u w0; w0.x = pk[0].x; w0.y = pk[0].y; w0.z = pk[1].x; w0.w = pk[1].y;
            if (!dry) *(v4u*)((bf16*)(F.ws + WS_YG) + ((cid * 4 + 2 * mt + vp) * 64 + lane_i) * 8) = w0; } }
    }
#undef CP_LOAD
#undef CP_BAR
    __syncthreads();
}
__device__ __forceinline__ void chunk_scan(Frame& F, const bool dry = false) {
    const bf16* PTg = (const bf16*)(F.ws + WS_PT); const bf16* QTg = (const bf16*)(F.ws + WS_QT); const bf16* YLg = (const bf16*)(F.ws + WS_YG); bf16* ys = (bf16*)(F.ws + WS_YS2);
    const int qi = F.lane & 15, g = F.lane >> 4, w = F.wave & 3, ty = w & 1, vy0 = 2 * (w >> 1);
    constexpr int SRS = 144, SBUF = 64 * SRS;
    constexpr int YRS = 68, YBUF = SC * YRS * 4;
    LAS unsigned char* SL = F.lds;
    const int hs = (F.G >= 2 * NBATCH * NH) ? 2 : 1;
    for (int bh = (F.vcu % hs) ? NBATCH * NH : F.vcu / hs; bh < NBATCH * NH; bh += F.G / hs) {
        const int b = bh >> 4, h = bh & 15;
        __syncthreads();
        if (F.wave >= 4) { __syncthreads();
            const int u_ = F.wave - 4, tr_ = 8 * u_ + (F.lane >> 3), vc_ = 8 * (F.lane & 7);
            for (int ck = 0; ck < NCHK; ++ck) { asm volatile("s_barrier" ::: "memory");
                const LAS float* yb_ = (const LAS float*)(SL + 2 * SBUF + (ck & 1) * YBUF) + tr_ * YRS + vc_; const f32x4 a0 = *(const LAS f32x4*)yb_, a1 = *(const LAS f32x4*)(yb_ + 4);
                v4u wv_; wv_.x = cvt_pk_bf16(a0[0], a0[1]); wv_.y = cvt_pk_bf16(a0[2], a0[3]); wv_.z = cvt_pk_bf16(a1[0], a1[1]); wv_.w = cvt_pk_bf16(a1[2], a1[3]);
                bf16* yo_ = ys + ((size_t)b * SEQ + ck * SC + tr_) * D + h * HD + vc_; if (!dry) st_wt(yo_, wv_); }
            continue; }
        unsigned z_ = 0u; asm volatile("" : "+v"(z_));
        for (int i = F.lane; i < 16 * 64 / 8; i += 64) *(LAS v4u*)(SL + (16 * w + (i >> 3)) * SRS + (i & 7) * 16) = (v4u){z_, z_, z_, z_};
        __syncthreads();
        v4u pa0[2], qa0[2], pa1[2], qa1[2], pa2[2], qa2[2], pa3[2], qa3[2]; v2u lt0[4], lt1[4], lt2[4], lt3[4]; v2u yl0[2], yl1[2], yl2[2], yl3[2];
#define CS_LOAD(pa, qa, lt, yl, ck_) do { const size_t cid = (size_t)(ck_) * (NBATCH * NH) + bh; \
        _Pragma("unroll") for (int ks = 0; ks < 2; ++ks) { pa[ks] = __builtin_nontemporal_load((const v4u*)(PTg + (cid * 64 + 16 * w + qi) * 64 + 32 * ks + 8 * g)); qa[ks] = __builtin_nontemporal_load((const v4u*)(QTg + (cid * SC + 16 * ty + qi) * 64 + 32 * ks + 8 * g)); } \
        { const bf16* ltb_ = (const bf16*)(F.ws + lt_off((ck_), bh)) + ((size_t)w * 64 + F.lane) * 16; const v4u l0_ = __builtin_nontemporal_load((const v4u*)ltb_), l1_ = __builtin_nontemporal_load((const v4u*)(ltb_ + 8)); \
          lt[0].x = l0_.x; lt[0].y = l0_.y; lt[1].x = l0_.z; lt[1].y = l0_.w; lt[2].x = l1_.x; lt[2].y = l1_.y; lt[3].x = l1_.z; lt[3].y = l1_.w; } \
        { const v4u y0_ = __builtin_nontemporal_load((const v4u*)(YLg + ((cid * 4 + 2 * ty + (w >> 1)) * 64 + F.lane) * 8)); yl[0].x = y0_.x; yl[0].y = y0_.y; yl[1].x = y0_.z; yl[1].y = y0_.w; } } while (0)
#define CS_STEP(pa, qa, lt, yl, ck_) do { const LAS unsigned char* Sc = SL + ((ck_) & 1) * SBUF; LAS unsigned char* Sn = SL + (((ck_) + 1) & 1) * SBUF; \
        bf16x8 bfr[4][2]; \
        _Pragma("unroll") for (int nt = 0; nt < 4; ++nt) { _Pragma("unroll") for (int ks = 0; ks < 2; ++ks) bfr[nt][ks] = *(const LAS bf16x8*)(Sc + (16 * nt + qi) * SRS + 64 * ks + 16 * g); } \
        f32x4 y_[2]; \
        _Pragma("unroll") for (int i_ = 0; i_ < 2; ++i_) { y_[i_] = (f32x4){bflo(yl[i_].x), bfhi(yl[i_].x), bflo(yl[i_].y), bfhi(yl[i_].y)}; \
            _Pragma("unroll") for (int ks = 0; ks < 2; ++ks) { const bf16x8 by_ = *(const LAS bf16x8*)(Sc + (16 * (vy0 + i_) + qi) * SRS + 64 * ks + 16 * g);     \
                y_[i_] = __builtin_amdgcn_mfma_f32_16x16x32_bf16(__builtin_bit_cast(bf16x8, qa[ks]), by_, y_[i_], 0, 0, 0); } } \
        _Pragma("unroll") for (int nt = 0; nt < 4; ++nt) { f32x4 sn = {bflo(lt[nt].x), bfhi(lt[nt].x), bflo(lt[nt].y), bfhi(lt[nt].y)}; \
            _Pragma("unroll") for (int ks = 0; ks < 2; ++ks) sn = __builtin_amdgcn_mfma_f32_16x16x32_bf16(__builtin_bit_cast(bf16x8, pa[ks]), bfr[nt][ks], sn, 0, 0, 0); \
            *(LAS v2u*)(Sn + (16 * nt + qi) * SRS + (32 * (w >> 1) + 8 * g + 4 * (w & 1)) * 2) = pack4(sn); }       \
        __builtin_amdgcn_sched_barrier(0); \
        { const int ckn_ = (DRYCUT == 7 && dry) ? ((ck_) & 3) : ((ck_) + 4 < NCHK ? (ck_) + 4 : NCHK - 1); CS_LOAD(pa, qa, lt, yl, ckn_); }        \
        __builtin_amdgcn_sched_barrier(0);              \
        { LAS float* yb_ = (LAS float*)(SL + 2 * SBUF + ((ck_) & 1) * YBUF); \
          _Pragma("unroll") for (int i_ = 0; i_ < 2; ++i_) { _Pragma("unroll") for (int r = 0; r < 4; ++r) yb_[(16 * ty + 4 * g + r) * YRS + 16 * (vy0 + i_) + qi] = y_[i_][r]; } } \
        asm volatile("s_waitcnt lgkmcnt(0)\n\ts_barrier" ::: "memory");        \
        __builtin_amdgcn_sched_barrier(0); } while (0)
        CS_LOAD(pa0, qa0, lt0, yl0, 0); CS_LOAD(pa1, qa1, lt1, yl1, 1); CS_LOAD(pa2, qa2, lt2, yl2, 2); CS_LOAD(pa3, qa3, lt3, yl3, 3);
#pragma unroll 4
        for (int ck = 0; ck < NCHK; ck += 4) { CS_STEP(pa0, qa0, lt0, yl0, ck); CS_STEP(pa1, qa1, lt1, yl1, ck + 1); CS_STEP(pa2, qa2, lt2, yl2, ck + 2); CS_STEP(pa3, qa3, lt3, yl3, ck + 3); }
#undef CS_STEP
#undef CS_LOAD
    }
    __syncthreads();
}
__device__ __forceinline__ void post_phase(Frame& F, const bf16* vbuf, const float* k_a, const float* r_k, const float* gn_g, const float* gn_b) {
    const bf16* rb = (const bf16*)(F.ws + WS_R); const bf16* kb = (const bf16*)(F.ws + WS_KK); const bf16* ab = (const bf16*)(F.ws + WS_A); const bf16* gb = (const bf16*)(F.ws + WS_G);
    const bf16* ys = (const bf16*)(F.ws + WS_YS2); bf16* yg = (bf16*)(F.ws + WS_YG);
    f32x4 kav[2][2], rkv[2][2], gg[2][2], gbv[2][2];
#pragma unroll
    for (int jh = 0; jh < 2; ++jh)
#pragma unroll
        for (int q = 0; q < 2; ++q) { const int cc = 512 * jh + 8 * F.lane + 4 * q; kav[jh][q] = *(const f32x4*)(k_a + cc); rkv[jh][q] = *(const f32x4*)(r_k + cc); gg[jh][q] = *(const f32x4*)(gn_g + cc); gbv[jh][q] = *(const f32x4*)(gn_b + cc); }
    for (int row = F.gw; row < T; row += F.NGW) {
        v4u yw_[2]; v4u wr_[2], wk[2], wa[2], wv[2], wg[2];
#pragma unroll
        for (int jh = 0; jh < 2; ++jh) { const size_t o = (size_t)row * D + 512 * jh + 8 * F.lane;
            yw_[jh] = __builtin_nontemporal_load((const v4u*)(ys + o)); wr_[jh] = __builtin_nontemporal_load((const v4u*)(rb + o)); wk[jh] = __builtin_nontemporal_load((const v4u*)(kb + o)); wa[jh] = __builtin_nontemporal_load((const v4u*)(ab + o)); wv[jh] = __builtin_nontemporal_load((const v4u*)(vbuf + o)); wg[jh] = __builtin_nontemporal_load((const v4u*)(gb + o)); }
#pragma unroll
        for (int jh = 0; jh < 2; ++jh) { const size_t o = (size_t)row * D + 512 * jh + 8 * F.lane; v4u w;
            const f32x4 y0 = {bflo(yw_[jh].x), bfhi(yw_[jh].x), bflo(yw_[jh].y), bfhi(yw_[jh].y)}, y1 = {bflo(yw_[jh].z), bfhi(yw_[jh].z), bflo(yw_[jh].w), bfhi(yw_[jh].w)};
            const float mean = reduce8(((y0[0] + y0[1]) + (y0[2] + y0[3])) + ((y1[0] + y1[1]) + (y1[2] + y1[3]))) * (1.0f / HD); const f32x4 dy0 = y0 - mean, dy1 = y1 - mean;
            const float var = reduce8(((dy0[0] * dy0[0] + dy0[1] * dy0[1]) + (dy0[2] * dy0[2] + dy0[3] * dy0[3])) + ((dy1[0] * dy1[0] + dy1[1] * dy1[1]) + (dy1[2] * dy1[2] + dy1[3] * dy1[3]))) * (1.0f / HD);
            const float rstd = 1.0f / sqrtf(var + GN_EPS);
            f32x4 pr[2], v4[2], g4[2];
#pragma unroll
            for (int q = 0; q < 2; ++q) { const unsigned r0 = q ? wr_[jh].z : wr_[jh].x, r1 = q ? wr_[jh].w : wr_[jh].y, k0 = q ? wk[jh].z : wk[jh].x, k1 = q ? wk[jh].w : wk[jh].y, a0 = q ? wa[jh].z : wa[jh].x, a1 = q ? wa[jh].w : wa[jh].y;
                const unsigned v0 = q ? wv[jh].z : wv[jh].x, v1 = q ? wv[jh].w : wv[jh].y, g0 = q ? wg[jh].z : wg[jh].x, g1 = q ? wg[jh].w : wg[jh].y;
                const f32x4 r4 = {bflo(r0), bfhi(r0), bflo(r1), bfhi(r1)}, k4 = {bflo(k0), bfhi(k0), bflo(k1), bfhi(k1)}, a4 = {bflo(a0), bfhi(a0), bflo(a1), bfhi(a1)};
                v4[q] = (f32x4){bflo(v0), bfhi(v0), bflo(v1), bfhi(v1)}; g4[q] = (f32x4){bflo(g0), bfhi(g0), bflo(g1), bfhi(g1)};
                const f32x4 kh = k4 * (1.0f + (a4 - 1.0f) * kav[jh][q]); pr[q] = r4 * kh * rkv[jh][q]; }
            const float rk = reduce8(((pr[0][0] + pr[0][1]) + (pr[0][2] + pr[0][3])) + ((pr[1][0] + pr[1][1]) + (pr[1][2] + pr[1][3])));
            const f32x4 res0 = (dy0 * rstd * gg[jh][0] + gbv[jh][0] + v4[0] * rk) * g4[0], res1 = (dy1 * rstd * gg[jh][1] + gbv[jh][1] + v4[1] * rk) * g4[1];
            w.x = cvt_pk_bf16(res0[0], res0[1]); w.y = cvt_pk_bf16(res0[2], res0[3]); w.z = cvt_pk_bf16(res1[0], res1[1]); w.w = cvt_pk_bf16(res1[2], res1[3]); st_wt(yg + o, w); }
    }
}

__global__ void __launch_bounds__(NTHREADS, 2) fwd_kernel(Args args) {
    extern __shared__ __attribute__((aligned(16))) unsigned char lds_raw[];
    Frame F;
    F.lds = (LAS unsigned char*)lds_raw; F.ws = args.ws; F.out = args.out; F.ctl = (gu32*)(args.ws + WS_CTL);
    F.tid = 0; F.lane = 0; F.wave = __builtin_amdgcn_readfirstlane((int)threadIdx.x >> 6);
    F.G = gridDim.x; { const int bx = blockIdx.x; F.vcu = (F.G % 8 == 0) ? (bx % 8) * (F.G / 8) + bx / 8 : bx; }
    F.gw = F.vcu * NWAVES + F.wave; F.NGW = F.G * NWAVES;
    for (int i = threadIdx.x; i < (LDS_BYTES - MISC_OFF) / 4; i += NTHREADS) ((LAS unsigned*)(F.lds + MISC_OFF))[i] = 0u;
    __syncthreads();
    XcdBarrier bar = xcd_barrier_post((unsigned*)(F.ctl + CW_BAR), (volatile LAS unsigned*)(F.lds + MISC_OFF) + 8);
#if TIMING
    unsigned long long t_last = __builtin_amdgcn_s_memrealtime(), t_acc = 0; int t_class = 3, t_idx = 0;
#define GRID_BAR() do { xcd_barrier(bar); const unsigned long long now_ = __builtin_amdgcn_s_memrealtime(); if (t_class == TIMED_CLASS && ((TIMED_MASK >> t_idx) & 1)) t_acc += now_ - t_last; t_last = now_; ++t_idx; } while (0)
#define T_CLASS(c) do { t_class = (c); t_idx = 0; } while (0)
#else
#define GRID_BAR() xcd_barrier(bar)
#define T_CLASS(c) do { } while (0)
#endif
    if (threadIdx.x < 35) ((LAS unsigned long long*)(F.lds + PTAB_OFF))[threadIdx.x] = (unsigned long long)args.in[threadIdx.x];
    __syncthreads();
#define IN(k) in_ptr(F, (k))
    unsigned char* ws = args.ws;
    MoeTab MT; MT.cnt = (const LAS int*)(F.lds + TAB_OFF); MT.mtpref = MT.cnt + 65; MT.hoff = MT.mtpref + 66;

#if EN_P0
    { Frame P = phase_frame(F);
    cast_phase(P, IN(0));
    for (int j = 0; j < 2; ++j) {
        convert_plain(P, IN(1) + (size_t)j * D * 3 * D, D, 3 * D, (bf16*)(ws + WS_WQKV) + (size_t)j * 3 * D * D, 0);
        convert_plain(P, IN(2) + (size_t)j * D * D, D, D, (bf16*)(ws + WS_WOA) + (size_t)j * D * D, 0);
        for (int s = 0; s < 3; ++s) convert_plain(P, IN(5) + ((size_t)j * 3 + s) * D * D, D, D, (bf16*)(ws + WS_WRKV) + (size_t)j * 3 * D * D, s * D);
        convert_plain(P, IN(22) + (size_t)j * D * D, D, D, (bf16*)(ws + WS_WOB) + (size_t)j * D * D, 0);
        bf16* L1 = (bf16*)(ws + WS_L1) + (size_t)j * 4 * 256 * D; bf16* L2 = (bf16*)(ws + WS_L2) + (size_t)j * 4 * D * 256;
        { const SmallJob w1{IN(7) + (size_t)j * D * 64, D, 64, L1, 256, D}, a1{IN(10) + (size_t)j * D * 64, D, 64, L1 + 256 * D, 256, D}, g1{IN(15) + (size_t)j * D * 160, D, 160, L1 + 2 * 256 * D, 256, D};
          const SmallJob w2{IN(8) + (size_t)j * 64 * D, 64, D, L2, D, 256}, a2{IN(11) + (size_t)j * 64 * D, 64, D, L2 + D * 256, D, 256}, g2{IN(16) + (size_t)j * 160 * D, 160, D, L2 + 2 * D * 256, D, 256};
          const SmallJob v1{IN(13), D, 32, L1 + 3 * 256 * D, 256, D}, v2{IN(14), 32, D, L2 + 3 * D * 256, D, 256};
          convert_small4(P, w1, a1, g1, w2);
          if (j == 1) convert_small4(P, a2, g2, v1, v2); else { convert_small(P, a2.W, a2.K, a2.N, a2.WT, a2.Np, a2.Kp); convert_small(P, g2.W, g2.K, g2.N, g2.WT, g2.Np, g2.Kp); } }
    }
    { const SmallJob r0{IN(23), D, NE, (bf16*)(ws + WS_WR), 256, D}, r1{IN(23) + (size_t)1 * D * NE, D, NE, (bf16*)(ws + WS_WR) + (size_t)1 * 256 * D, 256, D};
      const SmallJob r2{IN(23) + (size_t)2 * D * NE, D, NE, (bf16*)(ws + WS_WR) + (size_t)2 * 256 * D, 256, D}, r3{IN(23) + (size_t)3 * D * NE, D, NE, (bf16*)(ws + WS_WR) + (size_t)3 * 256 * D, 256, D};
      convert_small4(P, r0, r1, r2, r3); }
    }
#endif
    GRID_BAR();

#define PH_BEGIN { Frame P = phase_frame(F);
#define PH_END } GRID_BAR();
    for (int i = 0; i < DEPTH; ++i) {
        const int j = i >> 1;
        if ((i & 1) == 0) { T_CLASS(0);
            PH_BEGIN
#if EN_QKV
              SchedDense S{T / 256, 12, P.G, (int)blockIdx.x, D, (const char*)(ws + WS_XB), (const char*)(ws + WS_WQKV) + (size_t)j * 3 * D * D * 2};
              EpiQKV E{(bf16*)(ws + WS_Q), (bf16*)(ws + WS_K), (bf16*)(ws + WS_VT)};
              _Pragma("nounroll") for (int rep = 0; rep < REP_QKV; ++rep) pg8::gemm_phase<D>(P.lds, P.tid, S, E);
#endif
            PH_END
            PH_BEGIN
#if EN_KMEAN
            kmean_phase(P);
#endif
            PH_END
            PH_BEGIN
#if EN_SEL
            sel_phase(P);
#endif
            PH_END
#if REP_ATTN > 1
            PH_BEGIN
            attn_phase<ATTN_PROBE>(P, IN(3));
            PH_END
#endif
            PH_BEGIN
#if EN_ATTN
            attn_phase<0>(P, IN(3));
#endif
            PH_END
            PH_BEGIN
#if EN_OPA
              SchedDense S{T / 256, 4, P.G, (int)blockIdx.x, D, (const char*)(ws + WS_O), (const char*)(ws + WS_WOA) + (size_t)j * D * D * 2};
              EpiAdd E{(bf16*)P.out, (const bf16*)(ws + WS_XB)};
              pg8::gemm_phase<D>(P.lds, P.tid, S, E);
#endif
            PH_END
        } else {
            T_CLASS(1);
            const size_t voff = (j == 0 ? WS_VF : WS_V);
            PH_BEGIN
#if EN_MIX
            for (int rep = 0; rep < REP_MIX; ++rep) mix_phase(P, IN(4) + (size_t)j * 6 * D);
#endif
            PH_END
            PH_BEGIN
#if EN_RKV
              SchedRkv S{T / 256, j == 0 ? 15 : 16, P.G, (int)blockIdx.x, (const char*)(ws + WS_XMIX), (const char*)(ws + WS_WRKV) + (size_t)j * 3 * D * D * 2, (const char*)(ws + WS_L1) + (size_t)j * 4 * 256 * D * 2};
              EpiRkv E{ws, voff};
              pg8::gemm_phase<D>(P.lds, P.tid, S, E);
#endif
            PH_END
            PH_BEGIN
#if EN_L2
              SchedL2 S{T / 256, j == 0 ? 12 : 16, P.G, (int)blockIdx.x, (const char*)(ws + WS_HL), (const char*)(ws + WS_L2) + (size_t)j * 4 * D * 256 * 2};
              EpiL2 E{(bf16*)(ws + WS_LW), (bf16*)(ws + WS_A), (bf16*)(ws + WS_G), (bf16*)(ws + voff), (const bf16*)(ws + WS_VF), IN(6) + j * D, IN(9) + j * D, IN(12)};
              pg8::gemm_phase<256>(P.lds, P.tid, S, E);
#endif
            PH_END
            PH_BEGIN
#if EN_SCAN
            for (int rep = 0; rep < REP_SCAN; ++rep) chunk_prep(P, (const bf16*)(ws + voff), IN(17) + j * D, IN(18) + j * D, rep + 1 < REP_SCAN);
#endif
            PH_END
            PH_BEGIN
#if EN_SCANB
            _Pragma("nounroll") for (int rep = 0; rep < REP_SCANB; ++rep) chunk_scan(P, rep + 1 < REP_SCANB);
#endif
            PH_END
            PH_BEGIN
#if EN_POST
#ifdef DBG_POST_COPY
            { const v4u* s_ = (const v4u*)(ws + WS_A); v4u* d_ = (v4u*)(ws + WS_YG); for (size_t q = (size_t)P.gw * 64 + P.lane; q < (size_t)T * D / 8; q += (size_t)P.NGW * 64) d_[q] = s_[q]; }
#else
            post_phase(P, (const bf16*)(ws + voff), IN(18) + j * D, IN(19) + j * D, IN(20) + j * D, IN(21) + j * D);
#endif
#endif
            PH_END
            PH_BEGIN
#if EN_OPB
              SchedDense S{T / 256, 4, P.G, (int)blockIdx.x, D, (const char*)(ws + WS_YG), (const char*)(ws + WS_WOB) + (size_t)j * D * D * 2};
              EpiAdd E{(bf16*)P.out, (const bf16*)(ws + WS_XB)};
              pg8::gemm_phase<D>(P.lds, P.tid, S, E);
#endif
            PH_END
        }
        T_CLASS(2);
        PH_BEGIN
#if EN_LN1
        ln1_route_phase(P, IN(31) + i * D, IN(32) + i * D, i, IN(24) + i * NE);
#endif
#if EN_CVT
        for (int rep = 0; rep < REP_CVT; ++rep) convert_moe(P, IN(25) + (size_t)i * NE * D * DE, IN(26) + (size_t)i * NE * D * DE, IN(27) + (size_t)i * NE * DE * D, IN(28) + (size_t)i * D * DE, IN(29) + (size_t)i * D * DE, IN(30) + (size_t)i * DE * D);
#endif
        PH_END
        PH_BEGIN
        moe_tables(P, i);
#if EN_G1
          SchedMoe1 S{P.G, P.vcu, MT, (const char*)(ws + WS_XB), (const char*)(ws + WS_WGU), (const int*)(ws + WS_TOKLIST), 0};
          _Pragma("nounroll") for (int rep = 0; rep < REP_G1; ++rep) { S.eh = 0; EpiSwiglu E{(bf16*)(ws + WS_H), rep + 1 < REP_G1}; pg8::gemm_phase<D>(P.lds, P.tid, S, E); }
#endif
        PH_END
        PH_BEGIN
#if EN_G2
          SchedMoe2 S{P.G, P.vcu, MT, (const char*)(ws + WS_H), (const char*)(ws + WS_WD), 0};
          if (G2_STAGGER > 0 && (P.vcu & 1)) { const unsigned long long t0_ = __builtin_amdgcn_s_memrealtime(); while (__builtin_amdgcn_s_memrealtime() - t0_ < (unsigned long long)G2_STAGGER) __builtin_amdgcn_s_sleep(8); }
          _Pragma("nounroll") for (int rep = 0; rep < REP_G2; ++rep) { S.eh = 0; EpiMoeDown E{ws, rep + 1 < REP_G2, (LAS float*)(P.lds + MISC_OFF + 4096)}; pg8::gemm_phase<DE>(P.lds, P.tid, S, E); }
#endif
        PH_END
        { Frame P = phase_frame(F);
#if EN_LN2
        ln2_phase(P, IN(33) + i * D, IN(34) + i * D, i == DEPTH - 1, MT);
#endif
        }
        if (i + 1 < DEPTH) GRID_BAR();
#if TIMING
        else { const unsigned long long now_ = __builtin_amdgcn_s_memrealtime(); if (t_class == TIMED_CLASS && ((TIMED_MASK >> t_idx) & 1)) t_acc += now_ - t_last; t_last = now_; }
#endif
    }
#if TIMING
    if (blockIdx.x == 0) { const unsigned long long t0_ = __builtin_amdgcn_s_memrealtime(); while (__builtin_amdgcn_s_memrealtime() - t0_ < (unsigned long long)TIMED_MULT * t_acc) __builtin_amdgcn_s_sleep(16); }
#endif
#undef IN
#undef GRID_BAR
}

extern "C" void kernel_launch(void* const* d_in, const int* in_sizes, int n_in, void* d_out, int out_size, void* d_ws, size_t ws_size, hipStream_t stream) {
    static int grid = 0;
    if (grid == 0) {
        if (n_in != 35 || out_size != T * D || ws_size < WS_END) { fprintf(stderr, "kernel_launch: unexpected shapes (n_in %d, out %d, ws %zu)\n", n_in, out_size, ws_size); grid = -1; return; }
        int dev = 0, cus = 0, per_cu = 0;
        if (hipGetDevice(&dev) != hipSuccess || hipDeviceGetAttribute(&cus, hipDeviceAttributeMultiprocessorCount, dev) != hipSuccess) { grid = -1; return; }
        if (hipFuncSetAttribute((const void*)fwd_kernel, hipFuncAttributeMaxDynamicSharedMemorySize, LDS_BYTES) != hipSuccess) { fprintf(stderr, "kernel_launch: hipFuncSetAttribute failed\n"); grid = -1; return; }
        if (hipOccupancyMaxActiveBlocksPerMultiprocessor(&per_cu, (const void*)fwd_kernel, NTHREADS, LDS_BYTES) != hipSuccess || per_cu < 1) { fprintf(stderr, "kernel_launch: occupancy query says %d\n", per_cu); }
        (void)hipGetLastError();
        grid = cus;
    }
    if (grid < 0) return;
    if (hipMemsetAsync((char*)d_ws + WS_CTL, 0, CTL_ZERO_BYTES, stream) != hipSuccess) return;
    Args a{};
    for (int i = 0; i < 35; ++i) a.in[i] = (const float*)d_in[i];
    a.out = (float*)d_out; a.ws = (unsigned char*)d_ws;
    hipLaunchKernelGGL(fwd_kernel, dim3(grid), dim3(NTHREADS), LDS_BYTES, stream, a);
}
```
